# Optimizing an MI355X kernel written in HIP

```python
import math
import jax, jax.numpy as jnp
from jax import lax
import numpy as np

D_MODEL = 1024
BATCH = 8
SEQ = 4096
DEPTH = 4

HG_HEADS = 4
HG_DK = 128
HG_DV = 128
HG_W = HG_HEADS * HG_DV
HG_CHUNK = 64
HG_F_MIN = 1e-6
DA_HEADS = 4
DA_DQK = 64
DA_DV = 2 * DA_DQK
DA_W = DA_HEADS * DA_DV
DA_QBLOCK = 128
MASK_VALUE = -1e30
RW_HEADS = 8
RW_DH = 64
RW_W = RW_HEADS * RW_DH
RW_LORA_W = 64
RW_LORA_A = 64
RW_LORA_G = 128
RW_IN_SIZES = (RW_W, RW_W, RW_W, RW_LORA_W, RW_LORA_A, RW_LORA_G)
RW_IN_W = 1792
RW_GN_EPS = 64e-5
IN_SIZES = (HG_HEADS * HG_DK, HG_HEADS * HG_DK, HG_W, HG_W,
            DA_HEADS * 2 * DA_DQK, DA_HEADS * 2 * DA_DQK, DA_W, RW_IN_W)
IN_W = 5376
N_BRANCH = 3
MIX_W = HG_W + DA_W + RW_W
N_EXPERTS = 16
N_GROUPS = 4
EXPERTS_PER_GROUP = 4
TOP_K = 2
D_EXPERT = 512
ALPHA = (2.0 * DEPTH) ** 0.25
BETA = (8.0 * DEPTH) ** -0.25
LN_EPS = 1e-5
RMS_EPS = 1e-6

kernel_name = "hybrid_hgrn2_diffattn_rwkv7_groupmoe_deepnorm"


def _split_points(sizes):
    return [int(s) for s in np.cumsum(np.asarray(sizes))[:-1]]


def layer_norm(x, g, b):
    xf = x.astype(jnp.float32)
    mu = jnp.mean(xf, axis=-1, keepdims=True)
    var = jnp.mean(jnp.square(xf - mu), axis=-1, keepdims=True)
    return ((xf - mu) * lax.rsqrt(var + LN_EPS) * g.astype(jnp.float32) + b.astype(jnp.float32)).astype(x.dtype)


def rms_norm(x, g):
    xf = x.astype(jnp.float32)
    return xf * lax.rsqrt(jnp.mean(jnp.square(xf), axis=-1, keepdims=True) + RMS_EPS) * g.astype(jnp.float32)


def _token_shift(a):
    return jnp.pad(a, ((0, 0), (1, 0), (0, 0)))[:, :-1]


def _alibi_slopes(n):
    return jnp.asarray([2.0 ** (-8.0 * (h + 1) / n) for h in range(n)], jnp.float32)


def hgrn2_mixer(q, f_pre, i, og, lb, norm_g):
    B, T, _ = q.shape
    n = T // HG_CHUNK
    z = f_pre.astype(jnp.float32)
    lb = lb.astype(jnp.float32)
    f = lb + (1.0 - lb) * jax.nn.sigmoid(z)
    log_f = jnp.log(jnp.maximum(f, HG_F_MIN))
    k = (1.0 - lb) * jax.nn.sigmoid(-z)

    def to_chunks(a, d):
        return a.reshape(B, n, HG_CHUNK, HG_HEADS, d).transpose(1, 0, 3, 2, 4)

    qc = to_chunks(q.astype(jnp.float32), HG_DK)
    kc = to_chunks(k, HG_DK)
    vc = to_chunks(i.astype(jnp.float32), HG_DV)
    gc = to_chunks(log_f, HG_DK)
    causal = jnp.tril(jnp.ones((HG_CHUNK, HG_CHUNK), bool))[:, :, None]

    def step(S, inp):
        qb, kb, vb, gb = inp
        b = jnp.cumsum(gb, axis=2)
        diff = b[:, :, :, None, :] - b[:, :, None, :, :]
        decay = jnp.where(causal, jnp.exp(jnp.minimum(diff, 0.0)), 0.0)
        a = jnp.einsum('bhtk,bhtsk,bhsk->bhts', qb, decay, kb)
        o = jnp.einsum('bhts,bhsv->bhtv', a, vb) + jnp.einsum('bhtk,bhkv->bhtv', qb * jnp.exp(b), S)
        b_last = b[:, :, -1:, :]
        S = jnp.exp(b_last[:, :, 0, :])[..., None] * S + jnp.einsum('bhsk,bhsv->bhkv', kb * jnp.exp(b_last - b), vb)
        return S, o

    S0 = jnp.zeros((B, HG_HEADS, HG_DK, HG_DV), jnp.float32)
    _, o = lax.scan(step, S0, (qc, kc, vc, gc))
    o = o.transpose(1, 0, 3, 2, 4).reshape(B, T, HG_HEADS, HG_DV)
    o = rms_norm(o, norm_g) * jax.nn.silu(og.reshape(B, T, HG_HEADS, HG_DV).astype(jnp.float32))
    return o.reshape(B, T, HG_W).astype(q.dtype)


def diff_attention(q, k, v, lam, lam_init, subln_g):
    B, T, _ = q.shape
    q = q.reshape(B, T, DA_HEADS, 2, DA_DQK).transpose(0, 3, 2, 1, 4) * (DA_DQK ** -0.5)
    k = k.reshape(B, T, DA_HEADS, 2, DA_DQK).transpose(0, 3, 2, 1, 4)
    v = v.reshape(B, T, DA_HEADS, DA_DV).transpose(0, 2, 1, 3)
    slopes = _alibi_slopes(DA_HEADS)
    outs = []
    for blk in range(T // DA_QBLOCK):
        q0, q1 = blk * DA_QBLOCK, (blk + 1) * DA_QBLOCK
        s = jnp.einsum('bmhqd,bmhkd->bmhqk', q[:, :, :, q0:q1], k[:, :, :, :q1]).astype(jnp.float32)
        dist = (jnp.arange(q0, q1)[:, None] - jnp.arange(q1)[None, :]).astype(jnp.float32)
        s = jnp.where(dist >= 0, s - slopes[:, None, None] * dist, MASK_VALUE)
        p = jax.nn.softmax(s, axis=-1)
        p = p[:, 0] - lam * p[:, 1]
        outs.append(jnp.einsum('bhqk,bhkd->bhqd', p.astype(v.dtype), v[:, :, :q1]))
    o = jnp.concatenate(outs, axis=2)
    o = rms_norm(o, subln_g) * (1.0 - lam_init)
    return o.transpose(0, 2, 1, 3).reshape(B, T, DA_W).astype(v.dtype)


def rwkv7_mixer(xs, mu, w0, w_up, a0, a_up, g_up, k_k, k_a, r_k, gn_g, gn_b):
    B, T, _ = xs.shape
    mu, w0, w_up, a0, a_up, g_up, k_k, k_a, r_k, gn_g, gn_b = [
        p.astype(jnp.float32) for p in (mu, w0, w_up, a0, a_up, g_up, k_k, k_a, r_k, gn_g, gn_b)]
    xs = xs.astype(jnp.float32)
    xs = xs + (_token_shift(xs) - xs) * mu
    r, k, v, wd, ad, gd = jnp.split(xs, _split_points(RW_IN_SIZES), axis=-1)
    w_log = -jax.nn.softplus(-(w0 + jnp.tanh(wd) @ w_up)) - 0.5
    decay = jnp.exp(-jnp.exp(w_log))
    a = jax.nn.sigmoid(a0 + ad @ a_up)
    g = jax.nn.sigmoid(gd) @ g_up

    def hd(t):
        return t.reshape(B, T, RW_HEADS, RW_DH)

    kk = hd(k * k_k)
    kk = kk * lax.rsqrt(jnp.maximum(jnp.sum(jnp.square(kk), axis=-1, keepdims=True), 1e-12))
    k = k * (1.0 + (a - 1.0) * k_a)
    r, decay, k, v, a = hd(r), hd(decay), hd(k), hd(v), hd(a)

    def step(S, inp):
        r_t, w_t, k_t, v_t, a_t, b_t = inp
        S = (S * w_t[:, :, None, :]
             + jnp.einsum('bhvk,bhk->bhv', S, a_t)[..., None] * b_t[:, :, None, :]
             + v_t[..., None] * k_t[:, :, None, :])
        return S, jnp.einsum('bhvk,bhk->bhv', S, r_t)

    def tm(t):
        return jnp.swapaxes(t, 0, 1)

    S0 = jnp.zeros((B, RW_HEADS, RW_DH, RW_DH), jnp.float32)
    _, o = lax.scan(step, S0, (tm(r), tm(decay), tm(k), tm(v), tm(-kk), tm(kk * a)))
    o = tm(o)
    m = jnp.mean(o, axis=-1, keepdims=True)
    var = jnp.mean(jnp.square(o - m), axis=-1, keepdims=True)
    o = (o - m) * lax.rsqrt(var + RW_GN_EPS) * gn_g.reshape(RW_HEADS, RW_DH) + gn_b.reshape(RW_HEADS, RW_DH)
    o = o + jnp.sum(r * k * r_k, axis=-1, keepdims=True) * v
    return o.reshape(B, T, RW_W) * g


def hybrid_mixer(u, w_in, hg_lb, hg_norm_g, lam, lam_init, da_subln_g,
                 rw_mu, rw_w0, rw_w_up, rw_a0, rw_a_up, rw_g_up, rw_k_k, rw_k_a, rw_r_k, rw_gn_g, rw_gn_b,
                 w_merge, b_merge, w_branch, w_out):
    hg_q, hg_f, hg_i, hg_og, da_q, da_k, da_v, rw_x = jnp.split(
        jnp.einsum('btd,de->bte', u, w_in), _split_points(IN_SIZES), axis=-1)
    o_hg = hgrn2_mixer(hg_q, hg_f, hg_i, hg_og, hg_lb, hg_norm_g)
    o_da = diff_attention(da_q, da_k, da_v, lam, lam_init, da_subln_g)
    o_rw = rwkv7_mixer(rw_x, rw_mu, rw_w0, rw_w_up, rw_a0, rw_a_up, rw_g_up,
                       rw_k_k, rw_k_a, rw_r_k, rw_gn_g, rw_gn_b)
    wb_hg, wb_da, wb_rw = jnp.split(w_branch, _split_points((HG_W, DA_W, RW_W)), axis=0)
    merged = jnp.zeros_like(u)
    for br, (o, wb) in enumerate(((o_hg, wb_hg), (o_da, wb_da), (o_rw, wb_rw))):
        gate = jax.nn.sigmoid(u @ w_merge[br] + b_merge[br])
        merged = merged + gate * (o.astype(u.dtype) @ wb)
    return merged @ w_out


def grouped_moe(u, w_router, router_bias, w_gate, w_up, w_down):
    B, T, D = u.shape
    t = u.reshape(B * T, D)
    scores = jax.nn.softmax((t @ w_router).astype(jnp.float32), axis=-1)
    sel = scores + router_bias.astype(jnp.float32)
    grp_score = jnp.sum(lax.top_k(sel.reshape(-1, N_GROUPS, EXPERTS_PER_GROUP), TOP_K)[0], axis=-1)
    gmask = jax.nn.one_hot(jnp.argmax(grp_score, axis=-1), N_GROUPS, dtype=jnp.bool_)
    emask = jnp.repeat(gmask, EXPERTS_PER_GROUP, axis=-1)
    _, idx = lax.top_k(jnp.where(emask, sel, MASK_VALUE), TOP_K)
    w = jnp.take_along_axis(scores, idx, axis=-1)
    w = w / jnp.sum(w, axis=-1, keepdims=True)
    combine = jnp.sum(jax.nn.one_hot(idx, N_EXPERTS, dtype=jnp.float32) * w[..., None], axis=1).astype(t.dtype)
    y = jnp.zeros_like(t)
    for e in range(N_EXPERTS):
        h = jax.nn.silu(t @ w_gate[e]) * (t @ w_up[e])
        y = y + combine[:, e:e + 1] * (h @ w_down[e])
    return y.reshape(B, T, D)


def setup_inputs(seed: int = 0) -> dict:
    key = jax.random.key(seed)
    ks = iter(jax.random.split(key, 40))
    L, D = DEPTH, D_MODEL

    def nrm(shape, std):
        return std * jax.random.normal(next(ks), shape, jnp.float32)

    return {
        "x": nrm((BATCH, SEQ, D), 1.0),
        "c": nrm((BATCH, D), 1.0),
        "w_ada": nrm((L, D, 6 * D), 0.5 * D ** -0.5),
        "b_ada": nrm((L, 6 * D), 0.02),
        "w_in": nrm((L, D, IN_W), D ** -0.5),
        "hg_lb_logits": nrm((L, HG_HEADS * HG_DK), 1.0),
        "hg_norm_g": 1.0 + nrm((L, HG_DV), 0.02),
        "da_lambda": nrm((L, 4, DA_DQK), 0.1),
        "da_subln_g": 1.0 + nrm((L, DA_DV), 0.02),
        "rw_mu": jax.random.uniform(next(ks), (L, RW_IN_W), jnp.float32),
        "rw_w0": -1.0 + nrm((L, RW_W), 0.5),
        "rw_w_up": nrm((L, RW_LORA_W, RW_W), 0.1),
        "rw_a0": nrm((L, RW_W), 0.1),
        "rw_a_up": nrm((L, RW_LORA_A, RW_W), RW_LORA_A ** -0.5),
        "rw_g_up": nrm((L, RW_LORA_G, RW_W), RW_LORA_G ** -0.5),
        "rw_k_k": 0.85 + nrm((L, RW_W), 0.02),
        "rw_k_a": 1.0 + nrm((L, RW_W), 0.02),
        "rw_r_k": nrm((L, RW_HEADS, RW_DH), 0.1),
        "rw_gn_g": 1.0 + nrm((L, RW_W), 0.02),
        "rw_gn_b": nrm((L, RW_W), 0.02),
        "w_merge": nrm((L, N_BRANCH, D, D), D ** -0.5),
        "b_merge": nrm((L, N_BRANCH, D), 0.02),
        "w_branch": nrm((L, MIX_W, D), BETA * HG_W ** -0.5),
        "w_out": nrm((L, D, D), BETA * D ** -0.5),
        "ln_g": 1.0 + nrm((L, 2, D), 0.02),
        "ln_b": nrm((L, 2, D), 0.02),
        "w_router": nrm((D, N_EXPERTS), D ** -0.5),
        "router_bias": nrm((N_EXPERTS,), 0.01),
        "w_exp_gate": nrm((L, N_EXPERTS, D, D_EXPERT), D ** -0.5),
        "w_exp_up": nrm((L, N_EXPERTS, D, D_EXPERT), D ** -0.5),
        "w_exp_down": nrm((L, N_EXPERTS, D_EXPERT, D), BETA * D_EXPERT ** -0.5),
    }


def reference(x, c, w_ada, b_ada, w_in, hg_lb_logits, hg_norm_g, da_lambda, da_subln_g,
              rw_mu, rw_w0, rw_w_up, rw_a0, rw_a_up, rw_g_up, rw_k_k, rw_k_a, rw_r_k, rw_gn_g, rw_gn_b,
              w_merge, b_merge, w_branch, w_out, ln_g, ln_b, w_router, router_bias,
              w_exp_gate, w_exp_up, w_exp_down):
    sm = jax.nn.softmax(hg_lb_logits.astype(jnp.float32), axis=0)
    hg_lb = jnp.cumsum(sm, axis=0) - sm[0:1]
    cond = jax.nn.silu(c)
    for l in range(DEPTH):
        mod = (cond @ w_ada[l] + b_ada[l])[:, None, :]
        sh1, sc1, g1, sh2, sc2, g2 = jnp.split(mod, 6, axis=-1)
        lq1, lk1, lq2, lk2 = da_lambda[l].astype(jnp.float32)
        lam_init = 0.8 - 0.6 * math.exp(-0.3 * l)
        lam = jnp.exp(jnp.sum(lq1 * lk1)) - jnp.exp(jnp.sum(lq2 * lk2)) + lam_init
        u = x * (1.0 + sc1) + sh1
        mix = hybrid_mixer(u, w_in[l], hg_lb[l], hg_norm_g[l], lam, lam_init, da_subln_g[l],
                           rw_mu[l], rw_w0[l], rw_w_up[l], rw_a0[l], rw_a_up[l], rw_g_up[l],
                           rw_k_k[l], rw_k_a[l], rw_r_k[l], rw_gn_g[l], rw_gn_b[l],
                           w_merge[l], b_merge[l], w_branch[l], w_out[l])
        x = layer_norm(ALPHA * x + (1.0 + g1) * mix, ln_g[l, 0], ln_b[l, 0])
        u = x * (1.0 + sc2) + sh2
        ffn = grouped_moe(u, w_router, router_bias, w_exp_gate[l], w_exp_up[l], w_exp_down[l])
        x = layer_norm(ALPHA * x + (1.0 + g2) * ffn, ln_g[l, 1], ln_b[l, 1])
    return x
```

```cpp
#include <hip/hip_runtime.h>
#include <hip/hip_bf16.h>
#include <cstdio>
#include <cstdint>

#ifndef MK_PER_PHASE
#define MK_PER_PHASE 1
#endif

#define GAS __attribute__((address_space(1)))
#define LAS __attribute__((address_space(3)))
typedef unsigned short bf16;
typedef unsigned v4u __attribute__((ext_vector_type(4)));
typedef unsigned v2u __attribute__((ext_vector_type(2)));
typedef float f32x4 __attribute__((ext_vector_type(4)));
typedef float f32x2 __attribute__((ext_vector_type(2)));
typedef float f32x16 __attribute__((ext_vector_type(16)));
typedef short bf16x8 __attribute__((ext_vector_type(8)));
typedef short s16x4 __attribute__((ext_vector_type(4)));
typedef GAS unsigned gu32;
#define RLX_AGENT __ATOMIC_RELAXED, __HIP_MEMORY_SCOPE_AGENT
#define LDS_WAIT() asm volatile("s_waitcnt lgkmcnt(0)" ::: "memory")
#define VM_WAIT() asm volatile("s_waitcnt vmcnt(0)" ::: "memory")

constexpr int DM = 1024, NB = 8, T = 4096, NL = 4, M = NB * T;
constexpr int INW = 5376;
constexpr int C_HGQ = 0, C_HGF = 512, C_HGI = 1024, C_HGO = 1536, C_DAQ = 2048, C_DAK = 2560, C_DAV = 3072, C_RW = 3584;
constexpr int C_RWR = C_RW, C_RWK = C_RW + 512, C_RWV = C_RW + 1024, C_RWWD = C_RW + 1536, C_RWAD = C_RW + 1600, C_RWGD = C_RW + 1664;
constexpr int NE = 16, DE = 512;
constexpr float ALPHA = 1.681792830507429f;
constexpr float LN_EPS = 1e-5f, RMS_EPS = 1e-6f, RW_GN_EPS = 64e-5f, HG_F_MIN = 1e-6f;
constexpr float LOG2E = 1.4426950408889634f;
constexpr float C2Q = 0.125f * LOG2E;

constexpr size_t MiB = 1u << 20;
constexpr size_t WS_CTL = 0, CTL_ZERO_BYTES = 1 * MiB;
constexpr size_t WS_MODP = 1 * MiB;
constexpr size_t WS_MOD = 7 * MiB;
constexpr size_t WS_SMALL = 8 * MiB;
constexpr size_t WS_TOK = 9 * MiB;
constexpr size_t WS_LORA = 11 * MiB;
constexpr int UP_ = 1536;
constexpr size_t WS_WA = 12 * MiB;
constexpr size_t WA_IN = 0, WA_MERGE = (size_t)INW * DM * 2, WA_BRANCH = WA_MERGE + (size_t)3 * DM * UP_ * 2, WA_OUT = WA_BRANCH + (size_t)DM * 1536 * 2, WA_END = WA_OUT + (size_t)DM * DM * 2;
constexpr size_t WS_WE = 40 * MiB;
constexpr size_t WE_GU = 0, WE_DT = (size_t)32 * MiB;
constexpr size_t WS_U = 88 * MiB;
constexpr size_t WS_PROJ = 184 * MiB;
constexpr size_t WS_OCAT = 520 * MiB;
constexpr size_t WS_OATT = 616 * MiB;
constexpr size_t WS_END = 680 * MiB;
constexpr size_t WS_GSCR = WS_PROJ;
constexpr size_t WS_MERGED = WS_PROJ + 96 * MiB;
constexpr size_t WS_MIX = WS_PROJ + 160 * MiB;
constexpr size_t WS_AS = WS_PROJ;
constexpr size_t WS_H = WS_PROJ + 224 * MiB;
constexpr size_t WS_Y = WS_OCAT;
constexpr int MAXROWS = 2 * M + NE * 256;
static_assert(WA_END <= 28 * MiB, "WA");
static_assert((size_t)MAXROWS * 2048 <= 160 * MiB && (size_t)MAXROWS * 1024 <= 112 * MiB, "moe buffers");

constexpr int CW_TMO = 0, CW_CODE = 1;
constexpr int CW_BAR = 4096;
constexpr int CW_ECNT = 16384;
constexpr int CW_AQ = 20480;

constexpr int RING_BYTES = 131072;
constexpr int LDSCTL_OFF = RING_BYTES, MISC_OFF = LDSCTL_OFF + 320;
constexpr int LDS_BYTES = 147456;
constexpr int NWAVES = 8, NTHR = 512;

__device__ __forceinline__ unsigned f2bf(float f) { unsigned u = __builtin_bit_cast(unsigned, f); return (u + 0x7fffu + ((u >> 16) & 1u)) >> 16; }
__device__ __forceinline__ unsigned pk2(float lo, float hi) { return f2bf(lo) | (f2bf(hi) << 16); }
__device__ __forceinline__ float bf2f(unsigned short b) { return __builtin_bit_cast(float, ((unsigned)b) << 16); }
__device__ __forceinline__ float bflo(unsigned w) { return __builtin_bit_cast(float, w << 16); }
__device__ __forceinline__ float bfhi(unsigned w) { return __builtin_bit_cast(float, w & 0xffff0000u); }
__device__ __forceinline__ unsigned cvt_pk_bf16(float lo, float hi) { unsigned r; asm volatile("v_cvt_pk_bf16_f32 %0, %1, %2" : "=v"(r) : "v"(lo), "v"(hi)); return r; }
__device__ __forceinline__ float sigmoidf_(float x) { return 1.0f / (1.0f + __expf(-x)); }
__device__ __forceinline__ float wave_sum(float v) {
#pragma unroll
    for (int o = 1; o < 64; o <<= 1) v += __shfl_xor(v, o);
    return v;
}

#define XB_TMO      128
#define XB_XCNT(j)  (256  + 64 * (j))
#define XB_XSUB(j)  (1280 + 64 * (j))
#define XB_XGEN(j)  (2304 + 64 * (j))
#define XB_TOP      3328
#define XB_TOPGEN   3392
#define XCD_BAR_WORDS 3456
#define XB_SPIN_CAP (1u << 20)

__device__ __forceinline__ unsigned xb_ld(unsigned* p)              { return __hip_atomic_load(p, __ATOMIC_RELAXED, __HIP_MEMORY_SCOPE_AGENT); }
__device__ __forceinline__ unsigned xb_add(unsigned* p, unsigned v) { return __hip_atomic_fetch_add(p, v, __ATOMIC_RELAXED, __HIP_MEMORY_SCOPE_AGENT); }
__device__ __forceinline__ unsigned xb_xcc_id() { return (unsigned)__builtin_amdgcn_s_getreg((3 << 11) | 20) & 0xFu; }
#define XB_SPIN(cond, bar) do { unsigned _sp = 0; while (cond) { __builtin_amdgcn_s_sleep(1); \
    if ((++_sp & 255u) == 0u) { if (xb_ld(&(bar)[XB_TMO])) break; if (_sp > XB_SPIN_CAP) { atomicAdd(&(bar)[XB_TMO], 1u); break; } } } } while (0)

struct XcdBarrier { unsigned* bar; unsigned x; volatile LAS unsigned* st; };

__device__ __forceinline__ XcdBarrier xcd_barrier_post(unsigned* bar, volatile LAS unsigned* st) {
    XcdBarrier b; b.bar = bar; b.x = xb_xcc_id(); b.st = st;
    if (threadIdx.x == 0) (void)xb_add(&bar[XB_XCNT(b.x)], 1u);
    return b;
}
__device__ __forceinline__ void xcd_barrier_complete(unsigned* bar, unsigned x, unsigned& nloc, unsigned& nx) {
    const unsigned G = gridDim.x * gridDim.y * gridDim.z;
    unsigned sum, cnt, mine, sp = 0u;
    for (;;) {
        sum = 0u; cnt = 0u; mine = 0u;
#pragma unroll 1
        for (unsigned j = 0; j < 16; ++j) { const unsigned c = xb_ld(&bar[XB_XCNT(j)]); sum += c; cnt += (c > 0u) ? 1u : 0u; mine = (j == x) ? c : mine; }
        if (sum == G) break;
        __builtin_amdgcn_s_sleep(1);
        if ((++sp & 255u) == 0u) { if (xb_ld(&bar[XB_TMO])) break; if (sp > XB_SPIN_CAP) { atomicAdd(&bar[XB_TMO], 1u); break; } }
    }
    nloc = mine > 0u ? mine : 1u; nx = cnt > 0u ? cnt : 1u;
}
__device__ __forceinline__ void xcd_barrier(const XcdBarrier& b) {
    asm volatile("s_waitcnt vmcnt(0)" ::: "memory");
    __syncthreads();
    if (threadIdx.x == 0) {
        unsigned* bar = b.bar;
        __builtin_amdgcn_s_waitcnt(0);
        unsigned nloc = b.st[0], nx = b.st[1];
        if (nloc == 0u) { xcd_barrier_complete(bar, b.x, nloc, nx); b.st[0] = nloc; b.st[1] = nx; }
        const unsigned old = xb_add(&bar[XB_XSUB(b.x)], 1u);
        const unsigned gen = old / nloc;
        if (old + 1u == (gen + 1u) * nloc) {
            __builtin_amdgcn_fence(__ATOMIC_RELEASE, "agent");
            asm volatile("s_waitcnt vmcnt(0)" ::: "memory");
            const unsigned og = xb_add(&bar[XB_TOP], 1u);
            const unsigned tg = og / nx;
            if (og + 1u == (tg + 1u) * nx) xb_add(&bar[XB_TOPGEN], 1u);
            else XB_SPIN(xb_ld(&bar[XB_TOPGEN]) == tg, bar);
            __builtin_amdgcn_fence(__ATOMIC_ACQUIRE, "agent");
            xb_add(&bar[XB_XGEN(b.x)], 1u);
            asm volatile("s_waitcnt vmcnt(0)" ::: "memory");
        } else {
            XB_SPIN(xb_ld(&bar[XB_XGEN(b.x)]) == gen, bar);
            __builtin_amdgcn_fence(__ATOMIC_ACQUIRE, "agent");
            asm volatile("s_waitcnt vmcnt(0)" ::: "memory");
        }
    }
    __syncthreads();
}
namespace pg8 {
#define PG8_LAS __attribute__((address_space(3)))
constexpr int BM = 256, BK = 64, HALF = 128, HTB = HALF * BK * 2, STAGE_BYTES = 8 * HTB, NXCD = 8, WGM = 8;
__host__ __device__ __forceinline__ int lds_byte(int r, int c) { const int st = (r >> 4) * 2 + (c >> 5), rr = r & 15, cc = c & 31, ob = rr * 64 + cc * 2; return st * 1024 + (ob ^ (((ob >> 9) & 1) << 5)); }
__host__ __device__ __forceinline__ void stage_rc(int b, int& R, int& C) { const int st = b / 1024, sb = b % 1024, swz = sb ^ (((sb >> 9) & 1) << 5); R = (st >> 1) * 16 + swz / 64; C = (st & 1) * 32 + (swz % 64) / 2; }
__host__ __device__ __forceinline__ int perm32(int rho) { const int n = rho >> 4, i = rho & 15; return 8 * (i >> 2) + 4 * n + (i & 3); }

struct GUnit {
    int kind;
    int r0, c0;
    int aux;
};
struct GOps {
    const char* A; const char* B; unsigned lda, ldb; int nt;
};
__device__ __forceinline__ bool static_tile(int nM, int nN, int G, int c, int i, int& pm, int& pn) {
    const int nwg = nM * nN; const long L = (long)i * G + c; if (L >= nwg) return false;
    int wgid = (int)L; { const int q = nwg / NXCD, r = nwg % NXCD, xcd = wgid % NXCD, off = wgid / NXCD; wgid = (xcd < r ? xcd * (q + 1) : r * (q + 1) + (xcd - r) * q) + off; }
    const int nig = WGM * nN, gid = wgid / nig, fm = gid * WGM, gsz = (nM - fm) < WGM ? (nM - fm) : WGM;
    pm = fm + ((wgid % nig) % gsz); pn = (wgid % nig) / gsz; return true;
}

template <bool VARLD, class Sched, class Epi>
__device__ __forceinline__ void gemm_phase(PG8_LAS unsigned char* lds, const Sched& S, const Epi& E) {
    int tid_ = threadIdx.x; asm volatile("" : "+v"(tid_));
    const int tid = tid_, wid = __builtin_amdgcn_readfirstlane(tid >> 6), lane = tid & 63, wr = wid >> 2, wc = wid & 3, fr = lane & 15, fq = lane >> 4;
    int R0, C0, R1, C1; stage_rc(tid * 16, R0, C0); stage_rc(tid * 16 + 8192, R1, C1);
    const int Rb0 = (R0 & ~31) + perm32(R0 & 31), Rb1 = (R1 & ~31) + perm32(R1 & 31);
    const unsigned ldsw = (unsigned)wid * 1024u;
    const int aoff = lds_byte(wr * 64 + fr, fq * 8), boff = lds_byte(wc * 32 + fr, fq * 8);
#define PG8_SA(b, h) (((b) * 2 + (h)) * HTB)
#define PG8_SB(b, h) ((4 + (b) * 2 + (h)) * HTB)
#define PG8_STAGE(bufoff, gbase, v0, v1) do { \
        __builtin_amdgcn_global_load_lds((const unsigned*)((const char*)(gbase) + (v0)), (PG8_LAS unsigned*)(lds + (bufoff) + ldsw), 16, 0, 0); \
        __builtin_amdgcn_global_load_lds((const unsigned*)((const char*)(gbase) + (v1)), (PG8_LAS unsigned*)(lds + (bufoff) + ldsw + 8192), 16, 0, 0); } while (0)
#define PG8_LDA(dst, b, h) do { _Pragma("unroll") for (int m = 0; m < 4; ++m) _Pragma("unroll") for (int k = 0; k < 2; ++k) dst[m][k] = *(const PG8_LAS bf16x8*)(lds + PG8_SA(b, h) + aoff + m * 2048 + k * 1024); } while (0)
#define PG8_LDB(dst, b, h) do { _Pragma("unroll") for (int n = 0; n < 2; ++n) _Pragma("unroll") for (int k = 0; k < 2; ++k) dst[n][k] = *(const PG8_LAS bf16x8*)(lds + PG8_SB(b, h) + boff + n * 2048 + k * 1024); } while (0)
#define PG8_MMA(ai, bj, At, Bt) do { __builtin_amdgcn_s_setprio(1); _Pragma("unroll") for (int m = 0; m < 4; ++m) _Pragma("unroll") for (int n = 0; n < 2; ++n) _Pragma("unroll") for (int k = 0; k < 2; ++k) \
        acc[ai][bj][m][n] = __builtin_amdgcn_mfma_f32_16x16x32_bf16(Bt[n][k], At[m][k], acc[ai][bj][m][n], 0, 0, 0); __builtin_amdgcn_s_setprio(0); } while (0)
#define PG8_WAIT_V(n) asm volatile("s_waitcnt vmcnt(" #n ")" ::: "memory")
#define PG8_WAIT_L(n) asm volatile("s_waitcnt lgkmcnt(" #n ")" ::: "memory")
#define PG8_BAR __builtin_amdgcn_s_barrier()
#define PG8_SCHED __builtin_amdgcn_sched_barrier(0)
    GUnit cur, nxt; GOps co, no_; int ui = 0;
    if (!S.next(0, cur, co)) return;
    f32x4 acc[2][2][4][2];
#pragma unroll
    for (int a = 0; a < 2; ++a)
#pragma unroll
        for (int b = 0; b < 2; ++b)
#pragma unroll
            for (int m = 0; m < 4; ++m)
#pragma unroll
                for (int n = 0; n < 2; ++n) acc[a][b][m][n] = (f32x4){0.f, 0.f, 0.f, 0.f};
    bf16x8 At[4][2], B0[2][2], B1[2][2];
    const char* cA = co.A; const char* cB = co.B;
    unsigned ldA = VARLD ? co.lda : Sched::LDA, ldB = VARLD ? co.ldb : Sched::LDB; int nt = (VARLD || Sched::VARNT) ? co.nt : Sched::NT;
    unsigned vA0 = (unsigned)R0 * ldA + (unsigned)C0 * 2u, vA1 = (unsigned)R1 * ldA + (unsigned)C1 * 2u;
    unsigned vB0 = (unsigned)Rb0 * ldB + (unsigned)C0 * 2u, vB1 = (unsigned)Rb1 * ldB + (unsigned)C1 * 2u;
    unsigned hA = (unsigned)HALF * ldA, hB = (unsigned)HALF * ldB;
    PG8_STAGE(PG8_SB(0, 0), cB, vB0, vB1); PG8_STAGE(PG8_SB(0, 1), cB + hB, vB0, vB1); PG8_STAGE(PG8_SA(0, 0), cA, vA0, vA1); PG8_STAGE(PG8_SA(0, 1), cA + hA, vA0, vA1);
    if (wr == 1) PG8_BAR;
    PG8_WAIT_V(2); PG8_BAR;
    PG8_STAGE(PG8_SB(1, 0), cB + 128, vB0, vB1); PG8_STAGE(PG8_SA(1, 0), cA + 128, vA0, vA1); PG8_STAGE(PG8_SB(1, 1), cB + hB + 128, vB0, vB1);
    PG8_WAIT_V(6); PG8_BAR;
    for (;;) {
        const bool has_next = S.next(ui + 1, nxt, no_);
        const char* nA = has_next ? no_.A : cA; const char* nB = has_next ? no_.B : cB;
        const unsigned nlda = (VARLD && has_next) ? no_.lda : ldA, nldb = (VARLD && has_next) ? no_.ldb : ldB;
        const int nnt = ((VARLD || Sched::VARNT) && has_next) ? no_.nt : nt;
        for (int t = 0; t < nt; t += 2) {
            const bool last = (t == nt - 2);
            if (Epi::HAS_MID) { PG8_SCHED; E.mid(acc, cur, t, wr, wc, fr, fq); PG8_SCHED; }
            const char* a1 = cA + (size_t)(t + 1) * 128;
            const char* a2 = last ? nA : cA + (size_t)(t + 2) * 128; const char* b2 = last ? nB : cB + (size_t)(t + 2) * 128;
            const char* a3 = a2 + 128; const char* b3 = b2 + 128;
            unsigned xA0 = vA0, xA1 = vA1, xB0 = vB0, xB1 = vB1, xhA = hA, xhB = hB;
            if (VARLD && last) { xA0 = (unsigned)R0 * nlda + (unsigned)C0 * 2u; xA1 = (unsigned)R1 * nlda + (unsigned)C1 * 2u; xB0 = (unsigned)Rb0 * nldb + (unsigned)C0 * 2u; xB1 = (unsigned)Rb1 * nldb + (unsigned)C1 * 2u; xhA = (unsigned)HALF * nlda; xhB = (unsigned)HALF * nldb; }
            PG8_LDB(B0, 0, 0); PG8_LDB(B1, 0, 1); PG8_SCHED; PG8_LDA(At, 0, 0); PG8_STAGE(PG8_SA(1, 1), a1 + hA, vA0, vA1);
            PG8_WAIT_V(8); PG8_WAIT_L(0); PG8_BAR; PG8_MMA(0, 0, At, B0); PG8_MMA(0, 1, At, B1); PG8_BAR; PG8_SCHED;
            PG8_LDA(At, 0, 1); PG8_STAGE(PG8_SB(0, 0), b2, xB0, xB1); PG8_STAGE(PG8_SB(0, 1), b2 + xhB, xB0, xB1); PG8_STAGE(PG8_SA(0, 0), a2, xA0, xA1);
            PG8_WAIT_V(8); PG8_WAIT_L(0); PG8_BAR; PG8_MMA(1, 0, At, B0); PG8_MMA(1, 1, At, B1); PG8_BAR; PG8_SCHED;
            PG8_LDB(B0, 1, 0); PG8_LDB(B1, 1, 1); PG8_SCHED; PG8_LDA(At, 1, 0); PG8_STAGE(PG8_SA(0, 1), a2 + xhA, xA0, xA1);
            PG8_WAIT_V(8); PG8_WAIT_L(0); PG8_BAR; PG8_MMA(0, 0, At, B0); PG8_MMA(0, 1, At, B1); PG8_BAR; PG8_SCHED;
            PG8_LDA(At, 1, 1); PG8_STAGE(PG8_SB(1, 0), b3, xB0, xB1); PG8_STAGE(PG8_SB(1, 1), b3 + xhB, xB0, xB1); PG8_STAGE(PG8_SA(1, 0), a3, xA0, xA1);
            PG8_WAIT_V(8); PG8_WAIT_L(0); PG8_BAR; PG8_MMA(1, 0, At, B0); PG8_MMA(1, 1, At, B1); PG8_BAR; PG8_SCHED;
        }
        if (wr == 0) PG8_BAR;
        PG8_SCHED; E(acc, cur, wr, wc, fr, fq); PG8_SCHED;
        if (!has_next) break;
#pragma unroll
        for (int a = 0; a < 2; ++a)
#pragma unroll
            for (int b = 0; b < 2; ++b)
#pragma unroll
                for (int m = 0; m < 4; ++m)
#pragma unroll
                    for (int n = 0; n < 2; ++n) acc[a][b][m][n] = (f32x4){0.f, 0.f, 0.f, 0.f};
        cur = nxt; cA = nA; cB = nB; ++ui;
        if (VARLD || Sched::VARNT) nt = nnt;
        if (VARLD) { ldA = nlda; ldB = nldb; vA0 = (unsigned)R0 * ldA + (unsigned)C0 * 2u; vA1 = (unsigned)R1 * ldA + (unsigned)C1 * 2u; vB0 = (unsigned)Rb0 * ldB + (unsigned)C0 * 2u; vB1 = (unsigned)Rb1 * ldB + (unsigned)C1 * 2u; hA = (unsigned)HALF * ldA; hB = (unsigned)HALF * ldB; }
        if (wr == 1) PG8_BAR;
    }
    PG8_WAIT_V(0);
    PG8_BAR;
#undef PG8_SA
#undef PG8_SB
#undef PG8_STAGE
#undef PG8_LDA
#undef PG8_LDB
#undef PG8_MMA
#undef PG8_WAIT_V
#undef PG8_WAIT_L
#undef PG8_BAR
#undef PG8_SCHED
}

template <int KM> struct Epi {
    static constexpr bool HAS_MID = (KM & 4) != 0;
    bf16* O; int ldc;
    float scale;
    const float* bias;
    v4u* gscr;
    __device__ __forceinline__ void mid(f32x4 (&acc)[2][2][4][2], const GUnit& u, int t, int wr, int wc, int fr, int fq) const {
        if (!(KM & 4) || u.kind != 2 || (t != 8 && t != 16)) return;
        const int sa = (t == 8) ? 0 : 1;
        const v4u* ga = gscr + ((size_t)sa * 512 + ((wr * 4 + wc) * 64 + fq * 16 + fr)) * 16; asm volatile("" : "+v"(ga)); const v4u* gb = ga + 16 * 512; asm volatile("" : "+v"(gb));
#pragma unroll
        for (int ai = 0; ai < 2; ++ai)
#pragma unroll
            for (int m = 0; m < 4; ++m) {
#pragma unroll
                for (int bj = 0; bj < 2; ++bj) { const int q = (ai * 4 + m) * 2 + bj; const v4u x = ga[q], y = gb[q];
                    f32x4 r0, r1;
                    r0[0] = bflo(x.x) * __builtin_amdgcn_rcpf(bflo(y.x)); r0[1] = bfhi(x.x) * __builtin_amdgcn_rcpf(bfhi(y.x)); r0[2] = bflo(x.y) * __builtin_amdgcn_rcpf(bflo(y.y)); r0[3] = bfhi(x.y) * __builtin_amdgcn_rcpf(bfhi(y.y));
                    r1[0] = bflo(x.z) * __builtin_amdgcn_rcpf(bflo(y.z)); r1[1] = bfhi(x.z) * __builtin_amdgcn_rcpf(bfhi(y.z)); r1[2] = bflo(x.w) * __builtin_amdgcn_rcpf(bflo(y.w)); r1[3] = bfhi(x.w) * __builtin_amdgcn_rcpf(bfhi(y.w));
                    acc[ai][bj][m][0] *= r0; acc[ai][bj][m][1] *= r1; }
                asm volatile("" ::: "memory"); }
    }
    __device__ __forceinline__ void operator()(f32x4 (&acc)[2][2][4][2], const GUnit& u, int wr, int wc, int fr, int fq) const {
        if ((KM & 1) && u.kind == 0) {
            const float sc = u.aux ? scale : 1.0f;
            const int row0 = u.r0 + wr * 64 + fr, col0 = u.c0 + wc * 32 + 8 * fq;
#pragma unroll
            for (int ai = 0; ai < 2; ++ai)
#pragma unroll
                for (int m = 0; m < 4; ++m) { bf16* rowp = O + (size_t)(row0 + ai * HALF + m * 16) * ldc + col0;
#pragma unroll
                    for (int bj = 0; bj < 2; ++bj) { const f32x4 v0 = acc[ai][bj][m][0] * sc, v1 = acc[ai][bj][m][1] * sc;
                        v4u w; w.x = cvt_pk_bf16(v0[0], v0[1]); w.y = cvt_pk_bf16(v0[2], v0[3]); w.z = cvt_pk_bf16(v1[0], v1[1]); w.w = cvt_pk_bf16(v1[2], v1[3]);
                        *(v4u*)(rowp + bj * HALF) = w; } }
        } else if ((KM & 2) && u.kind == 1) {
            const int bcol0 = u.c0 + wc * 32 + 8 * fq; const float* bp = bias + u.aux * 1024 + bcol0;
            v4u* gs = gscr + ((size_t)u.aux * 512 + ((wr * 4 + wc) * 64 + fq * 16 + fr)) * 16; asm volatile("" : "+v"(gs));
#pragma unroll
            for (int bj = 0; bj < 2; ++bj) { const f32x4 b0 = *(const f32x4*)(bp + bj * HALF), b1 = *(const f32x4*)(bp + bj * HALF + 4);
#pragma unroll
                for (int ai = 0; ai < 2; ++ai)
#pragma unroll
                    for (int m = 0; m < 4; ++m) { const f32x4 z0 = acc[ai][bj][m][0] + b0, z1 = acc[ai][bj][m][1] + b1; float g[8];
#pragma unroll
                        for (int j = 0; j < 4; ++j) { g[j] = fmaxf(sigmoidf_(z0[j]), 1e-30f); g[4 + j] = fmaxf(sigmoidf_(z1[j]), 1e-30f); }
                        v4u w; w.x = cvt_pk_bf16(g[0], g[1]); w.y = cvt_pk_bf16(g[2], g[3]); w.z = cvt_pk_bf16(g[4], g[5]); w.w = cvt_pk_bf16(g[6], g[7]);
                        gs[(ai * 4 + m) * 2 + bj] = w; } }
        } else if ((KM & 4) && u.kind == 2) {
            const v4u* gc = gscr + ((size_t)2 * 512 + ((wr * 4 + wc) * 64 + fq * 16 + fr)) * 16; asm volatile("" : "+v"(gc));
            const int row0 = u.r0 + wr * 64 + fr, col0 = u.c0 + wc * 32 + 8 * fq;
#pragma unroll
            for (int ai = 0; ai < 2; ++ai)
#pragma unroll
                for (int m = 0; m < 4; ++m) { bf16* rowp = O + (size_t)(row0 + ai * HALF + m * 16) * ldc + col0;
#pragma unroll
                    for (int bj = 0; bj < 2; ++bj) { const v4u y = gc[(ai * 4 + m) * 2 + bj]; const f32x4 a0 = acc[ai][bj][m][0], a1 = acc[ai][bj][m][1];
                        v4u w; w.x = cvt_pk_bf16(a0[0] * bflo(y.x), a0[1] * bfhi(y.x)); w.y = cvt_pk_bf16(a0[2] * bflo(y.y), a0[3] * bfhi(y.y));
                        w.z = cvt_pk_bf16(a1[0] * bflo(y.z), a1[1] * bfhi(y.z)); w.w = cvt_pk_bf16(a1[2] * bflo(y.w), a1[3] * bfhi(y.w));
                        *(v4u*)(rowp + bj * HALF) = w; }
                    asm volatile("" ::: "memory"); }
        } else if (KM & 8) {
            const int row0 = u.r0 + wr * 64 + fr, col0 = u.c0 + wc * 32 + 8 * fq;
#pragma unroll
            for (int ai = 0; ai < 2; ++ai)
#pragma unroll
                for (int m = 0; m < 4; ++m) { bf16* rowp = O + (size_t)(row0 + ai * HALF + m * 16) * ldc + col0; float hv[8];
#pragma unroll
                    for (int n = 0; n < 2; ++n)
#pragma unroll
                        for (int j = 0; j < 4; ++j) { const float gt = acc[ai][0][m][n][j], up = acc[ai][1][m][n][j]; hv[n * 4 + j] = gt * sigmoidf_(gt) * up; }
                    v4u w; w.x = cvt_pk_bf16(hv[0], hv[1]); w.y = cvt_pk_bf16(hv[2], hv[3]); w.z = cvt_pk_bf16(hv[4], hv[5]); w.w = cvt_pk_bf16(hv[6], hv[7]);
                    *(v4u*)rowp = w; }
        }
    }
};
}
namespace attn_body {
using bf16=__hip_bfloat16;
using bf16x8=__attribute__((ext_vector_type(8)))short;
using s16x4=__attribute__((ext_vector_type(4)))short;
using f32x16=__attribute__((ext_vector_type(16)))float;
using u32x4=__attribute__((ext_vector_type(4)))unsigned;
constexpr int SEQ=4096,D=64,PQ=5376,PO=1024;
constexpr int NW=8,QBLK=32,QB=QBLK*NW,KVBLK=64,NQB=SEQ/QB;
constexpr int ATTN_UNIT_ROWS=QB;
__device__ __forceinline__ int crow(int r,int hi){return (r&3)+8*(r>>2)+4*hi;}
#define SBAR() __builtin_amdgcn_sched_barrier(0)
__device__ __forceinline__ void cmask(f32x16&p0,f32x16&p1,int jb,int qrel,int hi){
  const float NEG=-INFINITY; int kb=64*jb+4*hi;
  #pragma unroll
  for(int r=0;r<16;++r){int kv=kb+(r&3)+8*(r>>2); if(kv>qrel)p0[r]=NEG; if(kv+32>qrel)p1[r]=NEG;}
}

constexpr int NSLOT=3, SLOTB=8192;
constexpr int LDS_K=0, LDS_V=NSLOT*SLOTB, LDS_WS=2*NSLOT*SLOTB, LDS_OST=LDS_WS+NW*64*4, LDS_BYTES=LDS_OST+NW*4096;
constexpr float C2=0.125f*1.4426950408889634f;
__device__ __forceinline__ void glds16(const void*gsrc,unsigned lds_dst){unsigned keep;
  asm volatile("s_mov_b32 %0, m0\n\ts_mov_b32 m0, %2\n\ts_nop 0\n\tglobal_load_lds_dwordx4 %1, off\n\ts_mov_b32 m0, %0":"=&s"(keep):"v"(gsrc),"s"(lds_dst):"memory");}
__device__ __forceinline__ float max3f(float a,float b,float c){float r;asm("v_max3_f32 %0, %1, %2, %3":"=v"(r):"v"(a),"v"(b),"v"(c));return r;}
__device__ __forceinline__ float max2f(float a,float b){float r;asm("v_max_f32_e32 %0, %1, %2":"=v"(r):"v"(a),"v"(b));return r;}
__device__ __forceinline__ float fadd_s(float a,float b){float r;asm("v_add_f32_e32 %0, %1, %2":"=v"(r):"v"(a),"v"(b));return r;}
__device__ __forceinline__ float fsub_s(float a,float b){float r;asm("v_sub_f32_e32 %0, %1, %2":"=v"(r):"v"(a),"v"(b));return r;}
typedef float f32x2_t __attribute__((ext_vector_type(2))); typedef __bf16 bf16x2_t __attribute__((ext_vector_type(2)));
__device__ __forceinline__ unsigned cvtpk_s(float lo,float hi){f32x2_t v={lo,hi};bf16x2_t b=__builtin_convertvector(v,bf16x2_t);return __builtin_bit_cast(unsigned,b);}
#define WAIT_BAR(N) asm volatile("s_waitcnt vmcnt(" #N ") lgkmcnt(0)\n\ts_barrier":::"memory")

__device__ __forceinline__ void qkt(f32x16&p0,f32x16&p1,const char*Kslot,const bf16x8*qr,int r32,int hi){ const f32x16 negm=f32x16{};
  const char*kb=Kslot+hi*1024+r32*16;
  #pragma unroll
  for(int d0=0;d0<4;++d0){
    const bf16x8 b0=*reinterpret_cast<const bf16x8*>(kb+d0*2048);
    const bf16x8 b1=*reinterpret_cast<const bf16x8*>(kb+d0*2048+512);
    if(d0==0){p0=__builtin_amdgcn_mfma_f32_32x32x16_bf16(b0,qr[0],negm,0,0,0);p1=__builtin_amdgcn_mfma_f32_32x32x16_bf16(b1,qr[0],negm,0,0,0);}
    else{p0=__builtin_amdgcn_mfma_f32_32x32x16_bf16(b0,qr[d0],p0,0,0,0);p1=__builtin_amdgcn_mfma_f32_32x32x16_bf16(b1,qr[d0],p1,0,0,0);}}
}
typedef __attribute__((address_space(3))) const char* lds_cptr;
typedef short v4i16_t __attribute__((ext_vector_type(4)));
__device__ __forceinline__ void kload8(bf16x8*kf,lds_cptr kp){
  kf[0]=*(const __attribute__((address_space(3))) bf16x8*)(kp);      kf[1]=*(const __attribute__((address_space(3))) bf16x8*)(kp+512);
  kf[2]=*(const __attribute__((address_space(3))) bf16x8*)(kp+2048); kf[3]=*(const __attribute__((address_space(3))) bf16x8*)(kp+2560);
  kf[4]=*(const __attribute__((address_space(3))) bf16x8*)(kp+4096); kf[5]=*(const __attribute__((address_space(3))) bf16x8*)(kp+4608);
  kf[6]=*(const __attribute__((address_space(3))) bf16x8*)(kp+6144); kf[7]=*(const __attribute__((address_space(3))) bf16x8*)(kp+6656);
}
__device__ __forceinline__ void kload2(bf16x8*kf,lds_cptr kp,int j){ kf[2*j]=*(const __attribute__((address_space(3))) bf16x8*)(kp+j*2048); kf[2*j+1]=*(const __attribute__((address_space(3))) bf16x8*)(kp+j*2048+512); }
__device__ __forceinline__ s16x4 vtr(lds_cptr p){ return __builtin_bit_cast(s16x4,__builtin_amdgcn_ds_read_tr16_b64_v4i16((__attribute__((address_space(3))) v4i16_t*)p)); }
__device__ __forceinline__ float rowmax(const f32x16&p0,const f32x16&p1){
  float a=max3f(p0[0],p0[1],p1[0]),b=max3f(p0[2],p0[3],p1[1]);a=max3f(a,p1[2],p1[3]);
  #pragma unroll
  for(int r=4;r<16;r+=4){a=max3f(a,p0[r],p0[r+1]);b=max3f(b,p0[r+2],p0[r+3]);a=max3f(a,p1[r],p1[r+1]);b=max3f(b,p1[r+2],p1[r+3]);}
  const float m=max2f(a,b);
  auto rr=__builtin_amdgcn_permlane32_swap(__float_as_uint(m),__float_as_uint(m),false,false);
  return max2f(__uint_as_float(rr[0]),__uint_as_float(rr[1]));
}
__device__ __forceinline__ void pv(f32x16*o,int vb,bf16x8 pa0,bf16x8 pa1,bf16x8 pa2,bf16x8 pa3){
  #pragma unroll
  for(int d0=0;d0<2;++d0){s16x4 lo[4],hi[4];
    #pragma unroll
    for(int ks=0;ks<4;++ks){
      asm volatile("ds_read_b64_tr_b16 %0,%1 offset:%c2":"=&v"(lo[ks]):"v"(vb),"i"(d0*4096+ks*1024):"memory");
      asm volatile("ds_read_b64_tr_b16 %0,%1 offset:%c2":"=&v"(hi[ks]):"v"(vb),"i"(d0*4096+ks*1024+512):"memory");}
    asm volatile("s_waitcnt lgkmcnt(0)":::"memory");SBAR();
    #define PK(k) (bf16x8){lo[k][0],lo[k][1],lo[k][2],lo[k][3],hi[k][0],hi[k][1],hi[k][2],hi[k][3]}
    o[d0]=__builtin_amdgcn_mfma_f32_32x32x16_bf16(pa0,PK(0),o[d0],0,0,0);
    o[d0]=__builtin_amdgcn_mfma_f32_32x32x16_bf16(pa1,PK(1),o[d0],0,0,0);
    o[d0]=__builtin_amdgcn_mfma_f32_32x32x16_bf16(pa2,PK(2),o[d0],0,0,0);
    o[d0]=__builtin_amdgcn_mfma_f32_32x32x16_bf16(pa3,PK(3),o[d0],0,0,0);
    #undef PK
  }
}

#ifndef ATTN_STORE16
#define ATTN_STORE16(p,v) (*(u32x4*)(p)=(v))
#endif
template<int THRL> __device__ __forceinline__ void attn_unit(int b,int qcol,int kcol,int vcol,int ocol,float slope2,int qb,const bf16*__restrict__ P,bf16*O,char*shm){
  int tid_=threadIdx.x; asm volatile("":"+v"(tid_));
  const int tid=tid_,lane=tid&63,r32=lane&31,hi=lane>>5; const int wid=__builtin_amdgcn_readfirstlane(tid>>6);
  const long rowbase=(long)b*SEQ; const int q0=qb*QB;
  const bf16*Qw=P+(rowbase+q0+wid*QBLK)*PQ+qcol;
  const bf16*Kh=P+rowbase*PQ+kcol,*Vh=P+rowbase*PQ+vcol;
  const unsigned lds0=(unsigned)(uintptr_t)shm;
  float*wsf=(float*)(shm+LDS_WS)+wid*64;
  const bf16*ksrc=Kh+(long)lane*PQ+wid*8;
  const bf16*vsrc=Vh+(long)(16*(wid&3)+(lane>>2))*PQ+(wid>>2)*32+(lane&3)*8;
  const unsigned kdst=lds0+LDS_K+wid*1024, vdst=lds0+LDS_V+wid*1024;
  #define DMA_K(t,slot) glds16(ksrc+(long)(t)*KVBLK*PQ,(unsigned)__builtin_amdgcn_readfirstlane(kdst+(slot)))
  #define DMA_V(t,slot) glds16(vsrc+(long)(t)*KVBLK*PQ,(unsigned)__builtin_amdgcn_readfirstlane(vdst+(slot)))
  const int vb0=(int)(lds0+LDS_V)+((lane>>4)&1)*32+(lane&3)*8+(4*hi+((lane&15)>>2))*64;
  const char*Kbase=shm+LDS_K; bf16x8 kf[8];
  const lds_cptr shm3=(lds_cptr)shm; const lds_cptr kp0=shm3+LDS_K+hi*1024+r32*16; const lds_cptr vp0=shm3+LDS_V+((lane>>4)&1)*32+(lane&3)*8+(4*hi+((lane&15)>>2))*64;
  const int NT=(q0+QB)/KVBLK;
  DMA_K(0,0);DMA_V(0,0);DMA_K(1,SLOTB);
  bf16x8 qr[4];
  #pragma unroll
  for(int d0=0;d0<4;++d0)qr[d0]=*reinterpret_cast<const bf16x8*>(&Qw[(long)r32*PQ+d0*16+hi*8]);
  float mhat=0.f,l_reg=0.f;f32x16 o[2];o[0]=f32x16{};o[1]=f32x16{};const f32x16 negm=f32x16{};
  const float sr1_=__builtin_bit_cast(float,__builtin_amdgcn_readfirstlane(__builtin_bit_cast(int,slope2))), sr2_=__builtin_bit_cast(float,__builtin_amdgcn_readfirstlane(__builtin_bit_cast(int,2.f*slope2))), sr3_=__builtin_bit_cast(float,__builtin_amdgcn_readfirstlane(__builtin_bit_cast(int,3.f*slope2)));
  const float hib=slope2*(float)(4*hi);
  #define ALIBI(P0,P1,t) do{ const float tm0_=slope2*(float)(64*(t))+hib-mhat; \
    _Pragma("unroll") for(int q_=0;q_<4;++q_){ const float a_=tm0_+(8.f*slope2)*(float)q_, b_=a_+32.f*slope2; \
      P0[4*q_]+=a_; P0[4*q_+1]=(P0[4*q_+1]+a_)+sr1_; P0[4*q_+2]=(P0[4*q_+2]+a_)+sr2_; P0[4*q_+3]=(P0[4*q_+3]+a_)+sr3_; \
      P1[4*q_]+=b_; P1[4*q_+1]=(P1[4*q_+1]+b_)+sr1_; P1[4*q_+2]=(P1[4*q_+2]+b_)+sr2_; P1[4*q_+3]=(P1[4*q_+3]+b_)+sr3_; } }while(0)
  const int qrel=wid*QBLK+r32;
  #define CMASK(P0,P1,t) do{int jb_=(t)-(NT-4); if(jb_>=0)cmask(P0,P1,jb_,qrel,hi);}while(0)
  bool resc=false;
  #define START(P0,P1) do{ const float rm=rowmax(P0,P1); resc=false; \
    { const float dl=rm; mhat=fadd_s(mhat,dl); \
      _Pragma("unroll") for(int r=0;r<16;++r){P0[r]=fsub_s(P0[r],dl);P1[r]=fsub_s(P1[r],dl);} \
      } \
    _Pragma("unroll") for(int r=0;r<16;++r)P0[r]=__builtin_amdgcn_exp2f(P0[r]); }while(0)
  #define RESC() do{ if(resc){ asm volatile("s_waitcnt lgkmcnt(0)":::"memory"); \
      _Pragma("unroll") for(int d_=0;d_<2;++d_) _Pragma("unroll") for(int r=0;r<16;++r)o[d_][r]*=wsf[crow(r,hi)]; } }while(0)
  f32x16 pA0,pA1,pB0,pB1;
  int sl_prev=0,sl_cur=0,sl_next=SLOTB;
  #define ROT() do{sl_prev=sl_cur;sl_cur=sl_next;sl_next=(sl_next==(NSLOT-1)*SLOTB)?0:sl_next+SLOTB;}while(0)
  DMA_K(2,2*SLOTB);
  WAIT_BAR(3);
  qkt(pA0,pA1,Kbase,qr,r32,hi);asm volatile("s_nop 15\n\ts_nop 7":"+v"(pA0),"+v"(pA1));ALIBI(pA0,pA1,0);asm volatile("":"+v"(pA0),"+v"(pA1));CMASK(pA0,pA1,0);
  START(pA0,pA1);
  _Pragma("unroll") for(int r=0;r<16;++r)pA1[r]=__builtin_amdgcn_exp2f(pA1[r]);
  WAIT_BAR(0);
  DMA_K(3,0);DMA_V(1,SLOTB);
  ROT();
  kload8(kf,kp0+sl_cur);
  WAIT_BAR(2);
  s16x4 vlo[8],vhi[8]; u32x4 pw0,pw1,pw2,pw3;
  #define PKW(P,B) cvtpk_s(P[B],P[B+1])
  #define PAF(k) __builtin_bit_cast(bf16x8,pw##k)
  #define VFR(i) (bf16x8){vlo[i][0],vlo[i][1],vlo[i][2],vlo[i][3],vhi[i][0],vhi[i][1],vhi[i][2],vhi[i][3]}
  #define PIN(x) asm volatile("":"+v"(x))
  #define MX3(a,b,c) __builtin_fmaxf(__builtin_fmaxf((a),(b)),(c))
  #define GAPA(MF,A0,A1,A2,A3,W0,W1,PW) do{ MF; sacc+=A0; sacc+=A1; sacc+=A2; sacc+=A3; PIN(sacc); W0; W1; PIN(PW); SBAR(); }while(0)
  #define EX(v) __builtin_amdgcn_exp2f(v)
  #define GAPB(MF,X,B) do{ MF; X[B]=EX(X[B]); X[B+1]=EX(X[B+1]); X[B+2]=EX(X[B+2]); X[B+3]=EX(X[B+3]); PIN(X); SBAR(); }while(0)
  #define VRD(i) do{ vlo[i]=vtr(vp_+(((i)>>2)*4096+((i)&3)*1024)); vhi[i]=vtr(vp_+(((i)>>2)*4096+((i)&3)*1024+512)); }while(0)
  #define KRD(G,j) do{ if(G){ kload2(kf,kp0+sl_next,j); SBAR(); } }while(0)
  #define STEP(C0,C1,P0,P1,t,GK,GV,GL) do{ SBAR(); \
    const lds_cptr vp_=vp0+sl_prev; \
    VRD(0); SBAR(); float sacc=(P0[0]+P0[1]); \
    GAPA(C0=__builtin_amdgcn_mfma_f32_32x32x16_bf16(kf[0],qr[0],negm,0,0,0), P0[2],P0[3],P0[4],P0[5],     pw0[0]=PKW(P0,0), pw0[1]=PKW(P0,2), pw0); \
    VRD(4); SBAR(); GAPA(C1=__builtin_amdgcn_mfma_f32_32x32x16_bf16(kf[1],qr[0],negm,0,0,0), P0[6],P0[7],P0[8],P0[9],     pw0[2]=PKW(P0,4), pw0[3]=PKW(P0,6), pw0); \
    VRD(1); SBAR(); GAPA(C0=__builtin_amdgcn_mfma_f32_32x32x16_bf16(kf[2],qr[1],C0,0,0,0),   P0[10],P0[11],P0[12],P0[13], pw1[0]=PKW(P0,8), pw1[1]=PKW(P0,10), pw1); \
    VRD(5); SBAR(); GAPA(C1=__builtin_amdgcn_mfma_f32_32x32x16_bf16(kf[3],qr[1],C1,0,0,0),   P0[14],P0[15],P1[0],P1[1],   pw1[2]=PKW(P0,12),pw1[3]=PKW(P0,14), pw1); \
    VRD(2); SBAR(); GAPA(C0=__builtin_amdgcn_mfma_f32_32x32x16_bf16(kf[4],qr[2],C0,0,0,0),   P1[2],P1[3],P1[4],P1[5],     pw2[0]=PKW(P1,0), pw2[1]=PKW(P1,2), pw2); \
    VRD(6); SBAR(); GAPA(C1=__builtin_amdgcn_mfma_f32_32x32x16_bf16(kf[5],qr[2],C1,0,0,0),   P1[6],P1[7],P1[8],P1[9],     pw2[2]=PKW(P1,4), pw2[3]=PKW(P1,6), pw2); \
    VRD(3); SBAR(); GAPA(C0=__builtin_amdgcn_mfma_f32_32x32x16_bf16(kf[6],qr[3],C0,0,0,0),   P1[10],P1[11],P1[12],P1[13], pw3[0]=PKW(P1,8), pw3[1]=PKW(P1,10), pw3); \
    VRD(7); SBAR(); GAPA(C1=__builtin_amdgcn_mfma_f32_32x32x16_bf16(kf[7],qr[3],C1,0,0,0),   P1[14],P1[15],0.f,0.f,       pw3[2]=PKW(P1,12),pw3[3]=PKW(P1,14), pw3); \
    l_reg+=sacc; \
    if(GK){DMA_K((t)+3,sl_cur);} if(GV){DMA_V((t)+1,sl_next);} \
    ALIBI(C0,C1,t); CMASK(C0,C1,t); \
    { float a=MX3(C0[0],C0[1],C1[0]),b=MX3(C0[2],C0[3],C1[1]); a=MX3(a,C1[2],C1[3]); \
      _Pragma("unroll") for(int r=4;r<16;r+=4){a=MX3(a,C0[r],C0[r+1]);b=MX3(b,C0[r+2],C0[r+3]);a=MX3(a,C1[r],C1[r+1]);b=MX3(b,C1[r+2],C1[r+3]);} \
      float rm=__builtin_fmaxf(a,b); { auto rr=__builtin_amdgcn_permlane32_swap(__float_as_uint(rm),__float_as_uint(rm),false,false); rm=__builtin_fmaxf(__uint_as_float(rr[0]),__uint_as_float(rr[1])); } \
      resc=false; \
      if(__builtin_expect(__any(rm>(float)THRL),0)){ const float dl=__builtin_fmaxf(rm,0.f); mhat+=dl; \
        _Pragma("unroll") for(int r=0;r<16;++r){C0[r]-=dl;C1[r]-=dl;} \
        const float f=__builtin_amdgcn_exp2f(-dl); l_reg*=f; if(hi==0)wsf[r32]=f; resc=true; } } \
    SBAR(); \
    GAPB(o[0]=__builtin_amdgcn_mfma_f32_32x32x16_bf16(PAF(0),VFR(0),o[0],0,0,0), C0,0); \
    GAPB(o[1]=__builtin_amdgcn_mfma_f32_32x32x16_bf16(PAF(0),VFR(4),o[1],0,0,0), C0,4); \
    KRD(GL,0); GAPB(o[0]=__builtin_amdgcn_mfma_f32_32x32x16_bf16(PAF(1),VFR(1),o[0],0,0,0), C0,8); \
    KRD(GL,1); GAPB(o[1]=__builtin_amdgcn_mfma_f32_32x32x16_bf16(PAF(1),VFR(5),o[1],0,0,0), C0,12); \
    KRD(GL,2); GAPB(o[0]=__builtin_amdgcn_mfma_f32_32x32x16_bf16(PAF(2),VFR(2),o[0],0,0,0), C1,0); \
    KRD(GL,3); GAPB(o[1]=__builtin_amdgcn_mfma_f32_32x32x16_bf16(PAF(2),VFR(6),o[1],0,0,0), C1,4); \
    GAPB(o[0]=__builtin_amdgcn_mfma_f32_32x32x16_bf16(PAF(3),VFR(3),o[0],0,0,0), C1,8); \
    GAPB(o[1]=__builtin_amdgcn_mfma_f32_32x32x16_bf16(PAF(3),VFR(7),o[1],0,0,0), C1,12); \
    }while(0)
  int t=1;
  #undef CMASK
  #define CMASK(P0,P1,t) do{}while(0)
  for(;t+5<NT;t+=2){
    STEP(pB0,pB1,pA0,pA1,t,true,true,true);     WAIT_BAR(2); RESC(); ROT();
    STEP(pA0,pA1,pB0,pB1,t+1,true,true,true);   WAIT_BAR(2); RESC(); ROT();
  }
  #undef CMASK
  #define CMASK(P0,P1,t) do{int jb_=(t)-(NT-4); if(jb_>=0)cmask(P0,P1,jb_,qrel,hi);}while(0)
  #define ENDW(tt) do{ if((tt)+3<NT){WAIT_BAR(2);} else if((tt)+2<NT){WAIT_BAR(1);} else {WAIT_BAR(0);} }while(0)
  for(;t+1<NT;t+=2){
    STEP(pB0,pB1,pA0,pA1,t,(t+3<NT),(t+1<NT),(t+1<NT));       ENDW(t);   RESC(); ROT();
    STEP(pA0,pA1,pB0,pB1,t+1,(t+4<NT),(t+2<NT),(t+2<NT));     ENDW(t+1); RESC(); ROT();
  }
  STEP(pB0,pB1,pA0,pA1,NT-1,false,false,false); RESC();
  { float sacc=pB0[0]+pB0[1]; _Pragma("unroll") for(int r=2;r<16;++r)sacc+=pB0[r]; _Pragma("unroll") for(int r=0;r<16;++r)sacc+=pB1[r]; l_reg+=sacc;
    pw0=(u32x4){PKW(pB0,0),PKW(pB0,2),PKW(pB0,4),PKW(pB0,6)};pw1=(u32x4){PKW(pB0,8),PKW(pB0,10),PKW(pB0,12),PKW(pB0,14)};pw2=(u32x4){PKW(pB1,0),PKW(pB1,2),PKW(pB1,4),PKW(pB1,6)};pw3=(u32x4){PKW(pB1,8),PKW(pB1,10),PKW(pB1,12),PKW(pB1,14)};
    SBAR(); pv(o,vb0+sl_cur,PAF(0),PAF(1),PAF(2),PAF(3)); }
  #undef PKW
  #undef PAF
  #undef VFR
  #undef PIN
  #undef MX3
  #undef GAPA
  #undef GAPB
  #undef EX
  #undef VRD
  #undef KRD
  #undef STEP
  #undef ENDW
  {auto rr=__builtin_amdgcn_permlane32_swap(__float_as_uint(l_reg),__float_as_uint(l_reg),false,false);l_reg=__uint_as_float(rr[0])+__uint_as_float(rr[1]);}
  if(hi==0)wsf[32+r32]=l_reg;asm volatile("s_waitcnt lgkmcnt(0)":::"memory");
  float rli[16];
  #pragma unroll
  for(int r=0;r<16;++r)rli[r]=__builtin_amdgcn_rcpf(wsf[32+crow(r,hi)]);
  bf16*Ow=O+(rowbase+q0+wid*QBLK)*PO+ocol;
  { bf16*stg=(bf16*)(shm+LDS_OST)+wid*2048;
    #pragma unroll
    for(int r=0;r<16;++r){const int orow=crow(r,hi);
      #pragma unroll
      for(int d0=0;d0<2;++d0)stg[orow*64+d0*32+r32]=__float2bfloat16(o[d0][r]*rli[r]);}
    asm volatile("s_waitcnt lgkmcnt(0)":::"memory");
    #pragma unroll
    for(int i=0;i<4;++i){const int row=i*8+(lane>>3),ch=lane&7; const u32x4 v=*(const u32x4*)(stg+row*64+ch*8); ATTN_STORE16(Ow+(long)row*PO+ch*8,v);} }
  asm volatile("s_waitcnt lgkmcnt(0)\n\ts_barrier":::"memory");
  #undef DMA_K
  #undef DMA_V
  #undef CMASK
  #undef START
  #undef RESC
  #undef ROT
  #undef ALIBI
}
constexpr int ATTN_LDS_BYTES=LDS_BYTES;
#undef SBAR
#undef WAIT_BAR
}
struct MixP {
    const bf16* proj; bf16* ocat; bf16* oatt;
    const float* hg_lb;
    const float* hg_norm_g;
    float lam, one_m_lam_init;
    const float* da_subln_g;
    const float *rw_mu, *rw_w0, *rw_a0, *rw_k_k, *rw_k_a, *rw_r_k, *rw_gn_g, *rw_gn_b;
    const bf16 *wupT, *aupT, *gupT;
    gu32* aq;
};

__device__ __forceinline__ void attn_group(const MixP& P, int b, int h, int qb, char* lds) {
    const float slope2 = exp2f(-2.0f * (float)(h + 1)) * LOG2E;
    const float s2 = __builtin_bit_cast(float, __builtin_amdgcn_readfirstlane(__builtin_bit_cast(int, slope2)));
    const attn_body::bf16* pr = (const attn_body::bf16*)P.proj; attn_body::bf16* oa = (attn_body::bf16*)P.oatt;
#pragma unroll 1
    for (int sub = 0; sub < 4; ++sub) {
        const int mp = sub >> 1, hf = sub & 1;
        attn_body::attn_unit<8>(b, C_DAQ + h * 128 + mp * 64, C_DAK + h * 128 + mp * 64, C_DAV + h * 128 + hf * 64, h * 256 + mp * 128 + hf * 64, s2, qb, pr, oa, lds);
    }
    VM_WAIT(); __syncthreads();
    {
        int tid_ = threadIdx.x; asm volatile("" : "+v"(tid_)); const int tid = tid_, row = tid >> 1, hf = tid & 1;
        const size_t grow = (size_t)b * T + (size_t)qb * 256 + row;
        const bf16* o0 = P.oatt + grow * 1024 + h * 256 + hf * 64; const bf16* o1 = o0 + 128;
        float v[64]; float ss = 0.f;
#pragma unroll
        for (int c = 0; c < 8; ++c) { const v4u x = __builtin_nontemporal_load((const v4u*)(o0) + c), y = __builtin_nontemporal_load((const v4u*)(o1) + c);
            const unsigned xs[4] = {x.x, x.y, x.z, x.w}, ys[4] = {y.x, y.y, y.z, y.w};
#pragma unroll
            for (int j = 0; j < 4; ++j) { const float a = bflo(xs[j]) - P.lam * bflo(ys[j]), d = bfhi(xs[j]) - P.lam * bfhi(ys[j]); v[c * 8 + 2 * j] = a; v[c * 8 + 2 * j + 1] = d; ss += a * a + d * d; } }
        ss += __shfl_xor(ss, 1);
        const float rs = rsqrtf(ss * (1.0f / 128.0f) + RMS_EPS) * P.one_m_lam_init;
        bf16* dst = P.ocat + grow * 1536 + 512 + h * 128 + hf * 64; const float* g = P.da_subln_g + hf * 64;
#pragma unroll
        for (int c = 0; c < 8; ++c) { v4u w; w.x = pk2(v[c * 8 + 0] * rs * g[c * 8 + 0], v[c * 8 + 1] * rs * g[c * 8 + 1]); w.y = pk2(v[c * 8 + 2] * rs * g[c * 8 + 2], v[c * 8 + 3] * rs * g[c * 8 + 3]);
            w.z = pk2(v[c * 8 + 4] * rs * g[c * 8 + 4], v[c * 8 + 5] * rs * g[c * 8 + 5]); w.w = pk2(v[c * 8 + 6] * rs * g[c * 8 + 6], v[c * 8 + 7] * rs * g[c * 8 + 7]);
            *((v4u*)dst + c) = w; }
    }
    __syncthreads();
}
__device__ __forceinline__ void attn_worker(const MixP& P, char* lds, volatile LAS unsigned* bcast, int tid) {
    for (;;) {
        if (tid == 0) bcast[0] = __hip_atomic_fetch_add(P.aq, 1u, RLX_AGENT);
        __syncthreads();
        const unsigned idx = bcast[0];
        __syncthreads();
        if (idx >= 512u) break;
        const int qb = 15 - (int)(idx >> 5), bh = (int)(idx & 31u);
        attn_group(P, bh >> 2, bh & 3, qb, lds);
    }
}

constexpr int HG_QH = 0, HG_QT = 17408, HG_KT = 34816, HG_KHT = 52224, HG_VV = 70656, HG_OG = 88064, HG_AM = 105472, HG_BQ = 114688, HG_SS = 116736, HG_DD = 118784, HG_END = 119296;
constexpr int HS = 272, HS2 = 144;
__device__ __forceinline__ s16x4 tr_rd(unsigned addr) { s16x4 r; asm volatile("ds_read_b64_tr_b16 %0, %1\n\ts_waitcnt lgkmcnt(0)" : "=&v"(r) : "v"(addr) : "memory"); return r; }
__device__ __forceinline__ void hgrn_unit(const MixP& P, int b, int h, LAS unsigned char* lds) {
    int tid_ = threadIdx.x; asm volatile("" : "+v"(tid_));
    const int tid = tid_, lane = tid & 63, w = __builtin_amdgcn_readfirstlane(tid >> 6), g = lane >> 4, li = lane & 15;
    const int kk_ = tid & 127, tq = tid >> 7;
    const float lb = P.hg_lb[h * 128 + kk_], oml = 1.0f - lb;
    LAS float* BQ = (LAS float*)(lds + HG_BQ); LAS float* SS = (LAS float*)(lds + HG_SS); LAS float* DD = (LAS float*)(lds + HG_DD);
    f32x4 Sacc[8];
#pragma unroll
    for (int i = 0; i < 8; ++i) Sacc[i] = (f32x4){0.f, 0.f, 0.f, 0.f};
    const unsigned ldsb = (unsigned)(uintptr_t)lds;
    const float ng = P.hg_norm_g[16 * w + li];
#pragma unroll 1
    for (int c = 0; c < 64; ++c) {
        const size_t row0 = (size_t)b * T + (size_t)c * 64;
        const bf16* base = P.proj + (row0 + 16 * tq) * INW + h * 128 + kk_;
        float cs[16], kv[16]; float run = 0.f;
#pragma unroll
        for (int i = 0; i < 16; ++i) { const float z = bf2f(base[(size_t)i * INW + C_HGF]); const float sg = sigmoidf_(z); const float f = lb + oml * sg;
            run += __logf(fmaxf(f, HG_F_MIN)); cs[i] = run; kv[i] = oml * (1.0f - sg); }
        BQ[tq * 128 + kk_] = run;
        __syncthreads();
        const float q0 = BQ[kk_], q1 = BQ[128 + kk_], q2 = BQ[256 + kk_], q3 = BQ[384 + kk_];
        const float off = (tq > 0 ? q0 : 0.f) + (tq > 1 ? q1 : 0.f) + (tq > 2 ? q2 : 0.f);
        const float blast = (q0 + q1) + (q2 + q3), ref = q0 + q1;
        if (tq == 0) DD[kk_] = __expf(blast);
#pragma unroll
        for (int i = 0; i < 16; ++i) { const int t = 16 * tq + i; const float bt = off + cs[i];
            const float q = bf2f(base[(size_t)i * INW + C_HGQ]);
            const unsigned short vraw = base[(size_t)i * INW + C_HGI], ograw = base[(size_t)i * INW + C_HGO];
            *(LAS unsigned short*)(lds + HG_QH + t * HS + kk_ * 2) = (unsigned short)f2bf(q * __expf(bt));
            *(LAS unsigned short*)(lds + HG_QT + t * HS + kk_ * 2) = (unsigned short)f2bf(q * __expf(fminf(bt - ref, 60.f)));
            *(LAS unsigned short*)(lds + HG_KT + t * HS + kk_ * 2) = (unsigned short)f2bf(kv[i] * __expf(fminf(ref - bt, 60.f)));
            *(LAS unsigned short*)(lds + HG_KHT + kk_ * HS2 + t * 2) = (unsigned short)f2bf(kv[i] * __expf(blast - bt));
            *(LAS unsigned short*)(lds + HG_VV + t * HS + kk_ * 2) = vraw;
            *(LAS unsigned short*)(lds + HG_OG + t * HS + kk_ * 2) = ograw; }
        __syncthreads();
        {   const int mt = w >> 1;
#pragma unroll
            for (int j = 0; j < 2; ++j) { const int st = 2 * (w & 1) + j; f32x4 a = (f32x4){0.f, 0.f, 0.f, 0.f};
#pragma unroll
                for (int ks = 0; ks < 4; ++ks) { const bf16x8 fa = *(const LAS bf16x8*)(lds + HG_KT + (16 * st + li) * HS + ks * 64 + g * 16);
                    const bf16x8 fb = *(const LAS bf16x8*)(lds + HG_QT + (16 * mt + li) * HS + ks * 64 + g * 16);
                    a = __builtin_amdgcn_mfma_f32_16x16x32_bf16(fa, fb, a, 0, 0, 0); }
                const int tt = 16 * mt + li, s0 = 16 * st + 4 * g;
                v2u wv; wv.x = pk2(s0 <= tt ? a[0] : 0.f, s0 + 1 <= tt ? a[1] : 0.f); wv.y = pk2(s0 + 2 <= tt ? a[2] : 0.f, s0 + 3 <= tt ? a[3] : 0.f);
                *(LAS v2u*)(lds + HG_AM + tt * HS2 + s0 * 2) = wv; }
        }
        __syncthreads();
        bf16x8 vf[2];
        {   const int q = li >> 2, p = li & 3;
#pragma unroll
            for (int ks = 0; ks < 2; ++ks) { const unsigned a0 = ldsb + HG_VV + (32 * ks + 8 * g + q) * HS + (16 * w + 4 * p) * 2;
                const s16x4 lo = tr_rd(a0), hi = tr_rd(a0 + 4 * HS);
                vf[ks] = (bf16x8){lo[0], lo[1], lo[2], lo[3], hi[0], hi[1], hi[2], hi[3]}; } }
        bf16x8 sb[4];
#pragma unroll
        for (int s = 0; s < 4; ++s) { v4u x; x.x = pk2(Sacc[2 * s][0], Sacc[2 * s][1]); x.y = pk2(Sacc[2 * s][2], Sacc[2 * s][3]); x.z = pk2(Sacc[2 * s + 1][0], Sacc[2 * s + 1][1]); x.w = pk2(Sacc[2 * s + 1][2], Sacc[2 * s + 1][3]);
            sb[s] = __builtin_bit_cast(bf16x8, x); }
        f32x4 o[4];
#pragma unroll
        for (int mt = 0; mt < 4; ++mt) { f32x4 a = (f32x4){0.f, 0.f, 0.f, 0.f};
#pragma unroll
            for (int ks = 0; ks < 2; ++ks) { const bf16x8 fa = *(const LAS bf16x8*)(lds + HG_AM + (16 * mt + li) * HS2 + ks * 64 + g * 16);
                a = __builtin_amdgcn_mfma_f32_16x16x32_bf16(fa, vf[ks], a, 0, 0, 0); }
#pragma unroll
            for (int s = 0; s < 4; ++s) { const LAS unsigned char* qp = lds + HG_QH + (16 * mt + li) * HS + (32 * s + 4 * g) * 2;
                const v2u lo = *(const LAS v2u*)qp, hi = *(const LAS v2u*)(qp + 32);
                v4u x; x.x = lo.x; x.y = lo.y; x.z = hi.x; x.w = hi.y;
                a = __builtin_amdgcn_mfma_f32_16x16x32_bf16(__builtin_bit_cast(bf16x8, x), sb[s], a, 0, 0, 0); }
            o[mt] = a; }
#pragma unroll
        for (int kt = 0; kt < 8; ++kt) { const f32x4 d = *(const LAS f32x4*)(DD + 16 * kt + 4 * g); f32x4 a = Sacc[kt] * d;
#pragma unroll
            for (int ks = 0; ks < 2; ++ks) { const bf16x8 fa = *(const LAS bf16x8*)(lds + HG_KHT + (16 * kt + li) * HS2 + ks * 64 + g * 16);
                a = __builtin_amdgcn_mfma_f32_16x16x32_bf16(fa, vf[ks], a, 0, 0, 0); }
            Sacc[kt] = a; }
#pragma unroll
        for (int mt = 0; mt < 4; ++mt)
#pragma unroll
            for (int r = 0; r < 4; ++r) { float s = o[mt][r] * o[mt][r]; s += __shfl_xor(s, 1); s += __shfl_xor(s, 2); s += __shfl_xor(s, 4); s += __shfl_xor(s, 8);
                if (li == 0) SS[(16 * mt + 4 * g + r) * 8 + w] = s; }
        __syncthreads();
#pragma unroll
        for (int mt = 0; mt < 4; ++mt)
#pragma unroll
            for (int r = 0; r < 4; ++r) { const int t = 16 * mt + 4 * g + r; const f32x4 s0 = *(const LAS f32x4*)(SS + t * 8), s1 = *(const LAS f32x4*)(SS + t * 8 + 4);
                const float ss = ((s0[0] + s0[1]) + (s0[2] + s0[3])) + ((s1[0] + s1[1]) + (s1[2] + s1[3]));
                const float rs = rsqrtf(ss * (1.0f / 128.0f) + RMS_EPS);
                const float og = bf2f(*(const LAS unsigned short*)(lds + HG_OG + t * HS + (16 * w + li) * 2));
                const float y = o[mt][r] * rs * ng * (og * sigmoidf_(og));
                P.ocat[(row0 + t) * 1536 + h * 128 + 16 * w + li] = (unsigned short)f2bf(y); }
        __syncthreads();
    }
}

constexpr int RW_R = 0, RW_W = 8192, RW_K2 = 16384, RW_V = 24576, RW_AA = 32768, RW_BB = 40960, RW_G = 49152, RW_O = 57344, RW_K1 = 65536, RW_A1 = 73728, RW_BON = 81920,
              RW_TW = 82176, RW_AD = RW_TW + 32 * 144, RW_SG = RW_AD + 32 * 144, RW_END = RW_SG + 32 * 272;
__device__ __forceinline__ void rwkv_unit(const MixP& P, int b, int h, LAS unsigned char* lds) {
    int tid_ = threadIdx.x; asm volatile("" : "+v"(tid_));
    const int tid = tid_, lane = tid & 63, w = __builtin_amdgcn_readfirstlane(tid >> 6), g = lane >> 4, li = lane & 15;
    LAS float* R = (LAS float*)(lds + RW_R); LAS float* W = (LAS float*)(lds + RW_W); LAS float* K2 = (LAS float*)(lds + RW_K2); LAS float* V = (LAS float*)(lds + RW_V);
    LAS float* AA = (LAS float*)(lds + RW_AA); LAS float* BB = (LAS float*)(lds + RW_BB); LAS float* G = (LAS float*)(lds + RW_G); LAS float* O = (LAS float*)(lds + RW_O);
    LAS float* K1 = (LAS float*)(lds + RW_K1); LAS float* A1 = (LAS float*)(lds + RW_A1); LAS float* BON = (LAS float*)(lds + RW_BON);
    const int hc = h * 64;
    float S[8];
#pragma unroll
    for (int j = 0; j < 8; ++j) S[j] = 0.f;
    const int mt = w >> 2, ntile = w & 3, cc = 16 * ntile + li;
    bf16x8 fwu[2], fau[2], fgu[4];
#pragma unroll
    for (int ks = 0; ks < 2; ++ks) { fwu[ks] = *(const bf16x8*)(P.wupT + (size_t)(hc + cc) * 64 + ks * 32 + g * 8); fau[ks] = *(const bf16x8*)(P.aupT + (size_t)(hc + cc) * 64 + ks * 32 + g * 8); }
#pragma unroll
    for (int ks = 0; ks < 4; ++ks) fgu[ks] = *(const bf16x8*)(P.gupT + (size_t)(hc + cc) * 128 + ks * 32 + g * 8);
    const float w0c = P.rw_w0[hc + cc], a0c = P.rw_a0[hc + cc];
#pragma unroll 1
    for (int blk = 0; blk < 128; ++blk) {
        const size_t row0 = (size_t)b * T + (size_t)blk * 32;
        for (int e = tid; e < 32 * 448; e += NTHR) { const int t = e / 448, c = e - t * 448;
            int pc; if (c < 64) pc = C_RWR + hc + c; else if (c < 128) pc = C_RWK + hc + (c - 64); else if (c < 192) pc = C_RWV + hc + (c - 128); else pc = C_RWWD + (c - 192);
            const bf16* src = P.proj + (row0 + t) * INW + pc;
            const float cur = bf2f(src[0]); const float prev = (blk == 0 && t == 0) ? 0.f : bf2f(*(src - INW));
            const float x = cur + (prev - cur) * P.rw_mu[pc - C_RW];
            if (c < 64) R[t * 64 + c] = x; else if (c < 128) K1[t * 64 + (c - 64)] = x; else if (c < 192) V[t * 64 + (c - 128)] = x;
            else if (c < 256) *(LAS unsigned short*)(lds + RW_TW + t * 144 + (c - 192) * 2) = (unsigned short)f2bf(tanhf(x));
            else if (c < 320) *(LAS unsigned short*)(lds + RW_AD + t * 144 + (c - 256) * 2) = (unsigned short)f2bf(x);
            else *(LAS unsigned short*)(lds + RW_SG + t * 272 + (c - 320) * 2) = (unsigned short)f2bf(sigmoidf_(x)); }
        __syncthreads();
        {   f32x4 aw = (f32x4){0.f, 0.f, 0.f, 0.f}, aa = aw, ag = aw;
#pragma unroll
            for (int ks = 0; ks < 2; ++ks) { const bf16x8 f1 = *(const LAS bf16x8*)(lds + RW_TW + (16 * mt + li) * 144 + ks * 64 + g * 16), f2 = *(const LAS bf16x8*)(lds + RW_AD + (16 * mt + li) * 144 + ks * 64 + g * 16);
                aw = __builtin_amdgcn_mfma_f32_16x16x32_bf16(f1, fwu[ks], aw, 0, 0, 0); aa = __builtin_amdgcn_mfma_f32_16x16x32_bf16(f2, fau[ks], aa, 0, 0, 0); }
#pragma unroll
            for (int ks = 0; ks < 4; ++ks) { const bf16x8 f3 = *(const LAS bf16x8*)(lds + RW_SG + (16 * mt + li) * 272 + ks * 64 + g * 16); ag = __builtin_amdgcn_mfma_f32_16x16x32_bf16(f3, fgu[ks], ag, 0, 0, 0); }
#pragma unroll
            for (int r = 0; r < 4; ++r) { const int t = 16 * mt + 4 * g + r; const float z = -(w0c + aw[r]);
                const float sp = fmaxf(z, 0.f) + log1pf(__expf(-fabsf(z))); const float wlog = -sp - 0.5f;
                W[t * 64 + cc] = __expf(-__expf(wlog)); A1[t * 64 + cc] = sigmoidf_(a0c + aa[r]); G[t * 64 + cc] = ag[r]; }
        }
        __syncthreads();
        {   const int t = tid >> 4, c0 = (tid & 15) * 4; float kkv[4], k1[4], a[4]; float ss = 0.f, bon = 0.f;
#pragma unroll
            for (int j = 0; j < 4; ++j) { k1[j] = K1[t * 64 + c0 + j]; a[j] = A1[t * 64 + c0 + j]; kkv[j] = k1[j] * P.rw_k_k[hc + c0 + j]; ss += kkv[j] * kkv[j]; }
            ss += __shfl_xor(ss, 1); ss += __shfl_xor(ss, 2); ss += __shfl_xor(ss, 4); ss += __shfl_xor(ss, 8);
            const float inv = rsqrtf(fmaxf(ss, 1e-12f));
#pragma unroll
            for (int j = 0; j < 4; ++j) { const float kn = kkv[j] * inv, k2 = k1[j] * (1.0f + (a[j] - 1.0f) * P.rw_k_a[hc + c0 + j]);
                AA[t * 64 + c0 + j] = -kn; BB[t * 64 + c0 + j] = kn * a[j]; K2[t * 64 + c0 + j] = k2; bon += R[t * 64 + c0 + j] * k2 * P.rw_r_k[hc + c0 + j]; }
            bon += __shfl_xor(bon, 1); bon += __shfl_xor(bon, 2); bon += __shfl_xor(bon, 4); bon += __shfl_xor(bon, 8);
            if ((tid & 15) == 0) BON[t] = bon; }
        __syncthreads();
        {   const int vr = lane >> 3, sg = lane & 7, vrow = 8 * w + vr;
#pragma unroll 2
            for (int t = 0; t < 32; ++t) { const int o8 = t * 64 + 8 * sg;
                const f32x4 a0 = *(const LAS f32x4*)(AA + o8), a1 = *(const LAS f32x4*)(AA + o8 + 4), w0 = *(const LAS f32x4*)(W + o8), w1 = *(const LAS f32x4*)(W + o8 + 4);
                const f32x4 b0 = *(const LAS f32x4*)(BB + o8), b1 = *(const LAS f32x4*)(BB + o8 + 4), k0 = *(const LAS f32x4*)(K2 + o8), k1 = *(const LAS f32x4*)(K2 + o8 + 4);
                const f32x4 r0 = *(const LAS f32x4*)(R + o8), r1 = *(const LAS f32x4*)(R + o8 + 4); const float vv = V[t * 64 + vrow];
                float sa = ((S[0] * a0[0] + S[1] * a0[1]) + (S[2] * a0[2] + S[3] * a0[3])) + ((S[4] * a1[0] + S[5] * a1[1]) + (S[6] * a1[2] + S[7] * a1[3]));
                sa += __shfl_xor(sa, 1); sa += __shfl_xor(sa, 2); sa += __shfl_xor(sa, 4);
#pragma unroll
                for (int j = 0; j < 4; ++j) { S[j] = S[j] * w0[j] + sa * b0[j] + vv * k0[j]; S[4 + j] = S[4 + j] * w1[j] + sa * b1[j] + vv * k1[j]; }
                float oo = ((S[0] * r0[0] + S[1] * r0[1]) + (S[2] * r0[2] + S[3] * r0[3])) + ((S[4] * r1[0] + S[5] * r1[1]) + (S[6] * r1[2] + S[7] * r1[3]));
                oo += __shfl_xor(oo, 1); oo += __shfl_xor(oo, 2); oo += __shfl_xor(oo, 4);
                if (sg == 0) O[t * 64 + vrow] = oo; }
        }
        __syncthreads();
        {   const int t = tid >> 4, c0 = (tid & 15) * 4; const f32x4 ov = *(const LAS f32x4*)(O + t * 64 + c0);
            float s = (ov[0] + ov[1]) + (ov[2] + ov[3]); s += __shfl_xor(s, 1); s += __shfl_xor(s, 2); s += __shfl_xor(s, 4); s += __shfl_xor(s, 8);
            const float mean = s * (1.0f / 64.0f); float q = 0.f;
#pragma unroll
            for (int j = 0; j < 4; ++j) { const float d = ov[j] - mean; q += d * d; }
            q += __shfl_xor(q, 1); q += __shfl_xor(q, 2); q += __shfl_xor(q, 4); q += __shfl_xor(q, 8);
            const float rs = rsqrtf(q * (1.0f / 64.0f) + RW_GN_EPS), bon = BON[t]; float y[4];
#pragma unroll
            for (int j = 0; j < 4; ++j) y[j] = ((ov[j] - mean) * rs * P.rw_gn_g[hc + c0 + j] + P.rw_gn_b[hc + c0 + j] + bon * V[t * 64 + c0 + j]) * G[t * 64 + c0 + j];
            v2u wv; wv.x = pk2(y[0], y[1]); wv.y = pk2(y[2], y[3]);
            *(v2u*)(P.ocat + (row0 + t) * 1536 + 1024 + hc + c0) = wv; }
        __syncthreads();
    }
}
struct Args { const float* in[31]; float* out; unsigned char* ws; int ph_lo, ph_hi; };
typedef const __attribute__((address_space(4))) Args* ArgP;
struct Frame {
    LAS unsigned char* lds; volatile LAS unsigned* MISC; gu32* ctl;
    int tid, lane, wave, vcu, G, bx;
};
constexpr int SM_HGLB = 0;
constexpr int SM_LAM = 2048;

__device__ __forceinline__ void transpose_item(const float* W, int K, int N, bf16* WT, int k0, int n0, int drow0, LAS float* scr, int lane, int dp = 0) {
    if (dp == 0) dp = K;
#pragma unroll 8
    for (int i = 0; i < 32; ++i) { const int kk = 2 * i + (lane >> 5); scr[kk * 33 + (lane & 31)] = W[(size_t)(k0 + kk) * N + n0 + (lane & 31)]; }
    LDS_WAIT(); asm volatile("" ::: "memory");
    const int c = lane & 7;
#pragma unroll
    for (int j = 0; j < 4; ++j) { const int n = (lane >> 3) + 8 * j; const LAS float* s = scr + (8 * c) * 33 + n;
        v4u o; o.x = pk2(s[0 * 33], s[1 * 33]); o.y = pk2(s[2 * 33], s[3 * 33]); o.z = pk2(s[4 * 33], s[5 * 33]); o.w = pk2(s[6 * 33], s[7 * 33]);
        *(GAS v4u*)(WT + (size_t)(drow0 + n) * dp + k0 + 8 * c) = o; }
    LDS_WAIT(); asm volatile("" ::: "memory");
}
constexpr int CV_IN = 2688, CV_MG = 1536, CV_BR = 768, CV_OUT = 512, CV_EX = 4096, CV_TOTAL = CV_IN + CV_MG + CV_BR + CV_OUT + 3 * CV_EX;
__device__ __forceinline__ void conv_layer(const Frame& F, ArgP A, int l) {
    LAS float* scr = (LAS float*)(F.lds + F.wave * 16384);
    const int gw = F.vcu * NWAVES + F.wave, NGW = F.G * NWAVES;
    bf16* wa = (bf16*)(A->ws + WS_WA); bf16* we = (bf16*)(A->ws + WS_WE);
    for (int it = gw; it < CV_TOTAL; it += NGW) {
        int r = it;
        if (r < CV_IN) { const int kb = r / 168, nb = r % 168; transpose_item(A->in[4] + (size_t)l * DM * INW, DM, INW, wa + WA_IN / 2, 64 * kb, 32 * nb, 32 * nb, scr, F.lane); continue; } r -= CV_IN;
        if (r < CV_MG) { const int br = r / 512, q = r % 512, kb = q / 32, nb = q % 32; transpose_item(A->in[20] + ((size_t)l * 3 + br) * DM * DM, DM, DM, wa + WA_MERGE / 2 + (size_t)br * DM * UP_, 64 * kb, 32 * nb, 32 * nb, scr, F.lane, UP_); continue; } r -= CV_MG;
        if (r < CV_BR) { const int kb = r / 32, nb = r % 32; transpose_item(A->in[22] + (size_t)l * 1536 * DM, 1536, DM, wa + WA_BRANCH / 2, 64 * kb, 32 * nb, 32 * nb, scr, F.lane); continue; } r -= CV_BR;
        if (r < CV_OUT) { const int kb = r / 32, nb = r % 32; transpose_item(A->in[23] + (size_t)l * DM * DM, DM, DM, wa + WA_OUT / 2, 64 * kb, 32 * nb, 32 * nb, scr, F.lane); continue; } r -= CV_OUT;
        if (r < 2 * CV_EX) { const int up = r / CV_EX, q = r % CV_EX, e = q / 256, q2 = q % 256, kb = q2 / 16, nb = q2 % 16, n0 = 32 * nb;
            transpose_item(A->in[28 + up] + ((size_t)l * NE + e) * DM * DE, DM, DE, we + WE_GU / 2 + (size_t)e * DM * DM, 64 * kb, n0, (n0 >> 7) * 256 + up * 128 + (n0 & 127), scr, F.lane); continue; } r -= 2 * CV_EX;
        { const int e = r / 256, q2 = r % 256, kb = q2 / 32, nb = q2 % 32; transpose_item(A->in[30] + ((size_t)l * NE + e) * DE * DM, DE, DM, we + WE_DT / 2 + (size_t)e * DM * DE, 64 * kb, 32 * nb, 32 * nb, scr, F.lane); }
    }
}

__device__ __forceinline__ void phase_prologue(const Frame& F, ArgP A) {
    {   LAS float* cond = (LAS float*)(F.lds);
        float* modp = (float*)(A->ws + WS_MODP);
        for (int it = F.vcu; it < NL * 24 * 4; it += F.G) { const int l = it / 96, r = it % 96, nb = r / 4, kq = r % 4;
            __syncthreads();
            for (int e = F.tid; e < 8 * 256; e += NTHR) { const float cv = A->in[1][(e >> 8) * DM + kq * 256 + (e & 255)]; cond[e] = cv * sigmoidf_(cv); }
            __syncthreads();
            const int n = nb * 256 + (F.tid & 255), kh = F.tid >> 8; float acc[8];
#pragma unroll
            for (int b = 0; b < 8; ++b) acc[b] = 0.f;
            const float* wp = A->in[2] + ((size_t)l * DM + kq * 256 + kh * 128) * 6144 + n;
#pragma unroll 4
            for (int k = 0; k < 128; ++k) { const float wv = wp[(size_t)k * 6144];
#pragma unroll
                for (int b = 0; b < 8; ++b) acc[b] += cond[b * 256 + kh * 128 + k] * wv; }
            const int kp = kq * 2 + kh;
#pragma unroll
            for (int b = 0; b < 8; ++b) modp[(((size_t)kp * NL + l) * NB + b) * 6144 + n] = acc[b]; }
        __syncthreads();
    }
    conv_layer(F, A, 0);
    {   bf16* lo = (bf16*)(A->ws + WS_LORA); const int gt = F.vcu * NTHR + F.tid, NGT = F.G * NTHR;
        for (int e = gt; e < NL * 512 * 64; e += NGT) { const int l = e / 32768, r = e % 32768, c = r >> 6, j = r & 63;
            lo[(size_t)l * 131072 + c * 64 + j] = (bf16)f2bf(A->in[11][(size_t)l * 32768 + j * 512 + c]);
            lo[(size_t)l * 131072 + 32768 + c * 64 + j] = (bf16)f2bf(A->in[13][(size_t)l * 32768 + j * 512 + c]); }
        for (int e = gt; e < NL * 512 * 128; e += NGT) { const int l = e / 65536, r = e % 65536, c = r >> 7, j = r & 127;
            lo[(size_t)l * 131072 + 65536 + c * 128 + j] = (bf16)f2bf(A->in[14][(size_t)l * 65536 + j * 512 + c]); }
    }
    if (F.vcu == 0) { float* sm = (float*)(A->ws + WS_SMALL);
        { const int k = F.tid; float z[4], mx = -1e30f;
#pragma unroll
          for (int l = 0; l < 4; ++l) { z[l] = A->in[5][l * 512 + k]; mx = fmaxf(mx, z[l]); }
          float s = 0.f;
#pragma unroll
          for (int l = 0; l < 4; ++l) { z[l] = __expf(z[l] - mx); s += z[l]; }
          const float inv = 1.0f / s;
          sm[SM_HGLB + k] = 0.f; sm[SM_HGLB + 512 + k] = z[1] * inv; sm[SM_HGLB + 1024 + k] = (z[1] + z[2]) * inv; sm[SM_HGLB + 1536 + k] = (z[1] + z[2] + z[3]) * inv; }
        if (F.wave < 4) { const int l = F.wave; const float* dl = A->in[7] + l * 256;
            const float s1 = wave_sum(dl[F.lane] * dl[64 + F.lane]), s2 = wave_sum(dl[128 + F.lane] * dl[192 + F.lane]);
            const float li = 0.8f - 0.6f * expf(-0.3f * (float)l);
            if (F.lane == 0) { sm[SM_LAM + l] = expf(s1) - expf(s2) + li; sm[SM_LAM + 4 + l] = 1.0f - li; } }
    }
}
__device__ __forceinline__ float mod_from_partials(ArgP A, int l, int b, int n) {
    const float* mp = (const float*)(A->ws + WS_MODP) + ((size_t)l * NB + b) * 6144 + n; float s = A->in[3][l * 6144 + n];
#pragma unroll
    for (int kp = 0; kp < 8; ++kp) s += mp[(size_t)kp * NL * NB * 6144];
    return s;
}
__device__ __forceinline__ void phase_mod_u0(const Frame& F, ArgP A) {
    float* mod = (float*)(A->ws + WS_MOD);
    for (int e = F.vcu * NTHR + F.tid; e < NL * NB * 6144; e += F.G * NTHR) { const int l = e / (NB * 6144), r = e % (NB * 6144); mod[e] = mod_from_partials(A, l, r / 6144, r % 6144); }
    bf16* U = (bf16*)(A->ws + WS_U);
    for (int rb = F.vcu; rb < M / 128; rb += F.G) { const int b = rb / 32;
        float sh[16], sc[16];
#pragma unroll
        for (int j = 0; j < 4; ++j)
#pragma unroll
            for (int i = 0; i < 4; ++i) { const int c = 4 * F.lane + 256 * j + i; sh[j * 4 + i] = mod_from_partials(A, 0, b, c); sc[j * 4 + i] = 1.0f + mod_from_partials(A, 0, b, 1024 + c); }
        for (int i = 0; i < 16; ++i) { const size_t row = (size_t)rb * 128 + F.wave * 16 + i;
            const f32x4* xr = (const f32x4*)(A->in[0] + row * DM) + F.lane; v2u* ur = (v2u*)(U + row * UP_) + F.lane;
#pragma unroll
            for (int j = 0; j < 4; ++j) { const f32x4 v = xr[64 * j]; v2u w; w.x = pk2(v[0] * sc[j * 4 + 0] + sh[j * 4 + 0], v[1] * sc[j * 4 + 1] + sh[j * 4 + 1]); w.y = pk2(v[2] * sc[j * 4 + 2] + sh[j * 4 + 2], v[3] * sc[j * 4 + 3] + sh[j * 4 + 3]); ur[64 * j] = w; } }
    }
}

__device__ __forceinline__ void phase_ln1(const Frame& F, ArgP A, int l) {
    const float* mod = (const float*)(A->ws + WS_MOD);
    const bf16* MIX = (const bf16*)(A->ws + WS_MIX); bf16* U = (bf16*)(A->ws + WS_U);
    const float* xin = (l == 0) ? A->in[0] : A->out;
    LAS float* wrT = (LAS float*)(F.lds);
    LAS int* te = (LAS int*)(F.lds + 65536);
    LAS int* tbase = (LAS int*)(F.lds + 65536 + 1024);
    int* tokpos = (int*)(A->ws + WS_TOK); float* tokw = (float*)(A->ws + WS_TOK + (size_t)M * 8);
    __syncthreads();
    for (int e = F.tid; e < 16 * 1024; e += NTHR) { const int ex = e >> 10, k = e & 1023; wrT[e] = A->in[26][k * 16 + ex]; }
    __syncthreads();
    float rb_[16];
#pragma unroll
    for (int e = 0; e < 16; ++e) rb_[e] = A->in[27][e];
    for (int rb = F.vcu; rb < M / 128; rb += F.G) { const int b = rb / 32; const float* mb = mod + ((size_t)l * NB + b) * 6144;
        float g1[16], sh2[16], sc2[16], lg[16], lb[16];
#pragma unroll
        for (int j = 0; j < 4; ++j)
#pragma unroll
            for (int i = 0; i < 4; ++i) { const int c = 4 * F.lane + 256 * j + i, q = j * 4 + i; g1[q] = 1.0f + mb[2048 + c]; sh2[q] = mb[3072 + c]; sc2[q] = 1.0f + mb[4096 + c]; lg[q] = A->in[24][(l * 2 + 0) * DM + c]; lb[q] = A->in[25][(l * 2 + 0) * DM + c]; }
#pragma unroll 1
        for (int i = 0; i < 16; ++i) { const int tl = F.wave * 16 + i; const size_t row = (size_t)rb * 128 + tl;
            const f32x4* xr = (const f32x4*)(xin + row * DM) + F.lane; const v2u* mr = (const v2u*)(MIX + row * DM) + F.lane;
            float y[16]; float s = 0.f;
#pragma unroll
            for (int j = 0; j < 4; ++j) { const f32x4 v = xr[64 * j]; const v2u m2 = mr[64 * j];
                y[j * 4 + 0] = ALPHA * v[0] + g1[j * 4 + 0] * bflo(m2.x); y[j * 4 + 1] = ALPHA * v[1] + g1[j * 4 + 1] * bfhi(m2.x);
                y[j * 4 + 2] = ALPHA * v[2] + g1[j * 4 + 2] * bflo(m2.y); y[j * 4 + 3] = ALPHA * v[3] + g1[j * 4 + 3] * bfhi(m2.y);
                s += (y[j * 4] + y[j * 4 + 1]) + (y[j * 4 + 2] + y[j * 4 + 3]); }
            const float mean = wave_sum(s) * (1.0f / DM); float q = 0.f;
#pragma unroll
            for (int k = 0; k < 16; ++k) { y[k] -= mean; q += y[k] * y[k]; }
            const float rstd = rsqrtf(wave_sum(q) * (1.0f / DM) + LN_EPS);
            f32x4* xo = (f32x4*)(A->out + row * DM) + F.lane; v2u* ur = (v2u*)(U + row * UP_) + F.lane; float u2[16];
#pragma unroll
            for (int j = 0; j < 4; ++j) { f32x4 o;
#pragma unroll
                for (int k = 0; k < 4; ++k) { o[k] = y[j * 4 + k] * rstd * lg[j * 4 + k] + lb[j * 4 + k]; u2[j * 4 + k] = o[k] * sc2[j * 4 + k] + sh2[j * 4 + k]; }
                xo[64 * j] = o; v2u w; w.x = pk2(u2[j * 4], u2[j * 4 + 1]); w.y = pk2(u2[j * 4 + 2], u2[j * 4 + 3]); ur[64 * j] = w; }
            float sc[16]; float mx = -1e30f;
#pragma unroll
            for (int e = 0; e < 16; ++e) { float p = 0.f;
#pragma unroll
                for (int j = 0; j < 4; ++j) { const f32x4 wv = *(const LAS f32x4*)(wrT + e * 1024 + 4 * F.lane + 256 * j); p += (u2[j * 4] * wv[0] + u2[j * 4 + 1] * wv[1]) + (u2[j * 4 + 2] * wv[2] + u2[j * 4 + 3] * wv[3]); }
                sc[e] = wave_sum(p); mx = fmaxf(mx, sc[e]); }
            float den = 0.f;
#pragma unroll
            for (int e = 0; e < 16; ++e) { sc[e] = __expf(sc[e] - mx); den += sc[e]; }
            const float iden = 1.0f / den; float sel[16];
#pragma unroll
            for (int e = 0; e < 16; ++e) { sc[e] *= iden; sel[e] = sc[e] + rb_[e]; }
            int bg = 0; float bgs = -1e30f;
#pragma unroll
            for (int gq = 0; gq < 4; ++gq) { float m1 = -1e30f, m2 = -1e30f;
#pragma unroll
                for (int k = 0; k < 4; ++k) { const float v = sel[gq * 4 + k]; if (v > m1) { m2 = m1; m1 = v; } else if (v > m2) m2 = v; }
                const float gs = m1 + m2; if (gs > bgs) { bgs = gs; bg = gq; } }
            int i0 = 0, i1 = 0; float v0 = -1e30f, v1 = -1e30f, w0 = 0.f, w1 = 0.f;
#pragma unroll
            for (int e = 0; e < 16; ++e) { if ((e >> 2) == bg) { const float v = sel[e]; if (v > v0) { v1 = v0; i1 = i0; w1 = w0; v0 = v; i0 = e; w0 = sc[e]; } else if (v > v1) { v1 = v; i1 = e; w1 = sc[e]; } } }
            const float iw = 1.0f / (w0 + w1);
            if (F.lane == 0) { te[tl * 2] = i0; te[tl * 2 + 1] = i1; tokw[row * 2] = w0 * iw; tokw[row * 2 + 1] = w1 * iw; }
        }
        __syncthreads();
        if (F.tid < 16) { int n = 0; for (int k = 0; k < 256; ++k) n += (te[k] == F.tid) ? 1 : 0;
            tbase[F.tid] = (int)__hip_atomic_fetch_add(F.ctl + CW_ECNT + 64 * l + F.tid, (unsigned)n, RLX_AGENT);
            int p = tbase[F.tid];
            for (int k = 0; k < 256; ++k) if (te[k] == F.tid) { tokpos[(size_t)rb * 256 + k] = (F.tid << 24) | p; ++p; } }
        __syncthreads();
    }
}
__device__ __forceinline__ void load_hb(const Frame& F, int l, volatile LAS int* hb, int c) {
    __syncthreads();
    if (F.tid == 0) { int acc = 0; for (int e = 0; e < 16; ++e) { hb[e] = acc; const int cn = (int)__hip_atomic_load(F.ctl + CW_ECNT + 64 * l + e, RLX_AGENT); acc += (cn + 255) & ~255; } hb[16] = acc; hb[17] = acc >> 8;
        const int nun = (acc >> 8) * 4; int n = 0;
        for (int L = c; L < nun && n < 12; L += F.G) { const int j = L >> 2, pn = L & 3; int e = 0; for (int k = 1; k < 16; ++k) e = (hb[k] <= j * 256) ? k : e; hb[19 + n] = (j << 8) | (pn << 4) | e; ++n; }
        hb[18] = n; }
    __syncthreads();
}
__device__ __forceinline__ void phase_scatter(const Frame& F, ArgP A, int l) {
    volatile LAS int* hb = (volatile LAS int*)(F.lds + 4096);
    load_hb(F, l, hb, 0);
    const int* tokpos = (const int*)(A->ws + WS_TOK); int* tokrow = (int*)(A->ws + WS_TOK + (size_t)M * 16);
    const bf16* U = (const bf16*)(A->ws + WS_U); bf16* AS = (bf16*)(A->ws + WS_AS);
    for (int rb = F.vcu; rb < M / 128; rb += F.G) {
        for (int i = 0; i < 32; ++i) { const int k = F.wave * 32 + i; const size_t idx = (size_t)rb * 256 + k; const int tp = tokpos[idx]; const int e = tp >> 24, pos = tp & 0xffffff;
            const int row = hb[e] + pos; const size_t tok = idx >> 1;
            const v4u* src = (const v4u*)(U + tok * UP_) + F.lane; v4u* dst = (v4u*)(AS + (size_t)row * DM) + F.lane;
            const v4u a = src[0], c = src[64]; dst[0] = a; dst[64] = c;
            if (F.lane == 0) tokrow[idx] = row; }
    }
}
__device__ __forceinline__ void phase_ln2(const Frame& F, ArgP A, int l) {
    const float* mod = (const float*)(A->ws + WS_MOD);
    const bf16* Y = (const bf16*)(A->ws + WS_Y); bf16* U = (bf16*)(A->ws + WS_U);
    const int* tokrow = (const int*)(A->ws + WS_TOK + (size_t)M * 16); const float* tokw = (const float*)(A->ws + WS_TOK + (size_t)M * 8);
    for (int rb = F.vcu; rb < M / 128; rb += F.G) { const int b = rb / 32; const float* mb = mod + ((size_t)l * NB + b) * 6144; const float* mn = mod + ((size_t)(l < NL - 1 ? l + 1 : l) * NB + b) * 6144;
        float g2[16], sh1[16], sc1[16], lg[16], lb[16];
#pragma unroll
        for (int j = 0; j < 4; ++j)
#pragma unroll
            for (int i = 0; i < 4; ++i) { const int c = 4 * F.lane + 256 * j + i, q = j * 4 + i; g2[q] = 1.0f + mb[5120 + c]; sh1[q] = mn[c]; sc1[q] = 1.0f + mn[1024 + c]; lg[q] = A->in[24][(l * 2 + 1) * DM + c]; lb[q] = A->in[25][(l * 2 + 1) * DM + c]; }
#pragma unroll 1
        for (int i = 0; i < 16; ++i) { const size_t row = (size_t)rb * 128 + F.wave * 16 + i;
            const int r0 = tokrow[row * 2], r1 = tokrow[row * 2 + 1]; const float w0 = tokw[row * 2], w1 = tokw[row * 2 + 1];
            const f32x4* xr = (const f32x4*)(A->out + row * DM) + F.lane; const v2u* y0 = (const v2u*)(Y + (size_t)r0 * DM) + F.lane; const v2u* y1 = (const v2u*)(Y + (size_t)r1 * DM) + F.lane;
            float y[16]; float s = 0.f;
#pragma unroll
            for (int j = 0; j < 4; ++j) { const f32x4 v = xr[64 * j]; const v2u a = y0[64 * j], c = y1[64 * j];
                y[j * 4 + 0] = ALPHA * v[0] + g2[j * 4 + 0] * (w0 * bflo(a.x) + w1 * bflo(c.x)); y[j * 4 + 1] = ALPHA * v[1] + g2[j * 4 + 1] * (w0 * bfhi(a.x) + w1 * bfhi(c.x));
                y[j * 4 + 2] = ALPHA * v[2] + g2[j * 4 + 2] * (w0 * bflo(a.y) + w1 * bflo(c.y)); y[j * 4 + 3] = ALPHA * v[3] + g2[j * 4 + 3] * (w0 * bfhi(a.y) + w1 * bfhi(c.y));
                s += (y[j * 4] + y[j * 4 + 1]) + (y[j * 4 + 2] + y[j * 4 + 3]); }
            const float mean = wave_sum(s) * (1.0f / DM); float q = 0.f;
#pragma unroll
            for (int k = 0; k < 16; ++k) { y[k] -= mean; q += y[k] * y[k]; }
            const float rstd = rsqrtf(wave_sum(q) * (1.0f / DM) + LN_EPS);
            f32x4* xo = (f32x4*)(A->out + row * DM) + F.lane; v2u* ur = (v2u*)(U + row * UP_) + F.lane;
#pragma unroll
            for (int j = 0; j < 4; ++j) { f32x4 o; float u[4];
#pragma unroll
                for (int k = 0; k < 4; ++k) { o[k] = y[j * 4 + k] * rstd * lg[j * 4 + k] + lb[j * 4 + k]; u[k] = o[k] * sc1[j * 4 + k] + sh1[j * 4 + k]; }
                xo[64 * j] = o; if (l < NL - 1) { v2u w; w.x = pk2(u[0], u[1]); w.y = pk2(u[2], u[3]); ur[64 * j] = w; } }
        }
    }
}
struct SchedProj {
    static constexpr unsigned LDA = UP_ * 2, LDB = 2048; static constexpr int NT = 16; static constexpr bool VARNT = false;
    const char* U; const char* W; int G, c;
    __device__ __forceinline__ bool next(int i, pg8::GUnit& u, pg8::GOps& o) const { int pm, pn; if (!pg8::static_tile(M / 256, INW / 256, G, c, i, pm, pn)) return false;
        o.A = U + (size_t)pm * 256 * LDA; o.B = W + (size_t)pn * 256 * 2048; u.kind = 0; u.r0 = pm * 256; u.c0 = pn * 256; u.aux = (pn == 8 || pn == 9) ? 1 : 0; return true; }
};
struct SchedBranch {
    static constexpr unsigned LDA = 3072, LDB = 3072; static constexpr int NT = 16; static constexpr bool VARNT = true;
    const char* U; const char* WM; const char* OC; const char* WB; int G, c;
    __device__ __forceinline__ bool next(int i, pg8::GUnit& u, pg8::GOps& o) const { int pm, pn; if (!pg8::static_tile(M / 256, 4, G, c, i >> 2, pm, pn)) return false; const int sub = i & 3;
        u.r0 = pm * 256; u.c0 = pn * 256;
        if (sub < 3) { o.A = U + (size_t)pm * 256 * 3072; o.B = WM + ((size_t)sub * 1024 + pn * 256) * 3072; o.nt = 16; u.kind = 1; u.aux = sub; }
        else { o.A = OC + (size_t)pm * 256 * 3072; o.B = WB + (size_t)pn * 256 * 3072; o.nt = 24; u.kind = 2; u.aux = 0; }
        return true; }
};
struct SchedOut {
    static constexpr unsigned LDA = 2048, LDB = 2048; static constexpr int NT = 16; static constexpr bool VARNT = false;
    const char* Am; const char* W; int G, c;
    __device__ __forceinline__ bool next(int i, pg8::GUnit& u, pg8::GOps& o) const { int pm, pn; if (!pg8::static_tile(M / 256, 4, G, c, i, pm, pn)) return false;
        o.A = Am + (size_t)pm * 256 * 2048; o.B = W + (size_t)pn * 256 * 2048; u.kind = 0; u.r0 = pm * 256; u.c0 = pn * 256; u.aux = 0; return true; }
};
template <int UP> struct SchedMoe {
    static constexpr unsigned LDA = UP ? 2048 : 1024, LDB = LDA; static constexpr int NT = UP ? 16 : 8; static constexpr bool VARNT = false;
    const char* Am; const char* W; volatile LAS int* hb;
    __device__ __forceinline__ bool next(int i, pg8::GUnit& u, pg8::GOps& o) const { const int n = __builtin_amdgcn_readfirstlane(hb[18]); if (i >= n) return false;
        const int pk = __builtin_amdgcn_readfirstlane(hb[19 + i]); const int j = pk >> 8, pn = (pk >> 4) & 15, e = pk & 15;
        u.r0 = j * 256; u.aux = 0; u.kind = UP ? 3 : 0; u.c0 = UP ? pn * 128 : pn * 256;
        o.A = Am + (size_t)j * 256 * LDA; o.B = W + ((size_t)e * 1024 + pn * 256) * LDB;
        return true; }
};

constexpr int NPH = 2 + 9 * NL;
#ifndef PH_MASK
#define PH_MASK 0xffff
#endif
#define PHM(b) ((PH_MASK >> (b)) & 1)
__global__ void __launch_bounds__(NTHR, 2) hybrid_fwd(Args args) {
    extern __shared__ __attribute__((aligned(16))) unsigned char lds[];
    Frame F; unsigned char* ws; ArgP A;
#define FRESH() do { int t_ = threadIdx.x; asm volatile("" : "+v"(t_)); { unsigned long long p_ = (unsigned long long)__builtin_amdgcn_kernarg_segment_ptr(); asm volatile("" : "+s"(p_)); A = (ArgP)p_; } ws = A->ws; \
        F.lds = (LAS unsigned char*)lds; F.MISC = (volatile LAS unsigned*)(F.lds + MISC_OFF); F.tid = t_; F.lane = t_ & 63; F.wave = __builtin_amdgcn_readfirstlane(t_ >> 6); \
        { int g_ = gridDim.x, b_ = blockIdx.x; asm volatile("" : "+s"(g_), "+s"(b_)); F.G = g_; F.bx = b_; F.vcu = (g_ % 8 == 0) ? (b_ % 8) * (g_ / 8) + b_ / 8 : b_; } F.ctl = (gu32*)(ws + WS_CTL); } while (0)
    FRESH();
    for (int u = F.tid; u < (LDS_BYTES - LDSCTL_OFF) / 4; u += NTHR) ((LAS unsigned*)(F.lds + LDSCTL_OFF))[u] = 0u;
    __syncthreads();
    XcdBarrier bar; bar.bar = (unsigned*)(ws + WS_CTL) + CW_BAR; bar.x = 0; bar.st = nullptr;
    if (!MK_PER_PHASE) bar = xcd_barrier_post((unsigned*)(ws + WS_CTL) + CW_BAR, F.MISC + 8);
    const int lo = A->ph_lo, hi = A->ph_hi;
#define IN(k) (lo <= (k) && (k) < hi)
#define SEAM(k) do { if (IN(k) && IN((k) + 1)) xcd_barrier(bar); } while (0)

    if (PHM(0) && IN(0)) { FRESH(); phase_prologue(F, A); SEAM(0); }
    if (PHM(1) && IN(1)) { FRESH(); phase_mod_u0(F, A); SEAM(1); }

#pragma unroll 1
    for (int l = 0; l < NL; ++l) {
        const int pb = 2 + 9 * l;
        if (PHM(2) && IN(pb + 0)) {
            FRESH(); const char* WA = (const char*)(ws + WS_WA); const char* WE = (const char*)(ws + WS_WE); (void)WA; (void)WE;
            SchedProj S{(const char*)(ws + WS_U), WA + WA_IN, F.G, F.bx};
            pg8::Epi<1> E{(bf16*)(ws + WS_PROJ), INW, C2Q, nullptr, nullptr};
            pg8::gemm_phase<false>(F.lds, S, E);
            SEAM(pb + 0);
        }
        if (IN(pb + 1)) {
            FRESH();
            const float* sm = (const float*)(ws + WS_SMALL);
            MixP P;
            P.proj = (const bf16*)(ws + WS_PROJ); P.ocat = (bf16*)(ws + WS_OCAT); P.oatt = (bf16*)(ws + WS_OATT);
            P.hg_lb = sm + SM_HGLB + l * 512; P.hg_norm_g = A->in[6] + l * 128; P.lam = sm[SM_LAM + l]; P.one_m_lam_init = sm[SM_LAM + 4 + l]; P.da_subln_g = A->in[8] + l * 128;
            P.rw_mu = A->in[9] + l * 1792; P.rw_w0 = A->in[10] + l * 512; P.rw_a0 = A->in[12] + l * 512; P.rw_k_k = A->in[15] + l * 512; P.rw_k_a = A->in[16] + l * 512;
            P.rw_r_k = A->in[17] + l * 512; P.rw_gn_g = A->in[18] + l * 512; P.rw_gn_b = A->in[19] + l * 512;
            const bf16* lo_ = (const bf16*)(ws + WS_LORA) + (size_t)l * 131072; P.wupT = lo_; P.aupT = lo_ + 32768; P.gupT = lo_ + 65536;
            P.aq = F.ctl + CW_AQ + 64 * l;
            if (F.G >= 128) {
                if (PHM(3) && F.vcu < 64) rwkv_unit(P, F.vcu >> 3, F.vcu & 7, F.lds);
                else if (PHM(4) && F.vcu < 96) hgrn_unit(P, (F.vcu - 64) >> 2, (F.vcu - 64) & 3, F.lds);
                else if (PHM(5)) attn_worker(P, (char*)lds, F.MISC + 16, F.tid);
            }
            SEAM(pb + 1);
        }
        if (PHM(6) && IN(pb + 2)) {
            FRESH(); const char* WA = (const char*)(ws + WS_WA); const char* WE = (const char*)(ws + WS_WE); (void)WA; (void)WE;
            SchedBranch S{(const char*)(ws + WS_U), WA + WA_MERGE, (const char*)(ws + WS_OCAT), WA + WA_BRANCH, F.G, F.bx};
            pg8::Epi<6> E{(bf16*)(ws + WS_MERGED), DM, 1.0f, A->in[21] + (size_t)l * 3 * DM, (v4u*)(ws + WS_GSCR) + (size_t)F.bx * 3 * 16 * 512};
            pg8::gemm_phase<false>(F.lds, S, E);
            SEAM(pb + 2);
        }
        if (PHM(7) && IN(pb + 3)) {
            FRESH(); const char* WA = (const char*)(ws + WS_WA); const char* WE = (const char*)(ws + WS_WE); (void)WA; (void)WE;
            SchedOut S{(const char*)(ws + WS_MERGED), WA + WA_OUT, F.G, F.bx};
            pg8::Epi<1> E{(bf16*)(ws + WS_MIX), DM, 1.0f, nullptr, nullptr};
            pg8::gemm_phase<false>(F.lds, S, E);
            SEAM(pb + 3);
        }
        if (PHM(8) && IN(pb + 4)) { FRESH(); phase_ln1(F, A, l); SEAM(pb + 4); }
        if (PHM(9) && IN(pb + 5)) { FRESH(); phase_scatter(F, A, l); SEAM(pb + 5); }
        if (PHM(10) && IN(pb + 6)) {
            FRESH(); const char* WA = (const char*)(ws + WS_WA); const char* WE = (const char*)(ws + WS_WE); (void)WA; (void)WE;
            volatile LAS int* hb = (volatile LAS int*)(F.lds + LDSCTL_OFF + 128);
            load_hb(F, l, hb, F.bx);
            SchedMoe<1> S{(const char*)(ws + WS_AS), WE + WE_GU, hb};
            pg8::Epi<8> E{(bf16*)(ws + WS_H), DE, 1.0f, nullptr, nullptr};
            pg8::gemm_phase<false>(F.lds, S, E);
            SEAM(pb + 6);
        }
        if (PHM(11) && IN(pb + 7)) {
            FRESH(); const char* WA = (const char*)(ws + WS_WA); const char* WE = (const char*)(ws + WS_WE); (void)WA; (void)WE;
            volatile LAS int* hb = (volatile LAS int*)(F.lds + LDSCTL_OFF + 128);
            load_hb(F, l, hb, F.bx);
            SchedMoe<0> S{(const char*)(ws + WS_H), WE + WE_DT, hb};
            pg8::Epi<1> E{(bf16*)(ws + WS_Y), DM, 1.0f, nullptr, nullptr};
            pg8::gemm_phase<false>(F.lds, S, E);
            SEAM(pb + 7);
        }
        if (PHM(12) && IN(pb + 8)) { FRESH(); if (l < NL - 1) conv_layer(F, A, l + 1); phase_ln2(F, A, l); SEAM(pb + 8); }
    }
#undef IN
#undef SEAM
}

extern "C" void kernel_launch(void* const* d_in, const int* in_sizes, int n_in, void* d_out, int out_size, void* d_ws, size_t ws_size, hipStream_t stream) {
    static int grid = 0;
    if (grid == 0) {
        if (n_in != 31 || out_size != M * DM || ws_size < WS_END) { fprintf(stderr, "kernel_launch: unexpected shapes (n_in %d, out %d, ws %zu < %zu); nothing launched\n", n_in, out_size, ws_size, (size_t)WS_END); grid = -1; return; }
        int dev = 0, cus = 0, per_cu = 0;
        if (hipGetDevice(&dev) != hipSuccess || hipDeviceGetAttribute(&cus, hipDeviceAttributeMultiprocessorCount, dev) != hipSuccess) { grid = -1; return; }
        if (hipFuncSetAttribute((const void*)hybrid_fwd, hipFuncAttributeMaxDynamicSharedMemorySize, LDS_BYTES) != hipSuccess) { fprintf(stderr, "kernel_launch: hipFuncSetAttribute failed\n"); grid = -1; return; }
        if (hipOccupancyMaxActiveBlocksPerMultiprocessor(&per_cu, (const void*)hybrid_fwd, NTHR, LDS_BYTES) != hipSuccess || per_cu < 1) { fprintf(stderr, "kernel_launch: occupancy query reports %d\n", per_cu); }
        (void)hipGetLastError();
        grid = cus;
        if (grid > 256) grid = 256;
    }
    if (grid < 0) return;
    (void)hipMemsetAsync((char*)d_ws + WS_CTL, 0, CTL_ZERO_BYTES, stream);
    Args a{};
    for (int i = 0; i < 31; ++i) a.in[i] = (const float*)d_in[i];
    a.out = (float*)d_out; a.ws = (unsigned char*)d_ws;
#if MK_PER_PHASE
    for (int p = 0; p < NPH; ++p) { a.ph_lo = p; a.ph_hi = p + 1; hipLaunchKernelGGL(hybrid_fwd, dim3(grid), dim3(NTHR), LDS_BYTES, stream, a); }
#else
    a.ph_lo = 0; a.ph_hi = NPH; hipLaunchKernelGGL(hybrid_fwd, dim3(grid), dim3(NTHR), LDS_BYTES, stream, a);
#endif
}
```

```cpp
#include <hip/hip_runtime.h>
#include <hip/hip_bf16.h>
#include <cstdio>
#include <cstdint>

#ifndef MK_PER_PHASE
#define MK_PER_PHASE 0
#endif

#define GAS __attribute__((address_space(1)))
#define LAS __attribute__((address_space(3)))
typedef unsigned short bf16;
typedef unsigned v4u __attribute__((ext_vector_type(4)));
typedef unsigned v2u __attribute__((ext_vector_type(2)));
typedef float f32x4 __attribute__((ext_vector_type(4)));
typedef float f32x2 __attribute__((ext_vector_type(2)));
typedef float f32x16 __attribute__((ext_vector_type(16)));
typedef short bf16x8 __attribute__((ext_vector_type(8)));
typedef short s16x4 __attribute__((ext_vector_type(4)));
typedef GAS unsigned gu32;
#define RLX_AGENT __ATOMIC_RELAXED, __HIP_MEMORY_SCOPE_AGENT
#define LDS_WAIT() asm volatile("s_waitcnt lgkmcnt(0)" ::: "memory")
#define VM_WAIT() asm volatile("s_waitcnt vmcnt(0)" ::: "memory")

constexpr int DM = 1024, NB = 8, T = 4096, NL = 4, M = NB * T;
constexpr int INW = 5376;
constexpr int C_HGQ = 0, C_HGF = 512, C_HGI = 1024, C_HGO = 1536, C_DAQ = 2048, C_DAK = 2560, C_DAV = 3072, C_RW = 3584;
constexpr int C_RWR = C_RW, C_RWK = C_RW + 512, C_RWV = C_RW + 1024, C_RWWD = C_RW + 1536, C_RWAD = C_RW + 1600, C_RWGD = C_RW + 1664;
constexpr int NE = 16, DE = 512;
constexpr float ALPHA = 1.681792830507429f;
constexpr float LN_EPS = 1e-5f, RMS_EPS = 1e-6f, RW_GN_EPS = 64e-5f, HG_F_MIN = 1e-6f;
constexpr float LOG2E = 1.4426950408889634f;
constexpr float C2Q = 0.125f * LOG2E;

constexpr size_t MiB = 1u << 20;
constexpr size_t WS_CTL = 0, CTL_ZERO_BYTES = 1 * MiB;
constexpr size_t WS_MODP = 1 * MiB;
constexpr size_t WS_MOD = 7 * MiB;
constexpr size_t WS_SMALL = 8 * MiB;
constexpr size_t WS_TOK = 9 * MiB;
constexpr size_t WS_LORA = 11 * MiB;
constexpr int UP_ = 1536;
constexpr size_t WS_WA = 12 * MiB;
constexpr size_t WA_IN = 0, WA_MERGE = (size_t)INW * DM * 2, WA_BRANCH = WA_MERGE + (size_t)3 * DM * UP_ * 2, WA_OUT = WA_BRANCH + (size_t)DM * 1536 * 2, WA_END = WA_OUT + (size_t)DM * DM * 2;
constexpr size_t WS_WE = 40 * MiB;
constexpr size_t WE_GU = 0, WE_DT = (size_t)32 * MiB;
constexpr size_t WS_U = 88 * MiB;
constexpr size_t WS_PROJ = 184 * MiB;
constexpr size_t WS_OCAT = 520 * MiB;
constexpr size_t WS_OATT = 616 * MiB;
constexpr size_t WS_END = 680 * MiB;
constexpr size_t WS_GSCR = WS_PROJ;
constexpr size_t WS_MERGED = WS_PROJ + 96 * MiB;
constexpr size_t WS_MIX = WS_PROJ + 160 * MiB;
constexpr size_t WS_AS = WS_PROJ;
constexpr size_t WS_H = WS_PROJ + 224 * MiB;
constexpr size_t WS_Y = WS_OCAT;
constexpr int MAXROWS = 2 * M + NE * 256;
static_assert(WA_END <= 28 * MiB, "WA");
static_assert((size_t)MAXROWS * 2048 <= 160 * MiB && (size_t)MAXROWS * 1024 <= 112 * MiB, "moe buffers");

constexpr int CW_TMO = 0, CW_CODE = 1;
constexpr int CW_BAR = 4096;
constexpr int CW_ECNT = 16384;
constexpr int CW_AQ = 20480;

constexpr int RING_BYTES = 131072;
constexpr int LDSCTL_OFF = RING_BYTES, MISC_OFF = LDSCTL_OFF + 320;
constexpr int LDS_BYTES = 147456;
constexpr int NWAVES = 8, NTHR = 512;

__device__ __forceinline__ unsigned f2bf(float f) { unsigned u = __builtin_bit_cast(unsigned, f); return (u + 0x7fffu + ((u >> 16) & 1u)) >> 16; }
__device__ __forceinline__ unsigned pk2(float lo, float hi) { return f2bf(lo) | (f2bf(hi) << 16); }
__device__ __forceinline__ float bf2f(unsigned short b) { return __builtin_bit_cast(float, ((unsigned)b) << 16); }
__device__ __forceinline__ float bflo(unsigned w) { return __builtin_bit_cast(float, w << 16); }
__device__ __forceinline__ float bfhi(unsigned w) { return __builtin_bit_cast(float, w & 0xffff0000u); }
__device__ __forceinline__ unsigned cvt_pk_bf16(float lo, float hi) { unsigned r; asm volatile("v_cvt_pk_bf16_f32 %0, %1, %2" : "=v"(r) : "v"(lo), "v"(hi)); return r; }
__device__ __forceinline__ float sigmoidf_(float x) { return 1.0f / (1.0f + __expf(-x)); }
__device__ __forceinline__ float wave_sum(float v) {
#pragma unroll
    for (int o = 1; o < 64; o <<= 1) v += __shfl_xor(v, o);
    return v;
}

#define XB_TMO      128
#define XB_XCNT(j)  (256  + 64 * (j))
#define XB_XSUB(j)  (1280 + 64 * (j))
#define XB_XGEN(j)  (2304 + 64 * (j))
#define XB_TOP      3328
#define XB_TOPGEN   3392
#define XCD_BAR_WORDS 3456
#define XB_SPIN_CAP (1u << 20)

__device__ __forceinline__ unsigned xb_ld(unsigned* p)              { return __hip_atomic_load(p, __ATOMIC_RELAXED, __HIP_MEMORY_SCOPE_AGENT); }
__device__ __forceinline__ unsigned xb_add(unsigned* p, unsigned v) { return __hip_atomic_fetch_add(p, v, __ATOMIC_RELAXED, __HIP_MEMORY_SCOPE_AGENT); }
__device__ __forceinline__ unsigned xb_xcc_id() { return (unsigned)__builtin_amdgcn_s_getreg((3 << 11) | 20) & 0xFu; }
#define XB_SPIN(cond, bar) do { unsigned _sp = 0; while (cond) { __builtin_amdgcn_s_sleep(1); \
    if ((++_sp & 255u) == 0u) { if (xb_ld(&(bar)[XB_TMO])) break; if (_sp > XB_SPIN_CAP) { atomicAdd(&(bar)[XB_TMO], 1u); break; } } } } while (0)

struct XcdBarrier { unsigned* bar; unsigned x; volatile LAS unsigned* st; };

__device__ __forceinline__ XcdBarrier xcd_barrier_post(unsigned* bar, volatile LAS unsigned* st) {
    XcdBarrier b; b.bar = bar; b.x = xb_xcc_id(); b.st = st;
    if (threadIdx.x == 0) (void)xb_add(&bar[XB_XCNT(b.x)], 1u);
    return b;
}
__device__ __forceinline__ void xcd_barrier_complete(unsigned* bar, unsigned x, unsigned& nloc, unsigned& nx) {
    const unsigned G = gridDim.x * gridDim.y * gridDim.z;
    unsigned sum, cnt, mine, sp = 0u;
    for (;;) {
        sum = 0u; cnt = 0u; mine = 0u;
#pragma unroll 1
        for (unsigned j = 0; j < 16; ++j) { const unsigned c = xb_ld(&bar[XB_XCNT(j)]); sum += c; cnt += (c > 0u) ? 1u : 0u; mine = (j == x) ? c : mine; }
        if (sum == G) break;
        __builtin_amdgcn_s_sleep(1);
        if ((++sp & 255u) == 0u) { if (xb_ld(&bar[XB_TMO])) break; if (sp > XB_SPIN_CAP) { atomicAdd(&bar[XB_TMO], 1u); break; } }
    }
    nloc = mine > 0u ? mine : 1u; nx = cnt > 0u ? cnt : 1u;
}
__device__ __forceinline__ void xcd_barrier(const XcdBarrier& b) {
    asm volatile("s_waitcnt vmcnt(0)" ::: "memory");
    __syncthreads();
    if (threadIdx.x == 0) {
        unsigned* bar = b.bar;
        __builtin_amdgcn_s_waitcnt(0);
        unsigned nloc = b.st[0], nx = b.st[1];
        if (nloc == 0u) { xcd_barrier_complete(bar, b.x, nloc, nx); b.st[0] = nloc; b.st[1] = nx; }
        const unsigned old = xb_add(&bar[XB_XSUB(b.x)], 1u);
        const unsigned gen = old / nloc;
        if (old + 1u == (gen + 1u) * nloc) {
            __builtin_amdgcn_fence(__ATOMIC_RELEASE, "agent");
            asm volatile("s_waitcnt vmcnt(0)" ::: "memory");
            const unsigned og = xb_add(&bar[XB_TOP], 1u);
            const unsigned tg = og / nx;
            if (og + 1u == (tg + 1u) * nx) xb_add(&bar[XB_TOPGEN], 1u);
            else XB_SPIN(xb_ld(&bar[XB_TOPGEN]) == tg, bar);
            __builtin_amdgcn_fence(__ATOMIC_ACQUIRE, "agent");
            xb_add(&bar[XB_XGEN(b.x)], 1u);
            asm volatile("s_waitcnt vmcnt(0)" ::: "memory");
        } else {
            XB_SPIN(xb_ld(&bar[XB_XGEN(b.x)]) == gen, bar);
            __builtin_amdgcn_fence(__ATOMIC_ACQUIRE, "agent");
            asm volatile("s_waitcnt vmcnt(0)" ::: "memory");
        }
    }
    __syncthreads();
}
namespace pg8 {
#define PG8_LAS __attribute__((address_space(3)))
constexpr int BM = 256, BK = 64, HALF = 128, HTB = HALF * BK * 2, STAGE_BYTES = 8 * HTB, NXCD = 8, WGM = 8;
__host__ __device__ __forceinline__ int lds_byte(int r, int c) { const int st = (r >> 4) * 2 + (c >> 5), rr = r & 15, cc = c & 31, ob = rr * 64 + cc * 2; return st * 1024 + (ob ^ (((ob >> 9) & 1) << 5)); }
__host__ __device__ __forceinline__ void stage_rc(int b, int& R, int& C) { const int st = b / 1024, sb = b % 1024, swz = sb ^ (((sb >> 9) & 1) << 5); R = (st >> 1) * 16 + swz / 64; C = (st & 1) * 32 + (swz % 64) / 2; }
__host__ __device__ __forceinline__ int perm32(int rho) { const int n = rho >> 4, i = rho & 15; return 8 * (i >> 2) + 4 * n + (i & 3); }

struct GUnit {
    int kind;
    int r0, c0;
    int aux;
};
struct GOps {
    const char* A; const char* B; unsigned lda, ldb; int nt;
};
__device__ __forceinline__ bool static_tile(int nM, int nN, int G, int c, int i, int& pm, int& pn) {
    const int nwg = nM * nN; const long L = (long)i * G + c; if (L >= nwg) return false;
    int wgid = (int)L; { const int q = nwg / NXCD, r = nwg % NXCD, xcd = wgid % NXCD, off = wgid / NXCD; wgid = (xcd < r ? xcd * (q + 1) : r * (q + 1) + (xcd - r) * q) + off; }
    const int nig = WGM * nN, gid = wgid / nig, fm = gid * WGM, gsz = (nM - fm) < WGM ? (nM - fm) : WGM;
    pm = fm + ((wgid % nig) % gsz); pn = (wgid % nig) / gsz; return true;
}

template <bool VARLD, class Sched, class Epi>
__device__ __forceinline__ void gemm_phase(PG8_LAS unsigned char* lds, const Sched& S, const Epi& E) {
    int tid_ = threadIdx.x; asm volatile("" : "+v"(tid_));
    const int tid = tid_, wid = __builtin_amdgcn_readfirstlane(tid >> 6), lane = tid & 63, wr = wid >> 2, wc = wid & 3, fr = lane & 15, fq = lane >> 4;
    int R0, C0, R1, C1; stage_rc(tid * 16, R0, C0); stage_rc(tid * 16 + 8192, R1, C1);
    const int Rb0 = (R0 & ~31) + perm32(R0 & 31), Rb1 = (R1 & ~31) + perm32(R1 & 31);
    const unsigned ldsw = (unsigned)wid * 1024u;
    const int aoff = lds_byte(wr * 64 + fr, fq * 8), boff = lds_byte(wc * 32 + fr, fq * 8);
#define PG8_SA(b, h) (((b) * 2 + (h)) * HTB)
#define PG8_SB(b, h) ((4 + (b) * 2 + (h)) * HTB)
#define PG8_STAGE(bufoff, gbase, v0, v1) do { \
        __builtin_amdgcn_global_load_lds((const unsigned*)((const char*)(gbase) + (v0)), (PG8_LAS unsigned*)(lds + (bufoff) + ldsw), 16, 0, 0); \
        __builtin_amdgcn_global_load_lds((const unsigned*)((const char*)(gbase) + (v1)), (PG8_LAS unsigned*)(lds + (bufoff) + ldsw + 8192), 16, 0, 0); } while (0)
#define PG8_LDA(dst, b, h) do { _Pragma("unroll") for (int m = 0; m < 4; ++m) _Pragma("unroll") for (int k = 0; k < 2; ++k) dst[m][k] = *(const PG8_LAS bf16x8*)(lds + PG8_SA(b, h) + aoff + m * 2048 + k * 1024); } while (0)
#define PG8_LDB(dst, b, h) do { _Pragma("unroll") for (int n = 0; n < 2; ++n) _Pragma("unroll") for (int k = 0; k < 2; ++k) dst[n][k] = *(const PG8_LAS bf16x8*)(lds + PG8_SB(b, h) + boff + n * 2048 + k * 1024); } while (0)
#define PG8_MMA(ai, bj, At, Bt) do { __builtin_amdgcn_s_setprio(1); _Pragma("unroll") for (int m = 0; m < 4; ++m) _Pragma("unroll") for (int n = 0; n < 2; ++n) _Pragma("unroll") for (int k = 0; k < 2; ++k) \
        acc[ai][bj][m][n] = __builtin_amdgcn_mfma_f32_16x16x32_bf16(Bt[n][k], At[m][k], acc[ai][bj][m][n], 0, 0, 0); __builtin_amdgcn_s_setprio(0); } while (0)
#define PG8_WAIT_V(n) asm volatile("s_waitcnt vmcnt(" #n ")" ::: "memory")
#define PG8_WAIT_L(n) asm volatile("s_waitcnt lgkmcnt(" #n ")" ::: "memory")
#define PG8_BAR __builtin_amdgcn_s_barrier()
#define PG8_SCHED __builtin_amdgcn_sched_barrier(0)
    GUnit cur, nxt; GOps co, no_; int ui = 0;
    if (!S.next(0, cur, co)) return;
    f32x4 acc[2][2][4][2];
#pragma unroll
    for (int a = 0; a < 2; ++a)
#pragma unroll
        for (int b = 0; b < 2; ++b)
#pragma unroll
            for (int m = 0; m < 4; ++m)
#pragma unroll
                for (int n = 0; n < 2; ++n) acc[a][b][m][n] = (f32x4){0.f, 0.f, 0.f, 0.f};
    bf16x8 At[4][2], B0[2][2], B1[2][2];
    const char* cA = co.A; const char* cB = co.B;
    unsigned ldA = VARLD ? co.lda : Sched::LDA, ldB = VARLD ? co.ldb : Sched::LDB; int nt = (VARLD || Sched::VARNT) ? co.nt : Sched::NT;
    unsigned vA0 = (unsigned)R0 * ldA + (unsigned)C0 * 2u, vA1 = (unsigned)R1 * ldA + (unsigned)C1 * 2u;
    unsigned vB0 = (unsigned)Rb0 * ldB + (unsigned)C0 * 2u, vB1 = (unsigned)Rb1 * ldB + (unsigned)C1 * 2u;
    unsigned hA = (unsigned)HALF * ldA, hB = (unsigned)HALF * ldB;
    PG8_STAGE(PG8_SB(0, 0), cB, vB0, vB1); PG8_STAGE(PG8_SB(0, 1), cB + hB, vB0, vB1); PG8_STAGE(PG8_SA(0, 0), cA, vA0, vA1); PG8_STAGE(PG8_SA(0, 1), cA + hA, vA0, vA1);
    if (wr == 1) PG8_BAR;
    PG8_WAIT_V(2); PG8_BAR;
    PG8_STAGE(PG8_SB(1, 0), cB + 128, vB0, vB1); PG8_STAGE(PG8_SA(1, 0), cA + 128, vA0, vA1); PG8_STAGE(PG8_SB(1, 1), cB + hB + 128, vB0, vB1);
    PG8_WAIT_V(6); PG8_BAR;
    for (;;) {
        const bool has_next = S.next(ui + 1, nxt, no_);
        const char* nA = has_next ? no_.A : cA; const char* nB = has_next ? no_.B : cB;
        const unsigned nlda = (VARLD && has_next) ? no_.lda : ldA, nldb = (VARLD && has_next) ? no_.ldb : ldB;
        const int nnt = ((VARLD || Sched::VARNT) && has_next) ? no_.nt : nt;
        for (int t = 0; t < nt; t += 2) {
            const bool last = (t == nt - 2);
            if (Epi::HAS_MID) { PG8_SCHED; E.mid(acc, cur, t, wr, wc, fr, fq); PG8_SCHED; }
            const char* a1 = cA + (size_t)(t + 1) * 128;
            const char* a2 = last ? nA : cA + (size_t)(t + 2) * 128; const char* b2 = last ? nB : cB + (size_t)(t + 2) * 128;
            const char* a3 = a2 + 128; const char* b3 = b2 + 128;
            unsigned xA0 = vA0, xA1 = vA1, xB0 = vB0, xB1 = vB1, xhA = hA, xhB = hB;
            if (VARLD && last) { xA0 = (unsigned)R0 * nlda + (unsigned)C0 * 2u; xA1 = (unsigned)R1 * nlda + (unsigned)C1 * 2u; xB0 = (unsigned)Rb0 * nldb + (unsigned)C0 * 2u; xB1 = (unsigned)Rb1 * nldb + (unsigned)C1 * 2u; xhA = (unsigned)HALF * nlda; xhB = (unsigned)HALF * nldb; }
            PG8_LDB(B0, 0, 0); PG8_LDB(B1, 0, 1); PG8_SCHED; PG8_LDA(At, 0, 0); PG8_STAGE(PG8_SA(1, 1), a1 + hA, vA0, vA1);
            PG8_WAIT_V(8); PG8_WAIT_L(0); PG8_BAR; PG8_MMA(0, 0, At, B0); PG8_MMA(0, 1, At, B1); PG8_BAR; PG8_SCHED;
            PG8_LDA(At, 0, 1); PG8_STAGE(PG8_SB(0, 0), b2, xB0, xB1); PG8_STAGE(PG8_SB(0, 1), b2 + xhB, xB0, xB1); PG8_STAGE(PG8_SA(0, 0), a2, xA0, xA1);
            PG8_WAIT_V(8); PG8_WAIT_L(0); PG8_BAR; PG8_MMA(1, 0, At, B0); PG8_MMA(1, 1, At, B1); PG8_BAR; PG8_SCHED;
            PG8_LDB(B0, 1, 0); PG8_LDB(B1, 1, 1); PG8_SCHED; PG8_LDA(At, 1, 0); PG8_STAGE(PG8_SA(0, 1), a2 + xhA, xA0, xA1);
            PG8_WAIT_V(8); PG8_WAIT_L(0); PG8_BAR; PG8_MMA(0, 0, At, B0); PG8_MMA(0, 1, At, B1); PG8_BAR; PG8_SCHED;
            PG8_LDA(At, 1, 1); PG8_STAGE(PG8_SB(1, 0), b3, xB0, xB1); PG8_STAGE(PG8_SB(1, 1), b3 + xhB, xB0, xB1); PG8_STAGE(PG8_SA(1, 0), a3, xA0, xA1);
            PG8_WAIT_V(8); PG8_WAIT_L(0); PG8_BAR; PG8_MMA(1, 0, At, B0); PG8_MMA(1, 1, At, B1); PG8_BAR; PG8_SCHED;
        }
        if (wr == 0) PG8_BAR;
        PG8_SCHED; E(acc, cur, wr, wc, fr, fq); PG8_SCHED;
        if (!has_next) break;
#pragma unroll
        for (int a = 0; a < 2; ++a)
#pragma unroll
            for (int b = 0; b < 2; ++b)
#pragma unroll
                for (int m = 0; m < 4; ++m)
#pragma unroll
                    for (int n = 0; n < 2; ++n) acc[a][b][m][n] = (f32x4){0.f, 0.f, 0.f, 0.f};
        cur = nxt; cA = nA; cB = nB; ++ui;
        if (VARLD || Sched::VARNT) nt = nnt;
        if (VARLD) { ldA = nlda; ldB = nldb; vA0 = (unsigned)R0 * ldA + (unsigned)C0 * 2u; vA1 = (unsigned)R1 * ldA + (unsigned)C1 * 2u; vB0 = (unsigned)Rb0 * ldB + (unsigned)C0 * 2u; vB1 = (unsigned)Rb1 * ldB + (unsigned)C1 * 2u; hA = (unsigned)HALF * ldA; hB = (unsigned)HALF * ldB; }
        if (wr == 1) PG8_BAR;
    }
    PG8_WAIT_V(0);
    PG8_BAR;
#undef PG8_SA
#undef PG8_SB
#undef PG8_STAGE
#undef PG8_LDA
#undef PG8_LDB
#undef PG8_MMA
#undef PG8_WAIT_V
#undef PG8_WAIT_L
#undef PG8_BAR
#undef PG8_SCHED
}

template <int KM> struct Epi {
    static constexpr bool HAS_MID = (KM & 4) != 0;
    bf16* O; int ldc;
    float scale;
    const float* bias;
    v4u* gscr;
    __device__ __forceinline__ void mid(f32x4 (&acc)[2][2][4][2], const GUnit& u, int t, int wr, int wc, int fr, int fq) const {
        if (!(KM & 4) || u.kind != 2 || (t != 8 && t != 16)) return;
        const int sa = (t == 8) ? 0 : 1;
        const v4u* ga = gscr + ((size_t)sa * 512 + ((wr * 4 + wc) * 64 + fq * 16 + fr)) * 16; asm volatile("" : "+v"(ga)); const v4u* gb = ga + 16 * 512; asm volatile("" : "+v"(gb));
#pragma unroll
        for (int ai = 0; ai < 2; ++ai)
#pragma unroll
            for (int m = 0; m < 4; ++m) {
#pragma unroll
                for (int bj = 0; bj < 2; ++bj) { const int q = (ai * 4 + m) * 2 + bj; const v4u x = ga[q], y = gb[q];
                    f32x4 r0, r1;
                    r0[0] = bflo(x.x) * __builtin_amdgcn_rcpf(bflo(y.x)); r0[1] = bfhi(x.x) * __builtin_amdgcn_rcpf(bfhi(y.x)); r0[2] = bflo(x.y) * __builtin_amdgcn_rcpf(bflo(y.y)); r0[3] = bfhi(x.y) * __builtin_amdgcn_rcpf(bfhi(y.y));
                    r1[0] = bflo(x.z) * __builtin_amdgcn_rcpf(bflo(y.z)); r1[1] = bfhi(x.z) * __builtin_amdgcn_rcpf(bfhi(y.z)); r1[2] = bflo(x.w) * __builtin_amdgcn_rcpf(bflo(y.w)); r1[3] = bfhi(x.w) * __builtin_amdgcn_rcpf(bfhi(y.w));
                    acc[ai][bj][m][0] *= r0; acc[ai][bj][m][1] *= r1; }
                asm volatile("" ::: "memory"); }
    }
    __device__ __forceinline__ void operator()(f32x4 (&acc)[2][2][4][2], const GUnit& u, int wr, int wc, int fr, int fq) const {
        if ((KM & 1) && u.kind == 0) {
            const float sc = u.aux ? scale : 1.0f;
            const int row0 = u.r0 + wr * 64 + fr, col0 = u.c0 + wc * 32 + 8 * fq;
#pragma unroll
            for (int ai = 0; ai < 2; ++ai)
#pragma unroll
                for (int m = 0; m < 4; ++m) { bf16* rowp = O + (size_t)(row0 + ai * HALF + m * 16) * ldc + col0;
#pragma unroll
                    for (int bj = 0; bj < 2; ++bj) { const f32x4 v0 = acc[ai][bj][m][0] * sc, v1 = acc[ai][bj][m][1] * sc;
                        v4u w; w.x = cvt_pk_bf16(v0[0], v0[1]); w.y = cvt_pk_bf16(v0[2], v0[3]); w.z = cvt_pk_bf16(v1[0], v1[1]); w.w = cvt_pk_bf16(v1[2], v1[3]);
                        *(v4u*)(rowp + bj * HALF) = w; } }
        } else if ((KM & 2) && u.kind == 1) {
            const int bcol0 = u.c0 + wc * 32 + 8 * fq; const float* bp = bias + u.aux * 1024 + bcol0;
            v4u* gs = gscr + ((size_t)u.aux * 512 + ((wr * 4 + wc) * 64 + fq * 16 + fr)) * 16; asm volatile("" : "+v"(gs));
#pragma unroll
            for (int bj = 0; bj < 2; ++bj) { const f32x4 b0 = *(const f32x4*)(bp + bj * HALF), b1 = *(const f32x4*)(bp + bj * HALF + 4);
#pragma unroll
                for (int ai = 0; ai < 2; ++ai)
#pragma unroll
                    for (int m = 0; m < 4; ++m) { const f32x4 z0 = acc[ai][bj][m][0] + b0, z1 = acc[ai][bj][m][1] + b1; float g[8];
#pragma unroll
                        for (int j = 0; j < 4; ++j) { g[j] = fmaxf(sigmoidf_(z0[j]), 1e-30f); g[4 + j] = fmaxf(sigmoidf_(z1[j]), 1e-30f); }
                        v4u w; w.x = cvt_pk_bf16(g[0], g[1]); w.y = cvt_pk_bf16(g[2], g[3]); w.z = cvt_pk_bf16(g[4], g[5]); w.w = cvt_pk_bf16(g[6], g[7]);
                        gs[(ai * 4 + m) * 2 + bj] = w; } }
        } else if ((KM & 4) && u.kind == 2) {
            const v4u* gc = gscr + ((size_t)2 * 512 + ((wr * 4 + wc) * 64 + fq * 16 + fr)) * 16; asm volatile("" : "+v"(gc));
            const int row0 = u.r0 + wr * 64 + fr, col0 = u.c0 + wc * 32 + 8 * fq;
#pragma unroll
            for (int ai = 0; ai < 2; ++ai)
#pragma unroll
                for (int m = 0; m < 4; ++m) { bf16* rowp = O + (size_t)(row0 + ai * HALF + m * 16) * ldc + col0;
#pragma unroll
                    for (int bj = 0; bj < 2; ++bj) { const v4u y = gc[(ai * 4 + m) * 2 + bj]; const f32x4 a0 = acc[ai][bj][m][0], a1 = acc[ai][bj][m][1];
                        v4u w; w.x = cvt_pk_bf16(a0[0] * bflo(y.x), a0[1] * bfhi(y.x)); w.y = cvt_pk_bf16(a0[2] * bflo(y.y), a0[3] * bfhi(y.y));
                        w.z = cvt_pk_bf16(a1[0] * bflo(y.z), a1[1] * bfhi(y.z)); w.w = cvt_pk_bf16(a1[2] * bflo(y.w), a1[3] * bfhi(y.w));
                        *(v4u*)(rowp + bj * HALF) = w; }
                    asm volatile("" ::: "memory"); }
        } else if (KM & 8) {
            const int row0 = u.r0 + wr * 64 + fr, col0 = u.c0 + wc * 32 + 8 * fq;
#pragma unroll
            for (int ai = 0; ai < 2; ++ai)
#pragma unroll
                for (int m = 0; m < 4; ++m) { bf16* rowp = O + (size_t)(row0 + ai * HALF + m * 16) * ldc + col0; float hv[8];
#pragma unroll
                    for (int n = 0; n < 2; ++n)
#pragma unroll
                        for (int j = 0; j < 4; ++j) { const float gt = acc[ai][0][m][n][j], up = acc[ai][1][m][n][j]; hv[n * 4 + j] = gt * sigmoidf_(gt) * up; }
                    v4u w; w.x = cvt_pk_bf16(hv[0], hv[1]); w.y = cvt_pk_bf16(hv[2], hv[3]); w.z = cvt_pk_bf16(hv[4], hv[5]); w.w = cvt_pk_bf16(hv[6], hv[7]);
                    *(v4u*)rowp = w; }
        }
    }
};
}
namespace attn_body {
using bf16=__hip_bfloat16;
using bf16x8=__attribute__((ext_vector_type(8)))short;
using s16x4=__attribute__((ext_vector_type(4)))short;
using f32x16=__attribute__((ext_vector_type(16)))float;
using u32x4=__attribute__((ext_vector_type(4)))unsigned;
constexpr int SEQ=4096,D=64,PQ=5376,PO=1024;
constexpr int NW=8,QBLK=32,QB=QBLK*NW,KVBLK=64,NQB=SEQ/QB;
constexpr int ATTN_UNIT_ROWS=QB;
__device__ __forceinline__ int crow(int r,int hi){return (r&3)+8*(r>>2)+4*hi;}
#define SBAR() __builtin_amdgcn_sched_barrier(0)
__device__ __forceinline__ void cmask(f32x16&p0,f32x16&p1,int jb,int qrel,int hi){
  const float NEG=-INFINITY; int kb=64*jb+4*hi;
  #pragma unroll
  for(int r=0;r<16;++r){int kv=kb+(r&3)+8*(r>>2); if(kv>qrel)p0[r]=NEG; if(kv+32>qrel)p1[r]=NEG;}
}

constexpr int NSLOT=3, SLOTB=8192;
constexpr int LDS_K=0, LDS_V=NSLOT*SLOTB, LDS_WS=2*NSLOT*SLOTB, LDS_OST=LDS_WS+NW*64*4, LDS_BYTES=LDS_OST+NW*4096;
constexpr float C2=0.125f*1.4426950408889634f;
__device__ __forceinline__ void glds16(const void*gsrc,unsigned lds_dst){unsigned keep;
  asm volatile("s_mov_b32 %0, m0\n\ts_mov_b32 m0, %2\n\ts_nop 0\n\tglobal_load_lds_dwordx4 %1, off\n\ts_mov_b32 m0, %0":"=&s"(keep):"v"(gsrc),"s"(lds_dst):"memory");}
__device__ __forceinline__ float max3f(float a,float b,float c){float r;asm("v_max3_f32 %0, %1, %2, %3":"=v"(r):"v"(a),"v"(b),"v"(c));return r;}
__device__ __forceinline__ float max2f(float a,float b){float r;asm("v_max_f32_e32 %0, %1, %2":"=v"(r):"v"(a),"v"(b));return r;}
__device__ __forceinline__ float fadd_s(float a,float b){float r;asm("v_add_f32_e32 %0, %1, %2":"=v"(r):"v"(a),"v"(b));return r;}
__device__ __forceinline__ float fsub_s(float a,float b){float r;asm("v_sub_f32_e32 %0, %1, %2":"=v"(r):"v"(a),"v"(b));return r;}
typedef float f32x2_t __attribute__((ext_vector_type(2))); typedef __bf16 bf16x2_t __attribute__((ext_vector_type(2)));
__device__ __forceinline__ unsigned cvtpk_s(float lo,float hi){f32x2_t v={lo,hi};bf16x2_t b=__builtin_convertvector(v,bf16x2_t);return __builtin_bit_cast(unsigned,b);}
#define WAIT_BAR(N) asm volatile("s_waitcnt vmcnt(" #N ") lgkmcnt(0)\n\ts_barrier":::"memory")

__device__ __forceinline__ void qkt(f32x16&p0,f32x16&p1,const char*Kslot,const bf16x8*qr,int r32,int hi){ const f32x16 negm=f32x16{};
  const char*kb=Kslot+hi*1024+r32*16;
  #pragma unroll
  for(int d0=0;d0<4;++d0){
    const bf16x8 b0=*reinterpret_cast<const bf16x8*>(kb+d0*2048);
    const bf16x8 b1=*reinterpret_cast<const bf16x8*>(kb+d0*2048+512);
    if(d0==0){p0=__builtin_amdgcn_mfma_f32_32x32x16_bf16(b0,qr[0],negm,0,0,0);p1=__builtin_amdgcn_mfma_f32_32x32x16_bf16(b1,qr[0],negm,0,0,0);}
    else{p0=__builtin_amdgcn_mfma_f32_32x32x16_bf16(b0,qr[d0],p0,0,0,0);p1=__builtin_amdgcn_mfma_f32_32x32x16_bf16(b1,qr[d0],p1,0,0,0);}}
}
typedef __attribute__((address_space(3))) const char* lds_cptr;
typedef short v4i16_t __attribute__((ext_vector_type(4)));
__device__ __forceinline__ void kload8(bf16x8*kf,lds_cptr kp){
  kf[0]=*(const __attribute__((address_space(3))) bf16x8*)(kp);      kf[1]=*(const __attribute__((address_space(3))) bf16x8*)(kp+512);
  kf[2]=*(const __attribute__((address_space(3))) bf16x8*)(kp+2048); kf[3]=*(const __attribute__((address_space(3))) bf16x8*)(kp+2560);
  kf[4]=*(const __attribute__((address_space(3))) bf16x8*)(kp+4096); kf[5]=*(const __attribute__((address_space(3))) bf16x8*)(kp+4608);
  kf[6]=*(const __attribute__((address_space(3))) bf16x8*)(kp+6144); kf[7]=*(const __attribute__((address_space(3))) bf16x8*)(kp+6656);
}
__device__ __forceinline__ void kload2(bf16x8*kf,lds_cptr kp,int j){ kf[2*j]=*(const __attribute__((address_space(3))) bf16x8*)(kp+j*2048); kf[2*j+1]=*(const __attribute__((address_space(3))) bf16x8*)(kp+j*2048+512); }
__device__ __forceinline__ s16x4 vtr(lds_cptr p){ return __builtin_bit_cast(s16x4,__builtin_amdgcn_ds_read_tr16_b64_v4i16((__attribute__((address_space(3))) v4i16_t*)p)); }
__device__ __forceinline__ float rowmax(const f32x16&p0,const f32x16&p1){
  float a=max3f(p0[0],p0[1],p1[0]),b=max3f(p0[2],p0[3],p1[1]);a=max3f(a,p1[2],p1[3]);
  #pragma unroll
  for(int r=4;r<16;r+=4){a=max3f(a,p0[r],p0[r+1]);b=max3f(b,p0[r+2],p0[r+3]);a=max3f(a,p1[r],p1[r+1]);b=max3f(b,p1[r+2],p1[r+3]);}
  const float m=max2f(a,b);
  auto rr=__builtin_amdgcn_permlane32_swap(__float_as_uint(m),__float_as_uint(m),false,false);
  return max2f(__uint_as_float(rr[0]),__uint_as_float(rr[1]));
}
__device__ __forceinline__ void pv(f32x16*o,int vb,bf16x8 pa0,bf16x8 pa1,bf16x8 pa2,bf16x8 pa3){
  #pragma unroll
  for(int d0=0;d0<2;++d0){s16x4 lo[4],hi[4];
    #pragma unroll
    for(int ks=0;ks<4;++ks){
      asm volatile("ds_read_b64_tr_b16 %0,%1 offset:%c2":"=&v"(lo[ks]):"v"(vb),"i"(d0*4096+ks*1024):"memory");
      asm volatile("ds_read_b64_tr_b16 %0,%1 offset:%c2":"=&v"(hi[ks]):"v"(vb),"i"(d0*4096+ks*1024+512):"memory");}
    asm volatile("s_waitcnt lgkmcnt(0)":::"memory");SBAR();
    #define PK(k) (bf16x8){lo[k][0],lo[k][1],lo[k][2],lo[k][3],hi[k][0],hi[k][1],hi[k][2],hi[k][3]}
    o[d0]=__builtin_amdgcn_mfma_f32_32x32x16_bf16(pa0,PK(0),o[d0],0,0,0);
    o[d0]=__builtin_amdgcn_mfma_f32_32x32x16_bf16(pa1,PK(1),o[d0],0,0,0);
    o[d0]=__builtin_amdgcn_mfma_f32_32x32x16_bf16(pa2,PK(2),o[d0],0,0,0);
    o[d0]=__builtin_amdgcn_mfma_f32_32x32x16_bf16(pa3,PK(3),o[d0],0,0,0);
    #undef PK
  }
}

#ifndef ATTN_STORE16
#define ATTN_STORE16(p,v) (*(u32x4*)(p)=(v))
#endif
template<int THRL> __device__ __forceinline__ void attn_unit(int b,int qcol,int kcol,int vcol,int ocol,float slope2,int qb,const bf16*__restrict__ P,bf16*O,char*shm){
  int tid_=threadIdx.x; asm volatile("":"+v"(tid_));
  const int tid=tid_,lane=tid&63,r32=lane&31,hi=lane>>5; const int wid=__builtin_amdgcn_readfirstlane(tid>>6);
  const long rowbase=(long)b*SEQ; const int q0=qb*QB;
  const bf16*Qw=P+(rowbase+q0+wid*QBLK)*PQ+qcol;
  const bf16*Kh=P+rowbase*PQ+kcol,*Vh=P+rowbase*PQ+vcol;
  const unsigned lds0=(unsigned)(uintptr_t)shm;
  float*wsf=(float*)(shm+LDS_WS)+wid*64;
  const bf16*ksrc=Kh+(long)lane*PQ+wid*8;
  const bf16*vsrc=Vh+(long)(16*(wid&3)+(lane>>2))*PQ+(wid>>2)*32+(lane&3)*8;
  const unsigned kdst=lds0+LDS_K+wid*1024, vdst=lds0+LDS_V+wid*1024;
  #define DMA_K(t,slot) glds16(ksrc+(long)(t)*KVBLK*PQ,(unsigned)__builtin_amdgcn_readfirstlane(kdst+(slot)))
  #define DMA_V(t,slot) glds16(vsrc+(long)(t)*KVBLK*PQ,(unsigned)__builtin_amdgcn_readfirstlane(vdst+(slot)))
  const int vb0=(int)(lds0+LDS_V)+((lane>>4)&1)*32+(lane&3)*8+(4*hi+((lane&15)>>2))*64;
  const char*Kbase=shm+LDS_K; bf16x8 kf[8];
  const lds_cptr shm3=(lds_cptr)shm; const lds_cptr kp0=shm3+LDS_K+hi*1024+r32*16; const lds_cptr vp0=shm3+LDS_V+((lane>>4)&1)*32+(lane&3)*8+(4*hi+((lane&15)>>2))*64;
  const int NT=(q0+QB)/KVBLK;
  DMA_K(0,0);DMA_V(0,0);DMA_K(1,SLOTB);
  bf16x8 qr[4];
  #pragma unroll
  for(int d0=0;d0<4;++d0)qr[d0]=*reinterpret_cast<const bf16x8*>(&Qw[(long)r32*PQ+d0*16+hi*8]);
  float mhat=0.f,l_reg=0.f;f32x16 o[2];o[0]=f32x16{};o[1]=f32x16{};const f32x16 negm=f32x16{};
  const float sr1_=__builtin_bit_cast(float,__builtin_amdgcn_readfirstlane(__builtin_bit_cast(int,slope2))), sr2_=__builtin_bit_cast(float,__builtin_amdgcn_readfirstlane(__builtin_bit_cast(int,2.f*slope2))), sr3_=__builtin_bit_cast(float,__builtin_amdgcn_readfirstlane(__builtin_bit_cast(int,3.f*slope2)));
  const float hib=slope2*(float)(4*hi);
  #define ALIBI(P0,P1,t) do{ const float tm0_=slope2*(float)(64*(t))+hib-mhat; \
    _Pragma("unroll") for(int q_=0;q_<4;++q_){ const float a_=tm0_+(8.f*slope2)*(float)q_, b_=a_+32.f*slope2; \
      P0[4*q_]+=a_; P0[4*q_+1]=(P0[4*q_+1]+a_)+sr1_; P0[4*q_+2]=(P0[4*q_+2]+a_)+sr2_; P0[4*q_+3]=(P0[4*q_+3]+a_)+sr3_; \
      P1[4*q_]+=b_; P1[4*q_+1]=(P1[4*q_+1]+b_)+sr1_; P1[4*q_+2]=(P1[4*q_+2]+b_)+sr2_; P1[4*q_+3]=(P1[4*q_+3]+b_)+sr3_; } }while(0)
  const int qrel=wid*QBLK+r32;
  #define CMASK(P0,P1,t) do{int jb_=(t)-(NT-4); if(jb_>=0)cmask(P0,P1,jb_,qrel,hi);}while(0)
  bool resc=false;
  #define START(P0,P1) do{ const float rm=rowmax(P0,P1); resc=false; \
    { const float dl=rm; mhat=fadd_s(mhat,dl); \
      _Pragma("unroll") for(int r=0;r<16;++r){P0[r]=fsub_s(P0[r],dl);P1[r]=fsub_s(P1[r],dl);} \
      } \
    _Pragma("unroll") for(int r=0;r<16;++r)P0[r]=__builtin_amdgcn_exp2f(P0[r]); }while(0)
  #define RESC() do{ if(resc){ asm volatile("s_waitcnt lgkmcnt(0)":::"memory"); \
      _Pragma("unroll") for(int d_=0;d_<2;++d_) _Pragma("unroll") for(int r=0;r<16;++r)o[d_][r]*=wsf[crow(r,hi)]; } }while(0)
  f32x16 pA0,pA1,pB0,pB1;
  int sl_prev=0,sl_cur=0,sl_next=SLOTB;
  #define ROT() do{sl_prev=sl_cur;sl_cur=sl_next;sl_next=(sl_next==(NSLOT-1)*SLOTB)?0:sl_next+SLOTB;}while(0)
  DMA_K(2,2*SLOTB);
  WAIT_BAR(3);
  qkt(pA0,pA1,Kbase,qr,r32,hi);asm volatile("s_nop 15\n\ts_nop 7":"+v"(pA0),"+v"(pA1));ALIBI(pA0,pA1,0);asm volatile("":"+v"(pA0),"+v"(pA1));CMASK(pA0,pA1,0);
  START(pA0,pA1);
  _Pragma("unroll") for(int r=0;r<16;++r)pA1[r]=__builtin_amdgcn_exp2f(pA1[r]);
  WAIT_BAR(0);
  DMA_K(3,0);DMA_V(1,SLOTB);
  ROT();
  kload8(kf,kp0+sl_cur);
  WAIT_BAR(2);
  s16x4 vlo[8],vhi[8]; u32x4 pw0,pw1,pw2,pw3;
  #define PKW(P,B) cvtpk_s(P[B],P[B+1])
  #define PAF(k) __builtin_bit_cast(bf16x8,pw##k)
  #define VFR(i) (bf16x8){vlo[i][0],vlo[i][1],vlo[i][2],vlo[i][3],vhi[i][0],vhi[i][1],vhi[i][2],vhi[i][3]}
  #define PIN(x) asm volatile("":"+v"(x))
  #define MX3(a,b,c) __builtin_fmaxf(__builtin_fmaxf((a),(b)),(c))
  #define GAPA(MF,A0,A1,A2,A3,W0,W1,PW) do{ MF; sacc+=A0; sacc+=A1; sacc+=A2; sacc+=A3; PIN(sacc); W0; W1; PIN(PW); SBAR(); }while(0)
  #define EX(v) __builtin_amdgcn_exp2f(v)
  #define GAPB(MF,X,B) do{ MF; X[B]=EX(X[B]); X[B+1]=EX(X[B+1]); X[B+2]=EX(X[B+2]); X[B+3]=EX(X[B+3]); PIN(X); SBAR(); }while(0)
  #define VRD(i) do{ vlo[i]=vtr(vp_+(((i)>>2)*4096+((i)&3)*1024)); vhi[i]=vtr(vp_+(((i)>>2)*4096+((i)&3)*1024+512)); }while(0)
  #define KRD(G,j) do{ if(G){ kload2(kf,kp0+sl_next,j); SBAR(); } }while(0)
  #define STEP(C0,C1,P0,P1,t,GK,GV,GL) do{ SBAR(); \
    const lds_cptr vp_=vp0+sl_prev; \
    VRD(0); SBAR(); float sacc=(P0[0]+P0[1]); \
    GAPA(C0=__builtin_amdgcn_mfma_f32_32x32x16_bf16(kf[0],qr[0],negm,0,0,0), P0[2],P0[3],P0[4],P0[5],     pw0[0]=PKW(P0,0), pw0[1]=PKW(P0,2), pw0); \
    VRD(4); SBAR(); GAPA(C1=__builtin_amdgcn_mfma_f32_32x32x16_bf16(kf[1],qr[0],negm,0,0,0), P0[6],P0[7],P0[8],P0[9],     pw0[2]=PKW(P0,4), pw0[3]=PKW(P0,6), pw0); \
    VRD(1); SBAR(); GAPA(C0=__builtin_amdgcn_mfma_f32_32x32x16_bf16(kf[2],qr[1],C0,0,0,0),   P0[10],P0[11],P0[12],P0[13], pw1[0]=PKW(P0,8), pw1[1]=PKW(P0,10), pw1); \
    VRD(5); SBAR(); GAPA(C1=__builtin_amdgcn_mfma_f32_32x32x16_bf16(kf[3],qr[1],C1,0,0,0),   P0[14],P0[15],P1[0],P1[1],   pw1[2]=PKW(P0,12),pw1[3]=PKW(P0,14), pw1); \
    VRD(2); SBAR(); GAPA(C0=__builtin_amdgcn_mfma_f32_32x32x16_bf16(kf[4],qr[2],C0,0,0,0),   P1[2],P1[3],P1[4],P1[5],     pw2[0]=PKW(P1,0), pw2[1]=PKW(P1,2), pw2); \
    VRD(6); SBAR(); GAPA(C1=__builtin_amdgcn_mfma_f32_32x32x16_bf16(kf[5],qr[2],C1,0,0,0),   P1[6],P1[7],P1[8],P1[9],     pw2[2]=PKW(P1,4), pw2[3]=PKW(P1,6), pw2); \
    VRD(3); SBAR(); GAPA(C0=__builtin_amdgcn_mfma_f32_32x32x16_bf16(kf[6],qr[3],C0,0,0,0),   P1[10],P1[11],P1[12],P1[13], pw3[0]=PKW(P1,8), pw3[1]=PKW(P1,10), pw3); \
    VRD(7); SBAR(); GAPA(C1=__builtin_amdgcn_mfma_f32_32x32x16_bf16(kf[7],qr[3],C1,0,0,0),   P1[14],P1[15],0.f,0.f,       pw3[2]=PKW(P1,12),pw3[3]=PKW(P1,14), pw3); \
    l_reg+=sacc; \
    if(GK){DMA_K((t)+3,sl_cur);} if(GV){DMA_V((t)+1,sl_next);} \
    ALIBI(C0,C1,t); CMASK(C0,C1,t); \
    { float a=MX3(C0[0],C0[1],C1[0]),b=MX3(C0[2],C0[3],C1[1]); a=MX3(a,C1[2],C1[3]); \
      _Pragma("unroll") for(int r=4;r<16;r+=4){a=MX3(a,C0[r],C0[r+1]);b=MX3(b,C0[r+2],C0[r+3]);a=MX3(a,C1[r],C1[r+1]);b=MX3(b,C1[r+2],C1[r+3]);} \
      float rm=__builtin_fmaxf(a,b); { auto rr=__builtin_amdgcn_permlane32_swap(__float_as_uint(rm),__float_as_uint(rm),false,false); rm=__builtin_fmaxf(__uint_as_float(rr[0]),__uint_as_float(rr[1])); } \
      resc=false; \
      if(__builtin_expect(__any(rm>(float)THRL),0)){ const float dl=__builtin_fmaxf(rm,0.f); mhat+=dl; \
        _Pragma("unroll") for(int r=0;r<16;++r){C0[r]-=dl;C1[r]-=dl;} \
        const float f=__builtin_amdgcn_exp2f(-dl); l_reg*=f; if(hi==0)wsf[r32]=f; resc=true; } } \
    SBAR(); \
    GAPB(o[0]=__builtin_amdgcn_mfma_f32_32x32x16_bf16(PAF(0),VFR(0),o[0],0,0,0), C0,0); \
    GAPB(o[1]=__builtin_amdgcn_mfma_f32_32x32x16_bf16(PAF(0),VFR(4),o[1],0,0,0), C0,4); \
    KRD(GL,0); GAPB(o[0]=__builtin_amdgcn_mfma_f32_32x32x16_bf16(PAF(1),VFR(1),o[0],0,0,0), C0,8); \
    KRD(GL,1); GAPB(o[1]=__builtin_amdgcn_mfma_f32_32x32x16_bf16(PAF(1),VFR(5),o[1],0,0,0), C0,12); \
    KRD(GL,2); GAPB(o[0]=__builtin_amdgcn_mfma_f32_32x32x16_bf16(PAF(2),VFR(2),o[0],0,0,0), C1,0); \
    KRD(GL,3); GAPB(o[1]=__builtin_amdgcn_mfma_f32_32x32x16_bf16(PAF(2),VFR(6),o[1],0,0,0), C1,4); \
    GAPB(o[0]=__builtin_amdgcn_mfma_f32_32x32x16_bf16(PAF(3),VFR(3),o[0],0,0,0), C1,8); \
    GAPB(o[1]=__builtin_amdgcn_mfma_f32_32x32x16_bf16(PAF(3),VFR(7),o[1],0,0,0), C1,12); \
    }while(0)
  int t=1;
  #undef CMASK
  #define CMASK(P0,P1,t) do{}while(0)
  for(;t+5<NT;t+=2){
    STEP(pB0,pB1,pA0,pA1,t,true,true,true);     WAIT_BAR(2); RESC(); ROT();
    STEP(pA0,pA1,pB0,pB1,t+1,true,true,true);   WAIT_BAR(2); RESC(); ROT();
  }
  #undef CMASK
  #define CMASK(P0,P1,t) do{int jb_=(t)-(NT-4); if(jb_>=0)cmask(P0,P1,jb_,qrel,hi);}while(0)
  #define ENDW(tt) do{ if((tt)+3<NT){WAIT_BAR(2);} else if((tt)+2<NT){WAIT_BAR(1);} else {WAIT_BAR(0);} }while(0)
  for(;t+1<NT;t+=2){
    STEP(pB0,pB1,pA0,pA1,t,(t+3<NT),(t+1<NT),(t+1<NT));       ENDW(t);   RESC(); ROT();
    STEP(pA0,pA1,pB0,pB1,t+1,(t+4<NT),(t+2<NT),(t+2<NT));     ENDW(t+1); RESC(); ROT();
  }
  STEP(pB0,pB1,pA0,pA1,NT-1,false,false,false); RESC();
  { float sacc=pB0[0]+pB0[1]; _Pragma("unroll") for(int r=2;r<16;++r)sacc+=pB0[r]; _Pragma("unroll") for(int r=0;r<16;++r)sacc+=pB1[r]; l_reg+=sacc;
    pw0=(u32x4){PKW(pB0,0),PKW(pB0,2),PKW(pB0,4),PKW(pB0,6)};pw1=(u32x4){PKW(pB0,8),PKW(pB0,10),PKW(pB0,12),PKW(pB0,14)};pw2=(u32x4){PKW(pB1,0),PKW(pB1,2),PKW(pB1,4),PKW(pB1,6)};pw3=(u32x4){PKW(pB1,8),PKW(pB1,10),PKW(pB1,12),PKW(pB1,14)};
    SBAR(); pv(o,vb0+sl_cur,PAF(0),PAF(1),PAF(2),PAF(3)); }
  #undef PKW
  #undef PAF
  #undef VFR
  #undef PIN
  #undef MX3
  #undef GAPA
  #undef GAPB
  #undef EX
  #undef VRD
  #undef KRD
  #undef STEP
  #undef ENDW
  {auto rr=__builtin_amdgcn_permlane32_swap(__float_as_uint(l_reg),__float_as_uint(l_reg),false,false);l_reg=__uint_as_float(rr[0])+__uint_as_float(rr[1]);}
  if(hi==0)wsf[32+r32]=l_reg;asm volatile("s_waitcnt lgkmcnt(0)":::"memory");
  float rli[16];
  #pragma unroll
  for(int r=0;r<16;++r)rli[r]=__builtin_amdgcn_rcpf(wsf[32+crow(r,hi)]);
  bf16*Ow=O+(rowbase+q0+wid*QBLK)*PO+ocol;
  { bf16*stg=(bf16*)(shm+LDS_OST)+wid*2048;
    #pragma unroll
    for(int r=0;r<16;++r){const int orow=crow(r,hi);
      #pragma unroll
      for(int d0=0;d0<2;++d0)stg[orow*64+d0*32+r32]=__float2bfloat16(o[d0][r]*rli[r]);}
    asm volatile("s_waitcnt lgkmcnt(0)":::"memory");
    #pragma unroll
    for(int i=0;i<4;++i){const int row=i*8+(lane>>3),ch=lane&7; const u32x4 v=*(const u32x4*)(stg+row*64+ch*8); ATTN_STORE16(Ow+(long)row*PO+ch*8,v);} }
  asm volatile("s_waitcnt lgkmcnt(0)\n\ts_barrier":::"memory");
  #undef DMA_K
  #undef DMA_V
  #undef CMASK
  #undef START
  #undef RESC
  #undef ROT
  #undef ALIBI
}
constexpr int ATTN_LDS_BYTES=LDS_BYTES;
#undef SBAR
#undef WAIT_BAR
}
struct MixP {
    const bf16* proj; bf16* ocat; bf16* oatt;
    const float* hg_lb;
    const float* hg_norm_g;
    float lam, one_m_lam_init;
    const float* da_subln_g;
    const float *rw_mu, *rw_w0, *rw_a0, *rw_k_k, *rw_k_a, *rw_r_k, *rw_gn_g, *rw_gn_b;
    const bf16 *wupT, *aupT, *gupT;
    gu32* aq;
};

__device__ __forceinline__ void attn_group(const MixP& P, int b, int h, int qb, char* lds) {
    const float slope2 = exp2f(-2.0f * (float)(h + 1)) * LOG2E;
    const float s2 = __builtin_bit_cast(float, __builtin_amdgcn_readfirstlane(__builtin_bit_cast(int, slope2)));
    const attn_body::bf16* pr = (const attn_body::bf16*)P.proj; attn_body::bf16* oa = (attn_body::bf16*)P.oatt;
#pragma unroll 1
    for (int sub = 0; sub < 4; ++sub) {
        const int mp = sub >> 1, hf = sub & 1;
        attn_body::attn_unit<8>(b, C_DAQ + h * 128 + mp * 64, C_DAK + h * 128 + mp * 64, C_DAV + h * 128 + hf * 64, h * 256 + mp * 128 + hf * 64, s2, qb, pr, oa, lds);
    }
    VM_WAIT(); __syncthreads();
    {
        int tid_ = threadIdx.x; asm volatile("" : "+v"(tid_)); const int tid = tid_, row = tid >> 1, hf = tid & 1;
        const size_t grow = (size_t)b * T + (size_t)qb * 256 + row;
        const bf16* o0 = P.oatt + grow * 1024 + h * 256 + hf * 64; const bf16* o1 = o0 + 128;
        float v[64]; float ss = 0.f;
#pragma unroll
        for (int c = 0; c < 8; ++c) { const v4u x = __builtin_nontemporal_load((const v4u*)(o0) + c), y = __builtin_nontemporal_load((const v4u*)(o1) + c);
            const unsigned xs[4] = {x.x, x.y, x.z, x.w}, ys[4] = {y.x, y.y, y.z, y.w};
#pragma unroll
            for (int j = 0; j < 4; ++j) { const float a = bflo(xs[j]) - P.lam * bflo(ys[j]), d = bfhi(xs[j]) - P.lam * bfhi(ys[j]); v[c * 8 + 2 * j] = a; v[c * 8 + 2 * j + 1] = d; ss += a * a + d * d; } }
        ss += __shfl_xor(ss, 1);
        const float rs = rsqrtf(ss * (1.0f / 128.0f) + RMS_EPS) * P.one_m_lam_init;
        bf16* dst = P.ocat + grow * 1536 + 512 + h * 128 + hf * 64; const float* g = P.da_subln_g + hf * 64;
#pragma unroll
        for (int c = 0; c < 8; ++c) { v4u w; w.x = pk2(v[c * 8 + 0] * rs * g[c * 8 + 0], v[c * 8 + 1] * rs * g[c * 8 + 1]); w.y = pk2(v[c * 8 + 2] * rs * g[c * 8 + 2], v[c * 8 + 3] * rs * g[c * 8 + 3]);
            w.z = pk2(v[c * 8 + 4] * rs * g[c * 8 + 4], v[c * 8 + 5] * rs * g[c * 8 + 5]); w.w = pk2(v[c * 8 + 6] * rs * g[c * 8 + 6], v[c * 8 + 7] * rs * g[c * 8 + 7]);
            *((v4u*)dst + c) = w; }
    }
    __syncthreads();
}
__device__ __forceinline__ void attn_worker(const MixP& P, char* lds, volatile LAS unsigned* bcast, int tid) {
    for (;;) {
        if (tid == 0) bcast[0] = __hip_atomic_fetch_add(P.aq, 1u, RLX_AGENT);
        __syncthreads();
        const unsigned idx = bcast[0];
        __syncthreads();
        if (idx >= 512u) break;
        const int qb = 15 - (int)(idx >> 5), bh = (int)(idx & 31u);
        attn_group(P, bh >> 2, bh & 3, qb, lds);
    }
}

constexpr int HG_QH = 0, HG_QT = 17408, HG_KT = 34816, HG_KHT = 52224, HG_VV = 70656, HG_OG = 88064, HG_AM = 105472, HG_BQ = 114688, HG_SS = 116736, HG_DD = 118784, HG_END = 119296;
constexpr int HS = 272, HS2 = 144;
__device__ __forceinline__ s16x4 tr_rd(unsigned addr) { s16x4 r; asm volatile("ds_read_b64_tr_b16 %0, %1\n\ts_waitcnt lgkmcnt(0)" : "=&v"(r) : "v"(addr) : "memory"); return r; }
__device__ __forceinline__ void hgrn_unit(const MixP& P, int b, int h, LAS unsigned char* lds) {
    int tid_ = threadIdx.x; asm volatile("" : "+v"(tid_));
    const int tid = tid_, lane = tid & 63, w = __builtin_amdgcn_readfirstlane(tid >> 6), g = lane >> 4, li = lane & 15;
    const int kk_ = tid & 127, tq = tid >> 7;
    const float lb = P.hg_lb[h * 128 + kk_], oml = 1.0f - lb;
    LAS float* BQ = (LAS float*)(lds + HG_BQ); LAS float* SS = (LAS float*)(lds + HG_SS); LAS float* DD = (LAS float*)(lds + HG_DD);
    f32x4 Sacc[8];
#pragma unroll
    for (int i = 0; i < 8; ++i) Sacc[i] = (f32x4){0.f, 0.f, 0.f, 0.f};
    const unsigned ldsb = (unsigned)(uintptr_t)lds;
    const float ng = P.hg_norm_g[16 * w + li];
#pragma unroll 1
    for (int c = 0; c < 64; ++c) {
        const size_t row0 = (size_t)b * T + (size_t)c * 64;
        const bf16* base = P.proj + (row0 + 16 * tq) * INW + h * 128 + kk_;
        float cs[16], kv[16]; float run = 0.f;
#pragma unroll
        for (int i = 0; i < 16; ++i) { const float z = bf2f(base[(size_t)i * INW + C_HGF]); const float sg = sigmoidf_(z); const float f = lb + oml * sg;
            run += __logf(fmaxf(f, HG_F_MIN)); cs[i] = run; kv[i] = oml * (1.0f - sg); }
        BQ[tq * 128 + kk_] = run;
        __syncthreads();
        const float q0 = BQ[kk_], q1 = BQ[128 + kk_], q2 = BQ[256 + kk_], q3 = BQ[384 + kk_];
        const float off = (tq > 0 ? q0 : 0.f) + (tq > 1 ? q1 : 0.f) + (tq > 2 ? q2 : 0.f);
        const float blast = (q0 + q1) + (q2 + q3), ref = q0 + q1;
        if (tq == 0) DD[kk_] = __expf(blast);
#pragma unroll
        for (int i = 0; i < 16; ++i) { const int t = 16 * tq + i; const float bt = off + cs[i];
            const float q = bf2f(base[(size_t)i * INW + C_HGQ]);
            const unsigned short vraw = base[(size_t)i * INW + C_HGI], ograw = base[(size_t)i * INW + C_HGO];
            *(LAS unsigned short*)(lds + HG_QH + t * HS + kk_ * 2) = (unsigned short)f2bf(q * __expf(bt));
            *(LAS unsigned short*)(lds + HG_QT + t * HS + kk_ * 2) = (unsigned short)f2bf(q * __expf(fminf(bt - ref, 60.f)));
            *(LAS unsigned short*)(lds + HG_KT + t * HS + kk_ * 2) = (unsigned short)f2bf(kv[i] * __expf(fminf(ref - bt, 60.f)));
            *(LAS unsigned short*)(lds + HG_KHT + kk_ * HS2 + t * 2) = (unsigned short)f2bf(kv[i] * __expf(blast - bt));
            *(LAS unsigned short*)(lds + HG_VV + t * HS + kk_ * 2) = vraw;
            *(LAS unsigned short*)(lds + HG_OG + t * HS + kk_ * 2) = ograw; }
        __syncthreads();
        {   const int mt = w >> 1;
#pragma unroll
            for (int j = 0; j < 2; ++j) { const int st = 2 * (w & 1) + j; f32x4 a = (f32x4){0.f, 0.f, 0.f, 0.f};
#pragma unroll
                for (int ks = 0; ks < 4; ++ks) { const bf16x8 fa = *(const LAS bf16x8*)(lds + HG_KT + (16 * st + li) * HS + ks * 64 + g * 16);
                    const bf16x8 fb = *(const LAS bf16x8*)(lds + HG_QT + (16 * mt + li) * HS + ks * 64 + g * 16);
                    a = __builtin_amdgcn_mfma_f32_16x16x32_bf16(fa, fb, a, 0, 0, 0); }
                const int tt = 16 * mt + li, s0 = 16 * st + 4 * g;
                v2u wv; wv.x = pk2(s0 <= tt ? a[0] : 0.f, s0 + 1 <= tt ? a[1] : 0.f); wv.y = pk2(s0 + 2 <= tt ? a[2] : 0.f, s0 + 3 <= tt ? a[3] : 0.f);
                *(LAS v2u*)(lds + HG_AM + tt * HS2 + s0 * 2) = wv; }
        }
        __syncthreads();
        bf16x8 vf[2];
        {   const int q = li >> 2, p = li & 3;
#pragma unroll
            for (int ks = 0; ks < 2; ++ks) { const unsigned a0 = ldsb + HG_VV + (32 * ks + 8 * g + q) * HS + (16 * w + 4 * p) * 2;
                const s16x4 lo = tr_rd(a0), hi = tr_rd(a0 + 4 * HS);
                vf[ks] = (bf16x8){lo[0], lo[1], lo[2], lo[3], hi[0], hi[1], hi[2], hi[3]}; } }
        bf16x8 sb[4];
#pragma unroll
        for (int s = 0; s < 4; ++s) { v4u x; x.x = pk2(Sacc[2 * s][0], Sacc[2 * s][1]); x.y = pk2(Sacc[2 * s][2], Sacc[2 * s][3]); x.z = pk2(Sacc[2 * s + 1][0], Sacc[2 * s + 1][1]); x.w = pk2(Sacc[2 * s + 1][2], Sacc[2 * s + 1][3]);
            sb[s] = __builtin_bit_cast(bf16x8, x); }
        f32x4 o[4];
#pragma unroll
        for (int mt = 0; mt < 4; ++mt) { f32x4 a = (f32x4){0.f, 0.f, 0.f, 0.f};
#pragma unroll
            for (int ks = 0; ks < 2; ++ks) { const bf16x8 fa = *(const LAS bf16x8*)(lds + HG_AM + (16 * mt + li) * HS2 + ks * 64 + g * 16);
                a = __builtin_amdgcn_mfma_f32_16x16x32_bf16(fa, vf[ks], a, 0, 0, 0); }
#pragma unroll
            for (int s = 0; s < 4; ++s) { const LAS unsigned char* qp = lds + HG_QH + (16 * mt + li) * HS + (32 * s + 4 * g) * 2;
                const v2u lo = *(const LAS v2u*)qp, hi = *(const LAS v2u*)(qp + 32);
                v4u x; x.x = lo.x; x.y = lo.y; x.z = hi.x; x.w = hi.y;
                a = __builtin_amdgcn_mfma_f32_16x16x32_bf16(__builtin_bit_cast(bf16x8, x), sb[s], a, 0, 0, 0); }
            o[mt] = a; }
#pragma unroll
        for (int kt = 0; kt < 8; ++kt) { const f32x4 d = *(const LAS f32x4*)(DD + 16 * kt + 4 * g); f32x4 a = Sacc[kt] * d;
#pragma unroll
            for (int ks = 0; ks < 2; ++ks) { const bf16x8 fa = *(const LAS bf16x8*)(lds + HG_KHT + (16 * kt + li) * HS2 + ks * 64 + g * 16);
                a = __builtin_amdgcn_mfma_f32_16x16x32_bf16(fa, vf[ks], a, 0, 0, 0); }
            Sacc[kt] = a; }
#pragma unroll
        for (int mt = 0; mt < 4; ++mt)
#pragma unroll
            for (int r = 0; r < 4; ++r) { float s = o[mt][r] * o[mt][r]; s += __shfl_xor(s, 1); s += __shfl_xor(s, 2); s += __shfl_xor(s, 4); s += __shfl_xor(s, 8);
                if (li == 0) SS[(16 * mt + 4 * g + r) * 8 + w] = s; }
        __syncthreads();
#pragma unroll
        for (int mt = 0; mt < 4; ++mt)
#pragma unroll
            for (int r = 0; r < 4; ++r) { const int t = 16 * mt + 4 * g + r; const f32x4 s0 = *(const LAS f32x4*)(SS + t * 8), s1 = *(const LAS f32x4*)(SS + t * 8 + 4);
                const float ss = ((s0[0] + s0[1]) + (s0[2] + s0[3])) + ((s1[0] + s1[1]) + (s1[2] + s1[3]));
                const float rs = rsqrtf(ss * (1.0f / 128.0f) + RMS_EPS);
                const float og = bf2f(*(const LAS unsigned short*)(lds + HG_OG + t * HS + (16 * w + li) * 2));
                const float y = o[mt][r] * rs * ng * (og * sigmoidf_(og));
                P.ocat[(row0 + t) * 1536 + h * 128 + 16 * w + li] = (unsigned short)f2bf(y); }
        __syncthreads();
    }
}

constexpr int RW_R = 0, RW_W = 8192, RW_K2 = 16384, RW_V = 24576, RW_AA = 32768, RW_BB = 40960, RW_G = 49152, RW_O = 57344, RW_K1 = 65536, RW_A1 = 73728, RW_BON = 81920,
              RW_TW = 82176, RW_AD = RW_TW + 32 * 144, RW_SG = RW_AD + 32 * 144, RW_END = RW_SG + 32 * 272;
__device__ __forceinline__ void rwkv_unit(const MixP& P, int b, int h, LAS unsigned char* lds) {
    int tid_ = threadIdx.x; asm volatile("" : "+v"(tid_));
    const int tid = tid_, lane = tid & 63, w = __builtin_amdgcn_readfirstlane(tid >> 6), g = lane >> 4, li = lane & 15;
    LAS float* R = (LAS float*)(lds + RW_R); LAS float* W = (LAS float*)(lds + RW_W); LAS float* K2 = (LAS float*)(lds + RW_K2); LAS float* V = (LAS float*)(lds + RW_V);
    LAS float* AA = (LAS float*)(lds + RW_AA); LAS float* BB = (LAS float*)(lds + RW_BB); LAS float* G = (LAS float*)(lds + RW_G); LAS float* O = (LAS float*)(lds + RW_O);
    LAS float* K1 = (LAS float*)(lds + RW_K1); LAS float* A1 = (LAS float*)(lds + RW_A1); LAS float* BON = (LAS float*)(lds + RW_BON);
    const int hc = h * 64;
    float S[8];
#pragma unroll
    for (int j = 0; j < 8; ++j) S[j] = 0.f;
    const int mt = w >> 2, ntile = w & 3, cc = 16 * ntile + li;
    bf16x8 fwu[2], fau[2], fgu[4];
#pragma unroll
    for (int ks = 0; ks < 2; ++ks) { fwu[ks] = *(const bf16x8*)(P.wupT + (size_t)(hc + cc) * 64 + ks * 32 + g * 8); fau[ks] = *(const bf16x8*)(P.aupT + (size_t)(hc + cc) * 64 + ks * 32 + g * 8); }
#pragma unroll
    for (int ks = 0; ks < 4; ++ks) fgu[ks] = *(const bf16x8*)(P.gupT + (size_t)(hc + cc) * 128 + ks * 32 + g * 8);
    const float w0c = P.rw_w0[hc + cc], a0c = P.rw_a0[hc + cc];
#pragma unroll 1
    for (int blk = 0; blk < 128; ++blk) {
        const size_t row0 = (size_t)b * T + (size_t)blk * 32;
        for (int e = tid; e < 32 * 448; e += NTHR) { const int t = e / 448, c = e - t * 448;
            int pc; if (c < 64) pc = C_RWR + hc + c; else if (c < 128) pc = C_RWK + hc + (c - 64); else if (c < 192) pc = C_RWV + hc + (c - 128); else pc = C_RWWD + (c - 192);
            const bf16* src = P.proj + (row0 + t) * INW + pc;
            const float cur = bf2f(src[0]); const float prev = (blk == 0 && t == 0) ? 0.f : bf2f(*(src - INW));
            const float x = cur + (prev - cur) * P.rw_mu[pc - C_RW];
            if (c < 64) R[t * 64 + c] = x; else if (c < 128) K1[t * 64 + (c - 64)] = x; else if (c < 192) V[t * 64 + (c - 128)] = x;
            else if (c < 256) *(LAS unsigned short*)(lds + RW_TW + t * 144 + (c - 192) * 2) = (unsigned short)f2bf(tanhf(x));
            else if (c < 320) *(LAS unsigned short*)(lds + RW_AD + t * 144 + (c - 256) * 2) = (unsigned short)f2bf(x);
            else *(LAS unsigned short*)(lds + RW_SG + t * 272 + (c - 320) * 2) = (unsigned short)f2bf(sigmoidf_(x)); }
        __syncthreads();
        {   f32x4 aw = (f32x4){0.f, 0.f, 0.f, 0.f}, aa = aw, ag = aw;
#pragma unroll
            for (int ks = 0; ks < 2; ++ks) { const bf16x8 f1 = *(const LAS bf16x8*)(lds + RW_TW + (16 * mt + li) * 144 + ks * 64 + g * 16), f2 = *(const LAS bf16x8*)(lds + RW_AD + (16 * mt + li) * 144 + ks * 64 + g * 16);
                aw = __builtin_amdgcn_mfma_f32_16x16x32_bf16(f1, fwu[ks], aw, 0, 0, 0); aa = __builtin_amdgcn_mfma_f32_16x16x32_bf16(f2, fau[ks], aa, 0, 0, 0); }
#pragma unroll
            for (int ks = 0; ks < 4; ++ks) { const bf16x8 f3 = *(const LAS bf16x8*)(lds + RW_SG + (16 * mt + li) * 272 + ks * 64 + g * 16); ag = __builtin_amdgcn_mfma_f32_16x16x32_bf16(f3, fgu[ks], ag, 0, 0, 0); }
#pragma unroll
            for (int r = 0; r < 4; ++r) { const int t = 16 * mt + 4 * g + r; const float z = -(w0c + aw[r]);
                const float sp = fmaxf(z, 0.f) + log1pf(__expf(-fabsf(z))); const float wlog = -sp - 0.5f;
                W[t * 64 + cc] = __expf(-__expf(wlog)); A1[t * 64 + cc] = sigmoidf_(a0c + aa[r]); G[t * 64 + cc] = ag[r]; }
        }
        __syncthreads();
        {   const int t = tid >> 4, c0 = (tid & 15) * 4; float kkv[4], k1[4], a[4]; float ss = 0.f, bon = 0.f;
#pragma unroll
            for (int j = 0; j < 4; ++j) { k1[j] = K1[t * 64 + c0 + j]; a[j] = A1[t * 64 + c0 + j]; kkv[j] = k1[j] * P.rw_k_k[hc + c0 + j]; ss += kkv[j] * kkv[j]; }
            ss += __shfl_xor(ss, 1); ss += __shfl_xor(ss, 2); ss += __shfl_xor(ss, 4); ss += __shfl_xor(ss, 8);
            const float inv = rsqrtf(fmaxf(ss, 1e-12f));
#pragma unroll
            for (int j = 0; j < 4; ++j) { const float kn = kkv[j] * inv, k2 = k1[j] * (1.0f + (a[j] - 1.0f) * P.rw_k_a[hc + c0 + j]);
                AA[t * 64 + c0 + j] = -kn; BB[t * 64 + c0 + j] = kn * a[j]; K2[t * 64 + c0 + j] = k2; bon += R[t * 64 + c0 + j] * k2 * P.rw_r_k[hc + c0 + j]; }
            bon += __shfl_xor(bon, 1); bon += __shfl_xor(bon, 2); bon += __shfl_xor(bon, 4); bon += __shfl_xor(bon, 8);
            if ((tid & 15) == 0) BON[t] = bon; }
        __syncthreads();
        {   const int vr = lane >> 3, sg = lane & 7, vrow = 8 * w + vr;
#pragma unroll 2
            for (int t = 0; t < 32; ++t) { const int o8 = t * 64 + 8 * sg;
                const f32x4 a0 = *(const LAS f32x4*)(AA + o8), a1 = *(const LAS f32x4*)(AA + o8 + 4), w0 = *(const LAS f32x4*)(W + o8), w1 = *(const LAS f32x4*)(W + o8 + 4);
                const f32x4 b0 = *(const LAS f32x4*)(BB + o8), b1 = *(const LAS f32x4*)(BB + o8 + 4), k0 = *(const LAS f32x4*)(K2 + o8), k1 = *(const LAS f32x4*)(K2 + o8 + 4);
                const f32x4 r0 = *(const LAS f32x4*)(R + o8), r1 = *(const LAS f32x4*)(R + o8 + 4); const float vv = V[t * 64 + vrow];
                float sa = ((S[0] * a0[0] + S[1] * a0[1]) + (S[2] * a0[2] + S[3] * a0[3])) + ((S[4] * a1[0] + S[5] * a1[1]) + (S[6] * a1[2] + S[7] * a1[3]));
                sa += __shfl_xor(sa, 1); sa += __shfl_xor(sa, 2); sa += __shfl_xor(sa, 4);
#pragma unroll
                for (int j = 0; j < 4; ++j) { S[j] = S[j] * w0[j] + sa * b0[j] + vv * k0[j]; S[4 + j] = S[4 + j] * w1[j] + sa * b1[j] + vv * k1[j]; }
                float oo = ((S[0] * r0[0] + S[1] * r0[1]) + (S[2] * r0[2] + S[3] * r0[3])) + ((S[4] * r1[0] + S[5] * r1[1]) + (S[6] * r1[2] + S[7] * r1[3]));
                oo += __shfl_xor(oo, 1); oo += __shfl_xor(oo, 2); oo += __shfl_xor(oo, 4);
                if (sg == 0) O[t * 64 + vrow] = oo; }
        }
        __syncthreads();
        {   const int t = tid >> 4, c0 = (tid & 15) * 4; const f32x4 ov = *(const LAS f32x4*)(O + t * 64 + c0);
            float s = (ov[0] + ov[1]) + (ov[2] + ov[3]); s += __shfl_xor(s, 1); s += __shfl_xor(s, 2); s += __shfl_xor(s, 4); s += __shfl_xor(s, 8);
            const float mean = s * (1.0f / 64.0f); float q = 0.f;
#pragma unroll
            for (int j = 0; j < 4; ++j) { const float d = ov[j] - mean; q += d * d; }
            q += __shfl_xor(q, 1); q += __shfl_xor(q, 2); q += __shfl_xor(q, 4); q += __shfl_xor(q, 8);
            const float rs = rsqrtf(q * (1.0f / 64.0f) + RW_GN_EPS), bon = BON[t]; float y[4];
#pragma unroll
            for (int j = 0; j < 4; ++j) y[j] = ((ov[j] - mean) * rs * P.rw_gn_g[hc + c0 + j] + P.rw_gn_b[hc + c0 + j] + bon * V[t * 64 + c0 + j]) * G[t * 64 + c0 + j];
            v2u wv; wv.x = pk2(y[0], y[1]); wv.y = pk2(y[2], y[3]);
            *(v2u*)(P.ocat + (row0 + t) * 1536 + 1024 + hc + c0) = wv; }
        __syncthreads();
    }
}
struct Args { const float* in[31]; float* out; unsigned char* ws; int ph_lo, ph_hi; };
typedef const __attribute__((address_space(4))) Args* ArgP;
struct Frame {
    LAS unsigned char* lds; volatile LAS unsigned* MISC; gu32* ctl;
    int tid, lane, wave, vcu, G, bx;
};
constexpr int SM_HGLB = 0;
constexpr int SM_LAM = 2048;

__device__ __forceinline__ void transpose_item(const float* W, int K, int N, bf16* WT, int k0, int n0, int drow0, LAS float* scr, int lane, int dp = 0) {
    if (dp == 0) dp = K;
#pragma unroll 8
    for (int i = 0; i < 32; ++i) { const int kk = 2 * i + (lane >> 5); scr[kk * 33 + (lane & 31)] = W[(size_t)(k0 + kk) * N + n0 + (lane & 31)]; }
    LDS_WAIT(); asm volatile("" ::: "memory");
    const int c = lane & 7;
#pragma unroll
    for (int j = 0; j < 4; ++j) { const int n = (lane >> 3) + 8 * j; const LAS float* s = scr + (8 * c) * 33 + n;
        v4u o; o.x = pk2(s[0 * 33], s[1 * 33]); o.y = pk2(s[2 * 33], s[3 * 33]); o.z = pk2(s[4 * 33], s[5 * 33]); o.w = pk2(s[6 * 33], s[7 * 33]);
        *(GAS v4u*)(WT + (size_t)(drow0 + n) * dp + k0 + 8 * c) = o; }
    LDS_WAIT(); asm volatile("" ::: "memory");
}
constexpr int CV_IN = 2688, CV_MG = 1536, CV_BR = 768, CV_OUT = 512, CV_EX = 4096, CV_TOTAL = CV_IN + CV_MG + CV_BR + CV_OUT + 3 * CV_EX;
__device__ __forceinline__ void conv_layer(const Frame& F, ArgP A, int l) {
    LAS float* scr = (LAS float*)(F.lds + F.wave * 16384);
    const int gw = F.vcu * NWAVES + F.wave, NGW = F.G * NWAVES;
    bf16* wa = (bf16*)(A->ws + WS_WA); bf16* we = (bf16*)(A->ws + WS_WE);
    for (int it = gw; it < CV_TOTAL; it += NGW) {
        int r = it;
        if (r < CV_IN) { const int kb = r / 168, nb = r % 168; transpose_item(A->in[4] + (size_t)l * DM * INW, DM, INW, wa + WA_IN / 2, 64 * kb, 32 * nb, 32 * nb, scr, F.lane); continue; } r -= CV_IN;
        if (r < CV_MG) { const int br = r / 512, q = r % 512, kb = q / 32, nb = q % 32; transpose_item(A->in[20] + ((size_t)l * 3 + br) * DM * DM, DM, DM, wa + WA_MERGE / 2 + (size_t)br * DM * UP_, 64 * kb, 32 * nb, 32 * nb, scr, F.lane, UP_); continue; } r -= CV_MG;
        if (r < CV_BR) { const int kb = r / 32, nb = r % 32; transpose_item(A->in[22] + (size_t)l * 1536 * DM, 1536, DM, wa + WA_BRANCH / 2, 64 * kb, 32 * nb, 32 * nb, scr, F.lane); continue; } r -= CV_BR;
        if (r < CV_OUT) { const int kb = r / 32, nb = r % 32; transpose_item(A->in[23] + (size_t)l * DM * DM, DM, DM, wa + WA_OUT / 2, 64 * kb, 32 * nb, 32 * nb, scr, F.lane); continue; } r -= CV_OUT;
        if (r < 2 * CV_EX) { const int up = r / CV_EX, q = r % CV_EX, e = q / 256, q2 = q % 256, kb = q2 / 16, nb = q2 % 16, n0 = 32 * nb;
            transpose_item(A->in[28 + up] + ((size_t)l * NE + e) * DM * DE, DM, DE, we + WE_GU / 2 + (size_t)e * DM * DM, 64 * kb, n0, (n0 >> 7) * 256 + up * 128 + (n0 & 127), scr, F.lane); continue; } r -= 2 * CV_EX;
        { const int e = r / 256, q2 = r % 256, kb = q2 / 32, nb = q2 % 32; transpose_item(A->in[30] + ((size_t)l * NE + e) * DE * DM, DE, DM, we + WE_DT / 2 + (size_t)e * DM * DE, 64 * kb, 32 * nb, 32 * nb, scr, F.lane); }
    }
}

__device__ __forceinline__ void phase_prologue(const Frame& F, ArgP A) {
    {   LAS float* cond = (LAS float*)(F.lds);
        float* modp = (float*)(A->ws + WS_MODP);
        for (int it = F.vcu; it < NL * 24 * 4; it += F.G) { const int l = it / 96, r = it % 96, nb = r / 4, kq = r % 4;
            __syncthreads();
            for (int e = F.tid; e < 8 * 256; e += NTHR) { const float cv = A->in[1][(e >> 8) * DM + kq * 256 + (e & 255)]; cond[e] = cv * sigmoidf_(cv); }
            __syncthreads();
            const int n = nb * 256 + (F.tid & 255), kh = F.tid >> 8; float acc[8];
#pragma unroll
            for (int b = 0; b < 8; ++b) acc[b] = 0.f;
            const float* wp = A->in[2] + ((size_t)l * DM + kq * 256 + kh * 128) * 6144 + n;
#pragma unroll 4
            for (int k = 0; k < 128; ++k) { const float wv = wp[(size_t)k * 6144];
#pragma unroll
                for (int b = 0; b < 8; ++b) acc[b] += cond[b * 256 + kh * 128 + k] * wv; }
            const int kp = kq * 2 + kh;
#pragma unroll
            for (int b = 0; b < 8; ++b) modp[(((size_t)kp * NL + l) * NB + b) * 6144 + n] = acc[b]; }
        __syncthreads();
    }
    conv_layer(F, A, 0);
    {   bf16* lo = (bf16*)(A->ws + WS_LORA); const int gt = F.vcu * NTHR + F.tid, NGT = F.G * NTHR;
        for (int e = gt; e < NL * 512 * 64; e += NGT) { const int l = e / 32768, r = e % 32768, c = r >> 6, j = r & 63;
            lo[(size_t)l * 131072 + c * 64 + j] = (bf16)f2bf(A->in[11][(size_t)l * 32768 + j * 512 + c]);
            lo[(size_t)l * 131072 + 32768 + c * 64 + j] = (bf16)f2bf(A->in[13][(size_t)l * 32768 + j * 512 + c]); }
        for (int e = gt; e < NL * 512 * 128; e += NGT) { const int l = e / 65536, r = e % 65536, c = r >> 7, j = r & 127;
            lo[(size_t)l * 131072 + 65536 + c * 128 + j] = (bf16)f2bf(A->in[14][(size_t)l * 65536 + j * 512 + c]); }
    }
    if (F.vcu == 0) { float* sm = (float*)(A->ws + WS_SMALL);
        { const int k = F.tid; float z[4], mx = -1e30f;
#pragma unroll
          for (int l = 0; l < 4; ++l) { z[l] = A->in[5][l * 512 + k]; mx = fmaxf(mx, z[l]); }
          float s = 0.f;
#pragma unroll
          for (int l = 0; l < 4; ++l) { z[l] = __expf(z[l] - mx); s += z[l]; }
          const float inv = 1.0f / s;
          sm[SM_HGLB + k] = 0.f; sm[SM_HGLB + 512 + k] = z[1] * inv; sm[SM_HGLB + 1024 + k] = (z[1] + z[2]) * inv; sm[SM_HGLB + 1536 + k] = (z[1] + z[2] + z[3]) * inv; }
        if (F.wave < 4) { const int l = F.wave; const float* dl = A->in[7] + l * 256;
            const float s1 = wave_sum(dl[F.lane] * dl[64 + F.lane]), s2 = wave_sum(dl[128 + F.lane] * dl[192 + F.lane]);
            const float li = 0.8f - 0.6f * expf(-0.3f * (float)l);
            if (F.lane == 0) { sm[SM_LAM + l] = expf(s1) - expf(s2) + li; sm[SM_LAM + 4 + l] = 1.0f - li; } }
    }
}
__device__ __forceinline__ float mod_from_partials(ArgP A, int l, int b, int n) {
    const float* mp = (const float*)(A->ws + WS_MODP) + ((size_t)l * NB + b) * 6144 + n; float s = A->in[3][l * 6144 + n];
#pragma unroll
    for (int kp = 0; kp < 8; ++kp) s += mp[(size_t)kp * NL * NB * 6144];
    return s;
}
__device__ __forceinline__ void phase_mod_u0(const Frame& F, ArgP A) {
    float* mod = (float*)(A->ws + WS_MOD);
    for (int e = F.vcu * NTHR + F.tid; e < NL * NB * 6144; e += F.G * NTHR) { const int l = e / (NB * 6144), r = e % (NB * 6144); mod[e] = mod_from_partials(A, l, r / 6144, r % 6144); }
    bf16* U = (bf16*)(A->ws + WS_U);
    for (int rb = F.vcu; rb < M / 128; rb += F.G) { const int b = rb / 32;
        float sh[16], sc[16];
#pragma unroll
        for (int j = 0; j < 4; ++j)
#pragma unroll
            for (int i = 0; i < 4; ++i) { const int c = 4 * F.lane + 256 * j + i; sh[j * 4 + i] = mod_from_partials(A, 0, b, c); sc[j * 4 + i] = 1.0f + mod_from_partials(A, 0, b, 1024 + c); }
        for (int i = 0; i < 16; ++i) { const size_t row = (size_t)rb * 128 + F.wave * 16 + i;
            const f32x4* xr = (const f32x4*)(A->in[0] + row * DM) + F.lane; v2u* ur = (v2u*)(U + row * UP_) + F.lane;
#pragma unroll
            for (int j = 0; j < 4; ++j) { const f32x4 v = xr[64 * j]; v2u w; w.x = pk2(v[0] * sc[j * 4 + 0] + sh[j * 4 + 0], v[1] * sc[j * 4 + 1] + sh[j * 4 + 1]); w.y = pk2(v[2] * sc[j * 4 + 2] + sh[j * 4 + 2], v[3] * sc[j * 4 + 3] + sh[j * 4 + 3]); ur[64 * j] = w; } }
    }
}

__device__ __forceinline__ void phase_ln1(const Frame& F, ArgP A, int l) {
    const float* mod = (const float*)(A->ws + WS_MOD);
    const bf16* MIX = (const bf16*)(A->ws + WS_MIX); bf16* U = (bf16*)(A->ws + WS_U);
    const float* xin = (l == 0) ? A->in[0] : A->out;
    LAS float* wrT = (LAS float*)(F.lds);
    LAS int* te = (LAS int*)(F.lds + 65536);
    LAS int* tbase = (LAS int*)(F.lds + 65536 + 1024);
    int* tokpos = (int*)(A->ws + WS_TOK); float* tokw = (float*)(A->ws + WS_TOK + (size_t)M * 8);
    __syncthreads();
    for (int e = F.tid; e < 16 * 1024; e += NTHR) { const int ex = e >> 10, k = e & 1023; wrT[e] = A->in[26][k * 16 + ex]; }
    __syncthreads();
    float rb_[16];
#pragma unroll
    for (int e = 0; e < 16; ++e) rb_[e] = A->in[27][e];
    for (int rb = F.vcu; rb < M / 128; rb += F.G) { const int b = rb / 32; const float* mb = mod + ((size_t)l * NB + b) * 6144;
        float g1[16], sh2[16], sc2[16], lg[16], lb[16];
#pragma unroll
        for (int j = 0; j < 4; ++j)
#pragma unroll
            for (int i = 0; i < 4; ++i) { const int c = 4 * F.lane + 256 * j + i, q = j * 4 + i; g1[q] = 1.0f + mb[2048 + c]; sh2[q] = mb[3072 + c]; sc2[q] = 1.0f + mb[4096 + c]; lg[q] = A->in[24][(l * 2 + 0) * DM + c]; lb[q] = A->in[25][(l * 2 + 0) * DM + c]; }
#pragma unroll 1
        for (int i = 0; i < 16; ++i) { const int tl = F.wave * 16 + i; const size_t row = (size_t)rb * 128 + tl;
            const f32x4* xr = (const f32x4*)(xin + row * DM) + F.lane; const v2u* mr = (const v2u*)(MIX + row * DM) + F.lane;
            float y[16]; float s = 0.f;
#pragma unroll
            for (int j = 0; j < 4; ++j) { const f32x4 v = xr[64 * j]; const v2u m2 = mr[64 * j];
                y[j * 4 + 0] = ALPHA * v[0] + g1[j * 4 + 0] * bflo(m2.x); y[j * 4 + 1] = ALPHA * v[1] + g1[j * 4 + 1] * bfhi(m2.x);
                y[j * 4 + 2] = ALPHA * v[2] + g1[j * 4 + 2] * bflo(m2.y); y[j * 4 + 3] = ALPHA * v[3] + g1[j * 4 + 3] * bfhi(m2.y);
                s += (y[j * 4] + y[j * 4 + 1]) + (y[j * 4 + 2] + y[j * 4 + 3]); }
            const float mean = wave_sum(s) * (1.0f / DM); float q = 0.f;
#pragma unroll
            for (int k = 0; k < 16; ++k) { y[k] -= mean; q += y[k] * y[k]; }
            const float rstd = rsqrtf(wave_sum(q) * (1.0f / DM) + LN_EPS);
            f32x4* xo = (f32x4*)(A->out + row * DM) + F.lane; v2u* ur = (v2u*)(U + row * UP_) + F.lane; float u2[16];
#pragma unroll
            for (int j = 0; j < 4; ++j) { f32x4 o;
#pragma unroll
                for (int k = 0; k < 4; ++k) { o[k] = y[j * 4 + k] * rstd * lg[j * 4 + k] + lb[j * 4 + k]; u2[j * 4 + k] = o[k] * sc2[j * 4 + k] + sh2[j * 4 + k]; }
                xo[64 * j] = o; v2u w; w.x = pk2(u2[j * 4], u2[j * 4 + 1]); w.y = pk2(u2[j * 4 + 2], u2[j * 4 + 3]); ur[64 * j] = w; }
            float sc[16]; float mx = -1e30f;
#pragma unroll
            for (int e = 0; e < 16; ++e) { float p = 0.f;
#pragma unroll
                for (int j = 0; j < 4; ++j) { const f32x4 wv = *(const LAS f32x4*)(wrT + e * 1024 + 4 * F.lane + 256 * j); p += (u2[j * 4] * wv[0] + u2[j * 4 + 1] * wv[1]) + (u2[j * 4 + 2] * wv[2] + u2[j * 4 + 3] * wv[3]); }
                sc[e] = wave_sum(p); mx = fmaxf(mx, sc[e]); }
            float den = 0.f;
#pragma unroll
            for (int e = 0; e < 16; ++e) { sc[e] = __expf(sc[e] - mx); den += sc[e]; }
            const float iden = 1.0f / den; float sel[16];
#pragma unroll
            for (int e = 0; e < 16; ++e) { sc[e] *= iden; sel[e] = sc[e] + rb_[e]; }
            int bg = 0; float bgs = -1e30f;
#pragma unroll
            for (int gq = 0; gq < 4; ++gq) { float m1 = -1e30f, m2 = -1e30f;
#pragma unroll
                for (int k = 0; k < 4; ++k) { const float v = sel[gq * 4 + k]; if (v > m1) { m2 = m1; m1 = v; } else if (v > m2) m2 = v; }
                const float gs = m1 + m2; if (gs > bgs) { bgs = gs; bg = gq; } }
            int i0 = 0, i1 = 0; float v0 = -1e30f, v1 = -1e30f, w0 = 0.f, w1 = 0.f;
#pragma unroll
            for (int e = 0; e < 16; ++e) { if ((e >> 2) == bg) { const float v = sel[e]; if (v > v0) { v1 = v0; i1 = i0; w1 = w0; v0 = v; i0 = e; w0 = sc[e]; } else if (v > v1) { v1 = v; i1 = e; w1 = sc[e]; } } }
            const float iw = 1.0f / (w0 + w1);
            if (F.lane == 0) { te[tl * 2] = i0; te[tl * 2 + 1] = i1; tokw[row * 2] = w0 * iw; tokw[row * 2 + 1] = w1 * iw; }
        }
        __syncthreads();
        if (F.tid < 16) { int n = 0; for (int k = 0; k < 256; ++k) n += (te[k] == F.tid) ? 1 : 0;
            tbase[F.tid] = (int)__hip_atomic_fetch_add(F.ctl + CW_ECNT + 64 * l + F.tid, (unsigned)n, RLX_AGENT);
            int p = tbase[F.tid];
            for (int k = 0; k < 256; ++k) if (te[k] == F.tid) { tokpos[(size_t)rb * 256 + k] = (F.tid << 24) | p; ++p; } }
        __syncthreads();
    }
}
__device__ __forceinline__ void load_hb(const Frame& F, int l, volatile LAS int* hb, int c) {
    __syncthreads();
    if (F.tid == 0) { int acc = 0; for (int e = 0; e < 16; ++e) { hb[e] = acc; const int cn = (int)__hip_atomic_load(F.ctl + CW_ECNT + 64 * l + e, RLX_AGENT); acc += (cn + 255) & ~255; } hb[16] = acc; hb[17] = acc >> 8;
        const int nun = (acc >> 8) * 4; int n = 0;
        for (int L = c; L < nun && n < 12; L += F.G) { const int j = L >> 2, pn = L & 3; int e = 0; for (int k = 1; k < 16; ++k) e = (hb[k] <= j * 256) ? k : e; hb[19 + n] = (j << 8) | (pn << 4) | e; ++n; }
        hb[18] = n; }
    __syncthreads();
}
__device__ __forceinline__ void phase_scatter(const Frame& F, ArgP A, int l) {
    volatile LAS int* hb = (volatile LAS int*)(F.lds + 4096);
    load_hb(F, l, hb, 0);
    const int* tokpos = (const int*)(A->ws + WS_TOK); int* tokrow = (int*)(A->ws + WS_TOK + (size_t)M * 16);
    const bf16* U = (const bf16*)(A->ws + WS_U); bf16* AS = (bf16*)(A->ws + WS_AS);
    for (int rb = F.vcu; rb < M / 128; rb += F.G) {
        for (int i = 0; i < 32; ++i) { const int k = F.wave * 32 + i; const size_t idx = (size_t)rb * 256 + k; const int tp = tokpos[idx]; const int e = tp >> 24, pos = tp & 0xffffff;
            const int row = hb[e] + pos; const size_t tok = idx >> 1;
            const v4u* src = (const v4u*)(U + tok * UP_) + F.lane; v4u* dst = (v4u*)(AS + (size_t)row * DM) + F.lane;
            const v4u a = src[0], c = src[64]; dst[0] = a; dst[64] = c;
            if (F.lane == 0) tokrow[idx] = row; }
    }
}
__device__ __forceinline__ void phase_ln2(const Frame& F, ArgP A, int l) {
    const float* mod = (const float*)(A->ws + WS_MOD);
    const bf16* Y = (const bf16*)(A->ws + WS_Y); bf16* U = (bf16*)(A->ws + WS_U);
    const int* tokrow = (const int*)(A->ws + WS_TOK + (size_t)M * 16); const float* tokw = (const float*)(A->ws + WS_TOK + (size_t)M * 8);
    for (int rb = F.vcu; rb < M / 128; rb += F.G) { const int b = rb / 32; const float* mb = mod + ((size_t)l * NB + b) * 6144; const float* mn = mod + ((size_t)(l < NL - 1 ? l + 1 : l) * NB + b) * 6144;
        float g2[16], sh1[16], sc1[16], lg[16], lb[16];
#pragma unroll
        for (int j = 0; j < 4; ++j)
#pragma unroll
            for (int i = 0; i < 4; ++i) { const int c = 4 * F.lane + 256 * j + i, q = j * 4 + i; g2[q] = 1.0f + mb[5120 + c]; sh1[q] = mn[c]; sc1[q] = 1.0f + mn[1024 + c]; lg[q] = A->in[24][(l * 2 + 1) * DM + c]; lb[q] = A->in[25][(l * 2 + 1) * DM + c]; }
#pragma unroll 1
        for (int i = 0; i < 16; ++i) { const size_t row = (size_t)rb * 128 + F.wave * 16 + i;
            const int r0 = tokrow[row * 2], r1 = tokrow[row * 2 + 1]; const float w0 = tokw[row * 2], w1 = tokw[row * 2 + 1];
            const f32x4* xr = (const f32x4*)(A->out + row * DM) + F.lane; const v2u* y0 = (const v2u*)(Y + (size_t)r0 * DM) + F.lane; const v2u* y1 = (const v2u*)(Y + (size_t)r1 * DM) + F.lane;
            float y[16]; float s = 0.f;
#pragma unroll
            for (int j = 0; j < 4; ++j) { const f32x4 v = xr[64 * j]; const v2u a = y0[64 * j], c = y1[64 * j];
                y[j * 4 + 0] = ALPHA * v[0] + g2[j * 4 + 0] * (w0 * bflo(a.x) + w1 * bflo(c.x)); y[j * 4 + 1] = ALPHA * v[1] + g2[j * 4 + 1] * (w0 * bfhi(a.x) + w1 * bfhi(c.x));
                y[j * 4 + 2] = ALPHA * v[2] + g2[j * 4 + 2] * (w0 * bflo(a.y) + w1 * bflo(c.y)); y[j * 4 + 3] = ALPHA * v[3] + g2[j * 4 + 3] * (w0 * bfhi(a.y) + w1 * bfhi(c.y));
                s += (y[j * 4] + y[j * 4 + 1]) + (y[j * 4 + 2] + y[j * 4 + 3]); }
            const float mean = wave_sum(s) * (1.0f / DM); float q = 0.f;
#pragma unroll
            for (int k = 0; k < 16; ++k) { y[k] -= mean; q += y[k] * y[k]; }
            const float rstd = rsqrtf(wave_sum(q) * (1.0f / DM) + LN_EPS);
            f32x4* xo = (f32x4*)(A->out + row * DM) + F.lane; v2u* ur = (v2u*)(U + row * UP_) + F.lane;
#pragma unroll
            for (int j = 0; j < 4; ++j) { f32x4 o; float u[4];
#pragma unroll
                for (int k = 0; k < 4; ++k) { o[k] = y[j * 4 + k] * rstd * lg[j * 4 + k] + lb[j * 4 + k]; u[k] = o[k] * sc1[j * 4 + k] + sh1[j * 4 + k]; }
                xo[64 * j] = o; if (l < NL - 1) { v2u w; w.x = pk2(u[0], u[1]); w.y = pk2(u[2], u[3]); ur[64 * j] = w; } }
        }
    }
}
struct SchedProj {
    static constexpr unsigned LDA = UP_ * 2, LDB = 2048; static constexpr int NT = 16; static constexpr bool VARNT = false;
    const char* U; const char* W; int G, c;
    __device__ __forceinline__ bool next(int i, pg8::GUnit& u, pg8::GOps& o) const { int pm, pn; if (!pg8::static_tile(M / 256, INW / 256, G, c, i, pm, pn)) return false;
        o.A = U + (size_t)pm * 256 * LDA; o.B = W + (size_t)pn * 256 * 2048; u.kind = 0; u.r0 = pm * 256; u.c0 = pn * 256; u.aux = (pn == 8 || pn == 9) ? 1 : 0; return true; }
};
struct SchedBranch {
    static constexpr unsigned LDA = 3072, LDB = 3072; static constexpr int NT = 16; static constexpr bool VARNT = true;
    const char* U; const char* WM; const char* OC; const char* WB; int G, c;
    __device__ __forceinline__ bool next(int i, pg8::GUnit& u, pg8::GOps& o) const { int pm, pn; if (!pg8::static_tile(M / 256, 4, G, c, i >> 2, pm, pn)) return false; const int sub = i & 3;
        u.r0 = pm * 256; u.c0 = pn * 256;
        if (sub < 3) { o.A = U + (size_t)pm * 256 * 3072; o.B = WM + ((size_t)sub * 1024 + pn * 256) * 3072; o.nt = 16; u.kind = 1; u.aux = sub; }
        else { o.A = OC + (size_t)pm * 256 * 3072; o.B = WB + (size_t)pn * 256 * 3072; o.nt = 24; u.kind = 2; u.aux = 0; }
        return true; }
};
struct SchedOut {
    static constexpr unsigned LDA = 2048, LDB = 2048; static constexpr int NT = 16; static constexpr bool VARNT = false;
    const char* Am; const char* W; int G, c;
    __device__ __forceinline__ bool next(int i, pg8::GUnit& u, pg8::GOps& o) const { int pm, pn; if (!pg8::static_tile(M / 256, 4, G, c, i, pm, pn)) return false;
        o.A = Am + (size_t)pm * 256 * 2048; o.B = W + (size_t)pn * 256 * 2048; u.kind = 0; u.r0 = pm * 256; u.c0 = pn * 256; u.aux = 0; return true; }
};
template <int UP> struct SchedMoe {
    static constexpr unsigned LDA = UP ? 2048 : 1024, LDB = LDA; static constexpr int NT = UP ? 16 : 8; static constexpr bool VARNT = false;
    const char* Am; const char* W; volatile LAS int* hb;
    __device__ __forceinline__ bool next(int i, pg8::GUnit& u, pg8::GOps& o) const { const int n = __builtin_amdgcn_readfirstlane(hb[18]); if (i >= n) return false;
        const int pk = __builtin_amdgcn_readfirstlane(hb[19 + i]); const int j = pk >> 8, pn = (pk >> 4) & 15, e = pk & 15;
        u.r0 = j * 256; u.aux = 0; u.kind = UP ? 3 : 0; u.c0 = UP ? pn * 128 : pn * 256;
        o.A = Am + (size_t)j * 256 * LDA; o.B = W + ((size_t)e * 1024 + pn * 256) * LDB;
        return true; }
};

constexpr int NPH = 2 + 9 * NL;
#ifndef PH_MASK
#define PH_MASK 0xffff
#endif
#define PHM(b) ((PH_MASK >> (b)) & 1)
__global__ void __launch_bounds__(NTHR, 2) hybrid_fwd(Args args) {
    extern __shared__ __attribute__((aligned(16))) unsigned char lds[];
    Frame F; unsigned char* ws; ArgP A;
#define FRESH() do { int t_ = threadIdx.x; asm volatile("" : "+v"(t_)); { unsigned long long p_ = (unsigned long long)__builtin_amdgcn_kernarg_segment_ptr(); asm volatile("" : "+s"(p_)); A = (ArgP)p_; } ws = A->ws; \
        F.lds = (LAS unsigned char*)lds; F.MISC = (volatile LAS unsigned*)(F.lds + MISC_OFF); F.tid = t_; F.lane = t_ & 63; F.wave = __builtin_amdgcn_readfirstlane(t_ >> 6); \
        { int g_ = gridDim.x, b_ = blockIdx.x; asm volatile("" : "+s"(g_), "+s"(b_)); F.G = g_; F.bx = b_; F.vcu = (g_ % 8 == 0) ? (b_ % 8) * (g_ / 8) + b_ / 8 : b_; } F.ctl = (gu32*)(ws + WS_CTL); } while (0)
    FRESH();
    for (int u = F.tid; u < (LDS_BYTES - LDSCTL_OFF) / 4; u += NTHR) ((LAS unsigned*)(F.lds + LDSCTL_OFF))[u] = 0u;
    __syncthreads();
    XcdBarrier bar; bar.bar = (unsigned*)(ws + WS_CTL) + CW_BAR; bar.x = 0; bar.st = nullptr;
    if (!MK_PER_PHASE) bar = xcd_barrier_post((unsigned*)(ws + WS_CTL) + CW_BAR, F.MISC + 8);
    const int lo = A->ph_lo, hi = A->ph_hi;
#define IN(k) (lo <= (k) && (k) < hi)
#define SEAM(k) do { if (IN(k) && IN((k) + 1)) xcd_barrier(bar); } while (0)

    if (PHM(0) && IN(0)) { FRESH(); phase_prologue(F, A); SEAM(0); }
    if (PHM(1) && IN(1)) { FRESH(); phase_mod_u0(F, A); SEAM(1); }

#pragma unroll 1
    for (int l = 0; l < NL; ++l) {
        const int pb = 2 + 9 * l;
        if (PHM(2) && IN(pb + 0)) {
            FRESH(); const char* WA = (const char*)(ws + WS_WA); const char* WE = (const char*)(ws + WS_WE); (void)WA; (void)WE;
            SchedProj S{(const char*)(ws + WS_U), WA + WA_IN, F.G, F.bx};
            pg8::Epi<1> E{(bf16*)(ws + WS_PROJ), INW, C2Q, nullptr, nullptr};
            pg8::gemm_phase<false>(F.lds, S, E);
            SEAM(pb + 0);
        }
        if (IN(pb + 1)) {
            FRESH();
            const float* sm = (const float*)(ws + WS_SMALL);
            MixP P;
            P.proj = (const bf16*)(ws + WS_PROJ); P.ocat = (bf16*)(ws + WS_OCAT); P.oatt = (bf16*)(ws + WS_OATT);
            P.hg_lb = sm + SM_HGLB + l * 512; P.hg_norm_g = A->in[6] + l * 128; P.lam = sm[SM_LAM + l]; P.one_m_lam_init = sm[SM_LAM + 4 + l]; P.da_subln_g = A->in[8] + l * 128;
            P.rw_mu = A->in[9] + l * 1792; P.rw_w0 = A->in[10] + l * 512; P.rw_a0 = A->in[12] + l * 512; P.rw_k_k = A->in[15] + l * 512; P.rw_k_a = A->in[16] + l * 512;
            P.rw_r_k = A->in[17] + l * 512; P.rw_gn_g = A->in[18] + l * 512; P.rw_gn_b = A->in[19] + l * 512;
            const bf16* lo_ = (const bf16*)(ws + WS_LORA) + (size_t)l * 131072; P.wupT = lo_; P.aupT = lo_ + 32768; P.gupT = lo_ + 65536;
            P.aq = F.ctl + CW_AQ + 64 * l;
            if (F.G >= 128) {
                if (PHM(3) && F.vcu < 64) rwkv_unit(P, F.vcu >> 3, F.vcu & 7, F.lds);
                else if (PHM(4) && F.vcu < 96) hgrn_unit(P, (F.vcu - 64) >> 2, (F.vcu - 64) & 3, F.lds);
                else if (PHM(5)) attn_worker(P, (char*)lds, F.MISC + 16, F.tid);
            }
            SEAM(pb + 1);
        }
        if (PHM(6) && IN(pb + 2)) {
            FRESH(); const char* WA = (const char*)(ws + WS_WA); const char* WE = (const char*)(ws + WS_WE); (void)WA; (void)WE;
            SchedBranch S{(const char*)(ws + WS_U), WA + WA_MERGE, (const char*)(ws + WS_OCAT), WA + WA_BRANCH, F.G, F.bx};
            pg8::Epi<6> E{(bf16*)(ws + WS_MERGED), DM, 1.0f, A->in[21] + (size_t)l * 3 * DM, (v4u*)(ws + WS_GSCR) + (size_t)F.bx * 3 * 16 * 512};
            pg8::gemm_phase<false>(F.lds, S, E);
            SEAM(pb + 2);
        }
        if (PHM(7) && IN(pb + 3)) {
            FRESH(); const char* WA = (const char*)(ws + WS_WA); const char* WE = (const char*)(ws + WS_WE); (void)WA; (void)WE;
            SchedOut S{(const char*)(ws + WS_MERGED), WA + WA_OUT, F.G, F.bx};
            pg8::Epi<1> E{(bf16*)(ws + WS_MIX), DM, 1.0f, nullptr, nullptr};
            pg8::gemm_phase<false>(F.lds, S, E);
            SEAM(pb + 3);
        }
        if (PHM(8) && IN(pb + 4)) { FRESH(); phase_ln1(F, A, l); SEAM(pb + 4); }
        if (PHM(9) && IN(pb + 5)) { FRESH(); phase_scatter(F, A, l); SEAM(pb + 5); }
        if (PHM(10) && IN(pb + 6)) {
            FRESH(); const char* WA = (const char*)(ws + WS_WA); const char* WE = (const char*)(ws + WS_WE); (void)WA; (void)WE;
            volatile LAS int* hb = (volatile LAS int*)(F.lds + LDSCTL_OFF + 128);
            load_hb(F, l, hb, F.bx);
            SchedMoe<1> S{(const char*)(ws + WS_AS), WE + WE_GU, hb};
            pg8::Epi<8> E{(bf16*)(ws + WS_H), DE, 1.0f, nullptr, nullptr};
            pg8::gemm_phase<false>(F.lds, S, E);
            SEAM(pb + 6);
        }
        if (PHM(11) && IN(pb + 7)) {
            FRESH(); const char* WA = (const char*)(ws + WS_WA); const char* WE = (const char*)(ws + WS_WE); (void)WA; (void)WE;
            volatile LAS int* hb = (volatile LAS int*)(F.lds + LDSCTL_OFF + 128);
            load_hb(F, l, hb, F.bx);
            SchedMoe<0> S{(const char*)(ws + WS_H), WE + WE_DT, hb};
            pg8::Epi<1> E{(bf16*)(ws + WS_Y), DM, 1.0f, nullptr, nullptr};
            pg8::gemm_phase<false>(F.lds, S, E);
            SEAM(pb + 7);
        }
        if (PHM(12) && IN(pb + 8)) { FRESH(); if (l < NL - 1) conv_layer(F, A, l + 1); phase_ln2(F, A, l); SEAM(pb + 8); }
    }
#undef IN
#undef SEAM
}

extern "C" void kernel_launch(void* const* d_in, const int* in_sizes, int n_in, void* d_out, int out_size, void* d_ws, size_t ws_size, hipStream_t stream) {
    static int grid = 0;
    if (grid == 0) {
        if (n_in != 31 || out_size != M * DM || ws_size < WS_END) { fprintf(stderr, "kernel_launch: unexpected shapes (n_in %d, out %d, ws %zu < %zu); nothing launched\n", n_in, out_size, ws_size, (size_t)WS_END); grid = -1; return; }
        int dev = 0, cus = 0, per_cu = 0;
        if (hipGetDevice(&dev) != hipSuccess || hipDeviceGetAttribute(&cus, hipDeviceAttributeMultiprocessorCount, dev) != hipSuccess) { grid = -1; return; }
        if (hipFuncSetAttribute((const void*)hybrid_fwd, hipFuncAttributeMaxDynamicSharedMemorySize, LDS_BYTES) != hipSuccess) { fprintf(stderr, "kernel_launch: hipFuncSetAttribute failed\n"); grid = -1; return; }
        if (hipOccupancyMaxActiveBlocksPerMultiprocessor(&per_cu, (const void*)hybrid_fwd, NTHR, LDS_BYTES) != hipSuccess || per_cu < 1) { fprintf(stderr, "kernel_launch: occupancy query reports %d\n", per_cu); }
        (void)hipGetLastError();
        grid = cus;
        if (grid > 256) grid = 256;
    }
    if (grid < 0) return;
    (void)hipMemsetAsync((char*)d_ws + WS_CTL, 0, CTL_ZERO_BYTES, stream);
    Args a{};
    for (int i = 0; i < 31; ++i) a.in[i] = (const float*)d_in[i];
    a.out = (float*)d_out; a.ws = (unsigned char*)d_ws;
#if MK_PER_PHASE
    for (int p = 0; p < NPH; ++p) { a.ph_lo = p; a.ph_hi = p + 1; hipLaunchKernelGGL(hybrid_fwd, dim3(grid), dim3(NTHR), LDS_BYTES, stream, a); }
#else
    a.ph_lo = 0; a.ph_hi = NPH; hipLaunchKernelGGL(hybrid_fwd, dim3(grid), dim3(NTHR), LDS_BYTES, stream, a);
#endif
}
```

```cpp
#include <hip/hip_runtime.h>
#include <hip/hip_bf16.h>
#include <cstdio>
#include <cstdint>

#ifndef MK_PER_PHASE
#define MK_PER_PHASE 0
#endif

#define GAS __attribute__((address_space(1)))
#define LAS __attribute__((address_space(3)))
typedef unsigned short bf16;
typedef unsigned v4u __attribute__((ext_vector_type(4)));
typedef unsigned v2u __attribute__((ext_vector_type(2)));
typedef float f32x4 __attribute__((ext_vector_type(4)));
typedef float f32x2 __attribute__((ext_vector_type(2)));
typedef float f32x16 __attribute__((ext_vector_type(16)));
typedef short bf16x8 __attribute__((ext_vector_type(8)));
typedef short s16x4 __attribute__((ext_vector_type(4)));
typedef GAS unsigned gu32;
#define RLX_AGENT __ATOMIC_RELAXED, __HIP_MEMORY_SCOPE_AGENT
#define LDS_WAIT() asm volatile("s_waitcnt lgkmcnt(0)" ::: "memory")
#define VM_WAIT() asm volatile("s_waitcnt vmcnt(0)" ::: "memory")

constexpr int DM = 1024, NB = 8, T = 4096, NL = 4, M = NB * T;
constexpr int INW = 5376;
constexpr int C_HGQ = 0, C_HGF = 512, C_HGI = 1024, C_HGO = 1536, C_DAQ = 2048, C_DAK = 2560, C_DAV = 3072, C_RW = 3584;
constexpr int C_RWR = C_RW, C_RWK = C_RW + 512, C_RWV = C_RW + 1024, C_RWWD = C_RW + 1536, C_RWAD = C_RW + 1600, C_RWGD = C_RW + 1664;
constexpr int NE = 16, DE = 512;
constexpr float ALPHA = 1.681792830507429f;
constexpr float LN_EPS = 1e-5f, RMS_EPS = 1e-6f, RW_GN_EPS = 64e-5f, HG_F_MIN = 1e-6f;
constexpr float LOG2E = 1.4426950408889634f;
constexpr float C2Q = 0.125f * LOG2E;

constexpr size_t MiB = 1u << 20;
constexpr size_t WS_CTL = 0, CTL_ZERO_BYTES = 1 * MiB;
constexpr size_t WS_MODP = 1 * MiB;
constexpr size_t WS_MOD = 7 * MiB;
constexpr size_t WS_SMALL = 8 * MiB;
constexpr size_t WS_TOK = 9 * MiB;
constexpr size_t WS_LORA = 11 * MiB;
constexpr int UP_ = 1536;
constexpr size_t WS_WA = 12 * MiB;
constexpr size_t WA_IN = 0, WA_MERGE = (size_t)INW * DM * 2, WA_BRANCH = WA_MERGE + (size_t)3 * DM * UP_ * 2, WA_OUT = WA_BRANCH + (size_t)DM * 1536 * 2, WA_END = WA_OUT + (size_t)DM * DM * 2;
constexpr size_t WS_WE = 40 * MiB;
constexpr size_t WE_GU = 0, WE_DT = (size_t)32 * MiB;
constexpr size_t WS_U = 88 * MiB;
constexpr size_t WS_PROJ = 184 * MiB;
constexpr size_t WS_OCAT = 520 * MiB;
constexpr size_t WS_OATT = 616 * MiB;
constexpr size_t WS_END = 680 * MiB;
constexpr size_t WS_GSCR = WS_PROJ;
constexpr size_t WS_MERGED = WS_PROJ + 96 * MiB;
constexpr size_t WS_MIX = WS_PROJ + 160 * MiB;
constexpr size_t WS_AS = WS_PROJ;
constexpr size_t WS_H = WS_PROJ + 224 * MiB;
constexpr size_t WS_Y = WS_OCAT;
constexpr int MAXROWS = 2 * M + NE * 256;
static_assert(WA_END <= 28 * MiB, "WA");
static_assert((size_t)MAXROWS * 2048 <= 160 * MiB && (size_t)MAXROWS * 1024 <= 112 * MiB, "moe buffers");

constexpr int CW_TMO = 0, CW_CODE = 1;
constexpr int CW_BAR = 4096;
constexpr int CW_ECNT = 16384;
constexpr int CW_AQ = 20480;

constexpr int RING_BYTES = 131072;
constexpr int LDSCTL_OFF = RING_BYTES, MISC_OFF = LDSCTL_OFF + 320;
constexpr int LDS_BYTES = 147456;
constexpr int NWAVES = 8, NTHR = 512;

__device__ __forceinline__ unsigned f2bf(float f) { unsigned u = __builtin_bit_cast(unsigned, f); return (u + 0x7fffu + ((u >> 16) & 1u)) >> 16; }
__device__ __forceinline__ unsigned pk2(float lo, float hi) { return f2bf(lo) | (f2bf(hi) << 16); }
__device__ __forceinline__ float bf2f(unsigned short b) { return __builtin_bit_cast(float, ((unsigned)b) << 16); }
__device__ __forceinline__ float bflo(unsigned w) { return __builtin_bit_cast(float, w << 16); }
__device__ __forceinline__ float bfhi(unsigned w) { return __builtin_bit_cast(float, w & 0xffff0000u); }
__device__ __forceinline__ unsigned cvt_pk_bf16(float lo, float hi) { unsigned r; asm volatile("v_cvt_pk_bf16_f32 %0, %1, %2" : "=v"(r) : "v"(lo), "v"(hi)); return r; }
__device__ __forceinline__ float sigmoidf_(float x) { return 1.0f / (1.0f + __expf(-x)); }
__device__ __forceinline__ float wave_sum(float v) {
#pragma unroll
    for (int o = 1; o < 64; o <<= 1) v += __shfl_xor(v, o);
    return v;
}

#define XB_TMO      128
#define XB_XCNT(j)  (256  + 64 * (j))
#define XB_XSUB(j)  (1280 + 64 * (j))
#define XB_XGEN(j)  (2304 + 64 * (j))
#define XB_TOP      3328
#define XB_TOPGEN   3392
#define XCD_BAR_WORDS 3456
#define XB_SPIN_CAP (1u << 20)

__device__ __forceinline__ unsigned xb_ld(unsigned* p)              { return __hip_atomic_load(p, __ATOMIC_RELAXED, __HIP_MEMORY_SCOPE_AGENT); }
__device__ __forceinline__ unsigned xb_add(unsigned* p, unsigned v) { return __hip_atomic_fetch_add(p, v, __ATOMIC_RELAXED, __HIP_MEMORY_SCOPE_AGENT); }
__device__ __forceinline__ unsigned xb_xcc_id() { return (unsigned)__builtin_amdgcn_s_getreg((3 << 11) | 20) & 0xFu; }
#define XB_SPIN(cond, bar) do { unsigned _sp = 0; while (cond) { __builtin_amdgcn_s_sleep(1); \
    if ((++_sp & 255u) == 0u) { if (xb_ld(&(bar)[XB_TMO])) break; if (_sp > XB_SPIN_CAP) { atomicAdd(&(bar)[XB_TMO], 1u); break; } } } } while (0)

struct XcdBarrier { unsigned* bar; unsigned x; volatile LAS unsigned* st; };

__device__ __forceinline__ XcdBarrier xcd_barrier_post(unsigned* bar, volatile LAS unsigned* st) {
    XcdBarrier b; b.bar = bar; b.x = xb_xcc_id(); b.st = st;
    if (threadIdx.x == 0) (void)xb_add(&bar[XB_XCNT(b.x)], 1u);
    return b;
}
__device__ __forceinline__ void xcd_barrier_complete(unsigned* bar, unsigned x, unsigned& nloc, unsigned& nx) {
    const unsigned G = gridDim.x * gridDim.y * gridDim.z;
    unsigned sum, cnt, mine, sp = 0u;
    for (;;) {
        sum = 0u; cnt = 0u; mine = 0u;
#pragma unroll 1
        for (unsigned j = 0; j < 16; ++j) { const unsigned c = xb_ld(&bar[XB_XCNT(j)]); sum += c; cnt += (c > 0u) ? 1u : 0u; mine = (j == x) ? c : mine; }
        if (sum == G) break;
        __builtin_amdgcn_s_sleep(1);
        if ((++sp & 255u) == 0u) { if (xb_ld(&bar[XB_TMO])) break; if (sp > XB_SPIN_CAP) { atomicAdd(&bar[XB_TMO], 1u); break; } }
    }
    nloc = mine > 0u ? mine : 1u; nx = cnt > 0u ? cnt : 1u;
}
__device__ __forceinline__ void xcd_barrier(const XcdBarrier& b) {
    asm volatile("s_waitcnt vmcnt(0)" ::: "memory");
    __syncthreads();
    if (threadIdx.x == 0) {
        unsigned* bar = b.bar;
        __builtin_amdgcn_s_waitcnt(0);
        unsigned nloc = b.st[0], nx = b.st[1];
        if (nloc == 0u) { xcd_barrier_complete(bar, b.x, nloc, nx); b.st[0] = nloc; b.st[1] = nx; }
        const unsigned old = xb_add(&bar[XB_XSUB(b.x)], 1u);
        const unsigned gen = old / nloc;
        if (old + 1u == (gen + 1u) * nloc) {
            __builtin_amdgcn_fence(__ATOMIC_RELEASE, "agent");
            asm volatile("s_waitcnt vmcnt(0)" ::: "memory");
            const unsigned og = xb_add(&bar[XB_TOP], 1u);
            const unsigned tg = og / nx;
            if (og + 1u == (tg + 1u) * nx) xb_add(&bar[XB_TOPGEN], 1u);
            else XB_SPIN(xb_ld(&bar[XB_TOPGEN]) == tg, bar);
            __builtin_amdgcn_fence(__ATOMIC_ACQUIRE, "agent");
            xb_add(&bar[XB_XGEN(b.x)], 1u);
            asm volatile("s_waitcnt vmcnt(0)" ::: "memory");
        } else {
            XB_SPIN(xb_ld(&bar[XB_XGEN(b.x)]) == gen, bar);
            __builtin_amdgcn_fence(__ATOMIC_ACQUIRE, "agent");
            asm volatile("s_waitcnt vmcnt(0)" ::: "memory");
        }
    }
    __syncthreads();
}
namespace pg8 {
#define PG8_LAS __attribute__((address_space(3)))
constexpr int BM = 256, BK = 64, HALF = 128, HTB = HALF * BK * 2, STAGE_BYTES = 8 * HTB, NXCD = 8, WGM = 8;
__host__ __device__ __forceinline__ int lds_byte(int r, int c) { const int st = (r >> 4) * 2 + (c >> 5), rr = r & 15, cc = c & 31, ob = rr * 64 + cc * 2; return st * 1024 + (ob ^ (((ob >> 9) & 1) << 5)); }
__host__ __device__ __forceinline__ void stage_rc(int b, int& R, int& C) { const int st = b / 1024, sb = b % 1024, swz = sb ^ (((sb >> 9) & 1) << 5); R = (st >> 1) * 16 + swz / 64; C = (st & 1) * 32 + (swz % 64) / 2; }
__host__ __device__ __forceinline__ int perm32(int rho) { const int n = rho >> 4, i = rho & 15; return 8 * (i >> 2) + 4 * n + (i & 3); }

struct GUnit {
    int kind;
    int r0, c0;
    int aux;
};
struct GOps {
    const char* A; const char* B; unsigned lda, ldb; int nt;
};
__device__ __forceinline__ bool static_tile(int nM, int nN, int G, int c, int i, int& pm, int& pn) {
    const int nwg = nM * nN; const long L = (long)i * G + c; if (L >= nwg) return false;
    int wgid = (int)L; { const int q = nwg / NXCD, r = nwg % NXCD, xcd = wgid % NXCD, off = wgid / NXCD; wgid = (xcd < r ? xcd * (q + 1) : r * (q + 1) + (xcd - r) * q) + off; }
    const int nig = WGM * nN, gid = wgid / nig, fm = gid * WGM, gsz = (nM - fm) < WGM ? (nM - fm) : WGM;
    pm = fm + ((wgid % nig) % gsz); pn = (wgid % nig) / gsz; return true;
}

template <bool VARLD, class Sched, class Epi>
__device__ __forceinline__ void gemm_phase(PG8_LAS unsigned char* lds, const Sched& S, const Epi& E) {
    int tid_ = threadIdx.x; asm volatile("" : "+v"(tid_));
    const int tid = tid_, wid = __builtin_amdgcn_readfirstlane(tid >> 6), lane = tid & 63, wr = wid >> 2, wc = wid & 3, fr = lane & 15, fq = lane >> 4;
    int R0, C0, R1, C1; stage_rc(tid * 16, R0, C0); stage_rc(tid * 16 + 8192, R1, C1);
    const int Rb0 = (R0 & ~31) + perm32(R0 & 31), Rb1 = (R1 & ~31) + perm32(R1 & 31);
    const unsigned ldsw = (unsigned)wid * 1024u;
    const int aoff = lds_byte(wr * 64 + fr, fq * 8), boff = lds_byte(wc * 32 + fr, fq * 8);
#define PG8_SA(b, h) (((b) * 2 + (h)) * HTB)
#define PG8_SB(b, h) ((4 + (b) * 2 + (h)) * HTB)
#define PG8_STAGE(bufoff, gbase, v0, v1) do { \
        __builtin_amdgcn_global_load_lds((const unsigned*)((const char*)(gbase) + (v0)), (PG8_LAS unsigned*)(lds + (bufoff) + ldsw), 16, 0, 0); \
        __builtin_amdgcn_global_load_lds((const unsigned*)((const char*)(gbase) + (v1)), (PG8_LAS unsigned*)(lds + (bufoff) + ldsw + 8192), 16, 0, 0); } while (0)
#define PG8_LDA(dst, b, h) do { _Pragma("unroll") for (int m = 0; m < 4; ++m) _Pragma("unroll") for (int k = 0; k < 2; ++k) dst[m][k] = *(const PG8_LAS bf16x8*)(lds + PG8_SA(b, h) + aoff + m * 2048 + k * 1024); } while (0)
#define PG8_LDB(dst, b, h) do { _Pragma("unroll") for (int n = 0; n < 2; ++n) _Pragma("unroll") for (int k = 0; k < 2; ++k) dst[n][k] = *(const PG8_LAS bf16x8*)(lds + PG8_SB(b, h) + boff + n * 2048 + k * 1024); } while (0)
#define PG8_MMA(ai, bj, At, Bt) do { __builtin_amdgcn_s_setprio(1); _Pragma("unroll") for (int m = 0; m < 4; ++m) _Pragma("unroll") for (int n = 0; n < 2; ++n) _Pragma("unroll") for (int k = 0; k < 2; ++k) \
        acc[ai][bj][m][n] = __builtin_amdgcn_mfma_f32_16x16x32_bf16(Bt[n][k], At[m][k], acc[ai][bj][m][n], 0, 0, 0); __builtin_amdgcn_s_setprio(0); } while (0)
#define PG8_WAIT_V(n) asm volatile("s_waitcnt vmcnt(" #n ")" ::: "memory")
#define PG8_WAIT_L(n) asm volatile("s_waitcnt lgkmcnt(" #n ")" ::: "memory")
#define PG8_BAR __builtin_amdgcn_s_barrier()
#define PG8_SCHED __builtin_amdgcn_sched_barrier(0)
    GUnit cur, nxt; GOps co, no_; int ui = 0;
    if (!S.next(0, cur, co)) return;
    f32x4 acc[2][2][4][2];
#pragma unroll
    for (int a = 0; a < 2; ++a)
#pragma unroll
        for (int b = 0; b < 2; ++b)
#pragma unroll
            for (int m = 0; m < 4; ++m)
#pragma unroll
                for (int n = 0; n < 2; ++n) acc[a][b][m][n] = (f32x4){0.f, 0.f, 0.f, 0.f};
    bf16x8 At[4][2], B0[2][2], B1[2][2];
    const char* cA = co.A; const char* cB = co.B;
    unsigned ldA = VARLD ? co.lda : Sched::LDA, ldB = VARLD ? co.ldb : Sched::LDB; int nt = (VARLD || Sched::VARNT) ? co.nt : Sched::NT;
    unsigned vA0 = (unsigned)R0 * ldA + (unsigned)C0 * 2u, vA1 = (unsigned)R1 * ldA + (unsigned)C1 * 2u;
    unsigned vB0 = (unsigned)Rb0 * ldB + (unsigned)C0 * 2u, vB1 = (unsigned)Rb1 * ldB + (unsigned)C1 * 2u;
    unsigned hA = (unsigned)HALF * ldA, hB = (unsigned)HALF * ldB;
    PG8_STAGE(PG8_SB(0, 0), cB, vB0, vB1); PG8_STAGE(PG8_SB(0, 1), cB + hB, vB0, vB1); PG8_STAGE(PG8_SA(0, 0), cA, vA0, vA1); PG8_STAGE(PG8_SA(0, 1), cA + hA, vA0, vA1);
    if (wr == 1) PG8_BAR;
    PG8_WAIT_V(2); PG8_BAR;
    PG8_STAGE(PG8_SB(1, 0), cB + 128, vB0, vB1); PG8_STAGE(PG8_SA(1, 0), cA + 128, vA0, vA1); PG8_STAGE(PG8_SB(1, 1), cB + hB + 128, vB0, vB1);
    PG8_WAIT_V(6); PG8_BAR;
    for (;;) {
        const bool has_next = S.next(ui + 1, nxt, no_);
        const char* nA = has_next ? no_.A : cA; const char* nB = has_next ? no_.B : cB;
        const unsigned nlda = (VARLD && has_next) ? no_.lda : ldA, nldb = (VARLD && has_next) ? no_.ldb : ldB;
        const int nnt = ((VARLD || Sched::VARNT) && has_next) ? no_.nt : nt;
        for (int t = 0; t < nt; t += 2) {
            const bool last = (t == nt - 2);
            if (Epi::HAS_MID) { PG8_SCHED; E.mid(acc, cur, t, wr, wc, fr, fq); PG8_SCHED; }
            const char* a1 = cA + (size_t)(t + 1) * 128;
            const char* a2 = last ? nA : cA + (size_t)(t + 2) * 128; const char* b2 = last ? nB : cB + (size_t)(t + 2) * 128;
            const char* a3 = a2 + 128; const char* b3 = b2 + 128;
            unsigned xA0 = vA0, xA1 = vA1, xB0 = vB0, xB1 = vB1, xhA = hA, xhB = hB;
            if (VARLD && last) { xA0 = (unsigned)R0 * nlda + (unsigned)C0 * 2u; xA1 = (unsigned)R1 * nlda + (unsigned)C1 * 2u; xB0 = (unsigned)Rb0 * nldb + (unsigned)C0 * 2u; xB1 = (unsigned)Rb1 * nldb + (unsigned)C1 * 2u; xhA = (unsigned)HALF * nlda; xhB = (unsigned)HALF * nldb; }
            PG8_LDB(B0, 0, 0); PG8_LDB(B1, 0, 1); PG8_SCHED; PG8_LDA(At, 0, 0); PG8_STAGE(PG8_SA(1, 1), a1 + hA, vA0, vA1);
            PG8_WAIT_V(8); PG8_WAIT_L(0); PG8_BAR; PG8_MMA(0, 0, At, B0); PG8_MMA(0, 1, At, B1); PG8_BAR; PG8_SCHED;
            PG8_LDA(At, 0, 1); PG8_STAGE(PG8_SB(0, 0), b2, xB0, xB1); PG8_STAGE(PG8_SB(0, 1), b2 + xhB, xB0, xB1); PG8_STAGE(PG8_SA(0, 0), a2, xA0, xA1);
            PG8_WAIT_V(8); PG8_WAIT_L(0); PG8_BAR; PG8_MMA(1, 0, At, B0); PG8_MMA(1, 1, At, B1); PG8_BAR; PG8_SCHED;
            PG8_LDB(B0, 1, 0); PG8_LDB(B1, 1, 1); PG8_SCHED; PG8_LDA(At, 1, 0); PG8_STAGE(PG8_SA(0, 1), a2 + xhA, xA0, xA1);
            PG8_WAIT_V(8); PG8_WAIT_L(0); PG8_BAR; PG8_MMA(0, 0, At, B0); PG8_MMA(0, 1, At, B1); PG8_BAR; PG8_SCHED;
            PG8_LDA(At, 1, 1); PG8_STAGE(PG8_SB(1, 0), b3, xB0, xB1); PG8_STAGE(PG8_SB(1, 1), b3 + xhB, xB0, xB1); PG8_STAGE(PG8_SA(1, 0), a3, xA0, xA1);
            PG8_WAIT_V(8); PG8_WAIT_L(0); PG8_BAR; PG8_MMA(1, 0, At, B0); PG8_MMA(1, 1, At, B1); PG8_BAR; PG8_SCHED;
        }
        if (wr == 0) PG8_BAR;
        PG8_SCHED; E(acc, cur, wr, wc, fr, fq); PG8_SCHED;
        if (!has_next) break;
#pragma unroll
        for (int a = 0; a < 2; ++a)
#pragma unroll
            for (int b = 0; b < 2; ++b)
#pragma unroll
                for (int m = 0; m < 4; ++m)
#pragma unroll
                    for (int n = 0; n < 2; ++n) acc[a][b][m][n] = (f32x4){0.f, 0.f, 0.f, 0.f};
        cur = nxt; cA = nA; cB = nB; ++ui;
        if (VARLD || Sched::VARNT) nt = nnt;
        if (VARLD) { ldA = nlda; ldB = nldb; vA0 = (unsigned)R0 * ldA + (unsigned)C0 * 2u; vA1 = (unsigned)R1 * ldA + (unsigned)C1 * 2u; vB0 = (unsigned)Rb0 * ldB + (unsigned)C0 * 2u; vB1 = (unsigned)Rb1 * ldB + (unsigned)C1 * 2u; hA = (unsigned)HALF * ldA; hB = (unsigned)HALF * ldB; }
        if (wr == 1) PG8_BAR;
    }
    PG8_WAIT_V(0);
    PG8_BAR;
#undef PG8_SA
#undef PG8_SB
#undef PG8_STAGE
#undef PG8_LDA
#undef PG8_LDB
#undef PG8_MMA
#undef PG8_WAIT_V
#undef PG8_WAIT_L
#undef PG8_BAR
#undef PG8_SCHED
}

template <int KM> struct Epi {
    static constexpr bool HAS_MID = (KM & 4) != 0;
    bf16* O; int ldc;
    float scale;
    const float* bias;
    v4u* gscr;
    __device__ __forceinline__ void mid(f32x4 (&acc)[2][2][4][2], const GUnit& u, int t, int wr, int wc, int fr, int fq) const {
        if (!(KM & 4) || u.kind != 2 || (t != 8 && t != 16)) return;
        const int sa = (t == 8) ? 0 : 1;
        const v4u* ga = gscr + ((size_t)sa * 512 + ((wr * 4 + wc) * 64 + fq * 16 + fr)) * 16; asm volatile("" : "+v"(ga)); const v4u* gb = ga + 16 * 512; asm volatile("" : "+v"(gb));
#pragma unroll
        for (int ai = 0; ai < 2; ++ai)
#pragma unroll
            for (int m = 0; m < 4; ++m) {
#pragma unroll
                for (int bj = 0; bj < 2; ++bj) { const int q = (ai * 4 + m) * 2 + bj; const v4u x = ga[q], y = gb[q];
                    f32x4 r0, r1;
                    r0[0] = bflo(x.x) * __builtin_amdgcn_rcpf(bflo(y.x)); r0[1] = bfhi(x.x) * __builtin_amdgcn_rcpf(bfhi(y.x)); r0[2] = bflo(x.y) * __builtin_amdgcn_rcpf(bflo(y.y)); r0[3] = bfhi(x.y) * __builtin_amdgcn_rcpf(bfhi(y.y));
                    r1[0] = bflo(x.z) * __builtin_amdgcn_rcpf(bflo(y.z)); r1[1] = bfhi(x.z) * __builtin_amdgcn_rcpf(bfhi(y.z)); r1[2] = bflo(x.w) * __builtin_amdgcn_rcpf(bflo(y.w)); r1[3] = bfhi(x.w) * __builtin_amdgcn_rcpf(bfhi(y.w));
                    acc[ai][bj][m][0] *= r0; acc[ai][bj][m][1] *= r1; }
                asm volatile("" ::: "memory"); }
    }
    __device__ __forceinline__ void operator()(f32x4 (&acc)[2][2][4][2], const GUnit& u, int wr, int wc, int fr, int fq) const {
        if ((KM & 1) && u.kind == 0) {
            const float sc = u.aux ? scale : 1.0f;
            const int row0 = u.r0 + wr * 64 + fr, col0 = u.c0 + wc * 32 + 8 * fq;
#pragma unroll
            for (int ai = 0; ai < 2; ++ai)
#pragma unroll
                for (int m = 0; m < 4; ++m) { bf16* rowp = O + (size_t)(row0 + ai * HALF + m * 16) * ldc + col0;
#pragma unroll
                    for (int bj = 0; bj < 2; ++bj) { const f32x4 v0 = acc[ai][bj][m][0] * sc, v1 = acc[ai][bj][m][1] * sc;
                        v4u w; w.x = cvt_pk_bf16(v0[0], v0[1]); w.y = cvt_pk_bf16(v0[2], v0[3]); w.z = cvt_pk_bf16(v1[0], v1[1]); w.w = cvt_pk_bf16(v1[2], v1[3]);
                        *(v4u*)(rowp + bj * HALF) = w; } }
        } else if ((KM & 2) && u.kind == 1) {
            const int bcol0 = u.c0 + wc * 32 + 8 * fq; const float* bp = bias + u.aux * 1024 + bcol0;
            v4u* gs = gscr + ((size_t)u.aux * 512 + ((wr * 4 + wc) * 64 + fq * 16 + fr)) * 16; asm volatile("" : "+v"(gs));
#pragma unroll
            for (int bj = 0; bj < 2; ++bj) { const f32x4 b0 = *(const f32x4*)(bp + bj * HALF), b1 = *(const f32x4*)(bp + bj * HALF + 4);
#pragma unroll
                for (int ai = 0; ai < 2; ++ai)
#pragma unroll
                    for (int m = 0; m < 4; ++m) { const f32x4 z0 = acc[ai][bj][m][0] + b0, z1 = acc[ai][bj][m][1] + b1; float g[8];
#pragma unroll
                        for (int j = 0; j < 4; ++j) { g[j] = fmaxf(sigmoidf_(z0[j]), 1e-30f); g[4 + j] = fmaxf(sigmoidf_(z1[j]), 1e-30f); }
                        v4u w; w.x = cvt_pk_bf16(g[0], g[1]); w.y = cvt_pk_bf16(g[2], g[3]); w.z = cvt_pk_bf16(g[4], g[5]); w.w = cvt_pk_bf16(g[6], g[7]);
                        gs[(ai * 4 + m) * 2 + bj] = w; } }
        } else if ((KM & 4) && u.kind == 2) {
            const v4u* gc = gscr + ((size_t)2 * 512 + ((wr * 4 + wc) * 64 + fq * 16 + fr)) * 16; asm volatile("" : "+v"(gc));
            const int row0 = u.r0 + wr * 64 + fr, col0 = u.c0 + wc * 32 + 8 * fq;
#pragma unroll
            for (int ai = 0; ai < 2; ++ai)
#pragma unroll
                for (int m = 0; m < 4; ++m) { bf16* rowp = O + (size_t)(row0 + ai * HALF + m * 16) * ldc + col0;
#pragma unroll
                    for (int bj = 0; bj < 2; ++bj) { const v4u y = gc[(ai * 4 + m) * 2 + bj]; const f32x4 a0 = acc[ai][bj][m][0], a1 = acc[ai][bj][m][1];
                        v4u w; w.x = cvt_pk_bf16(a0[0] * bflo(y.x), a0[1] * bfhi(y.x)); w.y = cvt_pk_bf16(a0[2] * bflo(y.y), a0[3] * bfhi(y.y));
                        w.z = cvt_pk_bf16(a1[0] * bflo(y.z), a1[1] * bfhi(y.z)); w.w = cvt_pk_bf16(a1[2] * bflo(y.w), a1[3] * bfhi(y.w));
                        *(v4u*)(rowp + bj * HALF) = w; }
                    asm volatile("" ::: "memory"); }
        } else if (KM & 8) {
            const int row0 = u.r0 + wr * 64 + fr, col0 = u.c0 + wc * 32 + 8 * fq;
#pragma unroll
            for (int ai = 0; ai < 2; ++ai)
#pragma unroll
                for (int m = 0; m < 4; ++m) { bf16* rowp = O + (size_t)(row0 + ai * HALF + m * 16) * ldc + col0; float hv[8];
#pragma unroll
                    for (int n = 0; n < 2; ++n)
#pragma unroll
                        for (int j = 0; j < 4; ++j) { const float gt = acc[ai][0][m][n][j], up = acc[ai][1][m][n][j]; hv[n * 4 + j] = gt * sigmoidf_(gt) * up; }
                    v4u w; w.x = cvt_pk_bf16(hv[0], hv[1]); w.y = cvt_pk_bf16(hv[2], hv[3]); w.z = cvt_pk_bf16(hv[4], hv[5]); w.w = cvt_pk_bf16(hv[6], hv[7]);
                    *(v4u*)rowp = w; }
        }
    }
};
}
namespace attn_body {
using bf16=__hip_bfloat16;
using bf16x8=__attribute__((ext_vector_type(8)))short;
using s16x4=__attribute__((ext_vector_type(4)))short;
using f32x16=__attribute__((ext_vector_type(16)))float;
using u32x4=__attribute__((ext_vector_type(4)))unsigned;
constexpr int SEQ=4096,D=64,PQ=5376,PO=1024;
constexpr int NW=8,QBLK=32,QB=QBLK*NW,KVBLK=64,NQB=SEQ/QB;
constexpr int ATTN_UNIT_ROWS=QB;
__device__ __forceinline__ int crow(int r,int hi){return (r&3)+8*(r>>2)+4*hi;}
#define SBAR() __builtin_amdgcn_sched_barrier(0)
__device__ __forceinline__ void cmask(f32x16&p0,f32x16&p1,int jb,int qrel,int hi){
  const float NEG=-INFINITY; int kb=64*jb+4*hi;
  #pragma unroll
  for(int r=0;r<16;++r){int kv=kb+(r&3)+8*(r>>2); if(kv>qrel)p0[r]=NEG; if(kv+32>qrel)p1[r]=NEG;}
}

constexpr int NSLOT=3, SLOTB=8192;
constexpr int LDS_K=0, LDS_V=NSLOT*SLOTB, LDS_WS=2*NSLOT*SLOTB, LDS_OST=LDS_WS+NW*64*4, LDS_BYTES=LDS_OST+NW*4096;
constexpr float C2=0.125f*1.4426950408889634f;
__device__ __forceinline__ void glds16(const void*gsrc,unsigned lds_dst){unsigned keep;
  asm volatile("s_mov_b32 %0, m0\n\ts_mov_b32 m0, %2\n\ts_nop 0\n\tglobal_load_lds_dwordx4 %1, off\n\ts_mov_b32 m0, %0":"=&s"(keep):"v"(gsrc),"s"(lds_dst):"memory");}
__device__ __forceinline__ float max3f(float a,float b,float c){float r;asm("v_max3_f32 %0, %1, %2, %3":"=v"(r):"v"(a),"v"(b),"v"(c));return r;}
__device__ __forceinline__ float max2f(float a,float b){float r;asm("v_max_f32_e32 %0, %1, %2":"=v"(r):"v"(a),"v"(b));return r;}
__device__ __forceinline__ float fadd_s(float a,float b){float r;asm("v_add_f32_e32 %0, %1, %2":"=v"(r):"v"(a),"v"(b));return r;}
__device__ __forceinline__ float fsub_s(float a,float b){float r;asm("v_sub_f32_e32 %0, %1, %2":"=v"(r):"v"(a),"v"(b));return r;}
typedef float f32x2_t __attribute__((ext_vector_type(2))); typedef __bf16 bf16x2_t __attribute__((ext_vector_type(2)));
__device__ __forceinline__ unsigned cvtpk_s(float lo,float hi){f32x2_t v={lo,hi};bf16x2_t b=__builtin_convertvector(v,bf16x2_t);return __builtin_bit_cast(unsigned,b);}
#define WAIT_BAR(N) asm volatile("s_waitcnt vmcnt(" #N ") lgkmcnt(0)\n\ts_barrier":::"memory")

__device__ __forceinline__ void qkt(f32x16&p0,f32x16&p1,const char*Kslot,const bf16x8*qr,int r32,int hi){ const f32x16 negm=f32x16{};
  const char*kb=Kslot+hi*1024+r32*16;
  #pragma unroll
  for(int d0=0;d0<4;++d0){
    const bf16x8 b0=*reinterpret_cast<const bf16x8*>(kb+d0*2048);
    const bf16x8 b1=*reinterpret_cast<const bf16x8*>(kb+d0*2048+512);
    if(d0==0){p0=__builtin_amdgcn_mfma_f32_32x32x16_bf16(b0,qr[0],negm,0,0,0);p1=__builtin_amdgcn_mfma_f32_32x32x16_bf16(b1,qr[0],negm,0,0,0);}
    else{p0=__builtin_amdgcn_mfma_f32_32x32x16_bf16(b0,qr[d0],p0,0,0,0);p1=__builtin_amdgcn_mfma_f32_32x32x16_bf16(b1,qr[d0],p1,0,0,0);}}
}
typedef __attribute__((address_space(3))) const char* lds_cptr;
typedef short v4i16_t __attribute__((ext_vector_type(4)));
__device__ __forceinline__ void kload8(bf16x8*kf,lds_cptr kp){
  kf[0]=*(const __attribute__((address_space(3))) bf16x8*)(kp);      kf[1]=*(const __attribute__((address_space(3))) bf16x8*)(kp+512);
  kf[2]=*(const __attribute__((address_space(3))) bf16x8*)(kp+2048); kf[3]=*(const __attribute__((address_space(3))) bf16x8*)(kp+2560);
  kf[4]=*(const __attribute__((address_space(3))) bf16x8*)(kp+4096); kf[5]=*(const __attribute__((address_space(3))) bf16x8*)(kp+4608);
  kf[6]=*(const __attribute__((address_space(3))) bf16x8*)(kp+6144); kf[7]=*(const __attribute__((address_space(3))) bf16x8*)(kp+6656);
}
__device__ __forceinline__ void kload2(bf16x8*kf,lds_cptr kp,int j){ kf[2*j]=*(const __attribute__((address_space(3))) bf16x8*)(kp+j*2048); kf[2*j+1]=*(const __attribute__((address_space(3))) bf16x8*)(kp+j*2048+512); }
__device__ __forceinline__ s16x4 vtr(lds_cptr p){ return __builtin_bit_cast(s16x4,__builtin_amdgcn_ds_read_tr16_b64_v4i16((__attribute__((address_space(3))) v4i16_t*)p)); }
__device__ __forceinline__ float rowmax(const f32x16&p0,const f32x16&p1){
  float a=max3f(p0[0],p0[1],p1[0]),b=max3f(p0[2],p0[3],p1[1]);a=max3f(a,p1[2],p1[3]);
  #pragma unroll
  for(int r=4;r<16;r+=4){a=max3f(a,p0[r],p0[r+1]);b=max3f(b,p0[r+2],p0[r+3]);a=max3f(a,p1[r],p1[r+1]);b=max3f(b,p1[r+2],p1[r+3]);}
  const float m=max2f(a,b);
  auto rr=__builtin_amdgcn_permlane32_swap(__float_as_uint(m),__float_as_uint(m),false,false);
  return max2f(__uint_as_float(rr[0]),__uint_as_float(rr[1]));
}
__device__ __forceinline__ void pv(f32x16*o,int vb,bf16x8 pa0,bf16x8 pa1,bf16x8 pa2,bf16x8 pa3){
  #pragma unroll
  for(int d0=0;d0<2;++d0){s16x4 lo[4],hi[4];
    #pragma unroll
    for(int ks=0;ks<4;++ks){
      asm volatile("ds_read_b64_tr_b16 %0,%1 offset:%c2":"=&v"(lo[ks]):"v"(vb),"i"(d0*4096+ks*1024):"memory");
      asm volatile("ds_read_b64_tr_b16 %0,%1 offset:%c2":"=&v"(hi[ks]):"v"(vb),"i"(d0*4096+ks*1024+512):"memory");}
    asm volatile("s_waitcnt lgkmcnt(0)":::"memory");SBAR();
    #define PK(k) (bf16x8){lo[k][0],lo[k][1],lo[k][2],lo[k][3],hi[k][0],hi[k][1],hi[k][2],hi[k][3]}
    o[d0]=__builtin_amdgcn_mfma_f32_32x32x16_bf16(pa0,PK(0),o[d0],0,0,0);
    o[d0]=__builtin_amdgcn_mfma_f32_32x32x16_bf16(pa1,PK(1),o[d0],0,0,0);
    o[d0]=__builtin_amdgcn_mfma_f32_32x32x16_bf16(pa2,PK(2),o[d0],0,0,0);
    o[d0]=__builtin_amdgcn_mfma_f32_32x32x16_bf16(pa3,PK(3),o[d0],0,0,0);
    #undef PK
  }
}

#ifndef ATTN_STORE16
#define ATTN_STORE16(p,v) (*(u32x4*)(p)=(v))
#endif
template<int THRL> __device__ __forceinline__ void attn_unit(int b,int qcol,int kcol,int vcol,int ocol,float slope2,int qb,const bf16*__restrict__ P,bf16*O,char*shm){
  int tid_=threadIdx.x; asm volatile("":"+v"(tid_));
  const int tid=tid_,lane=tid&63,r32=lane&31,hi=lane>>5; const int wid=__builtin_amdgcn_readfirstlane(tid>>6);
  const long rowbase=(long)b*SEQ; const int q0=qb*QB;
  const bf16*Qw=P+(rowbase+q0+wid*QBLK)*PQ+qcol;
  const bf16*Kh=P+rowbase*PQ+kcol,*Vh=P+rowbase*PQ+vcol;
  const unsigned lds0=(unsigned)(uintptr_t)shm;
  float*wsf=(float*)(shm+LDS_WS)+wid*64;
  const bf16*ksrc=Kh+(long)lane*PQ+wid*8;
  const bf16*vsrc=Vh+(long)(16*(wid&3)+(lane>>2))*PQ+(wid>>2)*32+(lane&3)*8;
  const unsigned kdst=lds0+LDS_K+wid*1024, vdst=lds0+LDS_V+wid*1024;
  #define DMA_K(t,slot) glds16(ksrc+(long)(t)*KVBLK*PQ,(unsigned)__builtin_amdgcn_readfirstlane(kdst+(slot)))
  #define DMA_V(t,slot) glds16(vsrc+(long)(t)*KVBLK*PQ,(unsigned)__builtin_amdgcn_readfirstlane(vdst+(slot)))
  const int vb0=(int)(lds0+LDS_V)+((lane>>4)&1)*32+(lane&3)*8+(4*hi+((lane&15)>>2))*64;
  const char*Kbase=shm+LDS_K; bf16x8 kf[8];
  const lds_cptr shm3=(lds_cptr)shm; const lds_cptr kp0=shm3+LDS_K+hi*1024+r32*16; const lds_cptr vp0=shm3+LDS_V+((lane>>4)&1)*32+(lane&3)*8+(4*hi+((lane&15)>>2))*64;
  const int NT=(q0+QB)/KVBLK;
  DMA_K(0,0);DMA_V(0,0);DMA_K(1,SLOTB);
  bf16x8 qr[4];
  #pragma unroll
  for(int d0=0;d0<4;++d0)qr[d0]=*reinterpret_cast<const bf16x8*>(&Qw[(long)r32*PQ+d0*16+hi*8]);
  float mhat=0.f,l_reg=0.f;f32x16 o[2];o[0]=f32x16{};o[1]=f32x16{};const f32x16 negm=f32x16{};
  const float sr1_=__builtin_bit_cast(float,__builtin_amdgcn_readfirstlane(__builtin_bit_cast(int,slope2))), sr2_=__builtin_bit_cast(float,__builtin_amdgcn_readfirstlane(__builtin_bit_cast(int,2.f*slope2))), sr3_=__builtin_bit_cast(float,__builtin_amdgcn_readfirstlane(__builtin_bit_cast(int,3.f*slope2)));
  const float hib=slope2*(float)(4*hi);
  #define ALIBI(P0,P1,t) do{ const float tm0_=slope2*(float)(64*(t))+hib-mhat; \
    _Pragma("unroll") for(int q_=0;q_<4;++q_){ const float a_=tm0_+(8.f*slope2)*(float)q_, b_=a_+32.f*slope2; \
      P0[4*q_]+=a_; P0[4*q_+1]=(P0[4*q_+1]+a_)+sr1_; P0[4*q_+2]=(P0[4*q_+2]+a_)+sr2_; P0[4*q_+3]=(P0[4*q_+3]+a_)+sr3_; \
      P1[4*q_]+=b_; P1[4*q_+1]=(P1[4*q_+1]+b_)+sr1_; P1[4*q_+2]=(P1[4*q_+2]+b_)+sr2_; P1[4*q_+3]=(P1[4*q_+3]+b_)+sr3_; } }while(0)
  const int qrel=wid*QBLK+r32;
  #define CMASK(P0,P1,t) do{int jb_=(t)-(NT-4); if(jb_>=0)cmask(P0,P1,jb_,qrel,hi);}while(0)
  bool resc=false;
  #define START(P0,P1) do{ const float rm=rowmax(P0,P1); resc=false; \
    { const float dl=rm; mhat=fadd_s(mhat,dl); \
      _Pragma("unroll") for(int r=0;r<16;++r){P0[r]=fsub_s(P0[r],dl);P1[r]=fsub_s(P1[r],dl);} \
      } \
    _Pragma("unroll") for(int r=0;r<16;++r)P0[r]=__builtin_amdgcn_exp2f(P0[r]); }while(0)
  #define RESC() do{ if(resc){ asm volatile("s_waitcnt lgkmcnt(0)":::"memory"); \
      _Pragma("unroll") for(int d_=0;d_<2;++d_) _Pragma("unroll") for(int r=0;r<16;++r)o[d_][r]*=wsf[crow(r,hi)]; } }while(0)
  f32x16 pA0,pA1,pB0,pB1;
  int sl_prev=0,sl_cur=0,sl_next=SLOTB;
  #define ROT() do{sl_prev=sl_cur;sl_cur=sl_next;sl_next=(sl_next==(NSLOT-1)*SLOTB)?0:sl_next+SLOTB;}while(0)
  DMA_K(2,2*SLOTB);
  WAIT_BAR(3);
  qkt(pA0,pA1,Kbase,qr,r32,hi);asm volatile("s_nop 15\n\ts_nop 7":"+v"(pA0),"+v"(pA1));ALIBI(pA0,pA1,0);asm volatile("":"+v"(pA0),"+v"(pA1));CMASK(pA0,pA1,0);
  START(pA0,pA1);
  _Pragma("unroll") for(int r=0;r<16;++r)pA1[r]=__builtin_amdgcn_exp2f(pA1[r]);
  WAIT_BAR(0);
  DMA_K(3,0);DMA_V(1,SLOTB);
  ROT();
  kload8(kf,kp0+sl_cur);
  WAIT_BAR(2);
  s16x4 vlo[8],vhi[8]; u32x4 pw0,pw1,pw2,pw3;
  #define PKW(P,B) cvtpk_s(P[B],P[B+1])
  #define PAF(k) __builtin_bit_cast(bf16x8,pw##k)
  #define VFR(i) (bf16x8){vlo[i][0],vlo[i][1],vlo[i][2],vlo[i][3],vhi[i][0],vhi[i][1],vhi[i][2],vhi[i][3]}
  #define PIN(x) asm volatile("":"+v"(x))
  #define MX3(a,b,c) __builtin_fmaxf(__builtin_fmaxf((a),(b)),(c))
  #define GAPA(MF,A0,A1,A2,A3,W0,W1,PW) do{ MF; sacc+=A0; sacc+=A1; sacc+=A2; sacc+=A3; PIN(sacc); W0; W1; PIN(PW); SBAR(); }while(0)
  #define EX(v) __builtin_amdgcn_exp2f(v)
  #define GAPB(MF,X,B) do{ MF; X[B]=EX(X[B]); X[B+1]=EX(X[B+1]); X[B+2]=EX(X[B+2]); X[B+3]=EX(X[B+3]); PIN(X); SBAR(); }while(0)
  #define VRD(i) do{ vlo[i]=vtr(vp_+(((i)>>2)*4096+((i)&3)*1024)); vhi[i]=vtr(vp_+(((i)>>2)*4096+((i)&3)*1024+512)); }while(0)
  #define KRD(G,j) do{ if(G){ kload2(kf,kp0+sl_next,j); SBAR(); } }while(0)
  #define STEP(C0,C1,P0,P1,t,GK,GV,GL) do{ SBAR(); \
    const lds_cptr vp_=vp0+sl_prev; \
    VRD(0); SBAR(); float sacc=(P0[0]+P0[1]); \
    GAPA(C0=__builtin_amdgcn_mfma_f32_32x32x16_bf16(kf[0],qr[0],negm,0,0,0), P0[2],P0[3],P0[4],P0[5],     pw0[0]=PKW(P0,0), pw0[1]=PKW(P0,2), pw0); \
    VRD(4); SBAR(); GAPA(C1=__builtin_amdgcn_mfma_f32_32x32x16_bf16(kf[1],qr[0],negm,0,0,0), P0[6],P0[7],P0[8],P0[9],     pw0[2]=PKW(P0,4), pw0[3]=PKW(P0,6), pw0); \
    VRD(1); SBAR(); GAPA(C0=__builtin_amdgcn_mfma_f32_32x32x16_bf16(kf[2],qr[1],C0,0,0,0),   P0[10],P0[11],P0[12],P0[13], pw1[0]=PKW(P0,8), pw1[1]=PKW(P0,10), pw1); \
    VRD(5); SBAR(); GAPA(C1=__builtin_amdgcn_mfma_f32_32x32x16_bf16(kf[3],qr[1],C1,0,0,0),   P0[14],P0[15],P1[0],P1[1],   pw1[2]=PKW(P0,12),pw1[3]=PKW(P0,14), pw1); \
    VRD(2); SBAR(); GAPA(C0=__builtin_amdgcn_mfma_f32_32x32x16_bf16(kf[4],qr[2],C0,0,0,0),   P1[2],P1[3],P1[4],P1[5],     pw2[0]=PKW(P1,0), pw2[1]=PKW(P1,2), pw2); \
    VRD(6); SBAR(); GAPA(C1=__builtin_amdgcn_mfma_f32_32x32x16_bf16(kf[5],qr[2],C1,0,0,0),   P1[6],P1[7],P1[8],P1[9],     pw2[2]=PKW(P1,4), pw2[3]=PKW(P1,6), pw2); \
    VRD(3); SBAR(); GAPA(C0=__builtin_amdgcn_mfma_f32_32x32x16_bf16(kf[6],qr[3],C0,0,0,0),   P1[10],P1[11],P1[12],P1[13], pw3[0]=PKW(P1,8), pw3[1]=PKW(P1,10), pw3); \
    VRD(7); SBAR(); GAPA(C1=__builtin_amdgcn_mfma_f32_32x32x16_bf16(kf[7],qr[3],C1,0,0,0),   P1[14],P1[15],0.f,0.f,       pw3[2]=PKW(P1,12),pw3[3]=PKW(P1,14), pw3); \
    l_reg+=sacc; \
    if(GK){DMA_K((t)+3,sl_cur);} if(GV){DMA_V((t)+1,sl_next);} \
    ALIBI(C0,C1,t); CMASK(C0,C1,t); \
    { float a=MX3(C0[0],C0[1],C1[0]),b=MX3(C0[2],C0[3],C1[1]); a=MX3(a,C1[2],C1[3]); \
      _Pragma("unroll") for(int r=4;r<16;r+=4){a=MX3(a,C0[r],C0[r+1]);b=MX3(b,C0[r+2],C0[r+3]);a=MX3(a,C1[r],C1[r+1]);b=MX3(b,C1[r+2],C1[r+3]);} \
      float rm=__builtin_fmaxf(a,b); { auto rr=__builtin_amdgcn_permlane32_swap(__float_as_uint(rm),__float_as_uint(rm),false,false); rm=__builtin_fmaxf(__uint_as_float(rr[0]),__uint_as_float(rr[1])); } \
      resc=false; \
      if(__builtin_expect(__any(rm>(float)THRL),0)){ const float dl=__builtin_fmaxf(rm,0.f); mhat+=dl; \
        _Pragma("unroll") for(int r=0;r<16;++r){C0[r]-=dl;C1[r]-=dl;} \
        const float f=__builtin_amdgcn_exp2f(-dl); l_reg*=f; if(hi==0)wsf[r32]=f; resc=true; } } \
    SBAR(); \
    GAPB(o[0]=__builtin_amdgcn_mfma_f32_32x32x16_bf16(PAF(0),VFR(0),o[0],0,0,0), C0,0); \
    GAPB(o[1]=__builtin_amdgcn_mfma_f32_32x32x16_bf16(PAF(0),VFR(4),o[1],0,0,0), C0,4); \
    KRD(GL,0); GAPB(o[0]=__builtin_amdgcn_mfma_f32_32x32x16_bf16(PAF(1),VFR(1),o[0],0,0,0), C0,8); \
    KRD(GL,1); GAPB(o[1]=__builtin_amdgcn_mfma_f32_32x32x16_bf16(PAF(1),VFR(5),o[1],0,0,0), C0,12); \
    KRD(GL,2); GAPB(o[0]=__builtin_amdgcn_mfma_f32_32x32x16_bf16(PAF(2),VFR(2),o[0],0,0,0), C1,0); \
    KRD(GL,3); GAPB(o[1]=__builtin_amdgcn_mfma_f32_32x32x16_bf16(PAF(2),VFR(6),o[1],0,0,0), C1,4); \
    GAPB(o[0]=__builtin_amdgcn_mfma_f32_32x32x16_bf16(PAF(3),VFR(3),o[0],0,0,0), C1,8); \
    GAPB(o[1]=__builtin_amdgcn_mfma_f32_32x32x16_bf16(PAF(3),VFR(7),o[1],0,0,0), C1,12); \
    }while(0)
  int t=1;
  #undef CMASK
  #define CMASK(P0,P1,t) do{}while(0)
  for(;t+5<NT;t+=2){
    STEP(pB0,pB1,pA0,pA1,t,true,true,true);     WAIT_BAR(2); RESC(); ROT();
    STEP(pA0,pA1,pB0,pB1,t+1,true,true,true);   WAIT_BAR(2); RESC(); ROT();
  }
  #undef CMASK
  #define CMASK(P0,P1,t) do{int jb_=(t)-(NT-4); if(jb_>=0)cmask(P0,P1,jb_,qrel,hi);}while(0)
  #define ENDW(tt) do{ if((tt)+3<NT){WAIT_BAR(2);} else if((tt)+2<NT){WAIT_BAR(1);} else {WAIT_BAR(0);} }while(0)
  for(;t+1<NT;t+=2){
    STEP(pB0,pB1,pA0,pA1,t,(t+3<NT),(t+1<NT),(t+1<NT));       ENDW(t);   RESC(); ROT();
    STEP(pA0,pA1,pB0,pB1,t+1,(t+4<NT),(t+2<NT),(t+2<NT));     ENDW(t+1); RESC(); ROT();
  }
  STEP(pB0,pB1,pA0,pA1,NT-1,false,false,false); RESC();
  { float sacc=pB0[0]+pB0[1]; _Pragma("unroll") for(int r=2;r<16;++r)sacc+=pB0[r]; _Pragma("unroll") for(int r=0;r<16;++r)sacc+=pB1[r]; l_reg+=sacc;
    pw0=(u32x4){PKW(pB0,0),PKW(pB0,2),PKW(pB0,4),PKW(pB0,6)};pw1=(u32x4){PKW(pB0,8),PKW(pB0,10),PKW(pB0,12),PKW(pB0,14)};pw2=(u32x4){PKW(pB1,0),PKW(pB1,2),PKW(pB1,4),PKW(pB1,6)};pw3=(u32x4){PKW(pB1,8),PKW(pB1,10),PKW(pB1,12),PKW(pB1,14)};
    SBAR(); pv(o,vb0+sl_cur,PAF(0),PAF(1),PAF(2),PAF(3)); }
  #undef PKW
  #undef PAF
  #undef VFR
  #undef PIN
  #undef MX3
  #undef GAPA
  #undef GAPB
  #undef EX
  #undef VRD
  #undef KRD
  #undef STEP
  #undef ENDW
  {auto rr=__builtin_amdgcn_permlane32_swap(__float_as_uint(l_reg),__float_as_uint(l_reg),false,false);l_reg=__uint_as_float(rr[0])+__uint_as_float(rr[1]);}
  if(hi==0)wsf[32+r32]=l_reg;asm volatile("s_waitcnt lgkmcnt(0)":::"memory");
  float rli[16];
  #pragma unroll
  for(int r=0;r<16;++r)rli[r]=__builtin_amdgcn_rcpf(wsf[32+crow(r,hi)]);
  bf16*Ow=O+(rowbase+q0+wid*QBLK)*PO+ocol;
  { bf16*stg=(bf16*)(shm+LDS_OST)+wid*2048;
    #pragma unroll
    for(int r=0;r<16;++r){const int orow=crow(r,hi);
      #pragma unroll
      for(int d0=0;d0<2;++d0)stg[orow*64+d0*32+r32]=__float2bfloat16(o[d0][r]*rli[r]);}
    asm volatile("s_waitcnt lgkmcnt(0)":::"memory");
    #pragma unroll
    for(int i=0;i<4;++i){const int row=i*8+(lane>>3),ch=lane&7; const u32x4 v=*(const u32x4*)(stg+row*64+ch*8); ATTN_STORE16(Ow+(long)row*PO+ch*8,v);} }
  asm volatile("s_waitcnt lgkmcnt(0)\n\ts_barrier":::"memory");
  #undef DMA_K
  #undef DMA_V
  #undef CMASK
  #undef START
  #undef RESC
  #undef ROT
  #undef ALIBI
}
constexpr int ATTN_LDS_BYTES=LDS_BYTES;
#undef SBAR
#undef WAIT_BAR
}
struct MixP {
    const bf16* proj; bf16* ocat; bf16* oatt;
    const float* hg_lb;
    const float* hg_norm_g;
    float lam, one_m_lam_init;
    const float* da_subln_g;
    const float *rw_mu, *rw_w0, *rw_a0, *rw_k_k, *rw_k_a, *rw_r_k, *rw_gn_g, *rw_gn_b;
    const bf16 *wupT, *aupT, *gupT;
    gu32* aq;
};

__device__ __forceinline__ void attn_group(const MixP& P, int b, int h, int qb, char* lds) {
    const float slope2 = exp2f(-2.0f * (float)(h + 1)) * LOG2E;
    const float s2 = __builtin_bit_cast(float, __builtin_amdgcn_readfirstlane(__builtin_bit_cast(int, slope2)));
    const attn_body::bf16* pr = (const attn_body::bf16*)P.proj; attn_body::bf16* oa = (attn_body::bf16*)P.oatt;
#pragma unroll 1
    for (int sub = 0; sub < 4; ++sub) {
        const int mp = sub >> 1, hf = sub & 1;
        attn_body::attn_unit<8>(b, C_DAQ + h * 128 + mp * 64, C_DAK + h * 128 + mp * 64, C_DAV + h * 128 + hf * 64, h * 256 + mp * 128 + hf * 64, s2, qb, pr, oa, lds);
    }
    VM_WAIT(); __syncthreads();
    {
        int tid_ = threadIdx.x; asm volatile("" : "+v"(tid_)); const int tid = tid_, row = tid >> 1, hf = tid & 1;
        const size_t grow = (size_t)b * T + (size_t)qb * 256 + row;
        const bf16* o0 = P.oatt + grow * 1024 + h * 256 + hf * 64; const bf16* o1 = o0 + 128;
        float v[64]; float ss = 0.f;
#pragma unroll
        for (int c = 0; c < 8; ++c) { const v4u x = __builtin_nontemporal_load((const v4u*)(o0) + c), y = __builtin_nontemporal_load((const v4u*)(o1) + c);
            const unsigned xs[4] = {x.x, x.y, x.z, x.w}, ys[4] = {y.x, y.y, y.z, y.w};
#pragma unroll
            for (int j = 0; j < 4; ++j) { const float a = bflo(xs[j]) - P.lam * bflo(ys[j]), d = bfhi(xs[j]) - P.lam * bfhi(ys[j]); v[c * 8 + 2 * j] = a; v[c * 8 + 2 * j + 1] = d; ss += a * a + d * d; } }
        ss += __shfl_xor(ss, 1);
        const float rs = rsqrtf(ss * (1.0f / 128.0f) + RMS_EPS) * P.one_m_lam_init;
        bf16* dst = P.ocat + grow * 1536 + 512 + h * 128 + hf * 64; const float* g = P.da_subln_g + hf * 64;
#pragma unroll
        for (int c = 0; c < 8; ++c) { v4u w; w.x = pk2(v[c * 8 + 0] * rs * g[c * 8 + 0], v[c * 8 + 1] * rs * g[c * 8 + 1]); w.y = pk2(v[c * 8 + 2] * rs * g[c * 8 + 2], v[c * 8 + 3] * rs * g[c * 8 + 3]);
            w.z = pk2(v[c * 8 + 4] * rs * g[c * 8 + 4], v[c * 8 + 5] * rs * g[c * 8 + 5]); w.w = pk2(v[c * 8 + 6] * rs * g[c * 8 + 6], v[c * 8 + 7] * rs * g[c * 8 + 7]);
            *((v4u*)dst + c) = w; }
    }
    __syncthreads();
}
__device__ __forceinline__ void attn_worker(const MixP& P, char* lds, volatile LAS unsigned* bcast, int tid) {
    for (;;) {
        if (tid == 0) bcast[0] = __hip_atomic_fetch_add(P.aq, 1u, RLX_AGENT);
        __syncthreads();
        const unsigned idx = bcast[0];
        __syncthreads();
        if (idx >= 512u) break;
        const int qb = 15 - (int)(idx >> 5), bh = (int)(idx & 31u);
        attn_group(P, bh >> 2, bh & 3, qb, lds);
    }
}

constexpr int HG_QH = 0, HG_QT = 17408, HG_KT = 34816, HG_KHT = 52224, HG_VV = 70656, HG_OG = 88064, HG_AM = 105472, HG_BQ = 114688, HG_SS = 116736, HG_DD = 118784, HG_END = 119296;
constexpr int HS = 272, HS2 = 144;
__device__ __forceinline__ s16x4 tr_rd(unsigned addr) { s16x4 r; asm volatile("ds_read_b64_tr_b16 %0, %1\n\ts_waitcnt lgkmcnt(0)" : "=&v"(r) : "v"(addr) : "memory"); return r; }
__device__ __forceinline__ void hgrn_unit(const MixP& P, int b, int h, LAS unsigned char* lds) {
    int tid_ = threadIdx.x; asm volatile("" : "+v"(tid_));
    const int tid = tid_, lane = tid & 63, w = __builtin_amdgcn_readfirstlane(tid >> 6), g = lane >> 4, li = lane & 15;
    const int kk_ = tid & 127, tq = tid >> 7;
    const float lb = P.hg_lb[h * 128 + kk_], oml = 1.0f - lb;
    LAS float* BQ = (LAS float*)(lds + HG_BQ); LAS float* SS = (LAS float*)(lds + HG_SS); LAS float* DD = (LAS float*)(lds + HG_DD);
    f32x4 Sacc[8];
#pragma unroll
    for (int i = 0; i < 8; ++i) Sacc[i] = (f32x4){0.f, 0.f, 0.f, 0.f};
    const unsigned ldsb = (unsigned)(uintptr_t)lds;
    const float ng = P.hg_norm_g[16 * w + li];
#pragma unroll 1
    for (int c = 0; c < 64; ++c) {
        const size_t row0 = (size_t)b * T + (size_t)c * 64;
        const bf16* base = P.proj + (row0 + 16 * tq) * INW + h * 128 + kk_;
        float cs[16], kv[16]; float run = 0.f;
#pragma unroll
        for (int i = 0; i < 16; ++i) { const float z = bf2f(base[(size_t)i * INW + C_HGF]); const float sg = sigmoidf_(z); const float f = lb + oml * sg;
            run += __logf(fmaxf(f, HG_F_MIN)); cs[i] = run; kv[i] = oml * (1.0f - sg); }
        BQ[tq * 128 + kk_] = run;
        __syncthreads();
        const float q0 = BQ[kk_], q1 = BQ[128 + kk_], q2 = BQ[256 + kk_], q3 = BQ[384 + kk_];
        const float off = (tq > 0 ? q0 : 0.f) + (tq > 1 ? q1 : 0.f) + (tq > 2 ? q2 : 0.f);
        const float blast = (q0 + q1) + (q2 + q3), ref = q0 + q1;
        if (tq == 0) DD[kk_] = __expf(blast);
#pragma unroll
        for (int i = 0; i < 16; ++i) { const int t = 16 * tq + i; const float bt = off + cs[i];
            const float q = bf2f(base[(size_t)i * INW + C_HGQ]);
            const unsigned short vraw = base[(size_t)i * INW + C_HGI], ograw = base[(size_t)i * INW + C_HGO];
            *(LAS unsigned short*)(lds + HG_QH + t * HS + kk_ * 2) = (unsigned short)f2bf(q * __expf(bt));
            *(LAS unsigned short*)(lds + HG_QT + t * HS + kk_ * 2) = (unsigned short)f2bf(q * __expf(fminf(bt - ref, 60.f)));
            *(LAS unsigned short*)(lds + HG_KT + t * HS + kk_ * 2) = (unsigned short)f2bf(kv[i] * __expf(fminf(ref - bt, 60.f)));
            *(LAS unsigned short*)(lds + HG_KHT + kk_ * HS2 + t * 2) = (unsigned short)f2bf(kv[i] * __expf(blast - bt));
            *(LAS unsigned short*)(lds + HG_VV + t * HS + kk_ * 2) = vraw;
            *(LAS unsigned short*)(lds + HG_OG + t * HS + kk_ * 2) = ograw; }
        __syncthreads();
        {   const int mt = w >> 1;
#pragma unroll
            for (int j = 0; j < 2; ++j) { const int st = 2 * (w & 1) + j; f32x4 a = (f32x4){0.f, 0.f, 0.f, 0.f};
#pragma unroll
                for (int ks = 0; ks < 4; ++ks) { const bf16x8 fa = *(const LAS bf16x8*)(lds + HG_KT + (16 * st + li) * HS + ks * 64 + g * 16);
                    const bf16x8 fb = *(const LAS bf16x8*)(lds + HG_QT + (16 * mt + li) * HS + ks * 64 + g * 16);
                    a = __builtin_amdgcn_mfma_f32_16x16x32_bf16(fa, fb, a, 0, 0, 0); }
                const int tt = 16 * mt + li, s0 = 16 * st + 4 * g;
                v2u wv; wv.x = pk2(s0 <= tt ? a[0] : 0.f, s0 + 1 <= tt ? a[1] : 0.f); wv.y = pk2(s0 + 2 <= tt ? a[2] : 0.f, s0 + 3 <= tt ? a[3] : 0.f);
                *(LAS v2u*)(lds + HG_AM + tt * HS2 + s0 * 2) = wv; }
        }
        __syncthreads();
        bf16x8 vf[2];
        {   const int q = li >> 2, p = li & 3;
#pragma unroll
            for (int ks = 0; ks < 2; ++ks) { const unsigned a0 = ldsb + HG_VV + (32 * ks + 8 * g + q) * HS + (16 * w + 4 * p) * 2;
                const s16x4 lo = tr_rd(a0), hi = tr_rd(a0 + 4 * HS);
                vf[ks] = (bf16x8){lo[0], lo[1], lo[2], lo[3], hi[0], hi[1], hi[2], hi[3]}; } }
        bf16x8 sb[4];
#pragma unroll
        for (int s = 0; s < 4; ++s) { v4u x; x.x = pk2(Sacc[2 * s][0], Sacc[2 * s][1]); x.y = pk2(Sacc[2 * s][2], Sacc[2 * s][3]); x.z = pk2(Sacc[2 * s + 1][0], Sacc[2 * s + 1][1]); x.w = pk2(Sacc[2 * s + 1][2], Sacc[2 * s + 1][3]);
            sb[s] = __builtin_bit_cast(bf16x8, x); }
        f32x4 o[4];
#pragma unroll
        for (int mt = 0; mt < 4; ++mt) { f32x4 a = (f32x4){0.f, 0.f, 0.f, 0.f};
#pragma unroll
            for (int ks = 0; ks < 2; ++ks) { const bf16x8 fa = *(const LAS bf16x8*)(lds + HG_AM + (16 * mt + li) * HS2 + ks * 64 + g * 16);
                a = __builtin_amdgcn_mfma_f32_16x16x32_bf16(fa, vf[ks], a, 0, 0, 0); }
#pragma unroll
            for (int s = 0; s < 4; ++s) { const LAS unsigned char* qp = lds + HG_QH + (16 * mt + li) * HS + (32 * s + 4 * g) * 2;
                const v2u lo = *(const LAS v2u*)qp, hi = *(const LAS v2u*)(qp + 32);
                v4u x; x.x = lo.x; x.y = lo.y; x.z = hi.x; x.w = hi.y;
                a = __builtin_amdgcn_mfma_f32_16x16x32_bf16(__builtin_bit_cast(bf16x8, x), sb[s], a, 0, 0, 0); }
            o[mt] = a; }
#pragma unroll
        for (int kt = 0; kt < 8; ++kt) { const f32x4 d = *(const LAS f32x4*)(DD + 16 * kt + 4 * g); f32x4 a = Sacc[kt] * d;
#pragma unroll
            for (int ks = 0; ks < 2; ++ks) { const bf16x8 fa = *(const LAS bf16x8*)(lds + HG_KHT + (16 * kt + li) * HS2 + ks * 64 + g * 16);
                a = __builtin_amdgcn_mfma_f32_16x16x32_bf16(fa, vf[ks], a, 0, 0, 0); }
            Sacc[kt] = a; }
#pragma unroll
        for (int mt = 0; mt < 4; ++mt)
#pragma unroll
            for (int r = 0; r < 4; ++r) { float s = o[mt][r] * o[mt][r]; s += __shfl_xor(s, 1); s += __shfl_xor(s, 2); s += __shfl_xor(s, 4); s += __shfl_xor(s, 8);
                if (li == 0) SS[(16 * mt + 4 * g + r) * 8 + w] = s; }
        __syncthreads();
#pragma unroll
        for (int mt = 0; mt < 4; ++mt)
#pragma unroll
            for (int r = 0; r < 4; ++r) { const int t = 16 * mt + 4 * g + r; const f32x4 s0 = *(const LAS f32x4*)(SS + t * 8), s1 = *(const LAS f32x4*)(SS + t * 8 + 4);
                const float ss = ((s0[0] + s0[1]) + (s0[2] + s0[3])) + ((s1[0] + s1[1]) + (s1[2] + s1[3]));
                const float rs = rsqrtf(ss * (1.0f / 128.0f) + RMS_EPS);
                const float og = bf2f(*(const LAS unsigned short*)(lds + HG_OG + t * HS + (16 * w + li) * 2));
                const float y = o[mt][r] * rs * ng * (og * sigmoidf_(og));
                P.ocat[(row0 + t) * 1536 + h * 128 + 16 * w + li] = (unsigned short)f2bf(y); }
        __syncthreads();
    }
}

constexpr int RS = 144;
constexpr int RW_RT = 0, RW_AT = 9216, RW_BT = 18432, RW_KT = 27648, RW_ATT = 36864, RW_BHT = 46080, RW_KHT = 55296, RW_VTT = 64512, RW_G = 73728,
              RW_X = 82944,
              RW_LW = RW_X, RW_A1 = RW_X + 17408, RW_WW = RW_X, RW_O = RW_X + 9216,
              RW_AAB = 109568, RW_AAKT = RW_AAB + 4096, RW_ARB = RW_AAKT + 2048, RW_ARK = RW_ARB + 2048, RW_TM = RW_ARK + 2048, RW_TAM = RW_TM + 2048,
              RW_GC = RW_TAM + 2048, RW_BON = RW_GC + 1024, RW_CST = RW_BON + 256, RW_END2 = RW_CST + 3072,
              RW_TW = RW_RT, RW_AD = RW_AT, RW_SG = RW_BT;
static_assert(RW_END2 <= 131072, "rwkv lds");
__device__ __forceinline__ void rwkv_unit(const MixP& P, int b, int h, LAS unsigned char* lds) {
    int tid0_ = threadIdx.x; asm volatile("" : "+v"(tid0_));
    const int hc = h * 64;
    int tid = tid0_, lane = tid & 63, g = lane >> 4, li = lane & 15, tt = tid >> 3, sg = tid & 7, c0 = sg * 8;
    const int w = __builtin_amdgcn_readfirstlane(tid >> 6);
    LAS float* LW = (LAS float*)(lds + RW_LW); LAS float* O = (LAS float*)(lds + RW_O); LAS float* GC = (LAS float*)(lds + RW_GC); LAS float* BON = (LAS float*)(lds + RW_BON);
    LAS float* AAB = (LAS float*)(lds + RW_AAB);
    f32x4 St[4];
#pragma unroll
    for (int i = 0; i < 4; ++i) St[i] = (f32x4){0.f, 0.f, 0.f, 0.f};
    LAS float* CST = (LAS float*)(lds + RW_CST);
    for (int e = tid; e < 768; e += NTHR) { float v;
        if (e < 192) v = P.rw_mu[(e >> 6) * 512 + hc + (e & 63)]; else if (e < 448) v = P.rw_mu[1536 + (e - 192)];
        else { const int q = (e - 448) >> 6, c = (e - 448) & 63; const float* src = q == 0 ? P.rw_k_k : q == 1 ? P.rw_k_a : q == 2 ? P.rw_r_k : q == 3 ? P.rw_gn_g : P.rw_gn_b; v = src[hc + c]; }
        CST[e] = v; }
    __syncthreads();
#define LD8(dst, off) do { const f32x4 a_ = *(const LAS f32x4*)(CST + (off)), b_ = *(const LAS f32x4*)(CST + (off) + 4); _Pragma("unroll") for (int q_ = 0; q_ < 4; ++q_) { dst[q_] = a_[q_]; dst[4 + q_] = b_[q_]; } } while (0)
    const int lmt = w >> 1;
    float w0c[2], a0c[2];
#pragma unroll
    for (int n = 0; n < 2; ++n) { const int cc = 16 * (2 * (w & 1) + n) + li; w0c[n] = P.rw_w0[hc + cc]; a0c[n] = P.rw_a0[hc + cc]; }
    v4u cur[7], prv[7];
    {   const bf16* src = P.proj + ((size_t)b * T + tt) * INW;
        cur[0] = *(const v4u*)(src + C_RWR + hc + c0); cur[1] = *(const v4u*)(src + C_RWK + hc + c0); cur[2] = *(const v4u*)(src + C_RWV + hc + c0); cur[3] = *(const v4u*)(src + C_RWWD + c0); cur[4] = *(const v4u*)(src + C_RWAD + c0);
        cur[5] = *(const v4u*)(src + C_RWGD + sg * 16); cur[6] = *(const v4u*)(src + C_RWGD + sg * 16 + 8);
        if (tt > 0) { const bf16* sp = src - INW; prv[0] = *(const v4u*)(sp + C_RWR + hc + c0); prv[1] = *(const v4u*)(sp + C_RWK + hc + c0); prv[2] = *(const v4u*)(sp + C_RWV + hc + c0); prv[3] = *(const v4u*)(sp + C_RWWD + c0); prv[4] = *(const v4u*)(sp + C_RWAD + c0);
            prv[5] = *(const v4u*)(sp + C_RWGD + sg * 16); prv[6] = *(const v4u*)(sp + C_RWGD + sg * 16 + 8); }
        else {
#pragma unroll
            for (int i = 0; i < 7; ++i) prv[i] = (v4u){0u, 0u, 0u, 0u}; } }
#pragma unroll 1
    for (int blk = 0; blk < 64; ++blk) {
        const size_t row0 = (size_t)b * T + (size_t)blk * 64;
        { int t_ = tid0_; asm volatile("" : "+v"(t_)); tid = t_; lane = tid & 63; g = lane >> 4; li = lane & 15; tt = tid >> 3; sg = tid & 7; c0 = sg * 8; }
        float rr[8], k1[8], vv[8];
        {   float xw[8], xa[8], xg[16];
#define SHIFT8(dst, ci, muv) do { const unsigned cw_[4] = {cur[ci].x, cur[ci].y, cur[ci].z, cur[ci].w}, pw_[4] = {prv[ci].x, prv[ci].y, prv[ci].z, prv[ci].w}; \
            _Pragma("unroll") for (int q_ = 0; q_ < 4; ++q_) { const float c_lo = bflo(cw_[q_]), c_hi = bfhi(cw_[q_]); dst[2 * q_] = c_lo + (bflo(pw_[q_]) - c_lo) * muv[2 * q_]; dst[2 * q_ + 1] = c_hi + (bfhi(pw_[q_]) - c_hi) * muv[2 * q_ + 1]; } } while (0)
            float mu_[8];
            LD8(mu_, c0); SHIFT8(rr, 0, mu_); LD8(mu_, 64 + c0); SHIFT8(k1, 1, mu_); LD8(mu_, 128 + c0); SHIFT8(vv, 2, mu_); LD8(mu_, 192 + c0); SHIFT8(xw, 3, mu_); LD8(mu_, 256 + c0); SHIFT8(xa, 4, mu_);
            { float* xg0 = xg; float* xg1 = xg + 8; LD8(mu_, 320 + sg * 16); SHIFT8(xg0, 5, mu_); LD8(mu_, 328 + sg * 16); SHIFT8(xg1, 6, mu_); }
#undef SHIFT8
            v4u o;
            o.x = pk2(tanhf(xw[0]), tanhf(xw[1])); o.y = pk2(tanhf(xw[2]), tanhf(xw[3])); o.z = pk2(tanhf(xw[4]), tanhf(xw[5])); o.w = pk2(tanhf(xw[6]), tanhf(xw[7]));
            *(LAS v4u*)(lds + RW_TW + tt * RS + c0 * 2) = o;
            o.x = pk2(xa[0], xa[1]); o.y = pk2(xa[2], xa[3]); o.z = pk2(xa[4], xa[5]); o.w = pk2(xa[6], xa[7]);
            *(LAS v4u*)(lds + RW_AD + tt * RS + c0 * 2) = o;
            o.x = pk2(sigmoidf_(xg[0]), sigmoidf_(xg[1])); o.y = pk2(sigmoidf_(xg[2]), sigmoidf_(xg[3])); o.z = pk2(sigmoidf_(xg[4]), sigmoidf_(xg[5])); o.w = pk2(sigmoidf_(xg[6]), sigmoidf_(xg[7]));
            *(LAS v4u*)(lds + RW_SG + tt * 272 + sg * 32) = o;
            o.x = pk2(sigmoidf_(xg[8]), sigmoidf_(xg[9])); o.y = pk2(sigmoidf_(xg[10]), sigmoidf_(xg[11])); o.z = pk2(sigmoidf_(xg[12]), sigmoidf_(xg[13])); o.w = pk2(sigmoidf_(xg[14]), sigmoidf_(xg[15]));
            *(LAS v4u*)(lds + RW_SG + tt * 272 + sg * 32 + 16) = o;
        }
        __syncthreads();
#pragma unroll
        for (int n = 0; n < 2; ++n) { const int ntile = 2 * (w & 1) + n, cc = 16 * ntile + li;
            f32x4 aw = (f32x4){0.f, 0.f, 0.f, 0.f}, aa = aw, ag = aw;
#pragma unroll
            for (int ks = 0; ks < 2; ++ks) { const bf16x8 f1 = *(const LAS bf16x8*)(lds + RW_TW + (16 * lmt + li) * RS + ks * 64 + g * 16), f2 = *(const LAS bf16x8*)(lds + RW_AD + (16 * lmt + li) * RS + ks * 64 + g * 16);
                const bf16x8 bw = *(const bf16x8*)(P.wupT + (size_t)(hc + cc) * 64 + ks * 32 + g * 8), ba = *(const bf16x8*)(P.aupT + (size_t)(hc + cc) * 64 + ks * 32 + g * 8);
                aw = __builtin_amdgcn_mfma_f32_16x16x32_bf16(f1, bw, aw, 0, 0, 0); aa = __builtin_amdgcn_mfma_f32_16x16x32_bf16(f2, ba, aa, 0, 0, 0); }
#pragma unroll
            for (int ks = 0; ks < 4; ++ks) { const bf16x8 f3 = *(const LAS bf16x8*)(lds + RW_SG + (16 * lmt + li) * 272 + ks * 64 + g * 16); const bf16x8 bg = *(const bf16x8*)(P.gupT + (size_t)(hc + cc) * 128 + ks * 32 + g * 8);
                ag = __builtin_amdgcn_mfma_f32_16x16x32_bf16(f3, bg, ag, 0, 0, 0); }
#pragma unroll
            for (int r = 0; r < 4; ++r) { const int t = 16 * lmt + 4 * g + r; const float z = -(w0c[n] + aw[r]);
                const float sp = fmaxf(z, 0.f) + log1pf(__expf(-fabsf(z)));
                LW[t * 68 + cc] = -__expf(-sp - 0.5f);
                *(LAS unsigned short*)(lds + RW_A1 + t * RS + cc * 2) = (unsigned short)f2bf(sigmoidf_(a0c[n] + aa[r]));
                *(LAS unsigned short*)(lds + RW_G + t * RS + cc * 2) = (unsigned short)f2bf(ag[r]); }
        }
        __syncthreads();
        if (tid < 256) { const int j = tid >> 6, c = tid & 63; float run = 0.f;
#pragma unroll
            for (int i = 0; i < 16; ++i) { run += LW[(16 * j + i) * 68 + c]; LW[(16 * j + i) * 68 + c] = run; }
            GC[j * 64 + c] = __expf(run); }
        __syncthreads();
        {   float a[8], clt[8], clm[8], clc[8];
            { const v4u av = *(const LAS v4u*)(lds + RW_A1 + tt * RS + c0 * 2); a[0] = bflo(av.x); a[1] = bfhi(av.x); a[2] = bflo(av.y); a[3] = bfhi(av.y); a[4] = bflo(av.z); a[5] = bfhi(av.z); a[6] = bflo(av.w); a[7] = bfhi(av.w); }
            const int tl = tt & 15, tC = (tt | 15);
            { const f32x4 x0 = *(const LAS f32x4*)(LW + tt * 68 + c0), x1 = *(const LAS f32x4*)(LW + tt * 68 + c0 + 4), y0 = *(const LAS f32x4*)(LW + tC * 68 + c0), y1 = *(const LAS f32x4*)(LW + tC * 68 + c0 + 4);
              f32x4 z0 = (f32x4){0.f, 0.f, 0.f, 0.f}, z1 = z0; if (tl > 0) { z0 = *(const LAS f32x4*)(LW + (tt - 1) * 68 + c0); z1 = *(const LAS f32x4*)(LW + (tt - 1) * 68 + c0 + 4); }
#pragma unroll
              for (int j = 0; j < 4; ++j) { clt[j] = x0[j]; clt[4 + j] = x1[j]; clc[j] = y0[j]; clc[4 + j] = y1[j]; clm[j] = z0[j]; clm[4 + j] = z1[j]; } }
            float kk[8], kkc[8], kac[8], rkc[8]; float ss = 0.f;
            LD8(kkc, 448 + c0); LD8(kac, 512 + c0); LD8(rkc, 576 + c0);
#pragma unroll
            for (int j = 0; j < 8; ++j) { kk[j] = k1[j] * kkc[j]; ss += kk[j] * kk[j]; }
            ss += __shfl_xor(ss, 1); ss += __shfl_xor(ss, 2); ss += __shfl_xor(ss, 4);
            const float inv = rsqrtf(fmaxf(ss, 1e-12f)); float bon = 0.f;
            float rt[8], at[8], bt[8], kt[8], bh[8], kh[8];
#pragma unroll
            for (int j = 0; j < 8; ++j) { const float kn = kk[j] * inv, k2 = k1[j] * (1.0f + (a[j] - 1.0f) * kac[j]); const float av = -kn, bv = kn * a[j];
                const float ig = __expf(-clt[j]), gh = __expf(clc[j] - clt[j]);
                rt[j] = rr[j] * __expf(clt[j]); at[j] = av * __expf(clm[j]); bt[j] = bv * ig; kt[j] = k2 * ig; bh[j] = bv * gh; kh[j] = k2 * gh; bon += rr[j] * k2 * rkc[j]; }
            bon += __shfl_xor(bon, 1); bon += __shfl_xor(bon, 2); bon += __shfl_xor(bon, 4);
            if (sg == 0) BON[tt] = bon;
            v4u o;
#define PK8(src) (o.x = pk2(src[0], src[1]), o.y = pk2(src[2], src[3]), o.z = pk2(src[4], src[5]), o.w = pk2(src[6], src[7]), o)
            *(LAS v4u*)(lds + RW_RT + tt * RS + c0 * 2) = PK8(rt); *(LAS v4u*)(lds + RW_AT + tt * RS + c0 * 2) = PK8(at); *(LAS v4u*)(lds + RW_BT + tt * RS + c0 * 2) = PK8(bt); *(LAS v4u*)(lds + RW_KT + tt * RS + c0 * 2) = PK8(kt);
#undef PK8
#pragma unroll
            for (int j = 0; j < 8; ++j) { *(LAS unsigned short*)(lds + RW_ATT + (c0 + j) * RS + tt * 2) = (unsigned short)f2bf(at[j]); *(LAS unsigned short*)(lds + RW_BHT + (c0 + j) * RS + tt * 2) = (unsigned short)f2bf(bh[j]);
                *(LAS unsigned short*)(lds + RW_KHT + (c0 + j) * RS + tt * 2) = (unsigned short)f2bf(kh[j]); *(LAS unsigned short*)(lds + RW_VTT + (c0 + j) * RS + tt * 2) = (unsigned short)f2bf(vv[j]); }
        }
        __syncthreads();
        {   const int j = w >> 1; const int rowb = (16 * j + li) * RS;
            bf16x8 fat[2], fbt[2], fkt[2], frt[2];
#pragma unroll
            for (int ks = 0; ks < 2; ++ks) { fbt[ks] = *(const LAS bf16x8*)(lds + RW_BT + rowb + ks * 64 + g * 16); fkt[ks] = *(const LAS bf16x8*)(lds + RW_KT + rowb + ks * 64 + g * 16);
                if ((w & 1) == 0) fat[ks] = *(const LAS bf16x8*)(lds + RW_AT + rowb + ks * 64 + g * 16); else frt[ks] = *(const LAS bf16x8*)(lds + RW_RT + rowb + ks * 64 + g * 16); }
            if ((w & 1) == 0) {
                f32x4 x = (f32x4){0.f, 0.f, 0.f, 0.f}, y = x;
#pragma unroll
                for (int ks = 0; ks < 2; ++ks) { x = __builtin_amdgcn_mfma_f32_16x16x32_bf16(fbt[ks], fat[ks], x, 0, 0, 0);
                    y = __builtin_amdgcn_mfma_f32_16x16x32_bf16(fat[ks], fkt[ks], y, 0, 0, 0); }
                f32x4 xm; v2u ym;
#pragma unroll
                for (int r = 0; r < 4; ++r) xm[r] = (4 * g + r < li) ? x[r] : 0.f;
                *(LAS f32x4*)(AAB + (j * 16 + li) * 16 + 4 * g) = xm;
                ym.x = pk2(li < 4 * g ? y[0] : 0.f, li < 4 * g + 1 ? y[1] : 0.f); ym.y = pk2(li < 4 * g + 2 ? y[2] : 0.f, li < 4 * g + 3 ? y[3] : 0.f);
                *(LAS v2u*)(lds + RW_AAKT + (j * 16 + li) * 32 + 8 * g) = ym;
            } else {
                f32x4 x = (f32x4){0.f, 0.f, 0.f, 0.f}, y = x;
#pragma unroll
                for (int ks = 0; ks < 2; ++ks) { x = __builtin_amdgcn_mfma_f32_16x16x32_bf16(fbt[ks], frt[ks], x, 0, 0, 0);
                    y = __builtin_amdgcn_mfma_f32_16x16x32_bf16(fkt[ks], frt[ks], y, 0, 0, 0); }
                v2u xm, ym;
                xm.x = pk2(4 * g <= li ? x[0] : 0.f, 4 * g + 1 <= li ? x[1] : 0.f); xm.y = pk2(4 * g + 2 <= li ? x[2] : 0.f, 4 * g + 3 <= li ? x[3] : 0.f);
                ym.x = pk2(4 * g <= li ? y[0] : 0.f, 4 * g + 1 <= li ? y[1] : 0.f); ym.y = pk2(4 * g + 2 <= li ? y[2] : 0.f, 4 * g + 3 <= li ? y[3] : 0.f);
                *(LAS v2u*)(lds + RW_ARB + (j * 16 + li) * 32 + 8 * g) = xm; *(LAS v2u*)(lds + RW_ARK + (j * 16 + li) * 32 + 8 * g) = ym;
            }
        }
        __syncthreads();
        if (w == 0) { const int j = g, col = li; float x[16];
#pragma unroll
            for (int t = 0; t < 16; ++t) { float s = (t == col) ? 1.f : 0.f;
#pragma unroll
                for (int q = 0; q < (t + 3) / 4; ++q) { const f32x4 av = *(const LAS f32x4*)(AAB + (j * 16 + t) * 16 + 4 * q);
#pragma unroll
                    for (int e = 0; e < 4; ++e) if (4 * q + e < t) s += av[e] * x[4 * q + e]; }
                x[t] = s; *(LAS unsigned short*)(lds + RW_TM + (j * 16 + t) * 32 + col * 2) = (unsigned short)f2bf(s); } }
        __syncthreads();
        {   const int j = w >> 1; const bf16x8 zf = (bf16x8){0, 0, 0, 0, 0, 0, 0, 0};
            const bf16x8 ft = (g < 2) ? *(const LAS bf16x8*)(lds + RW_TM + (j * 16 + li) * 32 + g * 16) : zf;
#pragma unroll
            for (int n = 0; n < 2; ++n) { const int ct = 2 * (w & 1) + n;
                const bf16x8 fa = (g < 2) ? *(const LAS bf16x8*)(lds + RW_ATT + (16 * ct + li) * RS + (16 * j + 8 * g) * 2) : zf;
                f32x4 x = __builtin_amdgcn_mfma_f32_16x16x32_bf16(fa, ft, (f32x4){0.f, 0.f, 0.f, 0.f}, 0, 0, 0);
                v2u xm; xm.x = pk2(x[0], x[1]); xm.y = pk2(x[2], x[3]);
                *(LAS v2u*)(lds + RW_WW + (16 * j + li) * RS + (16 * ct + 4 * g) * 2) = xm; }
            if ((w & 1) == 0) { const bf16x8 fa = (g < 2) ? *(const LAS bf16x8*)(lds + RW_AAKT + (j * 16 + li) * 32 + g * 16) : zf;
                f32x4 x = __builtin_amdgcn_mfma_f32_16x16x32_bf16(fa, ft, (f32x4){0.f, 0.f, 0.f, 0.f}, 0, 0, 0);
                v2u xm; xm.x = pk2(x[0], x[1]); xm.y = pk2(x[2], x[3]);
                *(LAS v2u*)(lds + RW_TAM + (j * 16 + li) * 32 + 8 * g) = xm; }
        }
        __syncthreads();
        if (blk < 63) { const bf16* src = P.proj + (row0 + 64 + tt) * INW; const bf16* sp = src - INW;
            cur[0] = *(const v4u*)(src + C_RWR + hc + c0); cur[1] = *(const v4u*)(src + C_RWK + hc + c0); cur[2] = *(const v4u*)(src + C_RWV + hc + c0); cur[3] = *(const v4u*)(src + C_RWWD + c0); cur[4] = *(const v4u*)(src + C_RWAD + c0);
            cur[5] = *(const v4u*)(src + C_RWGD + sg * 16); cur[6] = *(const v4u*)(src + C_RWGD + sg * 16 + 8);
            prv[0] = *(const v4u*)(sp + C_RWR + hc + c0); prv[1] = *(const v4u*)(sp + C_RWK + hc + c0); prv[2] = *(const v4u*)(sp + C_RWV + hc + c0); prv[3] = *(const v4u*)(sp + C_RWWD + c0); prv[4] = *(const v4u*)(sp + C_RWAD + c0);
            prv[5] = *(const v4u*)(sp + C_RWGD + sg * 16); prv[6] = *(const v4u*)(sp + C_RWGD + sg * 16 + 8); }
        if (w < 4) {
#pragma unroll 1
            for (int j = 0; j < 4; ++j) {
                bf16x8 sb[2];
#pragma unroll
                for (int s = 0; s < 2; ++s) { v4u x; x.x = pk2(St[2 * s][0], St[2 * s][1]); x.y = pk2(St[2 * s][2], St[2 * s][3]); x.z = pk2(St[2 * s + 1][0], St[2 * s + 1][1]); x.w = pk2(St[2 * s + 1][2], St[2 * s + 1][3]); sb[s] = __builtin_bit_cast(bf16x8, x); }
                const v2u vf = *(const LAS v2u*)(lds + RW_VTT + (16 * w + li) * RS + (16 * j + 4 * g) * 2);
                const int trow = (16 * j + li) * RS;
                f32x4 u = (f32x4){0.f, 0.f, 0.f, 0.f}, o = u;
#pragma unroll
                for (int s = 0; s < 2; ++s) { const v2u lo = *(const LAS v2u*)(lds + RW_WW + trow + (32 * s + 4 * g) * 2), hi = *(const LAS v2u*)(lds + RW_WW + trow + (32 * s + 16 + 4 * g) * 2);
                    v4u x; x.x = lo.x; x.y = lo.y; x.z = hi.x; x.w = hi.y; u = __builtin_amdgcn_mfma_f32_16x16x32_bf16(__builtin_bit_cast(bf16x8, x), sb[s], u, 0, 0, 0);
                    const v2u lo2 = *(const LAS v2u*)(lds + RW_RT + trow + (32 * s + 4 * g) * 2), hi2 = *(const LAS v2u*)(lds + RW_RT + trow + (32 * s + 16 + 4 * g) * 2);
                    v4u y; y.x = lo2.x; y.y = lo2.y; y.z = hi2.x; y.w = hi2.y; o = __builtin_amdgcn_mfma_f32_16x16x32_bf16(__builtin_bit_cast(bf16x8, y), sb[s], o, 0, 0, 0); }
                {   const v2u ta = *(const LAS v2u*)(lds + RW_TAM + (j * 16 + li) * 32 + 8 * g);
                    v4u x; x.x = ta.x; x.y = ta.y; x.z = 0u; x.w = 0u; v4u y; y.x = vf.x; y.y = vf.y; y.z = 0u; y.w = 0u;
                    u = __builtin_amdgcn_mfma_f32_16x16x32_bf16(__builtin_bit_cast(bf16x8, x), __builtin_bit_cast(bf16x8, y), u, 0, 0, 0); }
                v4u b2; b2.x = pk2(u[0], u[1]); b2.y = pk2(u[2], u[3]); b2.z = vf.x; b2.w = vf.y;
                const bf16x8 b2f = __builtin_bit_cast(bf16x8, b2);
                {   const v2u rb = *(const LAS v2u*)(lds + RW_ARB + (j * 16 + li) * 32 + 8 * g), rk = *(const LAS v2u*)(lds + RW_ARK + (j * 16 + li) * 32 + 8 * g);
                    v4u x; x.x = rb.x; x.y = rb.y; x.z = rk.x; x.w = rk.y; o = __builtin_amdgcn_mfma_f32_16x16x32_bf16(__builtin_bit_cast(bf16x8, x), b2f, o, 0, 0, 0); }
#pragma unroll
                for (int r = 0; r < 4; ++r) O[(16 * j + 4 * g + r) * 68 + 16 * w + li] = o[r];
#pragma unroll
                for (int kt = 0; kt < 4; ++kt) { const f32x4 gc = *(const LAS f32x4*)(GC + j * 64 + 16 * kt + 4 * g);
                    const v2u bh = *(const LAS v2u*)(lds + RW_BHT + (16 * kt + li) * RS + (16 * j + 4 * g) * 2), kh = *(const LAS v2u*)(lds + RW_KHT + (16 * kt + li) * RS + (16 * j + 4 * g) * 2);
                    v4u x; x.x = bh.x; x.y = bh.y; x.z = kh.x; x.w = kh.y;
                    St[kt] = __builtin_amdgcn_mfma_f32_16x16x32_bf16(__builtin_bit_cast(bf16x8, x), b2f, St[kt] * gc, 0, 0, 0); }
            }
        }
        __syncthreads();
        {   const f32x4 o0 = *(const LAS f32x4*)(O + tt * 68 + c0), o1 = *(const LAS f32x4*)(O + tt * 68 + c0 + 4); float ov[8];
#pragma unroll
            for (int j = 0; j < 4; ++j) { ov[j] = o0[j]; ov[4 + j] = o1[j]; }
            float s = 0.f;
#pragma unroll
            for (int j = 0; j < 8; ++j) s += ov[j];
            s += __shfl_xor(s, 1); s += __shfl_xor(s, 2); s += __shfl_xor(s, 4);
            const float mean = s * (1.0f / 64.0f); float q = 0.f;
#pragma unroll
            for (int j = 0; j < 8; ++j) { const float d = ov[j] - mean; q += d * d; }
            q += __shfl_xor(q, 1); q += __shfl_xor(q, 2); q += __shfl_xor(q, 4);
            const float rs = rsqrtf(q * (1.0f / 64.0f) + RW_GN_EPS), bon = BON[tt];
            const v4u gv = *(const LAS v4u*)(lds + RW_G + tt * RS + c0 * 2); const float gg[8] = {bflo(gv.x), bfhi(gv.x), bflo(gv.y), bfhi(gv.y), bflo(gv.z), bfhi(gv.z), bflo(gv.w), bfhi(gv.w)};
            float y[8], gng[8], gnb[8]; LD8(gng, 640 + c0); LD8(gnb, 704 + c0);
#pragma unroll
            for (int j = 0; j < 8; ++j) y[j] = ((ov[j] - mean) * rs * gng[j] + gnb[j] + bon * vv[j]) * gg[j];
            v4u wv; wv.x = pk2(y[0], y[1]); wv.y = pk2(y[2], y[3]); wv.z = pk2(y[4], y[5]); wv.w = pk2(y[6], y[7]);
            *(v4u*)(P.ocat + (row0 + tt) * 1536 + 1024 + hc + c0) = wv; }
        __syncthreads();
    }
#undef LD8
}
struct Args { const float* in[31]; float* out; unsigned char* ws; int ph_lo, ph_hi; };
typedef const __attribute__((address_space(4))) Args* ArgP;
struct Frame {
    LAS unsigned char* lds; volatile LAS unsigned* MISC; gu32* ctl;
    int tid, lane, wave, vcu, G, bx;
};
constexpr int SM_HGLB = 0;
constexpr int SM_LAM = 2048;

__device__ __forceinline__ void transpose_item(const float* W, int K, int N, bf16* WT, int k0, int n0, int drow0, LAS float* scr, int lane, int dp = 0) {
    if (dp == 0) dp = K;
#pragma unroll 8
    for (int i = 0; i < 32; ++i) { const int kk = 2 * i + (lane >> 5); scr[kk * 33 + (lane & 31)] = W[(size_t)(k0 + kk) * N + n0 + (lane & 31)]; }
    LDS_WAIT(); asm volatile("" ::: "memory");
    const int c = lane & 7;
#pragma unroll
    for (int j = 0; j < 4; ++j) { const int n = (lane >> 3) + 8 * j; const LAS float* s = scr + (8 * c) * 33 + n;
        v4u o; o.x = pk2(s[0 * 33], s[1 * 33]); o.y = pk2(s[2 * 33], s[3 * 33]); o.z = pk2(s[4 * 33], s[5 * 33]); o.w = pk2(s[6 * 33], s[7 * 33]);
        *(GAS v4u*)(WT + (size_t)(drow0 + n) * dp + k0 + 8 * c) = o; }
    LDS_WAIT(); asm volatile("" ::: "memory");
}
constexpr int CV_IN = 2688, CV_MG = 1536, CV_BR = 768, CV_OUT = 512, CV_EX = 4096, CV_TOTAL = CV_IN + CV_MG + CV_BR + CV_OUT + 3 * CV_EX;
__device__ __forceinline__ void conv_layer(const Frame& F, ArgP A, int l) {
    LAS float* scr = (LAS float*)(F.lds + F.wave * 16384);
    const int gw = F.vcu * NWAVES + F.wave, NGW = F.G * NWAVES;
    bf16* wa = (bf16*)(A->ws + WS_WA); bf16* we = (bf16*)(A->ws + WS_WE);
    for (int it = gw; it < CV_TOTAL; it += NGW) {
        int r = it;
        if (r < CV_IN) { const int kb = r / 168, nb = r % 168; transpose_item(A->in[4] + (size_t)l * DM * INW, DM, INW, wa + WA_IN / 2, 64 * kb, 32 * nb, 32 * nb, scr, F.lane); continue; } r -= CV_IN;
        if (r < CV_MG) { const int br = r / 512, q = r % 512, kb = q / 32, nb = q % 32; transpose_item(A->in[20] + ((size_t)l * 3 + br) * DM * DM, DM, DM, wa + WA_MERGE / 2 + (size_t)br * DM * UP_, 64 * kb, 32 * nb, 32 * nb, scr, F.lane, UP_); continue; } r -= CV_MG;
        if (r < CV_BR) { const int kb = r / 32, nb = r % 32; transpose_item(A->in[22] + (size_t)l * 1536 * DM, 1536, DM, wa + WA_BRANCH / 2, 64 * kb, 32 * nb, 32 * nb, scr, F.lane); continue; } r -= CV_BR;
        if (r < CV_OUT) { const int kb = r / 32, nb = r % 32; transpose_item(A->in[23] + (size_t)l * DM * DM, DM, DM, wa + WA_OUT / 2, 64 * kb, 32 * nb, 32 * nb, scr, F.lane); continue; } r -= CV_OUT;
        if (r < 2 * CV_EX) { const int up = r / CV_EX, q = r % CV_EX, e = q / 256, q2 = q % 256, kb = q2 / 16, nb = q2 % 16, n0 = 32 * nb;
            transpose_item(A->in[28 + up] + ((size_t)l * NE + e) * DM * DE, DM, DE, we + WE_GU / 2 + (size_t)e * DM * DM, 64 * kb, n0, (n0 >> 7) * 256 + up * 128 + (n0 & 127), scr, F.lane); continue; } r -= 2 * CV_EX;
        { const int e = r / 256, q2 = r % 256, kb = q2 / 32, nb = q2 % 32; transpose_item(A->in[30] + ((size_t)l * NE + e) * DE * DM, DE, DM, we + WE_DT / 2 + (size_t)e * DM * DE, 64 * kb, 32 * nb, 32 * nb, scr, F.lane); }
    }
}

__device__ __forceinline__ void phase_prologue(const Frame& F, ArgP A) {
    {   LAS float* cond = (LAS float*)(F.lds);
        float* modp = (float*)(A->ws + WS_MODP);
        for (int it = F.vcu; it < NL * 24 * 4; it += F.G) { const int l = it / 96, r = it % 96, nb = r / 4, kq = r % 4;
            __syncthreads();
            for (int e = F.tid; e < 8 * 256; e += NTHR) { const float cv = A->in[1][(e >> 8) * DM + kq * 256 + (e & 255)]; cond[e] = cv * sigmoidf_(cv); }
            __syncthreads();
            const int n = nb * 256 + (F.tid & 255), kh = F.tid >> 8; float acc[8];
#pragma unroll
            for (int b = 0; b < 8; ++b) acc[b] = 0.f;
            const float* wp = A->in[2] + ((size_t)l * DM + kq * 256 + kh * 128) * 6144 + n;
#pragma unroll 4
            for (int k = 0; k < 128; ++k) { const float wv = wp[(size_t)k * 6144];
#pragma unroll
                for (int b = 0; b < 8; ++b) acc[b] += cond[b * 256 + kh * 128 + k] * wv; }
            const int kp = kq * 2 + kh;
#pragma unroll
            for (int b = 0; b < 8; ++b) modp[(((size_t)kp * NL + l) * NB + b) * 6144 + n] = acc[b]; }
        __syncthreads();
    }
    conv_layer(F, A, 0);
    {   bf16* lo = (bf16*)(A->ws + WS_LORA); const int gt = F.vcu * NTHR + F.tid, NGT = F.G * NTHR;
        for (int e = gt; e < NL * 512 * 64; e += NGT) { const int l = e / 32768, r = e % 32768, c = r >> 6, j = r & 63;
            lo[(size_t)l * 131072 + c * 64 + j] = (bf16)f2bf(A->in[11][(size_t)l * 32768 + j * 512 + c]);
            lo[(size_t)l * 131072 + 32768 + c * 64 + j] = (bf16)f2bf(A->in[13][(size_t)l * 32768 + j * 512 + c]); }
        for (int e = gt; e < NL * 512 * 128; e += NGT) { const int l = e / 65536, r = e % 65536, c = r >> 7, j = r & 127;
            lo[(size_t)l * 131072 + 65536 + c * 128 + j] = (bf16)f2bf(A->in[14][(size_t)l * 65536 + j * 512 + c]); }
    }
    if (F.vcu == 0) { float* sm = (float*)(A->ws + WS_SMALL);
        { const int k = F.tid; float z[4], mx = -1e30f;
#pragma unroll
          for (int l = 0; l < 4; ++l) { z[l] = A->in[5][l * 512 + k]; mx = fmaxf(mx, z[l]); }
          float s = 0.f;
#pragma unroll
          for (int l = 0; l < 4; ++l) { z[l] = __expf(z[l] - mx); s += z[l]; }
          const float inv = 1.0f / s;
          sm[SM_HGLB + k] = 0.f; sm[SM_HGLB + 512 + k] = z[1] * inv; sm[SM_HGLB + 1024 + k] = (z[1] + z[2]) * inv; sm[SM_HGLB + 1536 + k] = (z[1] + z[2] + z[3]) * inv; }
        if (F.wave < 4) { const int l = F.wave; const float* dl = A->in[7] + l * 256;
            const float s1 = wave_sum(dl[F.lane] * dl[64 + F.lane]), s2 = wave_sum(dl[128 + F.lane] * dl[192 + F.lane]);
            const float li = 0.8f - 0.6f * expf(-0.3f * (float)l);
            if (F.lane == 0) { sm[SM_LAM + l] = expf(s1) - expf(s2) + li; sm[SM_LAM + 4 + l] = 1.0f - li; } }
    }
}
__device__ __forceinline__ float mod_from_partials(ArgP A, int l, int b, int n) {
    const float* mp = (const float*)(A->ws + WS_MODP) + ((size_t)l * NB + b) * 6144 + n; float s = A->in[3][l * 6144 + n];
#pragma unroll
    for (int kp = 0; kp < 8; ++kp) s += mp[(size_t)kp * NL * NB * 6144];
    return s;
}
__device__ __forceinline__ void phase_mod_u0(const Frame& F, ArgP A) {
    float* mod = (float*)(A->ws + WS_MOD);
    for (int e = F.vcu * NTHR + F.tid; e < NL * NB * 6144; e += F.G * NTHR) { const int l = e / (NB * 6144), r = e % (NB * 6144); mod[e] = mod_from_partials(A, l, r / 6144, r % 6144); }
    bf16* U = (bf16*)(A->ws + WS_U);
    for (int rb = F.vcu; rb < M / 128; rb += F.G) { const int b = rb / 32;
        float sh[16], sc[16];
#pragma unroll
        for (int j = 0; j < 4; ++j)
#pragma unroll
            for (int i = 0; i < 4; ++i) { const int c = 4 * F.lane + 256 * j + i; sh[j * 4 + i] = mod_from_partials(A, 0, b, c); sc[j * 4 + i] = 1.0f + mod_from_partials(A, 0, b, 1024 + c); }
        for (int i = 0; i < 16; ++i) { const size_t row = (size_t)rb * 128 + F.wave * 16 + i;
            const f32x4* xr = (const f32x4*)(A->in[0] + row * DM) + F.lane; v2u* ur = (v2u*)(U + row * UP_) + F.lane;
#pragma unroll
            for (int j = 0; j < 4; ++j) { const f32x4 v = xr[64 * j]; v2u w; w.x = pk2(v[0] * sc[j * 4 + 0] + sh[j * 4 + 0], v[1] * sc[j * 4 + 1] + sh[j * 4 + 1]); w.y = pk2(v[2] * sc[j * 4 + 2] + sh[j * 4 + 2], v[3] * sc[j * 4 + 3] + sh[j * 4 + 3]); ur[64 * j] = w; } }
    }
}

__device__ __forceinline__ void phase_ln1(const Frame& F, ArgP A, int l) {
    const float* mod = (const float*)(A->ws + WS_MOD);
    const bf16* MIX = (const bf16*)(A->ws + WS_MIX); bf16* U = (bf16*)(A->ws + WS_U);
    const float* xin = (l == 0) ? A->in[0] : A->out;
    LAS float* wrT = (LAS float*)(F.lds);
    LAS int* te = (LAS int*)(F.lds + 65536);
    LAS int* tbase = (LAS int*)(F.lds + 65536 + 1024);
    int* tokpos = (int*)(A->ws + WS_TOK); float* tokw = (float*)(A->ws + WS_TOK + (size_t)M * 8);
    __syncthreads();
    for (int e = F.tid; e < 16 * 1024; e += NTHR) { const int ex = e >> 10, k = e & 1023; wrT[e] = A->in[26][k * 16 + ex]; }
    __syncthreads();
    float rb_[16];
#pragma unroll
    for (int e = 0; e < 16; ++e) rb_[e] = A->in[27][e];
    for (int rb = F.vcu; rb < M / 128; rb += F.G) { const int b = rb / 32; const float* mb = mod + ((size_t)l * NB + b) * 6144;
        float g1[16], sh2[16], sc2[16], lg[16], lb[16];
#pragma unroll
        for (int j = 0; j < 4; ++j)
#pragma unroll
            for (int i = 0; i < 4; ++i) { const int c = 4 * F.lane + 256 * j + i, q = j * 4 + i; g1[q] = 1.0f + mb[2048 + c]; sh2[q] = mb[3072 + c]; sc2[q] = 1.0f + mb[4096 + c]; lg[q] = A->in[24][(l * 2 + 0) * DM + c]; lb[q] = A->in[25][(l * 2 + 0) * DM + c]; }
#pragma unroll 1
        for (int i = 0; i < 16; ++i) { const int tl = F.wave * 16 + i; const size_t row = (size_t)rb * 128 + tl;
            const f32x4* xr = (const f32x4*)(xin + row * DM) + F.lane; const v2u* mr = (const v2u*)(MIX + row * DM) + F.lane;
            float y[16]; float s = 0.f;
#pragma unroll
            for (int j = 0; j < 4; ++j) { const f32x4 v = xr[64 * j]; const v2u m2 = mr[64 * j];
                y[j * 4 + 0] = ALPHA * v[0] + g1[j * 4 + 0] * bflo(m2.x); y[j * 4 + 1] = ALPHA * v[1] + g1[j * 4 + 1] * bfhi(m2.x);
                y[j * 4 + 2] = ALPHA * v[2] + g1[j * 4 + 2] * bflo(m2.y); y[j * 4 + 3] = ALPHA * v[3] + g1[j * 4 + 3] * bfhi(m2.y);
                s += (y[j * 4] + y[j * 4 + 1]) + (y[j * 4 + 2] + y[j * 4 + 3]); }
            const float mean = wave_sum(s) * (1.0f / DM); float q = 0.f;
#pragma unroll
            for (int k = 0; k < 16; ++k) { y[k] -= mean; q += y[k] * y[k]; }
            const float rstd = rsqrtf(wave_sum(q) * (1.0f / DM) + LN_EPS);
            f32x4* xo = (f32x4*)(A->out + row * DM) + F.lane; v2u* ur = (v2u*)(U + row * UP_) + F.lane; float u2[16];
#pragma unroll
            for (int j = 0; j < 4; ++j) { f32x4 o;
#pragma unroll
                for (int k = 0; k < 4; ++k) { o[k] = y[j * 4 + k] * rstd * lg[j * 4 + k] + lb[j * 4 + k]; u2[j * 4 + k] = o[k] * sc2[j * 4 + k] + sh2[j * 4 + k]; }
                xo[64 * j] = o; v2u w; w.x = pk2(u2[j * 4], u2[j * 4 + 1]); w.y = pk2(u2[j * 4 + 2], u2[j * 4 + 3]); ur[64 * j] = w; }
            float sc[16]; float mx = -1e30f;
#pragma unroll
            for (int e = 0; e < 16; ++e) { float p = 0.f;
#pragma unroll
                for (int j = 0; j < 4; ++j) { const f32x4 wv = *(const LAS f32x4*)(wrT + e * 1024 + 4 * F.lane + 256 * j); p += (u2[j * 4] * wv[0] + u2[j * 4 + 1] * wv[1]) + (u2[j * 4 + 2] * wv[2] + u2[j * 4 + 3] * wv[3]); }
                sc[e] = wave_sum(p); mx = fmaxf(mx, sc[e]); }
            float den = 0.f;
#pragma unroll
            for (int e = 0; e < 16; ++e) { sc[e] = __expf(sc[e] - mx); den += sc[e]; }
            const float iden = 1.0f / den; float sel[16];
#pragma unroll
            for (int e = 0; e < 16; ++e) { sc[e] *= iden; sel[e] = sc[e] + rb_[e]; }
            int bg = 0; float bgs = -1e30f;
#pragma unroll
            for (int gq = 0; gq < 4; ++gq) { float m1 = -1e30f, m2 = -1e30f;
#pragma unroll
                for (int k = 0; k < 4; ++k) { const float v = sel[gq * 4 + k]; if (v > m1) { m2 = m1; m1 = v; } else if (v > m2) m2 = v; }
                const float gs = m1 + m2; if (gs > bgs) { bgs = gs; bg = gq; } }
            int i0 = 0, i1 = 0; float v0 = -1e30f, v1 = -1e30f, w0 = 0.f, w1 = 0.f;
#pragma unroll
            for (int e = 0; e < 16; ++e) { if ((e >> 2) == bg) { const float v = sel[e]; if (v > v0) { v1 = v0; i1 = i0; w1 = w0; v0 = v; i0 = e; w0 = sc[e]; } else if (v > v1) { v1 = v; i1 = e; w1 = sc[e]; } } }
            const float iw = 1.0f / (w0 + w1);
            if (F.lane == 0) { te[tl * 2] = i0; te[tl * 2 + 1] = i1; tokw[row * 2] = w0 * iw; tokw[row * 2 + 1] = w1 * iw; }
        }
        __syncthreads();
        if (F.tid < 16) { int n = 0; for (int k = 0; k < 256; ++k) n += (te[k] == F.tid) ? 1 : 0;
            tbase[F.tid] = (int)__hip_atomic_fetch_add(F.ctl + CW_ECNT + 64 * l + F.tid, (unsigned)n, RLX_AGENT);
            int p = tbase[F.tid];
            for (int k = 0; k < 256; ++k) if (te[k] == F.tid) { tokpos[(size_t)rb * 256 + k] = (F.tid << 24) | p; ++p; } }
        __syncthreads();
    }
}
__device__ __forceinline__ void load_hb(const Frame& F, int l, volatile LAS int* hb, int c) {
    __syncthreads();
    if (F.tid == 0) { int acc = 0; for (int e = 0; e < 16; ++e) { hb[e] = acc; const int cn = (int)__hip_atomic_load(F.ctl + CW_ECNT + 64 * l + e, RLX_AGENT); acc += (cn + 255) & ~255; } hb[16] = acc; hb[17] = acc >> 8;
        const int nun = (acc >> 8) * 4; int n = 0;
        for (int L = c; L < nun && n < 12; L += F.G) { const int j = L >> 2, pn = L & 3; int e = 0; for (int k = 1; k < 16; ++k) e = (hb[k] <= j * 256) ? k : e; hb[19 + n] = (j << 8) | (pn << 4) | e; ++n; }
        hb[18] = n; }
    __syncthreads();
}
__device__ __forceinline__ void phase_scatter(const Frame& F, ArgP A, int l) {
    volatile LAS int* hb = (volatile LAS int*)(F.lds + 4096);
    load_hb(F, l, hb, 0);
    const int* tokpos = (const int*)(A->ws + WS_TOK); int* tokrow = (int*)(A->ws + WS_TOK + (size_t)M * 16);
    const bf16* U = (const bf16*)(A->ws + WS_U); bf16* AS = (bf16*)(A->ws + WS_AS);
    for (int rb = F.vcu; rb < M / 128; rb += F.G) {
        for (int i = 0; i < 32; ++i) { const int k = F.wave * 32 + i; const size_t idx = (size_t)rb * 256 + k; const int tp = tokpos[idx]; const int e = tp >> 24, pos = tp & 0xffffff;
            const int row = hb[e] + pos; const size_t tok = idx >> 1;
            const v4u* src = (const v4u*)(U + tok * UP_) + F.lane; v4u* dst = (v4u*)(AS + (size_t)row * DM) + F.lane;
            const v4u a = src[0], c = src[64]; dst[0] = a; dst[64] = c;
            if (F.lane == 0) tokrow[idx] = row; }
    }
}
__device__ __forceinline__ void phase_ln2(const Frame& F, ArgP A, int l) {
    const float* mod = (const float*)(A->ws + WS_MOD);
    const bf16* Y = (const bf16*)(A->ws + WS_Y); bf16* U = (bf16*)(A->ws + WS_U);
    const int* tokrow = (const int*)(A->ws + WS_TOK + (size_t)M * 16); const float* tokw = (const float*)(A->ws + WS_TOK + (size_t)M * 8);
    for (int rb = F.vcu; rb < M / 128; rb += F.G) { const int b = rb / 32; const float* mb = mod + ((size_t)l * NB + b) * 6144; const float* mn = mod + ((size_t)(l < NL - 1 ? l + 1 : l) * NB + b) * 6144;
        float g2[16], sh1[16], sc1[16], lg[16], lb[16];
#pragma unroll
        for (int j = 0; j < 4; ++j)
#pragma unroll
            for (int i = 0; i < 4; ++i) { const int c = 4 * F.lane + 256 * j + i, q = j * 4 + i; g2[q] = 1.0f + mb[5120 + c]; sh1[q] = mn[c]; sc1[q] = 1.0f + mn[1024 + c]; lg[q] = A->in[24][(l * 2 + 1) * DM + c]; lb[q] = A->in[25][(l * 2 + 1) * DM + c]; }
#pragma unroll 1
        for (int i = 0; i < 16; ++i) { const size_t row = (size_t)rb * 128 + F.wave * 16 + i;
            const int r0 = tokrow[row * 2], r1 = tokrow[row * 2 + 1]; const float w0 = tokw[row * 2], w1 = tokw[row * 2 + 1];
            const f32x4* xr = (const f32x4*)(A->out + row * DM) + F.lane; const v2u* y0 = (const v2u*)(Y + (size_t)r0 * DM) + F.lane; const v2u* y1 = (const v2u*)(Y + (size_t)r1 * DM) + F.lane;
            float y[16]; float s = 0.f;
#pragma unroll
            for (int j = 0; j < 4; ++j) { const f32x4 v = xr[64 * j]; const v2u a = y0[64 * j], c = y1[64 * j];
                y[j * 4 + 0] = ALPHA * v[0] + g2[j * 4 + 0] * (w0 * bflo(a.x) + w1 * bflo(c.x)); y[j * 4 + 1] = ALPHA * v[1] + g2[j * 4 + 1] * (w0 * bfhi(a.x) + w1 * bfhi(c.x));
                y[j * 4 + 2] = ALPHA * v[2] + g2[j * 4 + 2] * (w0 * bflo(a.y) + w1 * bflo(c.y)); y[j * 4 + 3] = ALPHA * v[3] + g2[j * 4 + 3] * (w0 * bfhi(a.y) + w1 * bfhi(c.y));
                s += (y[j * 4] + y[j * 4 + 1]) + (y[j * 4 + 2] + y[j * 4 + 3]); }
            const float mean = wave_sum(s) * (1.0f / DM); float q = 0.f;
#pragma unroll
            for (int k = 0; k < 16; ++k) { y[k] -= mean; q += y[k] * y[k]; }
            const float rstd = rsqrtf(wave_sum(q) * (1.0f / DM) + LN_EPS);
            f32x4* xo = (f32x4*)(A->out + row * DM) + F.lane; v2u* ur = (v2u*)(U + row * UP_) + F.lane;
#pragma unroll
            for (int j = 0; j < 4; ++j) { f32x4 o; float u[4];
#pragma unroll
                for (int k = 0; k < 4; ++k) { o[k] = y[j * 4 + k] * rstd * lg[j * 4 + k] + lb[j * 4 + k]; u[k] = o[k] * sc1[j * 4 + k] + sh1[j * 4 + k]; }
                xo[64 * j] = o; if (l < NL - 1) { v2u w; w.x = pk2(u[0], u[1]); w.y = pk2(u[2], u[3]); ur[64 * j] = w; } }
        }
    }
}
struct SchedProj {
    static constexpr unsigned LDA = UP_ * 2, LDB = 2048; static constexpr int NT = 16; static constexpr bool VARNT = false;
    const char* U; const char* W; int G, c;
    __device__ __forceinline__ bool next(int i, pg8::GUnit& u, pg8::GOps& o) const { int pm, pn; if (!pg8::static_tile(M / 256, INW / 256, G, c, i, pm, pn)) return false;
        o.A = U + (size_t)pm * 256 * LDA; o.B = W + (size_t)pn * 256 * 2048; u.kind = 0; u.r0 = pm * 256; u.c0 = pn * 256; u.aux = (pn == 8 || pn == 9) ? 1 : 0; return true; }
};
struct SchedBranch {
    static constexpr unsigned LDA = 3072, LDB = 3072; static constexpr int NT = 16; static constexpr bool VARNT = true;
    const char* U; const char* WM; const char* OC; const char* WB; int G, c;
    __device__ __forceinline__ bool next(int i, pg8::GUnit& u, pg8::GOps& o) const { int pm, pn; if (!pg8::static_tile(M / 256, 4, G, c, i >> 2, pm, pn)) return false; const int sub = i & 3;
        u.r0 = pm * 256; u.c0 = pn * 256;
        if (sub < 3) { o.A = U + (size_t)pm * 256 * 3072; o.B = WM + ((size_t)sub * 1024 + pn * 256) * 3072; o.nt = 16; u.kind = 1; u.aux = sub; }
        else { o.A = OC + (size_t)pm * 256 * 3072; o.B = WB + (size_t)pn * 256 * 3072; o.nt = 24; u.kind = 2; u.aux = 0; }
        return true; }
};
struct SchedOut {
    static constexpr unsigned LDA = 2048, LDB = 2048; static constexpr int NT = 16; static constexpr bool VARNT = false;
    const char* Am; const char* W; int G, c;
    __device__ __forceinline__ bool next(int i, pg8::GUnit& u, pg8::GOps& o) const { int pm, pn; if (!pg8::static_tile(M / 256, 4, G, c, i, pm, pn)) return false;
        o.A = Am + (size_t)pm * 256 * 2048; o.B = W + (size_t)pn * 256 * 2048; u.kind = 0; u.r0 = pm * 256; u.c0 = pn * 256; u.aux = 0; return true; }
};
template <int UP> struct SchedMoe {
    static constexpr unsigned LDA = UP ? 2048 : 1024, LDB = LDA; static constexpr int NT = UP ? 16 : 8; static constexpr bool VARNT = false;
    const char* Am; const char* W; volatile LAS int* hb;
    __device__ __forceinline__ bool next(int i, pg8::GUnit& u, pg8::GOps& o) const { const int n = __builtin_amdgcn_readfirstlane(hb[18]); if (i >= n) return false;
        const int pk = __builtin_amdgcn_readfirstlane(hb[19 + i]); const int j = pk >> 8, pn = (pk >> 4) & 15, e = pk & 15;
        u.r0 = j * 256; u.aux = 0; u.kind = UP ? 3 : 0; u.c0 = UP ? pn * 128 : pn * 256;
        o.A = Am + (size_t)j * 256 * LDA; o.B = W + ((size_t)e * 1024 + pn * 256) * LDB;
        return true; }
};

constexpr int NPH = 2 + 9 * NL;
#ifndef PH_MASK
#define PH_MASK 0xffff
#endif
#define PHM(b) ((PH_MASK >> (b)) & 1)
#ifndef RPT_MASK
#define RPT_MASK 0
#endif
#define RPT(b) (1 + ((RPT_MASK >> (b)) & 1))
__global__ void __launch_bounds__(NTHR, 2) hybrid_fwd(Args args) {
    extern __shared__ __attribute__((aligned(16))) unsigned char lds[];
    Frame F; unsigned char* ws; ArgP A;
#define FRESH() do { int t_ = threadIdx.x; asm volatile("" : "+v"(t_)); { unsigned long long p_ = (unsigned long long)__builtin_amdgcn_kernarg_segment_ptr(); asm volatile("" : "+s"(p_)); A = (ArgP)p_; } ws = A->ws; \
        F.lds = (LAS unsigned char*)lds; F.MISC = (volatile LAS unsigned*)(F.lds + MISC_OFF); F.tid = t_; F.lane = t_ & 63; F.wave = __builtin_amdgcn_readfirstlane(t_ >> 6); \
        { int g_ = gridDim.x, b_ = blockIdx.x; asm volatile("" : "+s"(g_), "+s"(b_)); F.G = g_; F.bx = b_; F.vcu = (g_ % 8 == 0) ? (b_ % 8) * (g_ / 8) + b_ / 8 : b_; } F.ctl = (gu32*)(ws + WS_CTL); } while (0)
    FRESH();
    for (int u = F.tid; u < (LDS_BYTES - LDSCTL_OFF) / 4; u += NTHR) ((LAS unsigned*)(F.lds + LDSCTL_OFF))[u] = 0u;
    __syncthreads();
    XcdBarrier bar; bar.bar = (unsigned*)(ws + WS_CTL) + CW_BAR; bar.x = 0; bar.st = nullptr;
    if (!MK_PER_PHASE) bar = xcd_barrier_post((unsigned*)(ws + WS_CTL) + CW_BAR, F.MISC + 8);
    const int lo = A->ph_lo, hi = A->ph_hi;
#define IN(k) (lo <= (k) && (k) < hi)
#define SEAM(k) do { if (IN(k) && IN((k) + 1)) xcd_barrier(bar); } while (0)

    if (PHM(0) && IN(0)) { FRESH(); phase_prologue(F, A); SEAM(0); }
    if (PHM(1) && IN(1)) { FRESH(); phase_mod_u0(F, A); SEAM(1); }

#pragma unroll 1
    for (int l = 0; l < NL; ++l) {
        const int pb = 2 + 9 * l;
        if (PHM(2) && IN(pb + 0)) {
            FRESH(); const char* WA = (const char*)(ws + WS_WA); const char* WE = (const char*)(ws + WS_WE); (void)WA; (void)WE;
            SchedProj S{(const char*)(ws + WS_U), WA + WA_IN, F.G, F.bx};
            pg8::Epi<1> E{(bf16*)(ws + WS_PROJ), INW, C2Q, nullptr, nullptr};
            for (int rep = 0; rep < RPT(2); ++rep) pg8::gemm_phase<false>(F.lds, S, E);
            SEAM(pb + 0);
        }
        if (IN(pb + 1)) {
            FRESH();
            const float* sm = (const float*)(ws + WS_SMALL);
            MixP P;
            P.proj = (const bf16*)(ws + WS_PROJ); P.ocat = (bf16*)(ws + WS_OCAT); P.oatt = (bf16*)(ws + WS_OATT);
            P.hg_lb = sm + SM_HGLB + l * 512; P.hg_norm_g = A->in[6] + l * 128; P.lam = sm[SM_LAM + l]; P.one_m_lam_init = sm[SM_LAM + 4 + l]; P.da_subln_g = A->in[8] + l * 128;
            P.rw_mu = A->in[9] + l * 1792; P.rw_w0 = A->in[10] + l * 512; P.rw_a0 = A->in[12] + l * 512; P.rw_k_k = A->in[15] + l * 512; P.rw_k_a = A->in[16] + l * 512;
            P.rw_r_k = A->in[17] + l * 512; P.rw_gn_g = A->in[18] + l * 512; P.rw_gn_b = A->in[19] + l * 512;
            const bf16* lo_ = (const bf16*)(ws + WS_LORA) + (size_t)l * 131072; P.wupT = lo_; P.aupT = lo_ + 32768; P.gupT = lo_ + 65536;
            P.aq = F.ctl + CW_AQ + 64 * l;
            if (F.G >= 128) {
                if (PHM(3) && F.vcu < 64) { for (int rep = 0; rep < RPT(3); ++rep) rwkv_unit(P, F.vcu >> 3, F.vcu & 7, F.lds); }
                else if (PHM(4) && F.vcu < 96) { for (int rep = 0; rep < RPT(4); ++rep) hgrn_unit(P, (F.vcu - 64) >> 2, (F.vcu - 64) & 3, F.lds); }
                else if (PHM(5)) { for (int rep = 0; rep < RPT(5); ++rep) { P.aq = F.ctl + CW_AQ + 64 * l + 32 * rep; attn_worker(P, (char*)lds, F.MISC + 16, F.tid); } }
            }
            SEAM(pb + 1);
        }
        if (PHM(6) && IN(pb + 2)) {
            FRESH(); const char* WA = (const char*)(ws + WS_WA); const char* WE = (const char*)(ws + WS_WE); (void)WA; (void)WE;
            SchedBranch S{(const char*)(ws + WS_U), WA + WA_MERGE, (const char*)(ws + WS_OCAT), WA + WA_BRANCH, F.G, F.bx};
            pg8::Epi<6> E{(bf16*)(ws + WS_MERGED), DM, 1.0f, A->in[21] + (size_t)l * 3 * DM, (v4u*)(ws + WS_GSCR) + (size_t)F.bx * 3 * 16 * 512};
            for (int rep = 0; rep < RPT(6); ++rep) pg8::gemm_phase<false>(F.lds, S, E);
            SEAM(pb + 2);
        }
        if (PHM(7) && IN(pb + 3)) {
            FRESH(); const char* WA = (const char*)(ws + WS_WA); const char* WE = (const char*)(ws + WS_WE); (void)WA; (void)WE;
            SchedOut S{(const char*)(ws + WS_MERGED), WA + WA_OUT, F.G, F.bx};
            pg8::Epi<1> E{(bf16*)(ws + WS_MIX), DM, 1.0f, nullptr, nullptr};
            for (int rep = 0; rep < RPT(7); ++rep) pg8::gemm_phase<false>(F.lds, S, E);
            SEAM(pb + 3);
        }
        if (PHM(8) && IN(pb + 4)) { FRESH(); phase_ln1(F, A, l); SEAM(pb + 4); }
        if (PHM(9) && IN(pb + 5)) { FRESH(); for (int rep = 0; rep < RPT(9); ++rep) phase_scatter(F, A, l); SEAM(pb + 5); }
        if (PHM(10) && IN(pb + 6)) {
            FRESH(); const char* WA = (const char*)(ws + WS_WA); const char* WE = (const char*)(ws + WS_WE); (void)WA; (void)WE;
            volatile LAS int* hb = (volatile LAS int*)(F.lds + LDSCTL_OFF + 128);
            load_hb(F, l, hb, F.bx);
            SchedMoe<1> S{(const char*)(ws + WS_AS), WE + WE_GU, hb};
            pg8::Epi<8> E{(bf16*)(ws + WS_H), DE, 1.0f, nullptr, nullptr};
            for (int rep = 0; rep < RPT(10); ++rep) pg8::gemm_phase<false>(F.lds, S, E);
            SEAM(pb + 6);
        }
        if (PHM(11) && IN(pb + 7)) {
            FRESH(); const char* WA = (const char*)(ws + WS_WA); const char* WE = (const char*)(ws + WS_WE); (void)WA; (void)WE;
            volatile LAS int* hb = (volatile LAS int*)(F.lds + LDSCTL_OFF + 128);
            load_hb(F, l, hb, F.bx);
            SchedMoe<0> S{(const char*)(ws + WS_H), WE + WE_DT, hb};
            pg8::Epi<1> E{(bf16*)(ws + WS_Y), DM, 1.0f, nullptr, nullptr};
            for (int rep = 0; rep < RPT(11); ++rep) pg8::gemm_phase<false>(F.lds, S, E);
            SEAM(pb + 7);
        }
        if (PHM(12) && IN(pb + 8)) { FRESH(); if (l < NL - 1) conv_layer(F, A, l + 1); phase_ln2(F, A, l); SEAM(pb + 8); }
    }
#undef IN
#undef SEAM
}

extern "C" void kernel_launch(void* const* d_in, const int* in_sizes, int n_in, void* d_out, int out_size, void* d_ws, size_t ws_size, hipStream_t stream) {
    static int grid = 0;
    if (grid == 0) {
        if (n_in != 31 || out_size != M * DM || ws_size < WS_END) { fprintf(stderr, "kernel_launch: unexpected shapes (n_in %d, out %d, ws %zu < %zu); nothing launched\n", n_in, out_size, ws_size, (size_t)WS_END); grid = -1; return; }
        int dev = 0, cus = 0, per_cu = 0;
        if (hipGetDevice(&dev) != hipSuccess || hipDeviceGetAttribute(&cus, hipDeviceAttributeMultiprocessorCount, dev) != hipSuccess) { grid = -1; return; }
        if (hipFuncSetAttribute((const void*)hybrid_fwd, hipFuncAttributeMaxDynamicSharedMemorySize, LDS_BYTES) != hipSuccess) { fprintf(stderr, "kernel_launch: hipFuncSetAttribute failed\n"); grid = -1; return; }
        if (hipOccupancyMaxActiveBlocksPerMultiprocessor(&per_cu, (const void*)hybrid_fwd, NTHR, LDS_BYTES) != hipSuccess || per_cu < 1) { fprintf(stderr, "kernel_launch: occupancy query reports %d\n", per_cu); }
        (void)hipGetLastError();
        grid = cus;
        if (grid > 256) grid = 256;
    }
    if (grid < 0) return;
    (void)hipMemsetAsync((char*)d_ws + WS_CTL, 0, CTL_ZERO_BYTES, stream);
    Args a{};
    for (int i = 0; i < 31; ++i) a.in[i] = (const float*)d_in[i];
    a.out = (float*)d_out; a.ws = (unsigned char*)d_ws;
#if MK_PER_PHASE
    for (int p = 0; p < NPH; ++p) { a.ph_lo = p; a.ph_hi = p + 1; hipLaunchKernelGGL(hybrid_fwd, dim3(grid), dim3(NTHR), LDS_BYTES, stream, a); }
#else
    a.ph_lo = 0; a.ph_hi = NPH; hipLaunchKernelGGL(hybrid_fwd, dim3(grid), dim3(NTHR), LDS_BYTES, stream, a);
#endif
}
```

```cpp
#include <hip/hip_runtime.h>
#include <hip/hip_bf16.h>
#include <cstdio>
#include <cstdint>

#ifndef MK_PER_PHASE
#define MK_PER_PHASE 0
#endif

#define GAS __attribute__((address_space(1)))
#define LAS __attribute__((address_space(3)))
typedef unsigned short bf16;
typedef unsigned v4u __attribute__((ext_vector_type(4)));
typedef unsigned v2u __attribute__((ext_vector_type(2)));
typedef float f32x4 __attribute__((ext_vector_type(4)));
typedef float f32x2 __attribute__((ext_vector_type(2)));
typedef float f32x16 __attribute__((ext_vector_type(16)));
typedef short bf16x8 __attribute__((ext_vector_type(8)));
typedef short s16x4 __attribute__((ext_vector_type(4)));
typedef GAS unsigned gu32;
#define RLX_AGENT __ATOMIC_RELAXED, __HIP_MEMORY_SCOPE_AGENT
#define LDS_WAIT() asm volatile("s_waitcnt lgkmcnt(0)" ::: "memory")
#define VM_WAIT() asm volatile("s_waitcnt vmcnt(0)" ::: "memory")

constexpr int DM = 1024, NB = 8, T = 4096, NL = 4, M = NB * T;
constexpr int INW = 5376;
constexpr int C_HGQ = 0, C_HGF = 512, C_HGI = 1024, C_HGO = 1536, C_DAQ = 2048, C_DAK = 2560, C_DAV = 3072, C_RW = 3584;
constexpr int C_RWR = C_RW, C_RWK = C_RW + 512, C_RWV = C_RW + 1024, C_RWWD = C_RW + 1536, C_RWAD = C_RW + 1600, C_RWGD = C_RW + 1664;
constexpr int NE = 16, DE = 512;
constexpr float ALPHA = 1.681792830507429f;
constexpr float LN_EPS = 1e-5f, RMS_EPS = 1e-6f, RW_GN_EPS = 64e-5f, HG_F_MIN = 1e-6f;
constexpr float LOG2E = 1.4426950408889634f;
constexpr float C2Q = 0.125f * LOG2E;

constexpr size_t MiB = 1u << 20;
constexpr size_t WS_CTL = 0, CTL_ZERO_BYTES = 1 * MiB;
constexpr size_t WS_MODP = 1 * MiB;
constexpr size_t WS_MOD = 7 * MiB;
constexpr size_t WS_SMALL = 8 * MiB;
constexpr size_t WS_TOK = 9 * MiB;
constexpr size_t WS_LORA = 11 * MiB;
constexpr int UP_ = 1536;
constexpr size_t WS_WA = 12 * MiB;
constexpr size_t WA_IN = 0, WA_MERGE = (size_t)INW * DM * 2, WA_BRANCH = WA_MERGE + (size_t)3 * DM * UP_ * 2, WA_OUT = WA_BRANCH + (size_t)DM * 1536 * 2, WA_END = WA_OUT + (size_t)DM * DM * 2;
constexpr size_t WS_WE = 40 * MiB;
constexpr size_t WE_GU = 0, WE_DT = (size_t)32 * MiB;
constexpr size_t WS_U = 88 * MiB;
constexpr size_t WS_PROJ = 184 * MiB;
constexpr size_t WS_OCAT = 520 * MiB;
constexpr size_t WS_OATT = 616 * MiB;
constexpr size_t WS_END = 680 * MiB;
constexpr size_t WS_GSCR = WS_PROJ;
constexpr size_t WS_MERGED = WS_PROJ + 96 * MiB;
constexpr size_t WS_MIX = WS_PROJ + 160 * MiB;
constexpr size_t WS_AS = WS_PROJ;
constexpr size_t WS_H = WS_PROJ + 224 * MiB;
constexpr size_t WS_Y = WS_OCAT;
constexpr int MAXROWS = 2 * M + NE * 256;
static_assert(WA_END <= 28 * MiB, "WA");
static_assert((size_t)MAXROWS * 2048 <= 160 * MiB && (size_t)MAXROWS * 1024 <= 112 * MiB, "moe buffers");

constexpr int CW_TMO = 0, CW_CODE = 1;
constexpr int CW_BAR = 4096;
constexpr int CW_ECNT = 16384;
constexpr int CW_AQ = 20480;

constexpr int RING_BYTES = 131072;
constexpr int LDSCTL_OFF = RING_BYTES, MISC_OFF = LDSCTL_OFF + 320;
constexpr int LDS_BYTES = 147456;
constexpr int NWAVES = 8, NTHR = 512;

__device__ __forceinline__ unsigned f2bf(float f) { unsigned u = __builtin_bit_cast(unsigned, f); return (u + 0x7fffu + ((u >> 16) & 1u)) >> 16; }
__device__ __forceinline__ unsigned pk2(float lo, float hi) { return f2bf(lo) | (f2bf(hi) << 16); }
__device__ __forceinline__ float bf2f(unsigned short b) { return __builtin_bit_cast(float, ((unsigned)b) << 16); }
__device__ __forceinline__ float bflo(unsigned w) { return __builtin_bit_cast(float, w << 16); }
__device__ __forceinline__ float bfhi(unsigned w) { return __builtin_bit_cast(float, w & 0xffff0000u); }
__device__ __forceinline__ unsigned cvt_pk_bf16(float lo, float hi) { unsigned r; asm volatile("v_cvt_pk_bf16_f32 %0, %1, %2" : "=v"(r) : "v"(lo), "v"(hi)); return r; }
__device__ __forceinline__ float sigmoidf_(float x) { return 1.0f / (1.0f + __expf(-x)); }
__device__ __forceinline__ float wave_sum(float v) {
#pragma unroll
    for (int o = 1; o < 64; o <<= 1) v += __shfl_xor(v, o);
    return v;
}

#define XB_TMO      128
#define XB_XCNT(j)  (256  + 64 * (j))
#define XB_XSUB(j)  (1280 + 64 * (j))
#define XB_XGEN(j)  (2304 + 64 * (j))
#define XB_TOP      3328
#define XB_TOPGEN   3392
#define XCD_BAR_WORDS 3456
#define XB_SPIN_CAP (1u << 20)

__device__ __forceinline__ unsigned xb_ld(unsigned* p)              { return __hip_atomic_load(p, __ATOMIC_RELAXED, __HIP_MEMORY_SCOPE_AGENT); }
__device__ __forceinline__ unsigned xb_add(unsigned* p, unsigned v) { return __hip_atomic_fetch_add(p, v, __ATOMIC_RELAXED, __HIP_MEMORY_SCOPE_AGENT); }
__device__ __forceinline__ unsigned xb_xcc_id() { return (unsigned)__builtin_amdgcn_s_getreg((3 << 11) | 20) & 0xFu; }
#define XB_SPIN(cond, bar) do { unsigned _sp = 0; while (cond) { __builtin_amdgcn_s_sleep(1); \
    if ((++_sp & 255u) == 0u) { if (xb_ld(&(bar)[XB_TMO])) break; if (_sp > XB_SPIN_CAP) { atomicAdd(&(bar)[XB_TMO], 1u); break; } } } } while (0)

struct XcdBarrier { unsigned* bar; unsigned x; volatile LAS unsigned* st; };

__device__ __forceinline__ XcdBarrier xcd_barrier_post(unsigned* bar, volatile LAS unsigned* st) {
    XcdBarrier b; b.bar = bar; b.x = xb_xcc_id(); b.st = st;
    if (threadIdx.x == 0) (void)xb_add(&bar[XB_XCNT(b.x)], 1u);
    return b;
}
__device__ __forceinline__ void xcd_barrier_complete(unsigned* bar, unsigned x, unsigned& nloc, unsigned& nx) {
    const unsigned G = gridDim.x * gridDim.y * gridDim.z;
    unsigned sum, cnt, mine, sp = 0u;
    for (;;) {
        sum = 0u; cnt = 0u; mine = 0u;
#pragma unroll 1
        for (unsigned j = 0; j < 16; ++j) { const unsigned c = xb_ld(&bar[XB_XCNT(j)]); sum += c; cnt += (c > 0u) ? 1u : 0u; mine = (j == x) ? c : mine; }
        if (sum == G) break;
        __builtin_amdgcn_s_sleep(1);
        if ((++sp & 255u) == 0u) { if (xb_ld(&bar[XB_TMO])) break; if (sp > XB_SPIN_CAP) { atomicAdd(&bar[XB_TMO], 1u); break; } }
    }
    nloc = mine > 0u ? mine : 1u; nx = cnt > 0u ? cnt : 1u;
}
__device__ __forceinline__ void xcd_barrier(const XcdBarrier& b) {
    asm volatile("s_waitcnt vmcnt(0)" ::: "memory");
    __syncthreads();
    if (threadIdx.x == 0) {
        unsigned* bar = b.bar;
        __builtin_amdgcn_s_waitcnt(0);
        unsigned nloc = b.st[0], nx = b.st[1];
        if (nloc == 0u) { xcd_barrier_complete(bar, b.x, nloc, nx); b.st[0] = nloc; b.st[1] = nx; }
        const unsigned old = xb_add(&bar[XB_XSUB(b.x)], 1u);
        const unsigned gen = old / nloc;
        if (old + 1u == (gen + 1u) * nloc) {
            __builtin_amdgcn_fence(__ATOMIC_RELEASE, "agent");
            asm volatile("s_waitcnt vmcnt(0)" ::: "memory");
            const unsigned og = xb_add(&bar[XB_TOP], 1u);
            const unsigned tg = og / nx;
            if (og + 1u == (tg + 1u) * nx) xb_add(&bar[XB_TOPGEN], 1u);
            else XB_SPIN(xb_ld(&bar[XB_TOPGEN]) == tg, bar);
            __builtin_amdgcn_fence(__ATOMIC_ACQUIRE, "agent");
            xb_add(&bar[XB_XGEN(b.x)], 1u);
            asm volatile("s_waitcnt vmcnt(0)" ::: "memory");
        } else {
            XB_SPIN(xb_ld(&bar[XB_XGEN(b.x)]) == gen, bar);
            __builtin_amdgcn_fence(__ATOMIC_ACQUIRE, "agent");
            asm volatile("s_waitcnt vmcnt(0)" ::: "memory");
        }
    }
    __syncthreads();
}
namespace pg8 {
#define PG8_LAS __attribute__((address_space(3)))
constexpr int BM = 256, BK = 64, HALF = 128, HTB = HALF * BK * 2, STAGE_BYTES = 8 * HTB, NXCD = 8, WGM = 8;
__host__ __device__ __forceinline__ int lds_byte(int r, int c) { const int st = (r >> 4) * 2 + (c >> 5), rr = r & 15, cc = c & 31, ob = rr * 64 + cc * 2; return st * 1024 + (ob ^ (((ob >> 9) & 1) << 5)); }
__host__ __device__ __forceinline__ void stage_rc(int b, int& R, int& C) { const int st = b / 1024, sb = b % 1024, swz = sb ^ (((sb >> 9) & 1) << 5); R = (st >> 1) * 16 + swz / 64; C = (st & 1) * 32 + (swz % 64) / 2; }
__host__ __device__ __forceinline__ int perm32(int rho) { const int n = rho >> 4, i = rho & 15; return 8 * (i >> 2) + 4 * n + (i & 3); }

struct GUnit {
    int kind;
    int r0, c0;
    int aux;
};
struct GOps {
    const char* A; const char* B; unsigned lda, ldb; int nt;
};
__device__ __forceinline__ bool static_tile(int nM, int nN, int G, int c, int i, int& pm, int& pn) {
    const int nwg = nM * nN; const long L = (long)i * G + c; if (L >= nwg) return false;
    int wgid = (int)L; { const int q = nwg / NXCD, r = nwg % NXCD, xcd = wgid % NXCD, off = wgid / NXCD; wgid = (xcd < r ? xcd * (q + 1) : r * (q + 1) + (xcd - r) * q) + off; }
    const int nig = WGM * nN, gid = wgid / nig, fm = gid * WGM, gsz = (nM - fm) < WGM ? (nM - fm) : WGM;
    pm = fm + ((wgid % nig) % gsz); pn = (wgid % nig) / gsz; return true;
}

template <bool VARLD, class Sched, class Epi>
__device__ __forceinline__ void gemm_phase(PG8_LAS unsigned char* lds, const Sched& S, const Epi& E) {
    int tid_ = threadIdx.x; asm volatile("" : "+v"(tid_));
    const int tid = tid_, wid = __builtin_amdgcn_readfirstlane(tid >> 6), lane = tid & 63, wr = wid >> 2, wc = wid & 3, fr = lane & 15, fq = lane >> 4;
    int R0, C0, R1, C1; stage_rc(tid * 16, R0, C0); stage_rc(tid * 16 + 8192, R1, C1);
    const int Rb0 = (R0 & ~31) + perm32(R0 & 31), Rb1 = (R1 & ~31) + perm32(R1 & 31);
    const unsigned ldsw = (unsigned)wid * 1024u;
    const int aoff = lds_byte(wr * 64 + fr, fq * 8), boff = lds_byte(wc * 32 + fr, fq * 8);
#define PG8_SA(b, h) (((b) * 2 + (h)) * HTB)
#define PG8_SB(b, h) ((4 + (b) * 2 + (h)) * HTB)
#define PG8_STAGE(bufoff, gbase, v0, v1) do { \
        __builtin_amdgcn_global_load_lds((const unsigned*)((const char*)(gbase) + (v0)), (PG8_LAS unsigned*)(lds + (bufoff) + ldsw), 16, 0, 0); \
        __builtin_amdgcn_global_load_lds((const unsigned*)((const char*)(gbase) + (v1)), (PG8_LAS unsigned*)(lds + (bufoff) + ldsw + 8192), 16, 0, 0); } while (0)
#define PG8_LDA(dst, b, h) do { _Pragma("unroll") for (int m = 0; m < 4; ++m) _Pragma("unroll") for (int k = 0; k < 2; ++k) dst[m][k] = *(const PG8_LAS bf16x8*)(lds + PG8_SA(b, h) + aoff + m * 2048 + k * 1024); } while (0)
#define PG8_LDB(dst, b, h) do { _Pragma("unroll") for (int n = 0; n < 2; ++n) _Pragma("unroll") for (int k = 0; k < 2; ++k) dst[n][k] = *(const PG8_LAS bf16x8*)(lds + PG8_SB(b, h) + boff + n * 2048 + k * 1024); } while (0)
#define PG8_MMA(ai, bj, At, Bt) do { __builtin_amdgcn_s_setprio(1); _Pragma("unroll") for (int m = 0; m < 4; ++m) _Pragma("unroll") for (int n = 0; n < 2; ++n) _Pragma("unroll") for (int k = 0; k < 2; ++k) \
        acc[ai][bj][m][n] = __builtin_amdgcn_mfma_f32_16x16x32_bf16(Bt[n][k], At[m][k], acc[ai][bj][m][n], 0, 0, 0); __builtin_amdgcn_s_setprio(0); } while (0)
#define PG8_WAIT_V(n) asm volatile("s_waitcnt vmcnt(" #n ")" ::: "memory")
#define PG8_WAIT_L(n) asm volatile("s_waitcnt lgkmcnt(" #n ")" ::: "memory")
#define PG8_BAR __builtin_amdgcn_s_barrier()
#define PG8_SCHED __builtin_amdgcn_sched_barrier(0)
    GUnit cur, nxt; GOps co, no_; int ui = 0;
    if (!S.next(0, cur, co)) return;
    f32x4 acc[2][2][4][2];
#pragma unroll
    for (int a = 0; a < 2; ++a)
#pragma unroll
        for (int b = 0; b < 2; ++b)
#pragma unroll
            for (int m = 0; m < 4; ++m)
#pragma unroll
                for (int n = 0; n < 2; ++n) acc[a][b][m][n] = (f32x4){0.f, 0.f, 0.f, 0.f};
    bf16x8 At[4][2], B0[2][2], B1[2][2];
    const char* cA = co.A; const char* cB = co.B;
    unsigned ldA = VARLD ? co.lda : Sched::LDA, ldB = VARLD ? co.ldb : Sched::LDB; int nt = (VARLD || Sched::VARNT) ? co.nt : Sched::NT;
    unsigned vA0 = (unsigned)R0 * ldA + (unsigned)C0 * 2u, vA1 = (unsigned)R1 * ldA + (unsigned)C1 * 2u;
    unsigned vB0 = (unsigned)Rb0 * ldB + (unsigned)C0 * 2u, vB1 = (unsigned)Rb1 * ldB + (unsigned)C1 * 2u;
    unsigned hA = (unsigned)HALF * ldA, hB = (unsigned)HALF * ldB;
    PG8_STAGE(PG8_SB(0, 0), cB, vB0, vB1); PG8_STAGE(PG8_SB(0, 1), cB + hB, vB0, vB1); PG8_STAGE(PG8_SA(0, 0), cA, vA0, vA1); PG8_STAGE(PG8_SA(0, 1), cA + hA, vA0, vA1);
    if (wr == 1) PG8_BAR;
    PG8_WAIT_V(2); PG8_BAR;
    PG8_STAGE(PG8_SB(1, 0), cB + 128, vB0, vB1); PG8_STAGE(PG8_SA(1, 0), cA + 128, vA0, vA1); PG8_STAGE(PG8_SB(1, 1), cB + hB + 128, vB0, vB1);
    PG8_WAIT_V(6); PG8_BAR;
    for (;;) {
        const bool has_next = S.next(ui + 1, nxt, no_);
        const char* nA = has_next ? no_.A : cA; const char* nB = has_next ? no_.B : cB;
        const unsigned nlda = (VARLD && has_next) ? no_.lda : ldA, nldb = (VARLD && has_next) ? no_.ldb : ldB;
        const int nnt = ((VARLD || Sched::VARNT) && has_next) ? no_.nt : nt;
        for (int t = 0; t < nt; t += 2) {
            const bool last = (t == nt - 2);
            if (Epi::HAS_MID) { PG8_SCHED; E.mid(acc, cur, t, wr, wc, fr, fq); PG8_SCHED; }
            const char* a1 = cA + (size_t)(t + 1) * 128;
            const char* a2 = last ? nA : cA + (size_t)(t + 2) * 128; const char* b2 = last ? nB : cB + (size_t)(t + 2) * 128;
            const char* a3 = a2 + 128; const char* b3 = b2 + 128;
            unsigned xA0 = vA0, xA1 = vA1, xB0 = vB0, xB1 = vB1, xhA = hA, xhB = hB;
            if (VARLD && last) { xA0 = (unsigned)R0 * nlda + (unsigned)C0 * 2u; xA1 = (unsigned)R1 * nlda + (unsigned)C1 * 2u; xB0 = (unsigned)Rb0 * nldb + (unsigned)C0 * 2u; xB1 = (unsigned)Rb1 * nldb + (unsigned)C1 * 2u; xhA = (unsigned)HALF * nlda; xhB = (unsigned)HALF * nldb; }
            PG8_LDB(B0, 0, 0); PG8_LDB(B1, 0, 1); PG8_SCHED; PG8_LDA(At, 0, 0); PG8_STAGE(PG8_SA(1, 1), a1 + hA, vA0, vA1);
            PG8_WAIT_V(8); PG8_WAIT_L(0); PG8_BAR; PG8_MMA(0, 0, At, B0); PG8_MMA(0, 1, At, B1); PG8_BAR; PG8_SCHED;
            PG8_LDA(At, 0, 1); PG8_STAGE(PG8_SB(0, 0), b2, xB0, xB1); PG8_STAGE(PG8_SB(0, 1), b2 + xhB, xB0, xB1); PG8_STAGE(PG8_SA(0, 0), a2, xA0, xA1);
            PG8_WAIT_V(8); PG8_WAIT_L(0); PG8_BAR; PG8_MMA(1, 0, At, B0); PG8_MMA(1, 1, At, B1); PG8_BAR; PG8_SCHED;
            PG8_LDB(B0, 1, 0); PG8_LDB(B1, 1, 1); PG8_SCHED; PG8_LDA(At, 1, 0); PG8_STAGE(PG8_SA(0, 1), a2 + xhA, xA0, xA1);
            PG8_WAIT_V(8); PG8_WAIT_L(0); PG8_BAR; PG8_MMA(0, 0, At, B0); PG8_MMA(0, 1, At, B1); PG8_BAR; PG8_SCHED;
            PG8_LDA(At, 1, 1); PG8_STAGE(PG8_SB(1, 0), b3, xB0, xB1); PG8_STAGE(PG8_SB(1, 1), b3 + xhB, xB0, xB1); PG8_STAGE(PG8_SA(1, 0), a3, xA0, xA1);
            PG8_WAIT_V(8); PG8_WAIT_L(0); PG8_BAR; PG8_MMA(1, 0, At, B0); PG8_MMA(1, 1, At, B1); PG8_BAR; PG8_SCHED;
        }
        if (wr == 0) PG8_BAR;
        PG8_SCHED; E(acc, cur, wr, wc, fr, fq); PG8_SCHED;
        if (!has_next) break;
#pragma unroll
        for (int a = 0; a < 2; ++a)
#pragma unroll
            for (int b = 0; b < 2; ++b)
#pragma unroll
                for (int m = 0; m < 4; ++m)
#pragma unroll
                    for (int n = 0; n < 2; ++n) acc[a][b][m][n] = (f32x4){0.f, 0.f, 0.f, 0.f};
        cur = nxt; cA = nA; cB = nB; ++ui;
        if (VARLD || Sched::VARNT) nt = nnt;
        if (VARLD) { ldA = nlda; ldB = nldb; vA0 = (unsigned)R0 * ldA + (unsigned)C0 * 2u; vA1 = (unsigned)R1 * ldA + (unsigned)C1 * 2u; vB0 = (unsigned)Rb0 * ldB + (unsigned)C0 * 2u; vB1 = (unsigned)Rb1 * ldB + (unsigned)C1 * 2u; hA = (unsigned)HALF * ldA; hB = (unsigned)HALF * ldB; }
        if (wr == 1) PG8_BAR;
    }
    PG8_WAIT_V(0);
    PG8_BAR;
#undef PG8_SA
#undef PG8_SB
#undef PG8_STAGE
#undef PG8_LDA
#undef PG8_LDB
#undef PG8_MMA
#undef PG8_WAIT_V
#undef PG8_WAIT_L
#undef PG8_BAR
#undef PG8_SCHED
}

template <int KM> struct Epi {
    static constexpr bool HAS_MID = (KM & 4) != 0;
    bf16* O; int ldc;
    float scale;
    const float* bias;
    v4u* gscr;
    __device__ __forceinline__ void mid(f32x4 (&acc)[2][2][4][2], const GUnit& u, int t, int wr, int wc, int fr, int fq) const {
        if (!(KM & 4) || u.kind != 2 || (t != 8 && t != 16)) return;
        const int sa = (t == 8) ? 0 : 1;
        const v4u* ga = gscr + ((size_t)sa * 512 + ((wr * 4 + wc) * 64 + fq * 16 + fr)) * 16; asm volatile("" : "+v"(ga)); const v4u* gb = ga + 16 * 512; asm volatile("" : "+v"(gb));
#pragma unroll
        for (int ai = 0; ai < 2; ++ai)
#pragma unroll
            for (int m = 0; m < 4; ++m) {
#pragma unroll
                for (int bj = 0; bj < 2; ++bj) { const int q = (ai * 4 + m) * 2 + bj; const v4u x = ga[q], y = gb[q];
                    f32x4 r0, r1;
                    r0[0] = bflo(x.x) * __builtin_amdgcn_rcpf(bflo(y.x)); r0[1] = bfhi(x.x) * __builtin_amdgcn_rcpf(bfhi(y.x)); r0[2] = bflo(x.y) * __builtin_amdgcn_rcpf(bflo(y.y)); r0[3] = bfhi(x.y) * __builtin_amdgcn_rcpf(bfhi(y.y));
                    r1[0] = bflo(x.z) * __builtin_amdgcn_rcpf(bflo(y.z)); r1[1] = bfhi(x.z) * __builtin_amdgcn_rcpf(bfhi(y.z)); r1[2] = bflo(x.w) * __builtin_amdgcn_rcpf(bflo(y.w)); r1[3] = bfhi(x.w) * __builtin_amdgcn_rcpf(bfhi(y.w));
                    acc[ai][bj][m][0] *= r0; acc[ai][bj][m][1] *= r1; }
                asm volatile("" ::: "memory"); }
    }
    __device__ __forceinline__ void operator()(f32x4 (&acc)[2][2][4][2], const GUnit& u, int wr, int wc, int fr, int fq) const {
        if ((KM & 1) && u.kind == 0) {
            const float sc = u.aux ? scale : 1.0f;
            const int row0 = u.r0 + wr * 64 + fr, col0 = u.c0 + wc * 32 + 8 * fq;
#pragma unroll
            for (int ai = 0; ai < 2; ++ai)
#pragma unroll
                for (int m = 0; m < 4; ++m) { bf16* rowp = O + (size_t)(row0 + ai * HALF + m * 16) * ldc + col0;
#pragma unroll
                    for (int bj = 0; bj < 2; ++bj) { const f32x4 v0 = acc[ai][bj][m][0] * sc, v1 = acc[ai][bj][m][1] * sc;
                        v4u w; w.x = cvt_pk_bf16(v0[0], v0[1]); w.y = cvt_pk_bf16(v0[2], v0[3]); w.z = cvt_pk_bf16(v1[0], v1[1]); w.w = cvt_pk_bf16(v1[2], v1[3]);
                        *(v4u*)(rowp + bj * HALF) = w; } }
        } else if ((KM & 2) && u.kind == 1) {
            const int bcol0 = u.c0 + wc * 32 + 8 * fq; const float* bp = bias + u.aux * 1024 + bcol0;
            v4u* gs = gscr + ((size_t)u.aux * 512 + ((wr * 4 + wc) * 64 + fq * 16 + fr)) * 16; asm volatile("" : "+v"(gs));
#pragma unroll
            for (int bj = 0; bj < 2; ++bj) { const f32x4 b0 = *(const f32x4*)(bp + bj * HALF), b1 = *(const f32x4*)(bp + bj * HALF + 4);
#pragma unroll
                for (int ai = 0; ai < 2; ++ai)
#pragma unroll
                    for (int m = 0; m < 4; ++m) { const f32x4 z0 = acc[ai][bj][m][0] + b0, z1 = acc[ai][bj][m][1] + b1; float g[8];
#pragma unroll
                        for (int j = 0; j < 4; ++j) { g[j] = fmaxf(sigmoidf_(z0[j]), 1e-30f); g[4 + j] = fmaxf(sigmoidf_(z1[j]), 1e-30f); }
                        v4u w; w.x = cvt_pk_bf16(g[0], g[1]); w.y = cvt_pk_bf16(g[2], g[3]); w.z = cvt_pk_bf16(g[4], g[5]); w.w = cvt_pk_bf16(g[6], g[7]);
                        gs[(ai * 4 + m) * 2 + bj] = w; } }
        } else if ((KM & 4) && u.kind == 2) {
            const v4u* gc = gscr + ((size_t)2 * 512 + ((wr * 4 + wc) * 64 + fq * 16 + fr)) * 16; asm volatile("" : "+v"(gc));
            const int row0 = u.r0 + wr * 64 + fr, col0 = u.c0 + wc * 32 + 8 * fq;
#pragma unroll
            for (int ai = 0; ai < 2; ++ai)
#pragma unroll
                for (int m = 0; m < 4; ++m) { bf16* rowp = O + (size_t)(row0 + ai * HALF + m * 16) * ldc + col0;
#pragma unroll
                    for (int bj = 0; bj < 2; ++bj) { const v4u y = gc[(ai * 4 + m) * 2 + bj]; const f32x4 a0 = acc[ai][bj][m][0], a1 = acc[ai][bj][m][1];
                        v4u w; w.x = cvt_pk_bf16(a0[0] * bflo(y.x), a0[1] * bfhi(y.x)); w.y = cvt_pk_bf16(a0[2] * bflo(y.y), a0[3] * bfhi(y.y));
                        w.z = cvt_pk_bf16(a1[0] * bflo(y.z), a1[1] * bfhi(y.z)); w.w = cvt_pk_bf16(a1[2] * bflo(y.w), a1[3] * bfhi(y.w));
                        *(v4u*)(rowp + bj * HALF) = w; }
                    asm volatile("" ::: "memory"); }
        } else if (KM & 8) {
            const int row0 = u.r0 + wr * 64 + fr, col0 = u.c0 + wc * 32 + 8 * fq;
#pragma unroll
            for (int ai = 0; ai < 2; ++ai)
#pragma unroll
                for (int m = 0; m < 4; ++m) { bf16* rowp = O + (size_t)(row0 + ai * HALF + m * 16) * ldc + col0; float hv[8];
#pragma unroll
                    for (int n = 0; n < 2; ++n)
#pragma unroll
                        for (int j = 0; j < 4; ++j) { const float gt = acc[ai][0][m][n][j], up = acc[ai][1][m][n][j]; hv[n * 4 + j] = gt * sigmoidf_(gt) * up; }
                    v4u w; w.x = cvt_pk_bf16(hv[0], hv[1]); w.y = cvt_pk_bf16(hv[2], hv[3]); w.z = cvt_pk_bf16(hv[4], hv[5]); w.w = cvt_pk_bf16(hv[6], hv[7]);
                    *(v4u*)rowp = w; }
        }
    }
};
}
namespace attn_body {
using bf16=__hip_bfloat16;
using bf16x8=__attribute__((ext_vector_type(8)))short;
using s16x4=__attribute__((ext_vector_type(4)))short;
using f32x16=__attribute__((ext_vector_type(16)))float;
using u32x4=__attribute__((ext_vector_type(4)))unsigned;
constexpr int SEQ=4096,D=64,PQ=5376,PO=1024;
constexpr int NW=8,QBLK=32,QB=QBLK*NW,KVBLK=64,NQB=SEQ/QB;
constexpr int ATTN_UNIT_ROWS=QB;
__device__ __forceinline__ int crow(int r,int hi){return (r&3)+8*(r>>2)+4*hi;}
#define SBAR() __builtin_amdgcn_sched_barrier(0)
__device__ __forceinline__ void cmask(f32x16&p0,f32x16&p1,int jb,int qrel,int hi){
  const float NEG=-INFINITY; int kb=64*jb+4*hi;
  #pragma unroll
  for(int r=0;r<16;++r){int kv=kb+(r&3)+8*(r>>2); if(kv>qrel)p0[r]=NEG; if(kv+32>qrel)p1[r]=NEG;}
}

constexpr int NSLOT=3, SLOTB=8192;
constexpr int LDS_K=0, LDS_V=NSLOT*SLOTB, LDS_WS=2*NSLOT*SLOTB, LDS_OST=LDS_WS+NW*64*4, LDS_BYTES=LDS_OST+NW*4096;
constexpr float C2=0.125f*1.4426950408889634f;
__device__ __forceinline__ void glds16(const void*gsrc,unsigned lds_dst){unsigned keep;
  asm volatile("s_mov_b32 %0, m0\n\ts_mov_b32 m0, %2\n\ts_nop 0\n\tglobal_load_lds_dwordx4 %1, off\n\ts_mov_b32 m0, %0":"=&s"(keep):"v"(gsrc),"s"(lds_dst):"memory");}
__device__ __forceinline__ float max3f(float a,float b,float c){float r;asm("v_max3_f32 %0, %1, %2, %3":"=v"(r):"v"(a),"v"(b),"v"(c));return r;}
__device__ __forceinline__ float max2f(float a,float b){float r;asm("v_max_f32_e32 %0, %1, %2":"=v"(r):"v"(a),"v"(b));return r;}
__device__ __forceinline__ float fadd_s(float a,float b){float r;asm("v_add_f32_e32 %0, %1, %2":"=v"(r):"v"(a),"v"(b));return r;}
__device__ __forceinline__ float fsub_s(float a,float b){float r;asm("v_sub_f32_e32 %0, %1, %2":"=v"(r):"v"(a),"v"(b));return r;}
typedef float f32x2_t __attribute__((ext_vector_type(2))); typedef __bf16 bf16x2_t __attribute__((ext_vector_type(2)));
__device__ __forceinline__ unsigned cvtpk_s(float lo,float hi){f32x2_t v={lo,hi};bf16x2_t b=__builtin_convertvector(v,bf16x2_t);return __builtin_bit_cast(unsigned,b);}
#define WAIT_BAR(N) asm volatile("s_waitcnt vmcnt(" #N ") lgkmcnt(0)\n\ts_barrier":::"memory")

__device__ __forceinline__ void qkt(f32x16&p0,f32x16&p1,const char*Kslot,const bf16x8*qr,int r32,int hi){ const f32x16 negm=f32x16{};
  const char*kb=Kslot+hi*1024+r32*16;
  #pragma unroll
  for(int d0=0;d0<4;++d0){
    const bf16x8 b0=*reinterpret_cast<const bf16x8*>(kb+d0*2048);
    const bf16x8 b1=*reinterpret_cast<const bf16x8*>(kb+d0*2048+512);
    if(d0==0){p0=__builtin_amdgcn_mfma_f32_32x32x16_bf16(b0,qr[0],negm,0,0,0);p1=__builtin_amdgcn_mfma_f32_32x32x16_bf16(b1,qr[0],negm,0,0,0);}
    else{p0=__builtin_amdgcn_mfma_f32_32x32x16_bf16(b0,qr[d0],p0,0,0,0);p1=__builtin_amdgcn_mfma_f32_32x32x16_bf16(b1,qr[d0],p1,0,0,0);}}
}
typedef __attribute__((address_space(3))) const char* lds_cptr;
typedef short v4i16_t __attribute__((ext_vector_type(4)));
__device__ __forceinline__ void kload8(bf16x8*kf,lds_cptr kp){
  kf[0]=*(const __attribute__((address_space(3))) bf16x8*)(kp);      kf[1]=*(const __attribute__((address_space(3))) bf16x8*)(kp+512);
  kf[2]=*(const __attribute__((address_space(3))) bf16x8*)(kp+2048); kf[3]=*(const __attribute__((address_space(3))) bf16x8*)(kp+2560);
  kf[4]=*(const __attribute__((address_space(3))) bf16x8*)(kp+4096); kf[5]=*(const __attribute__((address_space(3))) bf16x8*)(kp+4608);
  kf[6]=*(const __attribute__((address_space(3))) bf16x8*)(kp+6144); kf[7]=*(const __attribute__((address_space(3))) bf16x8*)(kp+6656);
}
__device__ __forceinline__ void kload2(bf16x8*kf,lds_cptr kp,int j){ kf[2*j]=*(const __attribute__((address_space(3))) bf16x8*)(kp+j*2048); kf[2*j+1]=*(const __attribute__((address_space(3))) bf16x8*)(kp+j*2048+512); }
__device__ __forceinline__ s16x4 vtr(lds_cptr p){ return __builtin_bit_cast(s16x4,__builtin_amdgcn_ds_read_tr16_b64_v4i16((__attribute__((address_space(3))) v4i16_t*)p)); }
__device__ __forceinline__ float rowmax(const f32x16&p0,const f32x16&p1){
  float a=max3f(p0[0],p0[1],p1[0]),b=max3f(p0[2],p0[3],p1[1]);a=max3f(a,p1[2],p1[3]);
  #pragma unroll
  for(int r=4;r<16;r+=4){a=max3f(a,p0[r],p0[r+1]);b=max3f(b,p0[r+2],p0[r+3]);a=max3f(a,p1[r],p1[r+1]);b=max3f(b,p1[r+2],p1[r+3]);}
  const float m=max2f(a,b);
  auto rr=__builtin_amdgcn_permlane32_swap(__float_as_uint(m),__float_as_uint(m),false,false);
  return max2f(__uint_as_float(rr[0]),__uint_as_float(rr[1]));
}
__device__ __forceinline__ void pv(f32x16*o,int vb,bf16x8 pa0,bf16x8 pa1,bf16x8 pa2,bf16x8 pa3){
  #pragma unroll
  for(int d0=0;d0<2;++d0){s16x4 lo[4],hi[4];
    #pragma unroll
    for(int ks=0;ks<4;++ks){
      asm volatile("ds_read_b64_tr_b16 %0,%1 offset:%c2":"=&v"(lo[ks]):"v"(vb),"i"(d0*4096+ks*1024):"memory");
      asm volatile("ds_read_b64_tr_b16 %0,%1 offset:%c2":"=&v"(hi[ks]):"v"(vb),"i"(d0*4096+ks*1024+512):"memory");}
    asm volatile("s_waitcnt lgkmcnt(0)":::"memory");SBAR();
    #define PK(k) (bf16x8){lo[k][0],lo[k][1],lo[k][2],lo[k][3],hi[k][0],hi[k][1],hi[k][2],hi[k][3]}
    o[d0]=__builtin_amdgcn_mfma_f32_32x32x16_bf16(pa0,PK(0),o[d0],0,0,0);
    o[d0]=__builtin_amdgcn_mfma_f32_32x32x16_bf16(pa1,PK(1),o[d0],0,0,0);
    o[d0]=__builtin_amdgcn_mfma_f32_32x32x16_bf16(pa2,PK(2),o[d0],0,0,0);
    o[d0]=__builtin_amdgcn_mfma_f32_32x32x16_bf16(pa3,PK(3),o[d0],0,0,0);
    #undef PK
  }
}

#ifndef ATTN_STORE16
#define ATTN_STORE16(p,v) (*(u32x4*)(p)=(v))
#endif
template<int THRL> __device__ __forceinline__ void attn_unit(int b,int qcol,int kcol,int vcol,int ocol,float slope2,int qb,const bf16*__restrict__ P,bf16*O,char*shm){
  int tid_=threadIdx.x; asm volatile("":"+v"(tid_));
  const int tid=tid_,lane=tid&63,r32=lane&31,hi=lane>>5; const int wid=__builtin_amdgcn_readfirstlane(tid>>6);
  const long rowbase=(long)b*SEQ; const int q0=qb*QB;
  const bf16*Qw=P+(rowbase+q0+wid*QBLK)*PQ+qcol;
  const bf16*Kh=P+rowbase*PQ+kcol,*Vh=P+rowbase*PQ+vcol;
  const unsigned lds0=(unsigned)(uintptr_t)shm;
  float*wsf=(float*)(shm+LDS_WS)+wid*64;
  const bf16*ksrc=Kh+(long)lane*PQ+wid*8;
  const bf16*vsrc=Vh+(long)(16*(wid&3)+(lane>>2))*PQ+(wid>>2)*32+(lane&3)*8;
  const unsigned kdst=lds0+LDS_K+wid*1024, vdst=lds0+LDS_V+wid*1024;
  #define DMA_K(t,slot) glds16(ksrc+(long)(t)*KVBLK*PQ,(unsigned)__builtin_amdgcn_readfirstlane(kdst+(slot)))
  #define DMA_V(t,slot) glds16(vsrc+(long)(t)*KVBLK*PQ,(unsigned)__builtin_amdgcn_readfirstlane(vdst+(slot)))
  const int vb0=(int)(lds0+LDS_V)+((lane>>4)&1)*32+(lane&3)*8+(4*hi+((lane&15)>>2))*64;
  const char*Kbase=shm+LDS_K; bf16x8 kf[8];
  const lds_cptr shm3=(lds_cptr)shm; const lds_cptr kp0=shm3+LDS_K+hi*1024+r32*16; const lds_cptr vp0=shm3+LDS_V+((lane>>4)&1)*32+(lane&3)*8+(4*hi+((lane&15)>>2))*64;
  const int NT=(q0+QB)/KVBLK;
  DMA_K(0,0);DMA_V(0,0);DMA_K(1,SLOTB);
  bf16x8 qr[4];
  #pragma unroll
  for(int d0=0;d0<4;++d0)qr[d0]=*reinterpret_cast<const bf16x8*>(&Qw[(long)r32*PQ+d0*16+hi*8]);
  float mhat=0.f,l_reg=0.f;f32x16 o[2];o[0]=f32x16{};o[1]=f32x16{};const f32x16 negm=f32x16{};
  const float sr1_=__builtin_bit_cast(float,__builtin_amdgcn_readfirstlane(__builtin_bit_cast(int,slope2))), sr2_=__builtin_bit_cast(float,__builtin_amdgcn_readfirstlane(__builtin_bit_cast(int,2.f*slope2))), sr3_=__builtin_bit_cast(float,__builtin_amdgcn_readfirstlane(__builtin_bit_cast(int,3.f*slope2)));
  const float hib=slope2*(float)(4*hi);
  #define ALIBI(P0,P1,t) do{ const float tm0_=slope2*(float)(64*(t))+hib-mhat; \
    _Pragma("unroll") for(int q_=0;q_<4;++q_){ const float a_=tm0_+(8.f*slope2)*(float)q_, b_=a_+32.f*slope2; \
      P0[4*q_]+=a_; P0[4*q_+1]=(P0[4*q_+1]+a_)+sr1_; P0[4*q_+2]=(P0[4*q_+2]+a_)+sr2_; P0[4*q_+3]=(P0[4*q_+3]+a_)+sr3_; \
      P1[4*q_]+=b_; P1[4*q_+1]=(P1[4*q_+1]+b_)+sr1_; P1[4*q_+2]=(P1[4*q_+2]+b_)+sr2_; P1[4*q_+3]=(P1[4*q_+3]+b_)+sr3_; } }while(0)
  const int qrel=wid*QBLK+r32;
  #define CMASK(P0,P1,t) do{int jb_=(t)-(NT-4); if(jb_>=0)cmask(P0,P1,jb_,qrel,hi);}while(0)
  bool resc=false;
  #define START(P0,P1) do{ const float rm=rowmax(P0,P1); resc=false; \
    { const float dl=rm; mhat=fadd_s(mhat,dl); \
      _Pragma("unroll") for(int r=0;r<16;++r){P0[r]=fsub_s(P0[r],dl);P1[r]=fsub_s(P1[r],dl);} \
      } \
    _Pragma("unroll") for(int r=0;r<16;++r)P0[r]=__builtin_amdgcn_exp2f(P0[r]); }while(0)
  #define RESC() do{ if(resc){ asm volatile("s_waitcnt lgkmcnt(0)":::"memory"); \
      _Pragma("unroll") for(int d_=0;d_<2;++d_) _Pragma("unroll") for(int r=0;r<16;++r)o[d_][r]*=wsf[crow(r,hi)]; } }while(0)
  f32x16 pA0,pA1,pB0,pB1;
  int sl_prev=0,sl_cur=0,sl_next=SLOTB;
  #define ROT() do{sl_prev=sl_cur;sl_cur=sl_next;sl_next=(sl_next==(NSLOT-1)*SLOTB)?0:sl_next+SLOTB;}while(0)
  DMA_K(2,2*SLOTB);
  WAIT_BAR(3);
  qkt(pA0,pA1,Kbase,qr,r32,hi);asm volatile("s_nop 15\n\ts_nop 7":"+v"(pA0),"+v"(pA1));ALIBI(pA0,pA1,0);asm volatile("":"+v"(pA0),"+v"(pA1));CMASK(pA0,pA1,0);
  START(pA0,pA1);
  _Pragma("unroll") for(int r=0;r<16;++r)pA1[r]=__builtin_amdgcn_exp2f(pA1[r]);
  WAIT_BAR(0);
  DMA_K(3,0);DMA_V(1,SLOTB);
  ROT();
  kload8(kf,kp0+sl_cur);
  WAIT_BAR(2);
  s16x4 vlo[8],vhi[8]; u32x4 pw0,pw1,pw2,pw3;
  #define PKW(P,B) cvtpk_s(P[B],P[B+1])
  #define PAF(k) __builtin_bit_cast(bf16x8,pw##k)
  #define VFR(i) (bf16x8){vlo[i][0],vlo[i][1],vlo[i][2],vlo[i][3],vhi[i][0],vhi[i][1],vhi[i][2],vhi[i][3]}
  #define PIN(x) asm volatile("":"+v"(x))
  #define MX3(a,b,c) __builtin_fmaxf(__builtin_fmaxf((a),(b)),(c))
  #define GAPA(MF,A0,A1,A2,A3,W0,W1,PW) do{ MF; sacc+=A0; sacc+=A1; sacc+=A2; sacc+=A3; PIN(sacc); W0; W1; PIN(PW); SBAR(); }while(0)
  #define EX(v) __builtin_amdgcn_exp2f(v)
  #define GAPB(MF,X,B) do{ MF; X[B]=EX(X[B]); X[B+1]=EX(X[B+1]); X[B+2]=EX(X[B+2]); X[B+3]=EX(X[B+3]); PIN(X); SBAR(); }while(0)
  #define VRD(i) do{ vlo[i]=vtr(vp_+(((i)>>2)*4096+((i)&3)*1024)); vhi[i]=vtr(vp_+(((i)>>2)*4096+((i)&3)*1024+512)); }while(0)
  #define KRD(G,j) do{ if(G){ kload2(kf,kp0+sl_next,j); SBAR(); } }while(0)
  #define STEP(C0,C1,P0,P1,t,GK,GV,GL) do{ SBAR(); \
    const lds_cptr vp_=vp0+sl_prev; \
    VRD(0); SBAR(); float sacc=(P0[0]+P0[1]); \
    GAPA(C0=__builtin_amdgcn_mfma_f32_32x32x16_bf16(kf[0],qr[0],negm,0,0,0), P0[2],P0[3],P0[4],P0[5],     pw0[0]=PKW(P0,0), pw0[1]=PKW(P0,2), pw0); \
    VRD(4); SBAR(); GAPA(C1=__builtin_amdgcn_mfma_f32_32x32x16_bf16(kf[1],qr[0],negm,0,0,0), P0[6],P0[7],P0[8],P0[9],     pw0[2]=PKW(P0,4), pw0[3]=PKW(P0,6), pw0); \
    VRD(1); SBAR(); GAPA(C0=__builtin_amdgcn_mfma_f32_32x32x16_bf16(kf[2],qr[1],C0,0,0,0),   P0[10],P0[11],P0[12],P0[13], pw1[0]=PKW(P0,8), pw1[1]=PKW(P0,10), pw1); \
    VRD(5); SBAR(); GAPA(C1=__builtin_amdgcn_mfma_f32_32x32x16_bf16(kf[3],qr[1],C1,0,0,0),   P0[14],P0[15],P1[0],P1[1],   pw1[2]=PKW(P0,12),pw1[3]=PKW(P0,14), pw1); \
    VRD(2); SBAR(); GAPA(C0=__builtin_amdgcn_mfma_f32_32x32x16_bf16(kf[4],qr[2],C0,0,0,0),   P1[2],P1[3],P1[4],P1[5],     pw2[0]=PKW(P1,0), pw2[1]=PKW(P1,2), pw2); \
    VRD(6); SBAR(); GAPA(C1=__builtin_amdgcn_mfma_f32_32x32x16_bf16(kf[5],qr[2],C1,0,0,0),   P1[6],P1[7],P1[8],P1[9],     pw2[2]=PKW(P1,4), pw2[3]=PKW(P1,6), pw2); \
    VRD(3); SBAR(); GAPA(C0=__builtin_amdgcn_mfma_f32_32x32x16_bf16(kf[6],qr[3],C0,0,0,0),   P1[10],P1[11],P1[12],P1[13], pw3[0]=PKW(P1,8), pw3[1]=PKW(P1,10), pw3); \
    VRD(7); SBAR(); GAPA(C1=__builtin_amdgcn_mfma_f32_32x32x16_bf16(kf[7],qr[3],C1,0,0,0),   P1[14],P1[15],0.f,0.f,       pw3[2]=PKW(P1,12),pw3[3]=PKW(P1,14), pw3); \
    l_reg+=sacc; \
    if(GK){DMA_K((t)+3,sl_cur);} if(GV){DMA_V((t)+1,sl_next);} \
    ALIBI(C0,C1,t); CMASK(C0,C1,t); \
    { float a=MX3(C0[0],C0[1],C1[0]),b=MX3(C0[2],C0[3],C1[1]); a=MX3(a,C1[2],C1[3]); \
      _Pragma("unroll") for(int r=4;r<16;r+=4){a=MX3(a,C0[r],C0[r+1]);b=MX3(b,C0[r+2],C0[r+3]);a=MX3(a,C1[r],C1[r+1]);b=MX3(b,C1[r+2],C1[r+3]);} \
      float rm=__builtin_fmaxf(a,b); { auto rr=__builtin_amdgcn_permlane32_swap(__float_as_uint(rm),__float_as_uint(rm),false,false); rm=__builtin_fmaxf(__uint_as_float(rr[0]),__uint_as_float(rr[1])); } \
      resc=false; \
      if(__builtin_expect(__any(rm>(float)THRL),0)){ const float dl=__builtin_fmaxf(rm,0.f); mhat+=dl; \
        _Pragma("unroll") for(int r=0;r<16;++r){C0[r]-=dl;C1[r]-=dl;} \
        const float f=__builtin_amdgcn_exp2f(-dl); l_reg*=f; if(hi==0)wsf[r32]=f; resc=true; } } \
    SBAR(); \
    GAPB(o[0]=__builtin_amdgcn_mfma_f32_32x32x16_bf16(PAF(0),VFR(0),o[0],0,0,0), C0,0); \
    GAPB(o[1]=__builtin_amdgcn_mfma_f32_32x32x16_bf16(PAF(0),VFR(4),o[1],0,0,0), C0,4); \
    KRD(GL,0); GAPB(o[0]=__builtin_amdgcn_mfma_f32_32x32x16_bf16(PAF(1),VFR(1),o[0],0,0,0), C0,8); \
    KRD(GL,1); GAPB(o[1]=__builtin_amdgcn_mfma_f32_32x32x16_bf16(PAF(1),VFR(5),o[1],0,0,0), C0,12); \
    KRD(GL,2); GAPB(o[0]=__builtin_amdgcn_mfma_f32_32x32x16_bf16(PAF(2),VFR(2),o[0],0,0,0), C1,0); \
    KRD(GL,3); GAPB(o[1]=__builtin_amdgcn_mfma_f32_32x32x16_bf16(PAF(2),VFR(6),o[1],0,0,0), C1,4); \
    GAPB(o[0]=__builtin_amdgcn_mfma_f32_32x32x16_bf16(PAF(3),VFR(3),o[0],0,0,0), C1,8); \
    GAPB(o[1]=__builtin_amdgcn_mfma_f32_32x32x16_bf16(PAF(3),VFR(7),o[1],0,0,0), C1,12); \
    }while(0)
  int t=1;
  #undef CMASK
  #define CMASK(P0,P1,t) do{}while(0)
  for(;t+5<NT;t+=2){
    STEP(pB0,pB1,pA0,pA1,t,true,true,true);     WAIT_BAR(2); RESC(); ROT();
    STEP(pA0,pA1,pB0,pB1,t+1,true,true,true);   WAIT_BAR(2); RESC(); ROT();
  }
  #undef CMASK
  #define CMASK(P0,P1,t) do{int jb_=(t)-(NT-4); if(jb_>=0)cmask(P0,P1,jb_,qrel,hi);}while(0)
  #define ENDW(tt) do{ if((tt)+3<NT){WAIT_BAR(2);} else if((tt)+2<NT){WAIT_BAR(1);} else {WAIT_BAR(0);} }while(0)
  for(;t+1<NT;t+=2){
    STEP(pB0,pB1,pA0,pA1,t,(t+3<NT),(t+1<NT),(t+1<NT));       ENDW(t);   RESC(); ROT();
    STEP(pA0,pA1,pB0,pB1,t+1,(t+4<NT),(t+2<NT),(t+2<NT));     ENDW(t+1); RESC(); ROT();
  }
  STEP(pB0,pB1,pA0,pA1,NT-1,false,false,false); RESC();
  { float sacc=pB0[0]+pB0[1]; _Pragma("unroll") for(int r=2;r<16;++r)sacc+=pB0[r]; _Pragma("unroll") for(int r=0;r<16;++r)sacc+=pB1[r]; l_reg+=sacc;
    pw0=(u32x4){PKW(pB0,0),PKW(pB0,2),PKW(pB0,4),PKW(pB0,6)};pw1=(u32x4){PKW(pB0,8),PKW(pB0,10),PKW(pB0,12),PKW(pB0,14)};pw2=(u32x4){PKW(pB1,0),PKW(pB1,2),PKW(pB1,4),PKW(pB1,6)};pw3=(u32x4){PKW(pB1,8),PKW(pB1,10),PKW(pB1,12),PKW(pB1,14)};
    SBAR(); pv(o,vb0+sl_cur,PAF(0),PAF(1),PAF(2),PAF(3)); }
  #undef PKW
  #undef PAF
  #undef VFR
  #undef PIN
  #undef MX3
  #undef GAPA
  #undef GAPB
  #undef EX
  #undef VRD
  #undef KRD
  #undef STEP
  #undef ENDW
  {auto rr=__builtin_amdgcn_permlane32_swap(__float_as_uint(l_reg),__float_as_uint(l_reg),false,false);l_reg=__uint_as_float(rr[0])+__uint_as_float(rr[1]);}
  if(hi==0)wsf[32+r32]=l_reg;asm volatile("s_waitcnt lgkmcnt(0)":::"memory");
  float rli[16];
  #pragma unroll
  for(int r=0;r<16;++r)rli[r]=__builtin_amdgcn_rcpf(wsf[32+crow(r,hi)]);
  bf16*Ow=O+(rowbase+q0+wid*QBLK)*PO+ocol;
  { bf16*stg=(bf16*)(shm+LDS_OST)+wid*2048;
    #pragma unroll
    for(int r=0;r<16;++r){const int orow=crow(r,hi);
      #pragma unroll
      for(int d0=0;d0<2;++d0)stg[orow*64+d0*32+r32]=__float2bfloat16(o[d0][r]*rli[r]);}
    asm volatile("s_waitcnt lgkmcnt(0)":::"memory");
    #pragma unroll
    for(int i=0;i<4;++i){const int row=i*8+(lane>>3),ch=lane&7; const u32x4 v=*(const u32x4*)(stg+row*64+ch*8); ATTN_STORE16(Ow+(long)row*PO+ch*8,v);} }
  asm volatile("s_waitcnt lgkmcnt(0)\n\ts_barrier":::"memory");
  #undef DMA_K
  #undef DMA_V
  #undef CMASK
  #undef START
  #undef RESC
  #undef ROT
  #undef ALIBI
}
constexpr int ATTN_LDS_BYTES=LDS_BYTES;
#undef SBAR
#undef WAIT_BAR
}
struct MixP {
    const bf16* proj; bf16* ocat; bf16* oatt;
    const float* hg_lb;
    const float* hg_norm_g;
    float lam, one_m_lam_init;
    const float* da_subln_g;
    const float *rw_mu, *rw_w0, *rw_a0, *rw_k_k, *rw_k_a, *rw_r_k, *rw_gn_g, *rw_gn_b;
    const bf16 *wupT, *aupT, *gupT;
    gu32* aq;
};

__device__ __forceinline__ void attn_group(const MixP& P, int b, int h, int qb, char* lds) {
    const float slope2 = exp2f(-2.0f * (float)(h + 1)) * LOG2E;
    const float s2 = __builtin_bit_cast(float, __builtin_amdgcn_readfirstlane(__builtin_bit_cast(int, slope2)));
    const attn_body::bf16* pr = (const attn_body::bf16*)P.proj; attn_body::bf16* oa = (attn_body::bf16*)P.oatt;
#pragma unroll 1
    for (int sub = 0; sub < 4; ++sub) {
        const int mp = sub >> 1, hf = sub & 1;
        attn_body::attn_unit<8>(b, C_DAQ + h * 128 + mp * 64, C_DAK + h * 128 + mp * 64, C_DAV + h * 128 + hf * 64, h * 256 + mp * 128 + hf * 64, s2, qb, pr, oa, lds);
    }
    VM_WAIT(); __syncthreads();
    {
        int tid_ = threadIdx.x; asm volatile("" : "+v"(tid_)); const int tid = tid_, row = tid >> 1, hf = tid & 1;
        const size_t grow = (size_t)b * T + (size_t)qb * 256 + row;
        const bf16* o0 = P.oatt + grow * 1024 + h * 256 + hf * 64; const bf16* o1 = o0 + 128;
        float v[64]; float ss = 0.f;
#pragma unroll
        for (int c = 0; c < 8; ++c) { const v4u x = __builtin_nontemporal_load((const v4u*)(o0) + c), y = __builtin_nontemporal_load((const v4u*)(o1) + c);
            const unsigned xs[4] = {x.x, x.y, x.z, x.w}, ys[4] = {y.x, y.y, y.z, y.w};
#pragma unroll
            for (int j = 0; j < 4; ++j) { const float a = bflo(xs[j]) - P.lam * bflo(ys[j]), d = bfhi(xs[j]) - P.lam * bfhi(ys[j]); v[c * 8 + 2 * j] = a; v[c * 8 + 2 * j + 1] = d; ss += a * a + d * d; } }
        ss += __shfl_xor(ss, 1);
        const float rs = rsqrtf(ss * (1.0f / 128.0f) + RMS_EPS) * P.one_m_lam_init;
        bf16* dst = P.ocat + grow * 1536 + 512 + h * 128 + hf * 64; const float* g = P.da_subln_g + hf * 64;
#pragma unroll
        for (int c = 0; c < 8; ++c) { v4u w; w.x = pk2(v[c * 8 + 0] * rs * g[c * 8 + 0], v[c * 8 + 1] * rs * g[c * 8 + 1]); w.y = pk2(v[c * 8 + 2] * rs * g[c * 8 + 2], v[c * 8 + 3] * rs * g[c * 8 + 3]);
            w.z = pk2(v[c * 8 + 4] * rs * g[c * 8 + 4], v[c * 8 + 5] * rs * g[c * 8 + 5]); w.w = pk2(v[c * 8 + 6] * rs * g[c * 8 + 6], v[c * 8 + 7] * rs * g[c * 8 + 7]);
            *((v4u*)dst + c) = w; }
    }
    __syncthreads();
}
__device__ __forceinline__ void attn_worker(const MixP& P, char* lds, volatile LAS unsigned* bcast, int tid) {
    for (;;) {
        if (tid == 0) bcast[0] = __hip_atomic_fetch_add(P.aq, 1u, RLX_AGENT);
        __syncthreads();
        const unsigned idx = bcast[0];
        __syncthreads();
        if (idx >= 512u) break;
        const int qb = 15 - (int)(idx >> 5), bh = (int)(idx & 31u);
        attn_group(P, bh >> 2, bh & 3, qb, lds);
    }
}

constexpr int HG_QH = 0, HG_QT = 17408, HG_KT = 34816, HG_KHT = 52224, HG_VV = 70656, HG_OG = 88064, HG_AM = 105472, HG_BQ = 114688, HG_SS = 116736, HG_DD = 118784, HG_END = 119296;
constexpr int HS = 272, HS2 = 144;
__device__ __forceinline__ s16x4 tr_rd(unsigned addr) { s16x4 r; asm volatile("ds_read_b64_tr_b16 %0, %1\n\ts_waitcnt lgkmcnt(0)" : "=&v"(r) : "v"(addr) : "memory"); return r; }
__device__ __forceinline__ void hgrn_unit(const MixP& P, int b, int h, LAS unsigned char* lds) {
    int tid_ = threadIdx.x; asm volatile("" : "+v"(tid_));
    const int tid = tid_, lane = tid & 63, w = __builtin_amdgcn_readfirstlane(tid >> 6), g = lane >> 4, li = lane & 15;
    const int kk_ = tid & 127, tq = tid >> 7;
    const float lb = P.hg_lb[h * 128 + kk_], oml = 1.0f - lb;
    LAS float* BQ = (LAS float*)(lds + HG_BQ); LAS float* SS = (LAS float*)(lds + HG_SS); LAS float* DD = (LAS float*)(lds + HG_DD);
    f32x4 Sacc[8];
#pragma unroll
    for (int i = 0; i < 8; ++i) Sacc[i] = (f32x4){0.f, 0.f, 0.f, 0.f};
    const unsigned ldsb = (unsigned)(uintptr_t)lds;
    const float ng = P.hg_norm_g[16 * w + li];
    v4u pf[8];
#define HG_LOADPF(cc) do { const size_t r0_ = (size_t)b * T + (size_t)(cc) * 64; _Pragma("unroll") for (int i_ = 0; i_ < 8; ++i_) { const int ix_ = tid + 512 * (i_ & 1); \
        pf[i_] = *(const v4u*)(P.proj + (r0_ + (ix_ >> 4)) * INW + (i_ >> 1) * 512 + h * 128 + (ix_ & 15) * 8); } } while (0)
#define LBAR() asm volatile("s_waitcnt lgkmcnt(0)\n\ts_barrier" ::: "memory")
    HG_LOADPF(0);
#pragma unroll 1
    for (int c = 0; c < 64; ++c) {
        const size_t row0 = (size_t)b * T + (size_t)c * 64;
#pragma unroll
        for (int i = 0; i < 8; ++i) { const int ix = tid + 512 * (i & 1); const int reg = (i >> 1) == 0 ? HG_QH : (i >> 1) == 1 ? HG_KT : (i >> 1) == 2 ? HG_VV : HG_OG;
            *(LAS v4u*)(lds + reg + (ix >> 4) * HS + (ix & 15) * 16) = pf[i]; }
        if (c < 63) HG_LOADPF(c + 1);
        LBAR();
        float cs[16], kv[16]; float run = 0.f;
#pragma unroll
        for (int i = 0; i < 16; ++i) { const float z = bf2f(*(const LAS unsigned short*)(lds + HG_KT + (16 * tq + i) * HS + kk_ * 2)); const float sg = sigmoidf_(z); const float f = lb + oml * sg;
            run += __logf(fmaxf(f, HG_F_MIN)); cs[i] = run; kv[i] = oml * (1.0f - sg); }
        BQ[tq * 128 + kk_] = run;
        LBAR();
        const float q0 = BQ[kk_], q1 = BQ[128 + kk_], q2 = BQ[256 + kk_], q3 = BQ[384 + kk_];
        const float off = (tq > 0 ? q0 : 0.f) + (tq > 1 ? q1 : 0.f) + (tq > 2 ? q2 : 0.f);
        const float blast = (q0 + q1) + (q2 + q3), ref = q0 + q1;
        if (tq == 0) DD[kk_] = __expf(blast);
#pragma unroll
        for (int i = 0; i < 16; ++i) { const int t = 16 * tq + i; const float bt = off + cs[i];
            const float q = bf2f(*(const LAS unsigned short*)(lds + HG_QH + t * HS + kk_ * 2));
            *(LAS unsigned short*)(lds + HG_QH + t * HS + kk_ * 2) = (unsigned short)f2bf(q * __expf(bt));
            *(LAS unsigned short*)(lds + HG_QT + t * HS + kk_ * 2) = (unsigned short)f2bf(q * __expf(fminf(bt - ref, 60.f)));
            *(LAS unsigned short*)(lds + HG_KT + t * HS + kk_ * 2) = (unsigned short)f2bf(kv[i] * __expf(fminf(ref - bt, 60.f)));
            *(LAS unsigned short*)(lds + HG_KHT + kk_ * HS2 + t * 2) = (unsigned short)f2bf(kv[i] * __expf(blast - bt));
            }
        LBAR();
        {   const int mt = w >> 1;
#pragma unroll
            for (int j = 0; j < 2; ++j) { const int st = 2 * (w & 1) + j; f32x4 a = (f32x4){0.f, 0.f, 0.f, 0.f};
#pragma unroll
                for (int ks = 0; ks < 4; ++ks) { const bf16x8 fa = *(const LAS bf16x8*)(lds + HG_KT + (16 * st + li) * HS + ks * 64 + g * 16);
                    const bf16x8 fb = *(const LAS bf16x8*)(lds + HG_QT + (16 * mt + li) * HS + ks * 64 + g * 16);
                    a = __builtin_amdgcn_mfma_f32_16x16x32_bf16(fa, fb, a, 0, 0, 0); }
                const int tt = 16 * mt + li, s0 = 16 * st + 4 * g;
                v2u wv; wv.x = pk2(s0 <= tt ? a[0] : 0.f, s0 + 1 <= tt ? a[1] : 0.f); wv.y = pk2(s0 + 2 <= tt ? a[2] : 0.f, s0 + 3 <= tt ? a[3] : 0.f);
                *(LAS v2u*)(lds + HG_AM + tt * HS2 + s0 * 2) = wv; }
        }
        LBAR();
        bf16x8 vf[2];
        {   const int q = li >> 2, p = li & 3;
#pragma unroll
            for (int ks = 0; ks < 2; ++ks) { const unsigned a0 = ldsb + HG_VV + (32 * ks + 8 * g + q) * HS + (16 * w + 4 * p) * 2;
                const s16x4 lo = tr_rd(a0), hi = tr_rd(a0 + 4 * HS);
                vf[ks] = (bf16x8){lo[0], lo[1], lo[2], lo[3], hi[0], hi[1], hi[2], hi[3]}; } }
        bf16x8 sb[4];
#pragma unroll
        for (int s = 0; s < 4; ++s) { v4u x; x.x = pk2(Sacc[2 * s][0], Sacc[2 * s][1]); x.y = pk2(Sacc[2 * s][2], Sacc[2 * s][3]); x.z = pk2(Sacc[2 * s + 1][0], Sacc[2 * s + 1][1]); x.w = pk2(Sacc[2 * s + 1][2], Sacc[2 * s + 1][3]);
            sb[s] = __builtin_bit_cast(bf16x8, x); }
        f32x4 o[4];
#pragma unroll
        for (int mt = 0; mt < 4; ++mt) { f32x4 a = (f32x4){0.f, 0.f, 0.f, 0.f};
#pragma unroll
            for (int ks = 0; ks < 2; ++ks) { const bf16x8 fa = *(const LAS bf16x8*)(lds + HG_AM + (16 * mt + li) * HS2 + ks * 64 + g * 16);
                a = __builtin_amdgcn_mfma_f32_16x16x32_bf16(fa, vf[ks], a, 0, 0, 0); }
#pragma unroll
            for (int s = 0; s < 4; ++s) { const LAS unsigned char* qp = lds + HG_QH + (16 * mt + li) * HS + (32 * s + 4 * g) * 2;
                const v2u lo = *(const LAS v2u*)qp, hi = *(const LAS v2u*)(qp + 32);
                v4u x; x.x = lo.x; x.y = lo.y; x.z = hi.x; x.w = hi.y;
                a = __builtin_amdgcn_mfma_f32_16x16x32_bf16(__builtin_bit_cast(bf16x8, x), sb[s], a, 0, 0, 0); }
            o[mt] = a; }
#pragma unroll
        for (int kt = 0; kt < 8; ++kt) { const f32x4 d = *(const LAS f32x4*)(DD + 16 * kt + 4 * g); f32x4 a = Sacc[kt] * d;
#pragma unroll
            for (int ks = 0; ks < 2; ++ks) { const bf16x8 fa = *(const LAS bf16x8*)(lds + HG_KHT + (16 * kt + li) * HS2 + ks * 64 + g * 16);
                a = __builtin_amdgcn_mfma_f32_16x16x32_bf16(fa, vf[ks], a, 0, 0, 0); }
            Sacc[kt] = a; }
#pragma unroll
        for (int mt = 0; mt < 4; ++mt)
#pragma unroll
            for (int r = 0; r < 4; ++r) { float s = o[mt][r] * o[mt][r]; s += __shfl_xor(s, 1); s += __shfl_xor(s, 2); s += __shfl_xor(s, 4); s += __shfl_xor(s, 8);
                if (li == 0) SS[(16 * mt + 4 * g + r) * 8 + w] = s; }
        LBAR();
#pragma unroll
        for (int mt = 0; mt < 4; ++mt)
#pragma unroll
            for (int r = 0; r < 4; ++r) { const int t = 16 * mt + 4 * g + r; const f32x4 s0 = *(const LAS f32x4*)(SS + t * 8), s1 = *(const LAS f32x4*)(SS + t * 8 + 4);
                const float ss = ((s0[0] + s0[1]) + (s0[2] + s0[3])) + ((s1[0] + s1[1]) + (s1[2] + s1[3]));
                const float rs = rsqrtf(ss * (1.0f / 128.0f) + RMS_EPS);
                const float og = bf2f(*(const LAS unsigned short*)(lds + HG_OG + t * HS + (16 * w + li) * 2));
                const float y = o[mt][r] * rs * ng * (og * sigmoidf_(og));
                P.ocat[(row0 + t) * 1536 + h * 128 + 16 * w + li] = (unsigned short)f2bf(y); }
        LBAR();
    }
}
#undef HG_LOADPF

constexpr int RS = 144;
constexpr int RW_RT = 0, RW_AT = 9216, RW_BT = 18432, RW_KT = 27648, RW_ATT = 36864, RW_BHT = 46080, RW_KHT = 55296, RW_VTT = 64512, RW_G = 73728,
              RW_X = 82944,
              RW_LW = RW_X, RW_A1 = RW_X + 17408, RW_WW = RW_X, RW_O = RW_X + 9216,
              RW_AAB = 109568, RW_AAKT = RW_AAB + 4096, RW_ARB = RW_AAKT + 2048, RW_ARK = RW_ARB + 2048, RW_TM = RW_ARK + 2048, RW_TAM = RW_TM + 2048,
              RW_GC = RW_TAM + 2048, RW_BON = RW_GC + 1024, RW_CST = RW_BON + 256, RW_END2 = RW_CST + 3072,
              RW_TW = RW_RT, RW_AD = RW_AT, RW_SG = RW_BT;
static_assert(RW_END2 <= 131072, "rwkv lds");
__device__ __forceinline__ void rwkv_unit(const MixP& P, int b, int h, LAS unsigned char* lds) {
    int tid0_ = threadIdx.x; asm volatile("" : "+v"(tid0_));
    const int hc = h * 64;
    int tid = tid0_, lane = tid & 63, g = lane >> 4, li = lane & 15, tt = tid >> 3, sg = tid & 7, c0 = sg * 8;
    const int w = __builtin_amdgcn_readfirstlane(tid >> 6);
    LAS float* LW = (LAS float*)(lds + RW_LW); LAS float* O = (LAS float*)(lds + RW_O); LAS float* GC = (LAS float*)(lds + RW_GC); LAS float* BON = (LAS float*)(lds + RW_BON);
    LAS float* AAB = (LAS float*)(lds + RW_AAB);
    f32x4 St[4];
#pragma unroll
    for (int i = 0; i < 4; ++i) St[i] = (f32x4){0.f, 0.f, 0.f, 0.f};
    LAS float* CST = (LAS float*)(lds + RW_CST);
    for (int e = tid; e < 768; e += NTHR) { float v;
        if (e < 192) v = P.rw_mu[(e >> 6) * 512 + hc + (e & 63)]; else if (e < 448) v = P.rw_mu[1536 + (e - 192)];
        else { const int q = (e - 448) >> 6, c = (e - 448) & 63; const float* src = q == 0 ? P.rw_k_k : q == 1 ? P.rw_k_a : q == 2 ? P.rw_r_k : q == 3 ? P.rw_gn_g : P.rw_gn_b; v = src[hc + c]; }
        CST[e] = v; }
    LBAR();
#define LD8(dst, off) do { const f32x4 a_ = *(const LAS f32x4*)(CST + (off)), b_ = *(const LAS f32x4*)(CST + (off) + 4); _Pragma("unroll") for (int q_ = 0; q_ < 4; ++q_) { dst[q_] = a_[q_]; dst[4 + q_] = b_[q_]; } } while (0)
    const int lmt = w >> 1;
    float w0c[2], a0c[2];
#pragma unroll
    for (int n = 0; n < 2; ++n) { const int cc = 16 * (2 * (w & 1) + n) + li; w0c[n] = P.rw_w0[hc + cc]; a0c[n] = P.rw_a0[hc + cc]; }
    v4u cur[7], prv[7];
    {   const bf16* src = P.proj + ((size_t)b * T + tt) * INW;
        cur[0] = *(const v4u*)(src + C_RWR + hc + c0); cur[1] = *(const v4u*)(src + C_RWK + hc + c0); cur[2] = *(const v4u*)(src + C_RWV + hc + c0); cur[3] = *(const v4u*)(src + C_RWWD + c0); cur[4] = *(const v4u*)(src + C_RWAD + c0);
        cur[5] = *(const v4u*)(src + C_RWGD + sg * 16); cur[6] = *(const v4u*)(src + C_RWGD + sg * 16 + 8);
        if (tt > 0) { const bf16* sp = src - INW; prv[0] = *(const v4u*)(sp + C_RWR + hc + c0); prv[1] = *(const v4u*)(sp + C_RWK + hc + c0); prv[2] = *(const v4u*)(sp + C_RWV + hc + c0); prv[3] = *(const v4u*)(sp + C_RWWD + c0); prv[4] = *(const v4u*)(sp + C_RWAD + c0);
            prv[5] = *(const v4u*)(sp + C_RWGD + sg * 16); prv[6] = *(const v4u*)(sp + C_RWGD + sg * 16 + 8); }
        else {
#pragma unroll
            for (int i = 0; i < 7; ++i) prv[i] = (v4u){0u, 0u, 0u, 0u}; } }
#pragma unroll 1
    for (int blk = 0; blk < 64; ++blk) {
        const size_t row0 = (size_t)b * T + (size_t)blk * 64;
        { int t_ = tid0_; asm volatile("" : "+v"(t_)); tid = t_; lane = tid & 63; g = lane >> 4; li = lane & 15; tt = tid >> 3; sg = tid & 7; c0 = sg * 8; }
        bf16x8 bwf[2][2], baf[2][2], bgf[2][4];
#pragma unroll
        for (int n = 0; n < 2; ++n) { const int cc = 16 * (2 * (w & 1) + n) + li;
#pragma unroll
            for (int ks = 0; ks < 2; ++ks) { bwf[n][ks] = *(const bf16x8*)(P.wupT + (size_t)(hc + cc) * 64 + ks * 32 + g * 8); baf[n][ks] = *(const bf16x8*)(P.aupT + (size_t)(hc + cc) * 64 + ks * 32 + g * 8); }
#pragma unroll
            for (int ks = 0; ks < 4; ++ks) bgf[n][ks] = *(const bf16x8*)(P.gupT + (size_t)(hc + cc) * 128 + ks * 32 + g * 8); }
        float rr[8], k1[8], vv[8];
        {   float xw[8], xa[8], xg[16];
#define SHIFT8(dst, ci, muv) do { const unsigned cw_[4] = {cur[ci].x, cur[ci].y, cur[ci].z, cur[ci].w}, pw_[4] = {prv[ci].x, prv[ci].y, prv[ci].z, prv[ci].w}; \
            _Pragma("unroll") for (int q_ = 0; q_ < 4; ++q_) { const float c_lo = bflo(cw_[q_]), c_hi = bfhi(cw_[q_]); dst[2 * q_] = c_lo + (bflo(pw_[q_]) - c_lo) * muv[2 * q_]; dst[2 * q_ + 1] = c_hi + (bfhi(pw_[q_]) - c_hi) * muv[2 * q_ + 1]; } } while (0)
            float mu_[8];
            LD8(mu_, c0); SHIFT8(rr, 0, mu_); LD8(mu_, 64 + c0); SHIFT8(k1, 1, mu_); LD8(mu_, 128 + c0); SHIFT8(vv, 2, mu_); LD8(mu_, 192 + c0); SHIFT8(xw, 3, mu_); LD8(mu_, 256 + c0); SHIFT8(xa, 4, mu_);
            { float* xg0 = xg; float* xg1 = xg + 8; LD8(mu_, 320 + sg * 16); SHIFT8(xg0, 5, mu_); LD8(mu_, 328 + sg * 16); SHIFT8(xg1, 6, mu_); }
#undef SHIFT8
            v4u o;
            o.x = pk2(tanhf(xw[0]), tanhf(xw[1])); o.y = pk2(tanhf(xw[2]), tanhf(xw[3])); o.z = pk2(tanhf(xw[4]), tanhf(xw[5])); o.w = pk2(tanhf(xw[6]), tanhf(xw[7]));
            *(LAS v4u*)(lds + RW_TW + tt * RS + c0 * 2) = o;
            o.x = pk2(xa[0], xa[1]); o.y = pk2(xa[2], xa[3]); o.z = pk2(xa[4], xa[5]); o.w = pk2(xa[6], xa[7]);
            *(LAS v4u*)(lds + RW_AD + tt * RS + c0 * 2) = o;
            o.x = pk2(sigmoidf_(xg[0]), sigmoidf_(xg[1])); o.y = pk2(sigmoidf_(xg[2]), sigmoidf_(xg[3])); o.z = pk2(sigmoidf_(xg[4]), sigmoidf_(xg[5])); o.w = pk2(sigmoidf_(xg[6]), sigmoidf_(xg[7]));
            *(LAS v4u*)(lds + RW_SG + tt * 272 + sg * 32) = o;
            o.x = pk2(sigmoidf_(xg[8]), sigmoidf_(xg[9])); o.y = pk2(sigmoidf_(xg[10]), sigmoidf_(xg[11])); o.z = pk2(sigmoidf_(xg[12]), sigmoidf_(xg[13])); o.w = pk2(sigmoidf_(xg[14]), sigmoidf_(xg[15]));
            *(LAS v4u*)(lds + RW_SG + tt * 272 + sg * 32 + 16) = o;
        }
        LBAR();
#pragma unroll
        for (int n = 0; n < 2; ++n) { const int ntile = 2 * (w & 1) + n, cc = 16 * ntile + li;
            f32x4 aw = (f32x4){0.f, 0.f, 0.f, 0.f}, aa = aw, ag = aw;
#pragma unroll
            for (int ks = 0; ks < 2; ++ks) { const bf16x8 f1 = *(const LAS bf16x8*)(lds + RW_TW + (16 * lmt + li) * RS + ks * 64 + g * 16), f2 = *(const LAS bf16x8*)(lds + RW_AD + (16 * lmt + li) * RS + ks * 64 + g * 16);
                aw = __builtin_amdgcn_mfma_f32_16x16x32_bf16(f1, bwf[n][ks], aw, 0, 0, 0); aa = __builtin_amdgcn_mfma_f32_16x16x32_bf16(f2, baf[n][ks], aa, 0, 0, 0); }
#pragma unroll
            for (int ks = 0; ks < 4; ++ks) { const bf16x8 f3 = *(const LAS bf16x8*)(lds + RW_SG + (16 * lmt + li) * 272 + ks * 64 + g * 16);
                ag = __builtin_amdgcn_mfma_f32_16x16x32_bf16(f3, bgf[n][ks], ag, 0, 0, 0); }
#pragma unroll
            for (int r = 0; r < 4; ++r) { const int t = 16 * lmt + 4 * g + r; const float z = -(w0c[n] + aw[r]);
                const float sp = fmaxf(z, 0.f) + log1pf(__expf(-fabsf(z)));
                LW[t * 68 + cc] = -__expf(-sp - 0.5f);
                *(LAS unsigned short*)(lds + RW_A1 + t * RS + cc * 2) = (unsigned short)f2bf(sigmoidf_(a0c[n] + aa[r]));
                *(LAS unsigned short*)(lds + RW_G + t * RS + cc * 2) = (unsigned short)f2bf(ag[r]); }
        }
        LBAR();
        if (tid < 256) { const int j = tid >> 6, c = tid & 63; float run = 0.f;
#pragma unroll
            for (int i = 0; i < 16; ++i) { run += LW[(16 * j + i) * 68 + c]; LW[(16 * j + i) * 68 + c] = run; }
            GC[j * 64 + c] = __expf(run); }
        LBAR();
        {   float a[8], clt[8], clm[8], clc[8];
            { const v4u av = *(const LAS v4u*)(lds + RW_A1 + tt * RS + c0 * 2); a[0] = bflo(av.x); a[1] = bfhi(av.x); a[2] = bflo(av.y); a[3] = bfhi(av.y); a[4] = bflo(av.z); a[5] = bfhi(av.z); a[6] = bflo(av.w); a[7] = bfhi(av.w); }
            const int tl = tt & 15, tC = (tt | 15);
            { const f32x4 x0 = *(const LAS f32x4*)(LW + tt * 68 + c0), x1 = *(const LAS f32x4*)(LW + tt * 68 + c0 + 4), y0 = *(const LAS f32x4*)(LW + tC * 68 + c0), y1 = *(const LAS f32x4*)(LW + tC * 68 + c0 + 4);
              f32x4 z0 = (f32x4){0.f, 0.f, 0.f, 0.f}, z1 = z0; if (tl > 0) { z0 = *(const LAS f32x4*)(LW + (tt - 1) * 68 + c0); z1 = *(const LAS f32x4*)(LW + (tt - 1) * 68 + c0 + 4); }
#pragma unroll
              for (int j = 0; j < 4; ++j) { clt[j] = x0[j]; clt[4 + j] = x1[j]; clc[j] = y0[j]; clc[4 + j] = y1[j]; clm[j] = z0[j]; clm[4 + j] = z1[j]; } }
            float kk[8], kkc[8], kac[8], rkc[8]; float ss = 0.f;
            LD8(kkc, 448 + c0); LD8(kac, 512 + c0); LD8(rkc, 576 + c0);
#pragma unroll
            for (int j = 0; j < 8; ++j) { kk[j] = k1[j] * kkc[j]; ss += kk[j] * kk[j]; }
            ss += __shfl_xor(ss, 1); ss += __shfl_xor(ss, 2); ss += __shfl_xor(ss, 4);
            const float inv = rsqrtf(fmaxf(ss, 1e-12f)); float bon = 0.f;
            float rt[8], at[8], bt[8], kt[8], bh[8], kh[8];
#pragma unroll
            for (int j = 0; j < 8; ++j) { const float kn = kk[j] * inv, k2 = k1[j] * (1.0f + (a[j] - 1.0f) * kac[j]); const float av = -kn, bv = kn * a[j];
                const float ig = __expf(-clt[j]), gh = __expf(clc[j] - clt[j]);
                rt[j] = rr[j] * __expf(clt[j]); at[j] = av * __expf(clm[j]); bt[j] = bv * ig; kt[j] = k2 * ig; bh[j] = bv * gh; kh[j] = k2 * gh; bon += rr[j] * k2 * rkc[j]; }
            bon += __shfl_xor(bon, 1); bon += __shfl_xor(bon, 2); bon += __shfl_xor(bon, 4);
            if (sg == 0) BON[tt] = bon;
            v4u o;
#define PK8(src) (o.x = pk2(src[0], src[1]), o.y = pk2(src[2], src[3]), o.z = pk2(src[4], src[5]), o.w = pk2(src[6], src[7]), o)
            *(LAS v4u*)(lds + RW_RT + tt * RS + c0 * 2) = PK8(rt); *(LAS v4u*)(lds + RW_AT + tt * RS + c0 * 2) = PK8(at); *(LAS v4u*)(lds + RW_BT + tt * RS + c0 * 2) = PK8(bt); *(LAS v4u*)(lds + RW_KT + tt * RS + c0 * 2) = PK8(kt);
#undef PK8
#pragma unroll
            for (int j = 0; j < 8; ++j) { *(LAS unsigned short*)(lds + RW_ATT + (c0 + j) * RS + tt * 2) = (unsigned short)f2bf(at[j]); *(LAS unsigned short*)(lds + RW_BHT + (c0 + j) * RS + tt * 2) = (unsigned short)f2bf(bh[j]);
                *(LAS unsigned short*)(lds + RW_KHT + (c0 + j) * RS + tt * 2) = (unsigned short)f2bf(kh[j]); *(LAS unsigned short*)(lds + RW_VTT + (c0 + j) * RS + tt * 2) = (unsigned short)f2bf(vv[j]); }
        }
        LBAR();
        {   const int j = w >> 1; const int rowb = (16 * j + li) * RS;
            bf16x8 fat[2], fbt[2], fkt[2], frt[2];
#pragma unroll
            for (int ks = 0; ks < 2; ++ks) { fbt[ks] = *(const LAS bf16x8*)(lds + RW_BT + rowb + ks * 64 + g * 16); fkt[ks] = *(const LAS bf16x8*)(lds + RW_KT + rowb + ks * 64 + g * 16);
                if ((w & 1) == 0) fat[ks] = *(const LAS bf16x8*)(lds + RW_AT + rowb + ks * 64 + g * 16); else frt[ks] = *(const LAS bf16x8*)(lds + RW_RT + rowb + ks * 64 + g * 16); }
            if ((w & 1) == 0) {
                f32x4 x = (f32x4){0.f, 0.f, 0.f, 0.f}, y = x;
#pragma unroll
                for (int ks = 0; ks < 2; ++ks) { x = __builtin_amdgcn_mfma_f32_16x16x32_bf16(fbt[ks], fat[ks], x, 0, 0, 0);
                    y = __builtin_amdgcn_mfma_f32_16x16x32_bf16(fat[ks], fkt[ks], y, 0, 0, 0); }
                f32x4 xm; v2u ym;
#pragma unroll
                for (int r = 0; r < 4; ++r) xm[r] = (4 * g + r < li) ? x[r] : 0.f;
                *(LAS f32x4*)(AAB + (j * 16 + li) * 16 + 4 * g) = xm;
                ym.x = pk2(li < 4 * g ? y[0] : 0.f, li < 4 * g + 1 ? y[1] : 0.f); ym.y = pk2(li < 4 * g + 2 ? y[2] : 0.f, li < 4 * g + 3 ? y[3] : 0.f);
                *(LAS v2u*)(lds + RW_AAKT + (j * 16 + li) * 32 + 8 * g) = ym;
            } else {
                f32x4 x = (f32x4){0.f, 0.f, 0.f, 0.f}, y = x;
#pragma unroll
                for (int ks = 0; ks < 2; ++ks) { x = __builtin_amdgcn_mfma_f32_16x16x32_bf16(fbt[ks], frt[ks], x, 0, 0, 0);
                    y = __builtin_amdgcn_mfma_f32_16x16x32_bf16(fkt[ks], frt[ks], y, 0, 0, 0); }
                v2u xm, ym;
                xm.x = pk2(4 * g <= li ? x[0] : 0.f, 4 * g + 1 <= li ? x[1] : 0.f); xm.y = pk2(4 * g + 2 <= li ? x[2] : 0.f, 4 * g + 3 <= li ? x[3] : 0.f);
                ym.x = pk2(4 * g <= li ? y[0] : 0.f, 4 * g + 1 <= li ? y[1] : 0.f); ym.y = pk2(4 * g + 2 <= li ? y[2] : 0.f, 4 * g + 3 <= li ? y[3] : 0.f);
                *(LAS v2u*)(lds + RW_ARB + (j * 16 + li) * 32 + 8 * g) = xm; *(LAS v2u*)(lds + RW_ARK + (j * 16 + li) * 32 + 8 * g) = ym;
            }
        }
        LBAR();
        if (w == 0) { const int j = g, col = li; float x[16];
#pragma unroll
            for (int t = 0; t < 16; ++t) { float s = (t == col) ? 1.f : 0.f;
#pragma unroll
                for (int q = 0; q < (t + 3) / 4; ++q) { const f32x4 av = *(const LAS f32x4*)(AAB + (j * 16 + t) * 16 + 4 * q);
#pragma unroll
                    for (int e = 0; e < 4; ++e) if (4 * q + e < t) s += av[e] * x[4 * q + e]; }
                x[t] = s; *(LAS unsigned short*)(lds + RW_TM + (j * 16 + t) * 32 + col * 2) = (unsigned short)f2bf(s); } }
        LBAR();
        {   const int j = w >> 1; const bf16x8 zf = (bf16x8){0, 0, 0, 0, 0, 0, 0, 0};
            const bf16x8 ft = (g < 2) ? *(const LAS bf16x8*)(lds + RW_TM + (j * 16 + li) * 32 + g * 16) : zf;
#pragma unroll
            for (int n = 0; n < 2; ++n) { const int ct = 2 * (w & 1) + n;
                const bf16x8 fa = (g < 2) ? *(const LAS bf16x8*)(lds + RW_ATT + (16 * ct + li) * RS + (16 * j + 8 * g) * 2) : zf;
                f32x4 x = __builtin_amdgcn_mfma_f32_16x16x32_bf16(fa, ft, (f32x4){0.f, 0.f, 0.f, 0.f}, 0, 0, 0);
                v2u xm; xm.x = pk2(x[0], x[1]); xm.y = pk2(x[2], x[3]);
                *(LAS v2u*)(lds + RW_WW + (16 * j + li) * RS + (16 * ct + 4 * g) * 2) = xm; }
            if ((w & 1) == 0) { const bf16x8 fa = (g < 2) ? *(const LAS bf16x8*)(lds + RW_AAKT + (j * 16 + li) * 32 + g * 16) : zf;
                f32x4 x = __builtin_amdgcn_mfma_f32_16x16x32_bf16(fa, ft, (f32x4){0.f, 0.f, 0.f, 0.f}, 0, 0, 0);
                v2u xm; xm.x = pk2(x[0], x[1]); xm.y = pk2(x[2], x[3]);
                *(LAS v2u*)(lds + RW_TAM + (j * 16 + li) * 32 + 8 * g) = xm; }
        }
        LBAR();
        if (blk < 63) { const bf16* src = P.proj + (row0 + 64 + tt) * INW; const bf16* sp = src - INW;
            cur[0] = *(const v4u*)(src + C_RWR + hc + c0); cur[1] = *(const v4u*)(src + C_RWK + hc + c0); cur[2] = *(const v4u*)(src + C_RWV + hc + c0); cur[3] = *(const v4u*)(src + C_RWWD + c0); cur[4] = *(const v4u*)(src + C_RWAD + c0);
            cur[5] = *(const v4u*)(src + C_RWGD + sg * 16); cur[6] = *(const v4u*)(src + C_RWGD + sg * 16 + 8);
            prv[0] = *(const v4u*)(sp + C_RWR + hc + c0); prv[1] = *(const v4u*)(sp + C_RWK + hc + c0); prv[2] = *(const v4u*)(sp + C_RWV + hc + c0); prv[3] = *(const v4u*)(sp + C_RWWD + c0); prv[4] = *(const v4u*)(sp + C_RWAD + c0);
            prv[5] = *(const v4u*)(sp + C_RWGD + sg * 16); prv[6] = *(const v4u*)(sp + C_RWGD + sg * 16 + 8); }
        if (w < 4) {
#pragma unroll 1
            for (int j = 0; j < 4; ++j) {
                bf16x8 sb[2];
#pragma unroll
                for (int s = 0; s < 2; ++s) { v4u x; x.x = pk2(St[2 * s][0], St[2 * s][1]); x.y = pk2(St[2 * s][2], St[2 * s][3]); x.z = pk2(St[2 * s + 1][0], St[2 * s + 1][1]); x.w = pk2(St[2 * s + 1][2], St[2 * s + 1][3]); sb[s] = __builtin_bit_cast(bf16x8, x); }
                const v2u vf = *(const LAS v2u*)(lds + RW_VTT + (16 * w + li) * RS + (16 * j + 4 * g) * 2);
                const int trow = (16 * j + li) * RS;
                f32x4 u = (f32x4){0.f, 0.f, 0.f, 0.f}, o = u;
#pragma unroll
                for (int s = 0; s < 2; ++s) { const v2u lo = *(const LAS v2u*)(lds + RW_WW + trow + (32 * s + 4 * g) * 2), hi = *(const LAS v2u*)(lds + RW_WW + trow + (32 * s + 16 + 4 * g) * 2);
                    v4u x; x.x = lo.x; x.y = lo.y; x.z = hi.x; x.w = hi.y; u = __builtin_amdgcn_mfma_f32_16x16x32_bf16(__builtin_bit_cast(bf16x8, x), sb[s], u, 0, 0, 0);
                    const v2u lo2 = *(const LAS v2u*)(lds + RW_RT + trow + (32 * s + 4 * g) * 2), hi2 = *(const LAS v2u*)(lds + RW_RT + trow + (32 * s + 16 + 4 * g) * 2);
                    v4u y; y.x = lo2.x; y.y = lo2.y; y.z = hi2.x; y.w = hi2.y; o = __builtin_amdgcn_mfma_f32_16x16x32_bf16(__builtin_bit_cast(bf16x8, y), sb[s], o, 0, 0, 0); }
                {   const v2u ta = *(const LAS v2u*)(lds + RW_TAM + (j * 16 + li) * 32 + 8 * g);
                    v4u x; x.x = ta.x; x.y = ta.y; x.z = 0u; x.w = 0u; v4u y; y.x = vf.x; y.y = vf.y; y.z = 0u; y.w = 0u;
                    u = __builtin_amdgcn_mfma_f32_16x16x32_bf16(__builtin_bit_cast(bf16x8, x), __builtin_bit_cast(bf16x8, y), u, 0, 0, 0); }
                v4u b2; b2.x = pk2(u[0], u[1]); b2.y = pk2(u[2], u[3]); b2.z = vf.x; b2.w = vf.y;
                const bf16x8 b2f = __builtin_bit_cast(bf16x8, b2);
                {   const v2u rb = *(const LAS v2u*)(lds + RW_ARB + (j * 16 + li) * 32 + 8 * g), rk = *(const LAS v2u*)(lds + RW_ARK + (j * 16 + li) * 32 + 8 * g);
                    v4u x; x.x = rb.x; x.y = rb.y; x.z = rk.x; x.w = rk.y; o = __builtin_amdgcn_mfma_f32_16x16x32_bf16(__builtin_bit_cast(bf16x8, x), b2f, o, 0, 0, 0); }
#pragma unroll
                for (int r = 0; r < 4; ++r) O[(16 * j + 4 * g + r) * 68 + 16 * w + li] = o[r];
#pragma unroll
                for (int kt = 0; kt < 4; ++kt) { const f32x4 gc = *(const LAS f32x4*)(GC + j * 64 + 16 * kt + 4 * g);
                    const v2u bh = *(const LAS v2u*)(lds + RW_BHT + (16 * kt + li) * RS + (16 * j + 4 * g) * 2), kh = *(const LAS v2u*)(lds + RW_KHT + (16 * kt + li) * RS + (16 * j + 4 * g) * 2);
                    v4u x; x.x = bh.x; x.y = bh.y; x.z = kh.x; x.w = kh.y;
                    St[kt] = __builtin_amdgcn_mfma_f32_16x16x32_bf16(__builtin_bit_cast(bf16x8, x), b2f, St[kt] * gc, 0, 0, 0); }
            }
        }
        LBAR();
        {   const f32x4 o0 = *(const LAS f32x4*)(O + tt * 68 + c0), o1 = *(const LAS f32x4*)(O + tt * 68 + c0 + 4); float ov[8];
#pragma unroll
            for (int j = 0; j < 4; ++j) { ov[j] = o0[j]; ov[4 + j] = o1[j]; }
            float s = 0.f;
#pragma unroll
            for (int j = 0; j < 8; ++j) s += ov[j];
            s += __shfl_xor(s, 1); s += __shfl_xor(s, 2); s += __shfl_xor(s, 4);
            const float mean = s * (1.0f / 64.0f); float q = 0.f;
#pragma unroll
            for (int j = 0; j < 8; ++j) { const float d = ov[j] - mean; q += d * d; }
            q += __shfl_xor(q, 1); q += __shfl_xor(q, 2); q += __shfl_xor(q, 4);
            const float rs = rsqrtf(q * (1.0f / 64.0f) + RW_GN_EPS), bon = BON[tt];
            const v4u gv = *(const LAS v4u*)(lds + RW_G + tt * RS + c0 * 2); const float gg[8] = {bflo(gv.x), bfhi(gv.x), bflo(gv.y), bfhi(gv.y), bflo(gv.z), bfhi(gv.z), bflo(gv.w), bfhi(gv.w)};
            float y[8], gng[8], gnb[8]; LD8(gng, 640 + c0); LD8(gnb, 704 + c0);
#pragma unroll
            for (int j = 0; j < 8; ++j) y[j] = ((ov[j] - mean) * rs * gng[j] + gnb[j] + bon * vv[j]) * gg[j];
            v4u wv; wv.x = pk2(y[0], y[1]); wv.y = pk2(y[2], y[3]); wv.z = pk2(y[4], y[5]); wv.w = pk2(y[6], y[7]);
            *(v4u*)(P.ocat + (row0 + tt) * 1536 + 1024 + hc + c0) = wv; }
        LBAR();
    }
#undef LD8
#undef LBAR
}
struct Args { const float* in[31]; float* out; unsigned char* ws; int ph_lo, ph_hi; };
typedef const __attribute__((address_space(4))) Args* ArgP;
struct Frame {
    LAS unsigned char* lds; volatile LAS unsigned* MISC; gu32* ctl;
    int tid, lane, wave, vcu, G, bx;
};
constexpr int SM_HGLB = 0;
constexpr int SM_LAM = 2048;

__device__ __forceinline__ void transpose_item(const float* W, int K, int N, bf16* WT, int k0, int n0, int drow0, LAS float* scr, int lane, int dp = 0) {
    if (dp == 0) dp = K;
#pragma unroll 8
    for (int i = 0; i < 32; ++i) { const int kk = 2 * i + (lane >> 5); scr[kk * 33 + (lane & 31)] = W[(size_t)(k0 + kk) * N + n0 + (lane & 31)]; }
    LDS_WAIT(); asm volatile("" ::: "memory");
    const int c = lane & 7;
#pragma unroll
    for (int j = 0; j < 4; ++j) { const int n = (lane >> 3) + 8 * j; const LAS float* s = scr + (8 * c) * 33 + n;
        v4u o; o.x = pk2(s[0 * 33], s[1 * 33]); o.y = pk2(s[2 * 33], s[3 * 33]); o.z = pk2(s[4 * 33], s[5 * 33]); o.w = pk2(s[6 * 33], s[7 * 33]);
        *(GAS v4u*)(WT + (size_t)(drow0 + n) * dp + k0 + 8 * c) = o; }
    LDS_WAIT(); asm volatile("" ::: "memory");
}
constexpr int CV_IN = 2688, CV_MG = 1536, CV_BR = 768, CV_OUT = 512, CV_EX = 4096, CV_TOTAL = CV_IN + CV_MG + CV_BR + CV_OUT + 3 * CV_EX;
__device__ __forceinline__ void conv_layer(const Frame& F, ArgP A, int l) {
    LAS float* scr = (LAS float*)(F.lds + F.wave * 16384);
    const int gw = F.vcu * NWAVES + F.wave, NGW = F.G * NWAVES;
    bf16* wa = (bf16*)(A->ws + WS_WA); bf16* we = (bf16*)(A->ws + WS_WE);
    for (int it = gw; it < CV_TOTAL; it += NGW) {
        int r = it;
        if (r < CV_IN) { const int kb = r / 168, nb = r % 168; transpose_item(A->in[4] + (size_t)l * DM * INW, DM, INW, wa + WA_IN / 2, 64 * kb, 32 * nb, 32 * nb, scr, F.lane); continue; } r -= CV_IN;
        if (r < CV_MG) { const int br = r / 512, q = r % 512, kb = q / 32, nb = q % 32; transpose_item(A->in[20] + ((size_t)l * 3 + br) * DM * DM, DM, DM, wa + WA_MERGE / 2 + (size_t)br * DM * UP_, 64 * kb, 32 * nb, 32 * nb, scr, F.lane, UP_); continue; } r -= CV_MG;
        if (r < CV_BR) { const int kb = r / 32, nb = r % 32; transpose_item(A->in[22] + (size_t)l * 1536 * DM, 1536, DM, wa + WA_BRANCH / 2, 64 * kb, 32 * nb, 32 * nb, scr, F.lane); continue; } r -= CV_BR;
        if (r < CV_OUT) { const int kb = r / 32, nb = r % 32; transpose_item(A->in[23] + (size_t)l * DM * DM, DM, DM, wa + WA_OUT / 2, 64 * kb, 32 * nb, 32 * nb, scr, F.lane); continue; } r -= CV_OUT;
        if (r < 2 * CV_EX) { const int up = r / CV_EX, q = r % CV_EX, e = q / 256, q2 = q % 256, kb = q2 / 16, nb = q2 % 16, n0 = 32 * nb;
            transpose_item(A->in[28 + up] + ((size_t)l * NE + e) * DM * DE, DM, DE, we + WE_GU / 2 + (size_t)e * DM * DM, 64 * kb, n0, (n0 >> 7) * 256 + up * 128 + (n0 & 127), scr, F.lane); continue; } r -= 2 * CV_EX;
        { const int e = r / 256, q2 = r % 256, kb = q2 / 32, nb = q2 % 32; transpose_item(A->in[30] + ((size_t)l * NE + e) * DE * DM, DE, DM, we + WE_DT / 2 + (size_t)e * DM * DE, 64 * kb, 32 * nb, 32 * nb, scr, F.lane); }
    }
}

__device__ __forceinline__ void phase_prologue(const Frame& F, ArgP A) {
    {   LAS float* cond = (LAS float*)(F.lds);
        float* modp = (float*)(A->ws + WS_MODP);
        for (int it = F.vcu; it < NL * 24 * 4; it += F.G) { const int l = it / 96, r = it % 96, nb = r / 4, kq = r % 4;
            __syncthreads();
            for (int e = F.tid; e < 8 * 256; e += NTHR) { const float cv = A->in[1][(e >> 8) * DM + kq * 256 + (e & 255)]; cond[e] = cv * sigmoidf_(cv); }
            __syncthreads();
            const int n = nb * 256 + (F.tid & 255), kh = F.tid >> 8; float acc[8];
#pragma unroll
            for (int b = 0; b < 8; ++b) acc[b] = 0.f;
            const float* wp = A->in[2] + ((size_t)l * DM + kq * 256 + kh * 128) * 6144 + n;
#pragma unroll 4
            for (int k = 0; k < 128; ++k) { const float wv = wp[(size_t)k * 6144];
#pragma unroll
                for (int b = 0; b < 8; ++b) acc[b] += cond[b * 256 + kh * 128 + k] * wv; }
            const int kp = kq * 2 + kh;
#pragma unroll
            for (int b = 0; b < 8; ++b) modp[(((size_t)kp * NL + l) * NB + b) * 6144 + n] = acc[b]; }
        __syncthreads();
    }
    conv_layer(F, A, 0);
    {   bf16* lo = (bf16*)(A->ws + WS_LORA); const int gt = F.vcu * NTHR + F.tid, NGT = F.G * NTHR;
        for (int e = gt; e < NL * 512 * 64; e += NGT) { const int l = e / 32768, r = e % 32768, c = r >> 6, j = r & 63;
            lo[(size_t)l * 131072 + c * 64 + j] = (bf16)f2bf(A->in[11][(size_t)l * 32768 + j * 512 + c]);
            lo[(size_t)l * 131072 + 32768 + c * 64 + j] = (bf16)f2bf(A->in[13][(size_t)l * 32768 + j * 512 + c]); }
        for (int e = gt; e < NL * 512 * 128; e += NGT) { const int l = e / 65536, r = e % 65536, c = r >> 7, j = r & 127;
            lo[(size_t)l * 131072 + 65536 + c * 128 + j] = (bf16)f2bf(A->in[14][(size_t)l * 65536 + j * 512 + c]); }
    }
    if (F.vcu == 0) { float* sm = (float*)(A->ws + WS_SMALL);
        { const int k = F.tid; float z[4], mx = -1e30f;
#pragma unroll
          for (int l = 0; l < 4; ++l) { z[l] = A->in[5][l * 512 + k]; mx = fmaxf(mx, z[l]); }
          float s = 0.f;
#pragma unroll
          for (int l = 0; l < 4; ++l) { z[l] = __expf(z[l] - mx); s += z[l]; }
          const float inv = 1.0f / s;
          sm[SM_HGLB + k] = 0.f; sm[SM_HGLB + 512 + k] = z[1] * inv; sm[SM_HGLB + 1024 + k] = (z[1] + z[2]) * inv; sm[SM_HGLB + 1536 + k] = (z[1] + z[2] + z[3]) * inv; }
        if (F.wave < 4) { const int l = F.wave; const float* dl = A->in[7] + l * 256;
            const float s1 = wave_sum(dl[F.lane] * dl[64 + F.lane]), s2 = wave_sum(dl[128 + F.lane] * dl[192 + F.lane]);
            const float li = 0.8f - 0.6f * expf(-0.3f * (float)l);
            if (F.lane == 0) { sm[SM_LAM + l] = expf(s1) - expf(s2) + li; sm[SM_LAM + 4 + l] = 1.0f - li; } }
    }
}
__device__ __forceinline__ float mod_from_partials(ArgP A, int l, int b, int n) {
    const float* mp = (const float*)(A->ws + WS_MODP) + ((size_t)l * NB + b) * 6144 + n; float s = A->in[3][l * 6144 + n];
#pragma unroll
    for (int kp = 0; kp < 8; ++kp) s += mp[(size_t)kp * NL * NB * 6144];
    return s;
}
__device__ __forceinline__ void phase_mod_u0(const Frame& F, ArgP A) {
    float* mod = (float*)(A->ws + WS_MOD);
    for (int e = F.vcu * NTHR + F.tid; e < NL * NB * 6144; e += F.G * NTHR) { const int l = e / (NB * 6144), r = e % (NB * 6144); mod[e] = mod_from_partials(A, l, r / 6144, r % 6144); }
    bf16* U = (bf16*)(A->ws + WS_U);
    for (int rb = F.vcu; rb < M / 128; rb += F.G) { const int b = rb / 32;
        float sh[16], sc[16];
#pragma unroll
        for (int j = 0; j < 4; ++j)
#pragma unroll
            for (int i = 0; i < 4; ++i) { const int c = 4 * F.lane + 256 * j + i; sh[j * 4 + i] = mod_from_partials(A, 0, b, c); sc[j * 4 + i] = 1.0f + mod_from_partials(A, 0, b, 1024 + c); }
        for (int i = 0; i < 16; ++i) { const size_t row = (size_t)rb * 128 + F.wave * 16 + i;
            const f32x4* xr = (const f32x4*)(A->in[0] + row * DM) + F.lane; v2u* ur = (v2u*)(U + row * UP_) + F.lane;
#pragma unroll
            for (int j = 0; j < 4; ++j) { const f32x4 v = xr[64 * j]; v2u w; w.x = pk2(v[0] * sc[j * 4 + 0] + sh[j * 4 + 0], v[1] * sc[j * 4 + 1] + sh[j * 4 + 1]); w.y = pk2(v[2] * sc[j * 4 + 2] + sh[j * 4 + 2], v[3] * sc[j * 4 + 3] + sh[j * 4 + 3]); ur[64 * j] = w; } }
    }
}

__device__ __forceinline__ void phase_ln1(const Frame& F, ArgP A, int l) {
    const float* mod = (const float*)(A->ws + WS_MOD);
    const bf16* MIX = (const bf16*)(A->ws + WS_MIX); bf16* U = (bf16*)(A->ws + WS_U);
    const float* xin = (l == 0) ? A->in[0] : A->out;
    LAS float* wrT = (LAS float*)(F.lds);
    LAS int* te = (LAS int*)(F.lds + 65536);
    LAS int* tbase = (LAS int*)(F.lds + 65536 + 1024);
    int* tokpos = (int*)(A->ws + WS_TOK); float* tokw = (float*)(A->ws + WS_TOK + (size_t)M * 8);
    __syncthreads();
    for (int e = F.tid; e < 16 * 1024; e += NTHR) { const int ex = e >> 10, k = e & 1023; wrT[e] = A->in[26][k * 16 + ex]; }
    __syncthreads();
    float rb_[16];
#pragma unroll
    for (int e = 0; e < 16; ++e) rb_[e] = A->in[27][e];
    for (int rb = F.vcu; rb < M / 128; rb += F.G) { const int b = rb / 32; const float* mb = mod + ((size_t)l * NB + b) * 6144;
        float g1[16], sh2[16], sc2[16], lg[16], lb[16];
#pragma unroll
        for (int j = 0; j < 4; ++j)
#pragma unroll
            for (int i = 0; i < 4; ++i) { const int c = 4 * F.lane + 256 * j + i, q = j * 4 + i; g1[q] = 1.0f + mb[2048 + c]; sh2[q] = mb[3072 + c]; sc2[q] = 1.0f + mb[4096 + c]; lg[q] = A->in[24][(l * 2 + 0) * DM + c]; lb[q] = A->in[25][(l * 2 + 0) * DM + c]; }
#pragma unroll 1
        for (int i = 0; i < 16; ++i) { const int tl = F.wave * 16 + i; const size_t row = (size_t)rb * 128 + tl;
            const f32x4* xr = (const f32x4*)(xin + row * DM) + F.lane; const v2u* mr = (const v2u*)(MIX + row * DM) + F.lane;
            float y[16]; float s = 0.f;
#pragma unroll
            for (int j = 0; j < 4; ++j) { const f32x4 v = xr[64 * j]; const v2u m2 = mr[64 * j];
                y[j * 4 + 0] = ALPHA * v[0] + g1[j * 4 + 0] * bflo(m2.x); y[j * 4 + 1] = ALPHA * v[1] + g1[j * 4 + 1] * bfhi(m2.x);
                y[j * 4 + 2] = ALPHA * v[2] + g1[j * 4 + 2] * bflo(m2.y); y[j * 4 + 3] = ALPHA * v[3] + g1[j * 4 + 3] * bfhi(m2.y);
                s += (y[j * 4] + y[j * 4 + 1]) + (y[j * 4 + 2] + y[j * 4 + 3]); }
            const float mean = wave_sum(s) * (1.0f / DM); float q = 0.f;
#pragma unroll
            for (int k = 0; k < 16; ++k) { y[k] -= mean; q += y[k] * y[k]; }
            const float rstd = rsqrtf(wave_sum(q) * (1.0f / DM) + LN_EPS);
            f32x4* xo = (f32x4*)(A->out + row * DM) + F.lane; v2u* ur = (v2u*)(U + row * UP_) + F.lane; float u2[16];
#pragma unroll
            for (int j = 0; j < 4; ++j) { f32x4 o;
#pragma unroll
                for (int k = 0; k < 4; ++k) { o[k] = y[j * 4 + k] * rstd * lg[j * 4 + k] + lb[j * 4 + k]; u2[j * 4 + k] = o[k] * sc2[j * 4 + k] + sh2[j * 4 + k]; }
                xo[64 * j] = o; v2u w; w.x = pk2(u2[j * 4], u2[j * 4 + 1]); w.y = pk2(u2[j * 4 + 2], u2[j * 4 + 3]); ur[64 * j] = w; }
            float sc[16]; float mx = -1e30f;
#pragma unroll
            for (int e = 0; e < 16; ++e) { float p = 0.f;
#pragma unroll
                for (int j = 0; j < 4; ++j) { const f32x4 wv = *(const LAS f32x4*)(wrT + e * 1024 + 4 * F.lane + 256 * j); p += (u2[j * 4] * wv[0] + u2[j * 4 + 1] * wv[1]) + (u2[j * 4 + 2] * wv[2] + u2[j * 4 + 3] * wv[3]); }
                sc[e] = wave_sum(p); mx = fmaxf(mx, sc[e]); }
            float den = 0.f;
#pragma unroll
            for (int e = 0; e < 16; ++e) { sc[e] = __expf(sc[e] - mx); den += sc[e]; }
            const float iden = 1.0f / den; float sel[16];
#pragma unroll
            for (int e = 0; e < 16; ++e) { sc[e] *= iden; sel[e] = sc[e] + rb_[e]; }
            int bg = 0; float bgs = -1e30f;
#pragma unroll
            for (int gq = 0; gq < 4; ++gq) { float m1 = -1e30f, m2 = -1e30f;
#pragma unroll
                for (int k = 0; k < 4; ++k) { const float v = sel[gq * 4 + k]; if (v > m1) { m2 = m1; m1 = v; } else if (v > m2) m2 = v; }
                const float gs = m1 + m2; if (gs > bgs) { bgs = gs; bg = gq; } }
            int i0 = 0, i1 = 0; float v0 = -1e30f, v1 = -1e30f, w0 = 0.f, w1 = 0.f;
#pragma unroll
            for (int e = 0; e < 16; ++e) { if ((e >> 2) == bg) { const float v = sel[e]; if (v > v0) { v1 = v0; i1 = i0; w1 = w0; v0 = v; i0 = e; w0 = sc[e]; } else if (v > v1) { v1 = v; i1 = e; w1 = sc[e]; } } }
            const float iw = 1.0f / (w0 + w1);
            if (F.lane == 0) { te[tl * 2] = i0; te[tl * 2 + 1] = i1; tokw[row * 2] = w0 * iw; tokw[row * 2 + 1] = w1 * iw; }
        }
        __syncthreads();
        if (F.tid < 16) { int n = 0; for (int k = 0; k < 256; ++k) n += (te[k] == F.tid) ? 1 : 0;
            tbase[F.tid] = (int)__hip_atomic_fetch_add(F.ctl + CW_ECNT + 64 * l + F.tid, (unsigned)n, RLX_AGENT);
            int p = tbase[F.tid];
            for (int k = 0; k < 256; ++k) if (te[k] == F.tid) { tokpos[(size_t)rb * 256 + k] = (F.tid << 24) | p; ++p; } }
        __syncthreads();
    }
}
__device__ __forceinline__ void load_hb(const Frame& F, int l, volatile LAS int* hb, int c) {
    __syncthreads();
    if (F.tid == 0) { int acc = 0; for (int e = 0; e < 16; ++e) { hb[e] = acc; const int cn = (int)__hip_atomic_load(F.ctl + CW_ECNT + 64 * l + e, RLX_AGENT); acc += (cn + 255) & ~255; } hb[16] = acc; hb[17] = acc >> 8;
        const int nun = (acc >> 8) * 4; int n = 0;
        for (int L = c; L < nun && n < 12; L += F.G) { const int j = L >> 2, pn = L & 3; int e = 0; for (int k = 1; k < 16; ++k) e = (hb[k] <= j * 256) ? k : e; hb[19 + n] = (j << 8) | (pn << 4) | e; ++n; }
        hb[18] = n; }
    __syncthreads();
}
__device__ __forceinline__ void phase_scatter(const Frame& F, ArgP A, int l) {
    volatile LAS int* hb = (volatile LAS int*)(F.lds + 4096);
    load_hb(F, l, hb, 0);
    const int* tokpos = (const int*)(A->ws + WS_TOK); int* tokrow = (int*)(A->ws + WS_TOK + (size_t)M * 16);
    const bf16* U = (const bf16*)(A->ws + WS_U); bf16* AS = (bf16*)(A->ws + WS_AS);
    for (int rb = F.vcu; rb < M / 128; rb += F.G) {
        for (int i = 0; i < 32; ++i) { const int k = F.wave * 32 + i; const size_t idx = (size_t)rb * 256 + k; const int tp = tokpos[idx]; const int e = tp >> 24, pos = tp & 0xffffff;
            const int row = hb[e] + pos; const size_t tok = idx >> 1;
            const v4u* src = (const v4u*)(U + tok * UP_) + F.lane; v4u* dst = (v4u*)(AS + (size_t)row * DM) + F.lane;
            const v4u a = src[0], c = src[64]; dst[0] = a; dst[64] = c;
            if (F.lane == 0) tokrow[idx] = row; }
    }
}
__device__ __forceinline__ void phase_ln2(const Frame& F, ArgP A, int l) {
    const float* mod = (const float*)(A->ws + WS_MOD);
    const bf16* Y = (const bf16*)(A->ws + WS_Y); bf16* U = (bf16*)(A->ws + WS_U);
    const int* tokrow = (const int*)(A->ws + WS_TOK + (size_t)M * 16); const float* tokw = (const float*)(A->ws + WS_TOK + (size_t)M * 8);
    for (int rb = F.vcu; rb < M / 128; rb += F.G) { const int b = rb / 32; const float* mb = mod + ((size_t)l * NB + b) * 6144; const float* mn = mod + ((size_t)(l < NL - 1 ? l + 1 : l) * NB + b) * 6144;
        float g2[16], sh1[16], sc1[16], lg[16], lb[16];
#pragma unroll
        for (int j = 0; j < 4; ++j)
#pragma unroll
            for (int i = 0; i < 4; ++i) { const int c = 4 * F.lane + 256 * j + i, q = j * 4 + i; g2[q] = 1.0f + mb[5120 + c]; sh1[q] = mn[c]; sc1[q] = 1.0f + mn[1024 + c]; lg[q] = A->in[24][(l * 2 + 1) * DM + c]; lb[q] = A->in[25][(l * 2 + 1) * DM + c]; }
#pragma unroll 1
        for (int i = 0; i < 16; ++i) { const size_t row = (size_t)rb * 128 + F.wave * 16 + i;
            const int r0 = tokrow[row * 2], r1 = tokrow[row * 2 + 1]; const float w0 = tokw[row * 2], w1 = tokw[row * 2 + 1];
            const f32x4* xr = (const f32x4*)(A->out + row * DM) + F.lane; const v2u* y0 = (const v2u*)(Y + (size_t)r0 * DM) + F.lane; const v2u* y1 = (const v2u*)(Y + (size_t)r1 * DM) + F.lane;
            float y[16]; float s = 0.f;
#pragma unroll
            for (int j = 0; j < 4; ++j) { const f32x4 v = xr[64 * j]; const v2u a = y0[64 * j], c = y1[64 * j];
                y[j * 4 + 0] = ALPHA * v[0] + g2[j * 4 + 0] * (w0 * bflo(a.x) + w1 * bflo(c.x)); y[j * 4 + 1] = ALPHA * v[1] + g2[j * 4 + 1] * (w0 * bfhi(a.x) + w1 * bfhi(c.x));
                y[j * 4 + 2] = ALPHA * v[2] + g2[j * 4 + 2] * (w0 * bflo(a.y) + w1 * bflo(c.y)); y[j * 4 + 3] = ALPHA * v[3] + g2[j * 4 + 3] * (w0 * bfhi(a.y) + w1 * bfhi(c.y));
                s += (y[j * 4] + y[j * 4 + 1]) + (y[j * 4 + 2] + y[j * 4 + 3]); }
            const float mean = wave_sum(s) * (1.0f / DM); float q = 0.f;
#pragma unroll
            for (int k = 0; k < 16; ++k) { y[k] -= mean; q += y[k] * y[k]; }
            const float rstd = rsqrtf(wave_sum(q) * (1.0f / DM) + LN_EPS);
            f32x4* xo = (f32x4*)(A->out + row * DM) + F.lane; v2u* ur = (v2u*)(U + row * UP_) + F.lane;
#pragma unroll
            for (int j = 0; j < 4; ++j) { f32x4 o; float u[4];
#pragma unroll
                for (int k = 0; k < 4; ++k) { o[k] = y[j * 4 + k] * rstd * lg[j * 4 + k] + lb[j * 4 + k]; u[k] = o[k] * sc1[j * 4 + k] + sh1[j * 4 + k]; }
                xo[64 * j] = o; if (l < NL - 1) { v2u w; w.x = pk2(u[0], u[1]); w.y = pk2(u[2], u[3]); ur[64 * j] = w; } }
        }
    }
}
struct SchedProj {
    static constexpr unsigned LDA = UP_ * 2, LDB = 2048; static constexpr int NT = 16; static constexpr bool VARNT = false;
    const char* U; const char* W; int G, c;
    __device__ __forceinline__ bool next(int i, pg8::GUnit& u, pg8::GOps& o) const { int pm, pn; if (!pg8::static_tile(M / 256, INW / 256, G, c, i, pm, pn)) return false;
        o.A = U + (size_t)pm * 256 * LDA; o.B = W + (size_t)pn * 256 * 2048; u.kind = 0; u.r0 = pm * 256; u.c0 = pn * 256; u.aux = (pn == 8 || pn == 9) ? 1 : 0; return true; }
};
struct SchedBranch {
    static constexpr unsigned LDA = 3072, LDB = 3072; static constexpr int NT = 16; static constexpr bool VARNT = true;
    const char* U; const char* WM; const char* OC; const char* WB; int G, c;
    __device__ __forceinline__ bool next(int i, pg8::GUnit& u, pg8::GOps& o) const { int pm, pn; if (!pg8::static_tile(M / 256, 4, G, c, i >> 2, pm, pn)) return false; const int sub = i & 3;
        u.r0 = pm * 256; u.c0 = pn * 256;
        if (sub < 3) { o.A = U + (size_t)pm * 256 * 3072; o.B = WM + ((size_t)sub * 1024 + pn * 256) * 3072; o.nt = 16; u.kind = 1; u.aux = sub; }
        else { o.A = OC + (size_t)pm * 256 * 3072; o.B = WB + (size_t)pn * 256 * 3072; o.nt = 24; u.kind = 2; u.aux = 0; }
        return true; }
};
struct SchedOut {
    static constexpr unsigned LDA = 2048, LDB = 2048; static constexpr int NT = 16; static constexpr bool VARNT = false;
    const char* Am; const char* W; int G, c;
    __device__ __forceinline__ bool next(int i, pg8::GUnit& u, pg8::GOps& o) const { int pm, pn; if (!pg8::static_tile(M / 256, 4, G, c, i, pm, pn)) return false;
        o.A = Am + (size_t)pm * 256 * 2048; o.B = W + (size_t)pn * 256 * 2048; u.kind = 0; u.r0 = pm * 256; u.c0 = pn * 256; u.aux = 0; return true; }
};
template <int UP> struct SchedMoe {
    static constexpr unsigned LDA = UP ? 2048 : 1024, LDB = LDA; static constexpr int NT = UP ? 16 : 8; static constexpr bool VARNT = false;
    const char* Am; const char* W; volatile LAS int* hb;
    __device__ __forceinline__ bool next(int i, pg8::GUnit& u, pg8::GOps& o) const { const int n = __builtin_amdgcn_readfirstlane(hb[18]); if (i >= n) return false;
        const int pk = __builtin_amdgcn_readfirstlane(hb[19 + i]); const int j = pk >> 8, pn = (pk >> 4) & 15, e = pk & 15;
        u.r0 = j * 256; u.aux = 0; u.kind = UP ? 3 : 0; u.c0 = UP ? pn * 128 : pn * 256;
        o.A = Am + (size_t)j * 256 * LDA; o.B = W + ((size_t)e * 1024 + pn * 256) * LDB;
        return true; }
};

constexpr int NPH = 2 + 9 * NL;
#ifndef PH_MASK
#define PH_MASK 0xffff
#endif
#define PHM(b) ((PH_MASK >> (b)) & 1)
#ifndef RPT_MASK
#define RPT_MASK 0
#endif
#define RPT(b) (1 + ((RPT_MASK >> (b)) & 1))
__global__ void __launch_bounds__(NTHR, 2) hybrid_fwd(Args args) {
    extern __shared__ __attribute__((aligned(16))) unsigned char lds[];
    Frame F; unsigned char* ws; ArgP A;
#define FRESH() do { int t_ = threadIdx.x; asm volatile("" : "+v"(t_)); { unsigned long long p_ = (unsigned long long)__builtin_amdgcn_kernarg_segment_ptr(); asm volatile("" : "+s"(p_)); A = (ArgP)p_; } ws = A->ws; \
        F.lds = (LAS unsigned char*)lds; F.MISC = (volatile LAS unsigned*)(F.lds + MISC_OFF); F.tid = t_; F.lane = t_ & 63; F.wave = __builtin_amdgcn_readfirstlane(t_ >> 6); \
        { int g_ = gridDim.x, b_ = blockIdx.x; asm volatile("" : "+s"(g_), "+s"(b_)); F.G = g_; F.bx = b_; F.vcu = (g_ % 8 == 0) ? (b_ % 8) * (g_ / 8) + b_ / 8 : b_; } F.ctl = (gu32*)(ws + WS_CTL); } while (0)
    FRESH();
    for (int u = F.tid; u < (LDS_BYTES - LDSCTL_OFF) / 4; u += NTHR) ((LAS unsigned*)(F.lds + LDSCTL_OFF))[u] = 0u;
    __syncthreads();
    XcdBarrier bar; bar.bar = (unsigned*)(ws + WS_CTL) + CW_BAR; bar.x = 0; bar.st = nullptr;
    if (!MK_PER_PHASE) bar = xcd_barrier_post((unsigned*)(ws + WS_CTL) + CW_BAR, F.MISC + 8);
    const int lo = A->ph_lo, hi = A->ph_hi;
#define IN(k) (lo <= (k) && (k) < hi)
#define SEAM(k) do { if (IN(k) && IN((k) + 1)) xcd_barrier(bar); } while (0)

    if (PHM(0) && IN(0)) { FRESH(); phase_prologue(F, A); SEAM(0); }
    if (PHM(1) && IN(1)) { FRESH(); phase_mod_u0(F, A); SEAM(1); }

#pragma unroll 1
    for (int l = 0; l < NL; ++l) {
        const int pb = 2 + 9 * l;
        if (PHM(2) && IN(pb + 0)) {
            FRESH(); const char* WA = (const char*)(ws + WS_WA); const char* WE = (const char*)(ws + WS_WE); (void)WA; (void)WE;
            SchedProj S{(const char*)(ws + WS_U), WA + WA_IN, F.G, F.bx};
            pg8::Epi<1> E{(bf16*)(ws + WS_PROJ), INW, C2Q, nullptr, nullptr};
            for (int rep = 0; rep < RPT(2); ++rep) pg8::gemm_phase<false>(F.lds, S, E);
            SEAM(pb + 0);
        }
        if (IN(pb + 1)) {
            FRESH();
            const float* sm = (const float*)(ws + WS_SMALL);
            MixP P;
            P.proj = (const bf16*)(ws + WS_PROJ); P.ocat = (bf16*)(ws + WS_OCAT); P.oatt = (bf16*)(ws + WS_OATT);
            P.hg_lb = sm + SM_HGLB + l * 512; P.hg_norm_g = A->in[6] + l * 128; P.lam = sm[SM_LAM + l]; P.one_m_lam_init = sm[SM_LAM + 4 + l]; P.da_subln_g = A->in[8] + l * 128;
            P.rw_mu = A->in[9] + l * 1792; P.rw_w0 = A->in[10] + l * 512; P.rw_a0 = A->in[12] + l * 512; P.rw_k_k = A->in[15] + l * 512; P.rw_k_a = A->in[16] + l * 512;
            P.rw_r_k = A->in[17] + l * 512; P.rw_gn_g = A->in[18] + l * 512; P.rw_gn_b = A->in[19] + l * 512;
            const bf16* lo_ = (const bf16*)(ws + WS_LORA) + (size_t)l * 131072; P.wupT = lo_; P.aupT = lo_ + 32768; P.gupT = lo_ + 65536;
            P.aq = F.ctl + CW_AQ + 64 * l;
            if (F.G >= 128) {
                if (PHM(3) && F.vcu < 64) { for (int rep = 0; rep < RPT(3); ++rep) rwkv_unit(P, F.vcu >> 3, F.vcu & 7, F.lds); }
                else if (PHM(4) && F.vcu < 96) { for (int rep = 0; rep < RPT(4); ++rep) hgrn_unit(P, (F.vcu - 64) >> 2, (F.vcu - 64) & 3, F.lds); }
                else if (PHM(5)) { for (int rep = 0; rep < RPT(5); ++rep) { P.aq = F.ctl + CW_AQ + 64 * l + 32 * rep; attn_worker(P, (char*)lds, F.MISC + 16, F.tid); } }
            }
            SEAM(pb + 1);
        }
        if (PHM(6) && IN(pb + 2)) {
            FRESH(); const char* WA = (const char*)(ws + WS_WA); const char* WE = (const char*)(ws + WS_WE); (void)WA; (void)WE;
            SchedBranch S{(const char*)(ws + WS_U), WA + WA_MERGE, (const char*)(ws + WS_OCAT), WA + WA_BRANCH, F.G, F.bx};
            pg8::Epi<6> E{(bf16*)(ws + WS_MERGED), DM, 1.0f, A->in[21] + (size_t)l * 3 * DM, (v4u*)(ws + WS_GSCR) + (size_t)F.bx * 3 * 16 * 512};
            for (int rep = 0; rep < RPT(6); ++rep) pg8::gemm_phase<false>(F.lds, S, E);
            SEAM(pb + 2);
        }
        if (PHM(7) && IN(pb + 3)) {
            FRESH(); const char* WA = (const char*)(ws + WS_WA); const char* WE = (const char*)(ws + WS_WE); (void)WA; (void)WE;
            SchedOut S{(const char*)(ws + WS_MERGED), WA + WA_OUT, F.G, F.bx};
            pg8::Epi<1> E{(bf16*)(ws + WS_MIX), DM, 1.0f, nullptr, nullptr};
            for (int rep = 0; rep < RPT(7); ++rep) pg8::gemm_phase<false>(F.lds, S, E);
            SEAM(pb + 3);
        }
        if (PHM(8) && IN(pb + 4)) { FRESH(); phase_ln1(F, A, l); SEAM(pb + 4); }
        if (PHM(9) && IN(pb + 5)) { FRESH(); for (int rep = 0; rep < RPT(9); ++rep) phase_scatter(F, A, l); SEAM(pb + 5); }
        if (PHM(10) && IN(pb + 6)) {
            FRESH(); const char* WA = (const char*)(ws + WS_WA); const char* WE = (const char*)(ws + WS_WE); (void)WA; (void)WE;
            volatile LAS int* hb = (volatile LAS int*)(F.lds + LDSCTL_OFF + 128);
            load_hb(F, l, hb, F.bx);
            SchedMoe<1> S{(const char*)(ws + WS_AS), WE + WE_GU, hb};
            pg8::Epi<8> E{(bf16*)(ws + WS_H), DE, 1.0f, nullptr, nullptr};
            for (int rep = 0; rep < RPT(10); ++rep) pg8::gemm_phase<false>(F.lds, S, E);
            SEAM(pb + 6);
        }
        if (PHM(11) && IN(pb + 7)) {
            FRESH(); const char* WA = (const char*)(ws + WS_WA); const char* WE = (const char*)(ws + WS_WE); (void)WA; (void)WE;
            volatile LAS int* hb = (volatile LAS int*)(F.lds + LDSCTL_OFF + 128);
            load_hb(F, l, hb, F.bx);
            SchedMoe<0> S{(const char*)(ws + WS_H), WE + WE_DT, hb};
            pg8::Epi<1> E{(bf16*)(ws + WS_Y), DM, 1.0f, nullptr, nullptr};
            for (int rep = 0; rep < RPT(11); ++rep) pg8::gemm_phase<false>(F.lds, S, E);
            SEAM(pb + 7);
        }
        if (PHM(12) && IN(pb + 8)) { FRESH(); if (l < NL - 1) conv_layer(F, A, l + 1); phase_ln2(F, A, l); SEAM(pb + 8); }
    }
#undef IN
#undef SEAM
}

extern "C" void kernel_launch(void* const* d_in, const int* in_sizes, int n_in, void* d_out, int out_size, void* d_ws, size_t ws_size, hipStream_t stream) {
    static int grid = 0;
    if (grid == 0) {
        if (n_in != 31 || out_size != M * DM || ws_size < WS_END) { fprintf(stderr, "kernel_launch: unexpected shapes (n_in %d, out %d, ws %zu < %zu); nothing launched\n", n_in, out_size, ws_size, (size_t)WS_END); grid = -1; return; }
        int dev = 0, cus = 0, per_cu = 0;
        if (hipGetDevice(&dev) != hipSuccess || hipDeviceGetAttribute(&cus, hipDeviceAttributeMultiprocessorCount, dev) != hipSuccess) { grid = -1; return; }
        if (hipFuncSetAttribute((const void*)hybrid_fwd, hipFuncAttributeMaxDynamicSharedMemorySize, LDS_BYTES) != hipSuccess) { fprintf(stderr, "kernel_launch: hipFuncSetAttribute failed\n"); grid = -1; return; }
        if (hipOccupancyMaxActiveBlocksPerMultiprocessor(&per_cu, (const void*)hybrid_fwd, NTHR, LDS_BYTES) != hipSuccess || per_cu < 1) { fprintf(stderr, "kernel_launch: occupancy query reports %d\n", per_cu); }
        (void)hipGetLastError();
        grid = cus;
        if (grid > 256) grid = 256;
    }
    if (grid < 0) return;
    (void)hipMemsetAsync((char*)d_ws + WS_CTL, 0, CTL_ZERO_BYTES, stream);
    Args a{};
    for (int i = 0; i < 31; ++i) a.in[i] = (const float*)d_in[i];
    a.out = (float*)d_out; a.ws = (unsigned char*)d_ws;
#if MK_PER_PHASE
    for (int p = 0; p < NPH; ++p) { a.ph_lo = p; a.ph_hi = p + 1; hipLaunchKernelGGL(hybrid_fwd, dim3(grid), dim3(NTHR), LDS_BYTES, stream, a); }
#else
    a.ph_lo = 0; a.ph_hi = NPH; hipLaunchKernelGGL(hybrid_fwd, dim3(grid), dim3(NTHR), LDS_BYTES, stream, a);
#endif
}
```

```cpp
#include <hip/hip_runtime.h>
#include <hip/hip_bf16.h>
#include <cstdio>
#include <cstdint>

#ifndef MK_PER_PHASE
#define MK_PER_PHASE 0
#endif

#define GAS __attribute__((address_space(1)))
#define LAS __attribute__((address_space(3)))
typedef unsigned short bf16;
typedef unsigned v4u __attribute__((ext_vector_type(4)));
typedef unsigned v2u __attribute__((ext_vector_type(2)));
typedef float f32x4 __attribute__((ext_vector_type(4)));
typedef float f32x2 __attribute__((ext_vector_type(2)));
typedef float f32x16 __attribute__((ext_vector_type(16)));
typedef short bf16x8 __attribute__((ext_vector_type(8)));
typedef short s16x4 __attribute__((ext_vector_type(4)));
typedef GAS unsigned gu32;
#define RLX_AGENT __ATOMIC_RELAXED, __HIP_MEMORY_SCOPE_AGENT
#define LDS_WAIT() asm volatile("s_waitcnt lgkmcnt(0)" ::: "memory")
#define VM_WAIT() asm volatile("s_waitcnt vmcnt(0)" ::: "memory")

constexpr int DM = 1024, NB = 8, T = 4096, NL = 4, M = NB * T;
constexpr int INW = 5376;
constexpr int C_HGQ = 0, C_HGF = 512, C_HGI = 1024, C_HGO = 1536, C_DAQ = 2048, C_DAK = 2560, C_DAV = 3072, C_RW = 3584;
constexpr int C_RWR = C_RW, C_RWK = C_RW + 512, C_RWV = C_RW + 1024, C_RWWD = C_RW + 1536, C_RWAD = C_RW + 1600, C_RWGD = C_RW + 1664;
constexpr int NE = 16, DE = 512;
constexpr float ALPHA = 1.681792830507429f;
constexpr float LN_EPS = 1e-5f, RMS_EPS = 1e-6f, RW_GN_EPS = 64e-5f, HG_F_MIN = 1e-6f;
constexpr float LOG2E = 1.4426950408889634f;
constexpr float C2Q = 0.125f * LOG2E;

constexpr size_t MiB = 1u << 20;
constexpr size_t WS_CTL = 0, CTL_ZERO_BYTES = 1 * MiB;
constexpr size_t WS_MODP = 1 * MiB;
constexpr size_t WS_MOD = 7 * MiB;
constexpr size_t WS_SMALL = 8 * MiB;
constexpr size_t WS_TOK = 9 * MiB;
constexpr size_t WS_LORA = 11 * MiB;
constexpr int UP_ = 1536;
constexpr size_t WS_WA = 12 * MiB;
constexpr size_t WA_IN = 0, WA_MERGE = (size_t)INW * DM * 2, WA_BRANCH = WA_MERGE + (size_t)3 * DM * UP_ * 2, WA_OUT = WA_BRANCH + (size_t)DM * 1536 * 2, WA_END = WA_OUT + (size_t)DM * DM * 2;
constexpr size_t WS_WE = 40 * MiB;
constexpr size_t WE_GU = 0, WE_DT = (size_t)32 * MiB;
constexpr size_t WS_U = 88 * MiB;
constexpr size_t WS_PROJ = 184 * MiB;
constexpr size_t WS_OCAT = 520 * MiB;
constexpr size_t WS_OATT = 616 * MiB;
constexpr size_t WS_END = 680 * MiB;
constexpr size_t WS_GSCR = WS_PROJ;
constexpr size_t WS_MERGED = WS_PROJ + 96 * MiB;
constexpr size_t WS_MIX = WS_PROJ + 160 * MiB;
constexpr size_t WS_AS = WS_PROJ;
constexpr size_t WS_H = WS_PROJ + 224 * MiB;
constexpr size_t WS_Y = WS_OCAT;
constexpr int MAXROWS = 2 * M + NE * 256;
static_assert(WA_END <= 28 * MiB, "WA");
static_assert((size_t)MAXROWS * 2048 <= 160 * MiB && (size_t)MAXROWS * 1024 <= 112 * MiB, "moe buffers");

constexpr int CW_TMO = 0, CW_CODE = 1;
constexpr int CW_BAR = 4096;
constexpr int CW_ECNT = 16384;
constexpr int CW_AQ = 20480;

constexpr int RING_BYTES = 131072;
constexpr int LDSCTL_OFF = RING_BYTES, MISC_OFF = LDSCTL_OFF + 320;
constexpr int LDS_BYTES = 147456;
constexpr int NWAVES = 8, NTHR = 512;

__device__ __forceinline__ unsigned f2bf(float f) { unsigned u = __builtin_bit_cast(unsigned, f); return (u + 0x7fffu + ((u >> 16) & 1u)) >> 16; }
__device__ __forceinline__ unsigned pk2(float lo, float hi) { return f2bf(lo) | (f2bf(hi) << 16); }
__device__ __forceinline__ unsigned pk2a(float lo, float hi) { unsigned r; asm("v_cvt_pk_bf16_f32 %0, %1, %2" : "=v"(r) : "v"(lo), "v"(hi)); return r; }
__device__ __forceinline__ float tanh_fast(float x) { return 1.0f - 2.0f * __builtin_amdgcn_rcpf(1.0f + __expf(2.0f * x)); }
__device__ __forceinline__ float bf2f(unsigned short b) { return __builtin_bit_cast(float, ((unsigned)b) << 16); }
__device__ __forceinline__ float bflo(unsigned w) { return __builtin_bit_cast(float, w << 16); }
__device__ __forceinline__ float bfhi(unsigned w) { return __builtin_bit_cast(float, w & 0xffff0000u); }
__device__ __forceinline__ unsigned cvt_pk_bf16(float lo, float hi) { unsigned r; asm volatile("v_cvt_pk_bf16_f32 %0, %1, %2" : "=v"(r) : "v"(lo), "v"(hi)); return r; }
__device__ __forceinline__ float sigmoidf_(float x) { return __builtin_amdgcn_rcpf(1.0f + __expf(-x)); }
__device__ __forceinline__ float wave_sum(float v) {
#pragma unroll
    for (int o = 1; o < 64; o <<= 1) v += __shfl_xor(v, o);
    return v;
}

#define XB_TMO      128
#define XB_XCNT(j)  (256  + 64 * (j))
#define XB_XSUB(j)  (1280 + 64 * (j))
#define XB_XGEN(j)  (2304 + 64 * (j))
#define XB_TOP      3328
#define XB_TOPGEN   3392
#define XCD_BAR_WORDS 3456
#define XB_SPIN_CAP (1u << 20)

__device__ __forceinline__ unsigned xb_ld(unsigned* p)              { return __hip_atomic_load(p, __ATOMIC_RELAXED, __HIP_MEMORY_SCOPE_AGENT); }
__device__ __forceinline__ unsigned xb_add(unsigned* p, unsigned v) { return __hip_atomic_fetch_add(p, v, __ATOMIC_RELAXED, __HIP_MEMORY_SCOPE_AGENT); }
__device__ __forceinline__ unsigned xb_xcc_id() { return (unsigned)__builtin_amdgcn_s_getreg((3 << 11) | 20) & 0xFu; }
#define XB_SPIN(cond, bar) do { unsigned _sp = 0; while (cond) { __builtin_amdgcn_s_sleep(1); \
    if ((++_sp & 255u) == 0u) { if (xb_ld(&(bar)[XB_TMO])) break; if (_sp > XB_SPIN_CAP) { atomicAdd(&(bar)[XB_TMO], 1u); break; } } } } while (0)

struct XcdBarrier { unsigned* bar; unsigned x; volatile LAS unsigned* st; };

__device__ __forceinline__ XcdBarrier xcd_barrier_post(unsigned* bar, volatile LAS unsigned* st) {
    XcdBarrier b; b.bar = bar; b.x = xb_xcc_id(); b.st = st;
    if (threadIdx.x == 0) (void)xb_add(&bar[XB_XCNT(b.x)], 1u);
    return b;
}
__device__ __forceinline__ void xcd_barrier_complete(unsigned* bar, unsigned x, unsigned& nloc, unsigned& nx) {
    const unsigned G = gridDim.x * gridDim.y * gridDim.z;
    unsigned sum, cnt, mine, sp = 0u;
    for (;;) {
        sum = 0u; cnt = 0u; mine = 0u;
#pragma unroll 1
        for (unsigned j = 0; j < 16; ++j) { const unsigned c = xb_ld(&bar[XB_XCNT(j)]); sum += c; cnt += (c > 0u) ? 1u : 0u; mine = (j == x) ? c : mine; }
        if (sum == G) break;
        __builtin_amdgcn_s_sleep(1);
        if ((++sp & 255u) == 0u) { if (xb_ld(&bar[XB_TMO])) break; if (sp > XB_SPIN_CAP) { atomicAdd(&bar[XB_TMO], 1u); break; } }
    }
    nloc = mine > 0u ? mine : 1u; nx = cnt > 0u ? cnt : 1u;
}
__device__ __forceinline__ void xcd_barrier(const XcdBarrier& b) {
    asm volatile("s_waitcnt vmcnt(0)" ::: "memory");
    __syncthreads();
    if (threadIdx.x == 0) {
        unsigned* bar = b.bar;
        __builtin_amdgcn_s_waitcnt(0);
        unsigned nloc = b.st[0], nx = b.st[1];
        if (nloc == 0u) { xcd_barrier_complete(bar, b.x, nloc, nx); b.st[0] = nloc; b.st[1] = nx; }
        const unsigned old = xb_add(&bar[XB_XSUB(b.x)], 1u);
        const unsigned gen = old / nloc;
        if (old + 1u == (gen + 1u) * nloc) {
            __builtin_amdgcn_fence(__ATOMIC_RELEASE, "agent");
            asm volatile("s_waitcnt vmcnt(0)" ::: "memory");
            const unsigned og = xb_add(&bar[XB_TOP], 1u);
            const unsigned tg = og / nx;
            if (og + 1u == (tg + 1u) * nx) xb_add(&bar[XB_TOPGEN], 1u);
            else XB_SPIN(xb_ld(&bar[XB_TOPGEN]) == tg, bar);
            __builtin_amdgcn_fence(__ATOMIC_ACQUIRE, "agent");
            xb_add(&bar[XB_XGEN(b.x)], 1u);
            asm volatile("s_waitcnt vmcnt(0)" ::: "memory");
        } else {
            XB_SPIN(xb_ld(&bar[XB_XGEN(b.x)]) == gen, bar);
            __builtin_amdgcn_fence(__ATOMIC_ACQUIRE, "agent");
            asm volatile("s_waitcnt vmcnt(0)" ::: "memory");
        }
    }
    __syncthreads();
}
namespace pg8 {
#define PG8_LAS __attribute__((address_space(3)))
constexpr int BM = 256, BK = 64, HALF = 128, HTB = HALF * BK * 2, STAGE_BYTES = 8 * HTB, NXCD = 8, WGM = 8;
__host__ __device__ __forceinline__ int lds_byte(int r, int c) { const int st = (r >> 4) * 2 + (c >> 5), rr = r & 15, cc = c & 31, ob = rr * 64 + cc * 2; return st * 1024 + (ob ^ (((ob >> 9) & 1) << 5)); }
__host__ __device__ __forceinline__ void stage_rc(int b, int& R, int& C) { const int st = b / 1024, sb = b % 1024, swz = sb ^ (((sb >> 9) & 1) << 5); R = (st >> 1) * 16 + swz / 64; C = (st & 1) * 32 + (swz % 64) / 2; }
__host__ __device__ __forceinline__ int perm32(int rho) { const int n = rho >> 4, i = rho & 15; return 8 * (i >> 2) + 4 * n + (i & 3); }

struct GUnit {
    int kind;
    int r0, c0;
    int aux;
};
struct GOps {
    const char* A; const char* B; unsigned lda, ldb; int nt;
};
__device__ __forceinline__ bool static_tile(int nM, int nN, int G, int c, int i, int& pm, int& pn) {
    const int nwg = nM * nN; const long L = (long)i * G + c; if (L >= nwg) return false;
    int wgid = (int)L; { const int q = nwg / NXCD, r = nwg % NXCD, xcd = wgid % NXCD, off = wgid / NXCD; wgid = (xcd < r ? xcd * (q + 1) : r * (q + 1) + (xcd - r) * q) + off; }
    const int nig = WGM * nN, gid = wgid / nig, fm = gid * WGM, gsz = (nM - fm) < WGM ? (nM - fm) : WGM;
    pm = fm + ((wgid % nig) % gsz); pn = (wgid % nig) / gsz; return true;
}

template <bool VARLD, class Sched, class Epi>
__device__ __forceinline__ void gemm_phase(PG8_LAS unsigned char* lds, const Sched& S, const Epi& E) {
    int tid_ = threadIdx.x; asm volatile("" : "+v"(tid_));
    const int tid = tid_, wid = __builtin_amdgcn_readfirstlane(tid >> 6), lane = tid & 63, wr = wid >> 2, wc = wid & 3, fr = lane & 15, fq = lane >> 4;
    int R0, C0, R1, C1; stage_rc(tid * 16, R0, C0); stage_rc(tid * 16 + 8192, R1, C1);
    const int Rb0 = (R0 & ~31) + perm32(R0 & 31), Rb1 = (R1 & ~31) + perm32(R1 & 31);
    const unsigned ldsw = (unsigned)wid * 1024u;
    const int aoff = lds_byte(wr * 64 + fr, fq * 8), boff = lds_byte(wc * 32 + fr, fq * 8);
#define PG8_SA(b, h) (((b) * 2 + (h)) * HTB)
#define PG8_SB(b, h) ((4 + (b) * 2 + (h)) * HTB)
#define PG8_STAGE(bufoff, gbase, v0, v1) do { \
        __builtin_amdgcn_global_load_lds((const unsigned*)((const char*)(gbase) + (v0)), (PG8_LAS unsigned*)(lds + (bufoff) + ldsw), 16, 0, 0); \
        __builtin_amdgcn_global_load_lds((const unsigned*)((const char*)(gbase) + (v1)), (PG8_LAS unsigned*)(lds + (bufoff) + ldsw + 8192), 16, 0, 0); } while (0)
#define PG8_LDA(dst, b, h) do { _Pragma("unroll") for (int m = 0; m < 4; ++m) _Pragma("unroll") for (int k = 0; k < 2; ++k) dst[m][k] = *(const PG8_LAS bf16x8*)(lds + PG8_SA(b, h) + aoff + m * 2048 + k * 1024); } while (0)
#define PG8_LDB(dst, b, h) do { _Pragma("unroll") for (int n = 0; n < 2; ++n) _Pragma("unroll") for (int k = 0; k < 2; ++k) dst[n][k] = *(const PG8_LAS bf16x8*)(lds + PG8_SB(b, h) + boff + n * 2048 + k * 1024); } while (0)
#define PG8_MMA(ai, bj, At, Bt) do { __builtin_amdgcn_s_setprio(1); _Pragma("unroll") for (int m = 0; m < 4; ++m) _Pragma("unroll") for (int n = 0; n < 2; ++n) _Pragma("unroll") for (int k = 0; k < 2; ++k) \
        acc[ai][bj][m][n] = __builtin_amdgcn_mfma_f32_16x16x32_bf16(Bt[n][k], At[m][k], acc[ai][bj][m][n], 0, 0, 0); __builtin_amdgcn_s_setprio(0); } while (0)
#define PG8_WAIT_V(n) asm volatile("s_waitcnt vmcnt(" #n ")" ::: "memory")
#define PG8_WAIT_L(n) asm volatile("s_waitcnt lgkmcnt(" #n ")" ::: "memory")
#define PG8_BAR __builtin_amdgcn_s_barrier()
#define PG8_SCHED __builtin_amdgcn_sched_barrier(0)
    GUnit cur, nxt; GOps co, no_; int ui = 0;
    if (!S.next(0, cur, co)) return;
    f32x4 acc[2][2][4][2];
#pragma unroll
    for (int a = 0; a < 2; ++a)
#pragma unroll
        for (int b = 0; b < 2; ++b)
#pragma unroll
            for (int m = 0; m < 4; ++m)
#pragma unroll
                for (int n = 0; n < 2; ++n) acc[a][b][m][n] = (f32x4){0.f, 0.f, 0.f, 0.f};
    bf16x8 At[4][2], B0[2][2], B1[2][2];
    const char* cA = co.A; const char* cB = co.B;
    unsigned ldA = VARLD ? co.lda : Sched::LDA, ldB = VARLD ? co.ldb : Sched::LDB; int nt = (VARLD || Sched::VARNT) ? co.nt : Sched::NT;
    unsigned vA0 = (unsigned)R0 * ldA + (unsigned)C0 * 2u, vA1 = (unsigned)R1 * ldA + (unsigned)C1 * 2u;
    unsigned vB0 = (unsigned)Rb0 * ldB + (unsigned)C0 * 2u, vB1 = (unsigned)Rb1 * ldB + (unsigned)C1 * 2u;
    unsigned hA = (unsigned)HALF * ldA, hB = (unsigned)HALF * ldB;
    PG8_STAGE(PG8_SB(0, 0), cB, vB0, vB1); PG8_STAGE(PG8_SB(0, 1), cB + hB, vB0, vB1); PG8_STAGE(PG8_SA(0, 0), cA, vA0, vA1); PG8_STAGE(PG8_SA(0, 1), cA + hA, vA0, vA1);
    if (wr == 1) PG8_BAR;
    PG8_WAIT_V(2); PG8_BAR;
    PG8_STAGE(PG8_SB(1, 0), cB + 128, vB0, vB1); PG8_STAGE(PG8_SA(1, 0), cA + 128, vA0, vA1); PG8_STAGE(PG8_SB(1, 1), cB + hB + 128, vB0, vB1);
    PG8_WAIT_V(6); PG8_BAR;
    for (;;) {
        const bool has_next = S.next(ui + 1, nxt, no_);
        const char* nA = has_next ? no_.A : cA; const char* nB = has_next ? no_.B : cB;
        const unsigned nlda = (VARLD && has_next) ? no_.lda : ldA, nldb = (VARLD && has_next) ? no_.ldb : ldB;
        const int nnt = ((VARLD || Sched::VARNT) && has_next) ? no_.nt : nt;
        for (int t = 0; t < nt; t += 2) {
            const bool last = (t == nt - 2);
            if (Epi::HAS_MID) { PG8_SCHED; E.mid(acc, cur, t, wr, wc, fr, fq); PG8_SCHED; }
            const char* a1 = cA + (size_t)(t + 1) * 128;
            const char* a2 = last ? nA : cA + (size_t)(t + 2) * 128; const char* b2 = last ? nB : cB + (size_t)(t + 2) * 128;
            const char* a3 = a2 + 128; const char* b3 = b2 + 128;
            unsigned xA0 = vA0, xA1 = vA1, xB0 = vB0, xB1 = vB1, xhA = hA, xhB = hB;
            if (VARLD && last) { xA0 = (unsigned)R0 * nlda + (unsigned)C0 * 2u; xA1 = (unsigned)R1 * nlda + (unsigned)C1 * 2u; xB0 = (unsigned)Rb0 * nldb + (unsigned)C0 * 2u; xB1 = (unsigned)Rb1 * nldb + (unsigned)C1 * 2u; xhA = (unsigned)HALF * nlda; xhB = (unsigned)HALF * nldb; }
            PG8_LDB(B0, 0, 0); PG8_LDB(B1, 0, 1); PG8_SCHED; PG8_LDA(At, 0, 0); PG8_STAGE(PG8_SA(1, 1), a1 + hA, vA0, vA1);
            PG8_WAIT_V(8); PG8_WAIT_L(0); PG8_BAR; PG8_MMA(0, 0, At, B0); PG8_MMA(0, 1, At, B1); PG8_BAR; PG8_SCHED;
            PG8_LDA(At, 0, 1); PG8_STAGE(PG8_SB(0, 0), b2, xB0, xB1); PG8_STAGE(PG8_SB(0, 1), b2 + xhB, xB0, xB1); PG8_STAGE(PG8_SA(0, 0), a2, xA0, xA1);
            PG8_WAIT_V(8); PG8_WAIT_L(0); PG8_BAR; PG8_MMA(1, 0, At, B0); PG8_MMA(1, 1, At, B1); PG8_BAR; PG8_SCHED;
            PG8_LDB(B0, 1, 0); PG8_LDB(B1, 1, 1); PG8_SCHED; PG8_LDA(At, 1, 0); PG8_STAGE(PG8_SA(0, 1), a2 + xhA, xA0, xA1);
            PG8_WAIT_V(8); PG8_WAIT_L(0); PG8_BAR; PG8_MMA(0, 0, At, B0); PG8_MMA(0, 1, At, B1); PG8_BAR; PG8_SCHED;
            PG8_LDA(At, 1, 1); PG8_STAGE(PG8_SB(1, 0), b3, xB0, xB1); PG8_STAGE(PG8_SB(1, 1), b3 + xhB, xB0, xB1); PG8_STAGE(PG8_SA(1, 0), a3, xA0, xA1);
            PG8_WAIT_V(8); PG8_WAIT_L(0); PG8_BAR; PG8_MMA(1, 0, At, B0); PG8_MMA(1, 1, At, B1); PG8_BAR; PG8_SCHED;
        }
        if (wr == 0) PG8_BAR;
        PG8_SCHED; E(acc, cur, wr, wc, fr, fq); PG8_SCHED;
        if (!has_next) break;
#pragma unroll
        for (int a = 0; a < 2; ++a)
#pragma unroll
            for (int b = 0; b < 2; ++b)
#pragma unroll
                for (int m = 0; m < 4; ++m)
#pragma unroll
                    for (int n = 0; n < 2; ++n) acc[a][b][m][n] = (f32x4){0.f, 0.f, 0.f, 0.f};
        cur = nxt; cA = nA; cB = nB; ++ui;
        if (VARLD || Sched::VARNT) nt = nnt;
        if (VARLD) { ldA = nlda; ldB = nldb; vA0 = (unsigned)R0 * ldA + (unsigned)C0 * 2u; vA1 = (unsigned)R1 * ldA + (unsigned)C1 * 2u; vB0 = (unsigned)Rb0 * ldB + (unsigned)C0 * 2u; vB1 = (unsigned)Rb1 * ldB + (unsigned)C1 * 2u; hA = (unsigned)HALF * ldA; hB = (unsigned)HALF * ldB; }
        if (wr == 1) PG8_BAR;
    }
    PG8_WAIT_V(0);
    PG8_BAR;
#undef PG8_SA
#undef PG8_SB
#undef PG8_STAGE
#undef PG8_LDA
#undef PG8_LDB
#undef PG8_MMA
#undef PG8_WAIT_V
#undef PG8_WAIT_L
#undef PG8_BAR
#undef PG8_SCHED
}

template <int KM> struct Epi {
    static constexpr bool HAS_MID = (KM & 4) != 0;
    bf16* O; int ldc;
    float scale;
    const float* bias;
    v4u* gscr;
    __device__ __forceinline__ void mid(f32x4 (&acc)[2][2][4][2], const GUnit& u, int t, int wr, int wc, int fr, int fq) const {
        if (!(KM & 4) || u.kind != 2 || (t != 8 && t != 16)) return;
        const int sa = (t == 8) ? 0 : 1;
        const v4u* ga = gscr + ((size_t)sa * 512 + ((wr * 4 + wc) * 64 + fq * 16 + fr)) * 16; asm volatile("" : "+v"(ga)); const v4u* gb = ga + 16 * 512; asm volatile("" : "+v"(gb));
#pragma unroll
        for (int ai = 0; ai < 2; ++ai)
#pragma unroll
            for (int m = 0; m < 4; ++m) {
#pragma unroll
                for (int bj = 0; bj < 2; ++bj) { const int q = (ai * 4 + m) * 2 + bj; const v4u x = ga[q], y = gb[q];
                    f32x4 r0, r1;
                    r0[0] = bflo(x.x) * __builtin_amdgcn_rcpf(bflo(y.x)); r0[1] = bfhi(x.x) * __builtin_amdgcn_rcpf(bfhi(y.x)); r0[2] = bflo(x.y) * __builtin_amdgcn_rcpf(bflo(y.y)); r0[3] = bfhi(x.y) * __builtin_amdgcn_rcpf(bfhi(y.y));
                    r1[0] = bflo(x.z) * __builtin_amdgcn_rcpf(bflo(y.z)); r1[1] = bfhi(x.z) * __builtin_amdgcn_rcpf(bfhi(y.z)); r1[2] = bflo(x.w) * __builtin_amdgcn_rcpf(bflo(y.w)); r1[3] = bfhi(x.w) * __builtin_amdgcn_rcpf(bfhi(y.w));
                    acc[ai][bj][m][0] *= r0; acc[ai][bj][m][1] *= r1; }
                asm volatile("" ::: "memory"); }
    }
    __device__ __forceinline__ void operator()(f32x4 (&acc)[2][2][4][2], const GUnit& u, int wr, int wc, int fr, int fq) const {
        if ((KM & 1) && u.kind == 0) {
            const float sc = u.aux ? scale : 1.0f;
            const int row0 = u.r0 + wr * 64 + fr, col0 = u.c0 + wc * 32 + 8 * fq;
#pragma unroll
            for (int ai = 0; ai < 2; ++ai)
#pragma unroll
                for (int m = 0; m < 4; ++m) { bf16* rowp = O + (size_t)(row0 + ai * HALF + m * 16) * ldc + col0;
#pragma unroll
                    for (int bj = 0; bj < 2; ++bj) { const f32x4 v0 = acc[ai][bj][m][0] * sc, v1 = acc[ai][bj][m][1] * sc;
                        v4u w; w.x = cvt_pk_bf16(v0[0], v0[1]); w.y = cvt_pk_bf16(v0[2], v0[3]); w.z = cvt_pk_bf16(v1[0], v1[1]); w.w = cvt_pk_bf16(v1[2], v1[3]);
                        *(v4u*)(rowp + bj * HALF) = w; } }
        } else if ((KM & 2) && u.kind == 1) {
            const int bcol0 = u.c0 + wc * 32 + 8 * fq; const float* bp = bias + u.aux * 1024 + bcol0;
            v4u* gs = gscr + ((size_t)u.aux * 512 + ((wr * 4 + wc) * 64 + fq * 16 + fr)) * 16; asm volatile("" : "+v"(gs));
#pragma unroll
            for (int bj = 0; bj < 2; ++bj) { const f32x4 b0 = *(const f32x4*)(bp + bj * HALF), b1 = *(const f32x4*)(bp + bj * HALF + 4);
#pragma unroll
                for (int ai = 0; ai < 2; ++ai)
#pragma unroll
                    for (int m = 0; m < 4; ++m) { const f32x4 z0 = acc[ai][bj][m][0] + b0, z1 = acc[ai][bj][m][1] + b1; float g[8];
#pragma unroll
                        for (int j = 0; j < 4; ++j) { g[j] = fmaxf(sigmoidf_(z0[j]), 1e-30f); g[4 + j] = fmaxf(sigmoidf_(z1[j]), 1e-30f); }
                        v4u w; w.x = cvt_pk_bf16(g[0], g[1]); w.y = cvt_pk_bf16(g[2], g[3]); w.z = cvt_pk_bf16(g[4], g[5]); w.w = cvt_pk_bf16(g[6], g[7]);
                        gs[(ai * 4 + m) * 2 + bj] = w; } }
        } else if ((KM & 4) && u.kind == 2) {
            const v4u* gc = gscr + ((size_t)2 * 512 + ((wr * 4 + wc) * 64 + fq * 16 + fr)) * 16; asm volatile("" : "+v"(gc));
            const int row0 = u.r0 + wr * 64 + fr, col0 = u.c0 + wc * 32 + 8 * fq;
#pragma unroll
            for (int ai = 0; ai < 2; ++ai)
#pragma unroll
                for (int m = 0; m < 4; ++m) { bf16* rowp = O + (size_t)(row0 + ai * HALF + m * 16) * ldc + col0;
#pragma unroll
                    for (int bj = 0; bj < 2; ++bj) { const v4u y = gc[(ai * 4 + m) * 2 + bj]; const f32x4 a0 = acc[ai][bj][m][0], a1 = acc[ai][bj][m][1];
                        v4u w; w.x = cvt_pk_bf16(a0[0] * bflo(y.x), a0[1] * bfhi(y.x)); w.y = cvt_pk_bf16(a0[2] * bflo(y.y), a0[3] * bfhi(y.y));
                        w.z = cvt_pk_bf16(a1[0] * bflo(y.z), a1[1] * bfhi(y.z)); w.w = cvt_pk_bf16(a1[2] * bflo(y.w), a1[3] * bfhi(y.w));
                        *(v4u*)(rowp + bj * HALF) = w; }
                    asm volatile("" ::: "memory"); }
        } else if (KM & 8) {
            const int row0 = u.r0 + wr * 64 + fr, col0 = u.c0 + wc * 32 + 8 * fq;
#pragma unroll
            for (int ai = 0; ai < 2; ++ai)
#pragma unroll
                for (int m = 0; m < 4; ++m) { bf16* rowp = O + (size_t)(row0 + ai * HALF + m * 16) * ldc + col0; float hv[8];
#pragma unroll
                    for (int n = 0; n < 2; ++n)
#pragma unroll
                        for (int j = 0; j < 4; ++j) { const float gt = acc[ai][0][m][n][j], up = acc[ai][1][m][n][j]; hv[n * 4 + j] = gt * sigmoidf_(gt) * up; }
                    v4u w; w.x = cvt_pk_bf16(hv[0], hv[1]); w.y = cvt_pk_bf16(hv[2], hv[3]); w.z = cvt_pk_bf16(hv[4], hv[5]); w.w = cvt_pk_bf16(hv[6], hv[7]);
                    *(v4u*)rowp = w; }
        }
    }
};
}
namespace attn_body {
using bf16=__hip_bfloat16;
using bf16x8=__attribute__((ext_vector_type(8)))short;
using s16x4=__attribute__((ext_vector_type(4)))short;
using f32x16=__attribute__((ext_vector_type(16)))float;
using u32x4=__attribute__((ext_vector_type(4)))unsigned;
constexpr int SEQ=4096,D=64,PQ=5376,PO=1024;
constexpr int NW=8,QBLK=32,QB=QBLK*NW,KVBLK=64,NQB=SEQ/QB;
constexpr int ATTN_UNIT_ROWS=QB;
__device__ __forceinline__ int crow(int r,int hi){return (r&3)+8*(r>>2)+4*hi;}
#define SBAR() __builtin_amdgcn_sched_barrier(0)
__device__ __forceinline__ void cmask(f32x16&p0,f32x16&p1,int jb,int qrel,int hi){
  const float NEG=-INFINITY; int kb=64*jb+4*hi;
  #pragma unroll
  for(int r=0;r<16;++r){int kv=kb+(r&3)+8*(r>>2); if(kv>qrel)p0[r]=NEG; if(kv+32>qrel)p1[r]=NEG;}
}

constexpr int NSLOT=3, SLOTB=8192;
constexpr int LDS_K=0, LDS_V=NSLOT*SLOTB, LDS_WS=2*NSLOT*SLOTB, LDS_OST=LDS_WS+NW*64*4, LDS_BYTES=LDS_OST+NW*4096;
constexpr float C2=0.125f*1.4426950408889634f;
__device__ __forceinline__ void glds16(const void*gsrc,unsigned lds_dst){unsigned keep;
  asm volatile("s_mov_b32 %0, m0\n\ts_mov_b32 m0, %2\n\ts_nop 0\n\tglobal_load_lds_dwordx4 %1, off\n\ts_mov_b32 m0, %0":"=&s"(keep):"v"(gsrc),"s"(lds_dst):"memory");}
__device__ __forceinline__ float max3f(float a,float b,float c){float r;asm("v_max3_f32 %0, %1, %2, %3":"=v"(r):"v"(a),"v"(b),"v"(c));return r;}
__device__ __forceinline__ float max2f(float a,float b){float r;asm("v_max_f32_e32 %0, %1, %2":"=v"(r):"v"(a),"v"(b));return r;}
__device__ __forceinline__ float fadd_s(float a,float b){float r;asm("v_add_f32_e32 %0, %1, %2":"=v"(r):"v"(a),"v"(b));return r;}
__device__ __forceinline__ float fsub_s(float a,float b){float r;asm("v_sub_f32_e32 %0, %1, %2":"=v"(r):"v"(a),"v"(b));return r;}
typedef float f32x2_t __attribute__((ext_vector_type(2))); typedef __bf16 bf16x2_t __attribute__((ext_vector_type(2)));
__device__ __forceinline__ unsigned cvtpk_s(float lo,float hi){f32x2_t v={lo,hi};bf16x2_t b=__builtin_convertvector(v,bf16x2_t);return __builtin_bit_cast(unsigned,b);}
#define WAIT_BAR(N) asm volatile("s_waitcnt vmcnt(" #N ") lgkmcnt(0)\n\ts_barrier":::"memory")

__device__ __forceinline__ void qkt(f32x16&p0,f32x16&p1,const char*Kslot,const bf16x8*qr,int r32,int hi){ const f32x16 negm=f32x16{};
  const char*kb=Kslot+hi*1024+r32*16;
  #pragma unroll
  for(int d0=0;d0<4;++d0){
    const bf16x8 b0=*reinterpret_cast<const bf16x8*>(kb+d0*2048);
    const bf16x8 b1=*reinterpret_cast<const bf16x8*>(kb+d0*2048+512);
    if(d0==0){p0=__builtin_amdgcn_mfma_f32_32x32x16_bf16(b0,qr[0],negm,0,0,0);p1=__builtin_amdgcn_mfma_f32_32x32x16_bf16(b1,qr[0],negm,0,0,0);}
    else{p0=__builtin_amdgcn_mfma_f32_32x32x16_bf16(b0,qr[d0],p0,0,0,0);p1=__builtin_amdgcn_mfma_f32_32x32x16_bf16(b1,qr[d0],p1,0,0,0);}}
}
typedef __attribute__((address_space(3))) const char* lds_cptr;
typedef short v4i16_t __attribute__((ext_vector_type(4)));
__device__ __forceinline__ void kload8(bf16x8*kf,lds_cptr kp){
  kf[0]=*(const __attribute__((address_space(3))) bf16x8*)(kp);      kf[1]=*(const __attribute__((address_space(3))) bf16x8*)(kp+512);
  kf[2]=*(const __attribute__((address_space(3))) bf16x8*)(kp+2048); kf[3]=*(const __attribute__((address_space(3))) bf16x8*)(kp+2560);
  kf[4]=*(const __attribute__((address_space(3))) bf16x8*)(kp+4096); kf[5]=*(const __attribute__((address_space(3))) bf16x8*)(kp+4608);
  kf[6]=*(const __attribute__((address_space(3))) bf16x8*)(kp+6144); kf[7]=*(const __attribute__((address_space(3))) bf16x8*)(kp+6656);
}
__device__ __forceinline__ void kload2(bf16x8*kf,lds_cptr kp,int j){ kf[2*j]=*(const __attribute__((address_space(3))) bf16x8*)(kp+j*2048); kf[2*j+1]=*(const __attribute__((address_space(3))) bf16x8*)(kp+j*2048+512); }
__device__ __forceinline__ s16x4 vtr(lds_cptr p){ return __builtin_bit_cast(s16x4,__builtin_amdgcn_ds_read_tr16_b64_v4i16((__attribute__((address_space(3))) v4i16_t*)p)); }
__device__ __forceinline__ float rowmax(const f32x16&p0,const f32x16&p1){
  float a=max3f(p0[0],p0[1],p1[0]),b=max3f(p0[2],p0[3],p1[1]);a=max3f(a,p1[2],p1[3]);
  #pragma unroll
  for(int r=4;r<16;r+=4){a=max3f(a,p0[r],p0[r+1]);b=max3f(b,p0[r+2],p0[r+3]);a=max3f(a,p1[r],p1[r+1]);b=max3f(b,p1[r+2],p1[r+3]);}
  const float m=max2f(a,b);
  auto rr=__builtin_amdgcn_permlane32_swap(__float_as_uint(m),__float_as_uint(m),false,false);
  return max2f(__uint_as_float(rr[0]),__uint_as_float(rr[1]));
}
__device__ __forceinline__ void pv(f32x16*o,int vb,bf16x8 pa0,bf16x8 pa1,bf16x8 pa2,bf16x8 pa3){
  #pragma unroll
  for(int d0=0;d0<2;++d0){s16x4 lo[4],hi[4];
    #pragma unroll
    for(int ks=0;ks<4;++ks){
      asm volatile("ds_read_b64_tr_b16 %0,%1 offset:%c2":"=&v"(lo[ks]):"v"(vb),"i"(d0*4096+ks*1024):"memory");
      asm volatile("ds_read_b64_tr_b16 %0,%1 offset:%c2":"=&v"(hi[ks]):"v"(vb),"i"(d0*4096+ks*1024+512):"memory");}
    asm volatile("s_waitcnt lgkmcnt(0)":::"memory");SBAR();
    #define PK(k) (bf16x8){lo[k][0],lo[k][1],lo[k][2],lo[k][3],hi[k][0],hi[k][1],hi[k][2],hi[k][3]}
    o[d0]=__builtin_amdgcn_mfma_f32_32x32x16_bf16(pa0,PK(0),o[d0],0,0,0);
    o[d0]=__builtin_amdgcn_mfma_f32_32x32x16_bf16(pa1,PK(1),o[d0],0,0,0);
    o[d0]=__builtin_amdgcn_mfma_f32_32x32x16_bf16(pa2,PK(2),o[d0],0,0,0);
    o[d0]=__builtin_amdgcn_mfma_f32_32x32x16_bf16(pa3,PK(3),o[d0],0,0,0);
    #undef PK
  }
}

#ifndef ATTN_STORE16
#define ATTN_STORE16(p,v) (*(u32x4*)(p)=(v))
#endif
template<int THRL> __device__ __forceinline__ void attn_unit(int b,int qcol,int kcol,int vcol,int ocol,float slope2,int qb,const bf16*__restrict__ P,bf16*O,char*shm){
  int tid_=threadIdx.x; asm volatile("":"+v"(tid_));
  const int tid=tid_,lane=tid&63,r32=lane&31,hi=lane>>5; const int wid=__builtin_amdgcn_readfirstlane(tid>>6);
  const long rowbase=(long)b*SEQ; const int q0=qb*QB;
  const bf16*Qw=P+(rowbase+q0+wid*QBLK)*PQ+qcol;
  const bf16*Kh=P+rowbase*PQ+kcol,*Vh=P+rowbase*PQ+vcol;
  const unsigned lds0=(unsigned)(uintptr_t)shm;
  float*wsf=(float*)(shm+LDS_WS)+wid*64;
  const bf16*ksrc=Kh+(long)lane*PQ+wid*8;
  const bf16*vsrc=Vh+(long)(16*(wid&3)+(lane>>2))*PQ+(wid>>2)*32+(lane&3)*8;
  const unsigned kdst=lds0+LDS_K+wid*1024, vdst=lds0+LDS_V+wid*1024;
  #define DMA_K(t,slot) glds16(ksrc+(long)(t)*KVBLK*PQ,(unsigned)__builtin_amdgcn_readfirstlane(kdst+(slot)))
  #define DMA_V(t,slot) glds16(vsrc+(long)(t)*KVBLK*PQ,(unsigned)__builtin_amdgcn_readfirstlane(vdst+(slot)))
  const int vb0=(int)(lds0+LDS_V)+((lane>>4)&1)*32+(lane&3)*8+(4*hi+((lane&15)>>2))*64;
  const char*Kbase=shm+LDS_K; bf16x8 kf[8];
  const lds_cptr shm3=(lds_cptr)shm; const lds_cptr kp0=shm3+LDS_K+hi*1024+r32*16; const lds_cptr vp0=shm3+LDS_V+((lane>>4)&1)*32+(lane&3)*8+(4*hi+((lane&15)>>2))*64;
  const int NT=(q0+QB)/KVBLK;
  DMA_K(0,0);DMA_V(0,0);DMA_K(1,SLOTB);
  bf16x8 qr[4];
  #pragma unroll
  for(int d0=0;d0<4;++d0)qr[d0]=*reinterpret_cast<const bf16x8*>(&Qw[(long)r32*PQ+d0*16+hi*8]);
  float mhat=0.f,l_reg=0.f;f32x16 o[2];o[0]=f32x16{};o[1]=f32x16{};const f32x16 negm=f32x16{};
  const float sr1_=__builtin_bit_cast(float,__builtin_amdgcn_readfirstlane(__builtin_bit_cast(int,slope2))), sr2_=__builtin_bit_cast(float,__builtin_amdgcn_readfirstlane(__builtin_bit_cast(int,2.f*slope2))), sr3_=__builtin_bit_cast(float,__builtin_amdgcn_readfirstlane(__builtin_bit_cast(int,3.f*slope2)));
  const float hib=slope2*(float)(4*hi);
  #define ALIBI(P0,P1,t) do{ const float tm0_=slope2*(float)(64*(t))+hib-mhat; \
    _Pragma("unroll") for(int q_=0;q_<4;++q_){ const float a_=tm0_+(8.f*slope2)*(float)q_, b_=a_+32.f*slope2; \
      P0[4*q_]+=a_; P0[4*q_+1]=(P0[4*q_+1]+a_)+sr1_; P0[4*q_+2]=(P0[4*q_+2]+a_)+sr2_; P0[4*q_+3]=(P0[4*q_+3]+a_)+sr3_; \
      P1[4*q_]+=b_; P1[4*q_+1]=(P1[4*q_+1]+b_)+sr1_; P1[4*q_+2]=(P1[4*q_+2]+b_)+sr2_; P1[4*q_+3]=(P1[4*q_+3]+b_)+sr3_; } }while(0)
  const int qrel=wid*QBLK+r32;
  #define CMASK(P0,P1,t) do{int jb_=(t)-(NT-4); if(jb_>=0)cmask(P0,P1,jb_,qrel,hi);}while(0)
  bool resc=false;
  #define START(P0,P1) do{ const float rm=rowmax(P0,P1); resc=false; \
    { const float dl=rm; mhat=fadd_s(mhat,dl); \
      _Pragma("unroll") for(int r=0;r<16;++r){P0[r]=fsub_s(P0[r],dl);P1[r]=fsub_s(P1[r],dl);} \
      } \
    _Pragma("unroll") for(int r=0;r<16;++r)P0[r]=__builtin_amdgcn_exp2f(P0[r]); }while(0)
  #define RESC() do{ if(resc){ asm volatile("s_waitcnt lgkmcnt(0)":::"memory"); \
      _Pragma("unroll") for(int d_=0;d_<2;++d_) _Pragma("unroll") for(int r=0;r<16;++r)o[d_][r]*=wsf[crow(r,hi)]; } }while(0)
  f32x16 pA0,pA1,pB0,pB1;
  int sl_prev=0,sl_cur=0,sl_next=SLOTB;
  #define ROT() do{sl_prev=sl_cur;sl_cur=sl_next;sl_next=(sl_next==(NSLOT-1)*SLOTB)?0:sl_next+SLOTB;}while(0)
  DMA_K(2,2*SLOTB);
  WAIT_BAR(3);
  qkt(pA0,pA1,Kbase,qr,r32,hi);asm volatile("s_nop 15\n\ts_nop 7":"+v"(pA0),"+v"(pA1));ALIBI(pA0,pA1,0);asm volatile("":"+v"(pA0),"+v"(pA1));CMASK(pA0,pA1,0);
  START(pA0,pA1);
  _Pragma("unroll") for(int r=0;r<16;++r)pA1[r]=__builtin_amdgcn_exp2f(pA1[r]);
  WAIT_BAR(0);
  DMA_K(3,0);DMA_V(1,SLOTB);
  ROT();
  kload8(kf,kp0+sl_cur);
  WAIT_BAR(2);
  s16x4 vlo[8],vhi[8]; u32x4 pw0,pw1,pw2,pw3;
  #define PKW(P,B) cvtpk_s(P[B],P[B+1])
  #define PAF(k) __builtin_bit_cast(bf16x8,pw##k)
  #define VFR(i) (bf16x8){vlo[i][0],vlo[i][1],vlo[i][2],vlo[i][3],vhi[i][0],vhi[i][1],vhi[i][2],vhi[i][3]}
  #define PIN(x) asm volatile("":"+v"(x))
  #define MX3(a,b,c) __builtin_fmaxf(__builtin_fmaxf((a),(b)),(c))
  #define GAPA(MF,A0,A1,A2,A3,W0,W1,PW) do{ MF; sacc+=A0; sacc+=A1; sacc+=A2; sacc+=A3; PIN(sacc); W0; W1; PIN(PW); SBAR(); }while(0)
  #define EX(v) __builtin_amdgcn_exp2f(v)
  #define GAPB(MF,X,B) do{ MF; X[B]=EX(X[B]); X[B+1]=EX(X[B+1]); X[B+2]=EX(X[B+2]); X[B+3]=EX(X[B+3]); PIN(X); SBAR(); }while(0)
  #define VRD(i) do{ vlo[i]=vtr(vp_+(((i)>>2)*4096+((i)&3)*1024)); vhi[i]=vtr(vp_+(((i)>>2)*4096+((i)&3)*1024+512)); }while(0)
  #define KRD(G,j) do{ if(G){ kload2(kf,kp0+sl_next,j); SBAR(); } }while(0)
  #define STEP(C0,C1,P0,P1,t,GK,GV,GL) do{ SBAR(); \
    const lds_cptr vp_=vp0+sl_prev; \
    VRD(0); SBAR(); float sacc=(P0[0]+P0[1]); \
    GAPA(C0=__builtin_amdgcn_mfma_f32_32x32x16_bf16(kf[0],qr[0],negm,0,0,0), P0[2],P0[3],P0[4],P0[5],     pw0[0]=PKW(P0,0), pw0[1]=PKW(P0,2), pw0); \
    VRD(4); SBAR(); GAPA(C1=__builtin_amdgcn_mfma_f32_32x32x16_bf16(kf[1],qr[0],negm,0,0,0), P0[6],P0[7],P0[8],P0[9],     pw0[2]=PKW(P0,4), pw0[3]=PKW(P0,6), pw0); \
    VRD(1); SBAR(); GAPA(C0=__builtin_amdgcn_mfma_f32_32x32x16_bf16(kf[2],qr[1],C0,0,0,0),   P0[10],P0[11],P0[12],P0[13], pw1[0]=PKW(P0,8), pw1[1]=PKW(P0,10), pw1); \
    VRD(5); SBAR(); GAPA(C1=__builtin_amdgcn_mfma_f32_32x32x16_bf16(kf[3],qr[1],C1,0,0,0),   P0[14],P0[15],P1[0],P1[1],   pw1[2]=PKW(P0,12),pw1[3]=PKW(P0,14), pw1); \
    VRD(2); SBAR(); GAPA(C0=__builtin_amdgcn_mfma_f32_32x32x16_bf16(kf[4],qr[2],C0,0,0,0),   P1[2],P1[3],P1[4],P1[5],     pw2[0]=PKW(P1,0), pw2[1]=PKW(P1,2), pw2); \
    VRD(6); SBAR(); GAPA(C1=__builtin_amdgcn_mfma_f32_32x32x16_bf16(kf[5],qr[2],C1,0,0,0),   P1[6],P1[7],P1[8],P1[9],     pw2[2]=PKW(P1,4), pw2[3]=PKW(P1,6), pw2); \
    VRD(3); SBAR(); GAPA(C0=__builtin_amdgcn_mfma_f32_32x32x16_bf16(kf[6],qr[3],C0,0,0,0),   P1[10],P1[11],P1[12],P1[13], pw3[0]=PKW(P1,8), pw3[1]=PKW(P1,10), pw3); \
    VRD(7); SBAR(); GAPA(C1=__builtin_amdgcn_mfma_f32_32x32x16_bf16(kf[7],qr[3],C1,0,0,0),   P1[14],P1[15],0.f,0.f,       pw3[2]=PKW(P1,12),pw3[3]=PKW(P1,14), pw3); \
    l_reg+=sacc; \
    if(GK){DMA_K((t)+3,sl_cur);} if(GV){DMA_V((t)+1,sl_next);} \
    ALIBI(C0,C1,t); CMASK(C0,C1,t); \
    { float a=MX3(C0[0],C0[1],C1[0]),b=MX3(C0[2],C0[3],C1[1]); a=MX3(a,C1[2],C1[3]); \
      _Pragma("unroll") for(int r=4;r<16;r+=4){a=MX3(a,C0[r],C0[r+1]);b=MX3(b,C0[r+2],C0[r+3]);a=MX3(a,C1[r],C1[r+1]);b=MX3(b,C1[r+2],C1[r+3]);} \
      float rm=__builtin_fmaxf(a,b); { auto rr=__builtin_amdgcn_permlane32_swap(__float_as_uint(rm),__float_as_uint(rm),false,false); rm=__builtin_fmaxf(__uint_as_float(rr[0]),__uint_as_float(rr[1])); } \
      resc=false; \
      if(__builtin_expect(__any(rm>(float)THRL),0)){ const float dl=__builtin_fmaxf(rm,0.f); mhat+=dl; \
        _Pragma("unroll") for(int r=0;r<16;++r){C0[r]-=dl;C1[r]-=dl;} \
        const float f=__builtin_amdgcn_exp2f(-dl); l_reg*=f; if(hi==0)wsf[r32]=f; resc=true; } } \
    SBAR(); \
    GAPB(o[0]=__builtin_amdgcn_mfma_f32_32x32x16_bf16(PAF(0),VFR(0),o[0],0,0,0), C0,0); \
    GAPB(o[1]=__builtin_amdgcn_mfma_f32_32x32x16_bf16(PAF(0),VFR(4),o[1],0,0,0), C0,4); \
    KRD(GL,0); GAPB(o[0]=__builtin_amdgcn_mfma_f32_32x32x16_bf16(PAF(1),VFR(1),o[0],0,0,0), C0,8); \
    KRD(GL,1); GAPB(o[1]=__builtin_amdgcn_mfma_f32_32x32x16_bf16(PAF(1),VFR(5),o[1],0,0,0), C0,12); \
    KRD(GL,2); GAPB(o[0]=__builtin_amdgcn_mfma_f32_32x32x16_bf16(PAF(2),VFR(2),o[0],0,0,0), C1,0); \
    KRD(GL,3); GAPB(o[1]=__builtin_amdgcn_mfma_f32_32x32x16_bf16(PAF(2),VFR(6),o[1],0,0,0), C1,4); \
    GAPB(o[0]=__builtin_amdgcn_mfma_f32_32x32x16_bf16(PAF(3),VFR(3),o[0],0,0,0), C1,8); \
    GAPB(o[1]=__builtin_amdgcn_mfma_f32_32x32x16_bf16(PAF(3),VFR(7),o[1],0,0,0), C1,12); \
    }while(0)
  int t=1;
  #undef CMASK
  #define CMASK(P0,P1,t) do{}while(0)
  for(;t+5<NT;t+=2){
    STEP(pB0,pB1,pA0,pA1,t,true,true,true);     WAIT_BAR(2); RESC(); ROT();
    STEP(pA0,pA1,pB0,pB1,t+1,true,true,true);   WAIT_BAR(2); RESC(); ROT();
  }
  #undef CMASK
  #define CMASK(P0,P1,t) do{int jb_=(t)-(NT-4); if(jb_>=0)cmask(P0,P1,jb_,qrel,hi);}while(0)
  #define ENDW(tt) do{ if((tt)+3<NT){WAIT_BAR(2);} else if((tt)+2<NT){WAIT_BAR(1);} else {WAIT_BAR(0);} }while(0)
  for(;t+1<NT;t+=2){
    STEP(pB0,pB1,pA0,pA1,t,(t+3<NT),(t+1<NT),(t+1<NT));       ENDW(t);   RESC(); ROT();
    STEP(pA0,pA1,pB0,pB1,t+1,(t+4<NT),(t+2<NT),(t+2<NT));     ENDW(t+1); RESC(); ROT();
  }
  STEP(pB0,pB1,pA0,pA1,NT-1,false,false,false); RESC();
  { float sacc=pB0[0]+pB0[1]; _Pragma("unroll") for(int r=2;r<16;++r)sacc+=pB0[r]; _Pragma("unroll") for(int r=0;r<16;++r)sacc+=pB1[r]; l_reg+=sacc;
    pw0=(u32x4){PKW(pB0,0),PKW(pB0,2),PKW(pB0,4),PKW(pB0,6)};pw1=(u32x4){PKW(pB0,8),PKW(pB0,10),PKW(pB0,12),PKW(pB0,14)};pw2=(u32x4){PKW(pB1,0),PKW(pB1,2),PKW(pB1,4),PKW(pB1,6)};pw3=(u32x4){PKW(pB1,8),PKW(pB1,10),PKW(pB1,12),PKW(pB1,14)};
    SBAR(); pv(o,vb0+sl_cur,PAF(0),PAF(1),PAF(2),PAF(3)); }
  #undef PKW
  #undef PAF
  #undef VFR
  #undef PIN
  #undef MX3
  #undef GAPA
  #undef GAPB
  #undef EX
  #undef VRD
  #undef KRD
  #undef STEP
  #undef ENDW
  {auto rr=__builtin_amdgcn_permlane32_swap(__float_as_uint(l_reg),__float_as_uint(l_reg),false,false);l_reg=__uint_as_float(rr[0])+__uint_as_float(rr[1]);}
  if(hi==0)wsf[32+r32]=l_reg;asm volatile("s_waitcnt lgkmcnt(0)":::"memory");
  float rli[16];
  #pragma unroll
  for(int r=0;r<16;++r)rli[r]=__builtin_amdgcn_rcpf(wsf[32+crow(r,hi)]);
  bf16*Ow=O+(rowbase+q0+wid*QBLK)*PO+ocol;
  { bf16*stg=(bf16*)(shm+LDS_OST)+wid*2048;
    #pragma unroll
    for(int r=0;r<16;++r){const int orow=crow(r,hi);
      #pragma unroll
      for(int d0=0;d0<2;++d0)stg[orow*64+d0*32+r32]=__float2bfloat16(o[d0][r]*rli[r]);}
    asm volatile("s_waitcnt lgkmcnt(0)":::"memory");
    #pragma unroll
    for(int i=0;i<4;++i){const int row=i*8+(lane>>3),ch=lane&7; const u32x4 v=*(const u32x4*)(stg+row*64+ch*8); ATTN_STORE16(Ow+(long)row*PO+ch*8,v);} }
  asm volatile("s_waitcnt lgkmcnt(0)\n\ts_barrier":::"memory");
  #undef DMA_K
  #undef DMA_V
  #undef CMASK
  #undef START
  #undef RESC
  #undef ROT
  #undef ALIBI
}
constexpr int ATTN_LDS_BYTES=LDS_BYTES;
#undef SBAR
#undef WAIT_BAR
}
struct MixP {
    const bf16* proj; bf16* ocat; bf16* oatt;
    const float* hg_lb;
    const float* hg_norm_g;
    float lam, one_m_lam_init;
    const float* da_subln_g;
    const float *rw_mu, *rw_w0, *rw_a0, *rw_k_k, *rw_k_a, *rw_r_k, *rw_gn_g, *rw_gn_b;
    const bf16 *wupT, *aupT, *gupT;
    gu32* aq;
};

__device__ __forceinline__ void attn_group(const MixP& P, int b, int h, int qb, char* lds) {
    const float slope2 = exp2f(-2.0f * (float)(h + 1)) * LOG2E;
    const float s2 = __builtin_bit_cast(float, __builtin_amdgcn_readfirstlane(__builtin_bit_cast(int, slope2)));
    const attn_body::bf16* pr = (const attn_body::bf16*)P.proj; attn_body::bf16* oa = (attn_body::bf16*)P.oatt;
#pragma unroll 1
    for (int sub = 0; sub < 4; ++sub) {
        const int mp = sub >> 1, hf = sub & 1;
        attn_body::attn_unit<8>(b, C_DAQ + h * 128 + mp * 64, C_DAK + h * 128 + mp * 64, C_DAV + h * 128 + hf * 64, h * 256 + mp * 128 + hf * 64, s2, qb, pr, oa, lds);
    }
    VM_WAIT(); __syncthreads();
    {
        int tid_ = threadIdx.x; asm volatile("" : "+v"(tid_)); const int tid = tid_, row = tid >> 1, hf = tid & 1;
        const size_t grow = (size_t)b * T + (size_t)qb * 256 + row;
        const bf16* o0 = P.oatt + grow * 1024 + h * 256 + hf * 64; const bf16* o1 = o0 + 128;
        float v[64]; float ss = 0.f;
#pragma unroll
        for (int c = 0; c < 8; ++c) { const v4u x = __builtin_nontemporal_load((const v4u*)(o0) + c), y = __builtin_nontemporal_load((const v4u*)(o1) + c);
            const unsigned xs[4] = {x.x, x.y, x.z, x.w}, ys[4] = {y.x, y.y, y.z, y.w};
#pragma unroll
            for (int j = 0; j < 4; ++j) { const float a = bflo(xs[j]) - P.lam * bflo(ys[j]), d = bfhi(xs[j]) - P.lam * bfhi(ys[j]); v[c * 8 + 2 * j] = a; v[c * 8 + 2 * j + 1] = d; ss += a * a + d * d; } }
        ss += __shfl_xor(ss, 1);
        const float rs = rsqrtf(ss * (1.0f / 128.0f) + RMS_EPS) * P.one_m_lam_init;
        bf16* dst = P.ocat + grow * 1536 + 512 + h * 128 + hf * 64; const float* g = P.da_subln_g + hf * 64;
#pragma unroll
        for (int c = 0; c < 8; ++c) { v4u w; w.x = pk2(v[c * 8 + 0] * rs * g[c * 8 + 0], v[c * 8 + 1] * rs * g[c * 8 + 1]); w.y = pk2(v[c * 8 + 2] * rs * g[c * 8 + 2], v[c * 8 + 3] * rs * g[c * 8 + 3]);
            w.z = pk2(v[c * 8 + 4] * rs * g[c * 8 + 4], v[c * 8 + 5] * rs * g[c * 8 + 5]); w.w = pk2(v[c * 8 + 6] * rs * g[c * 8 + 6], v[c * 8 + 7] * rs * g[c * 8 + 7]);
            *((v4u*)dst + c) = w; }
    }
    __syncthreads();
}
__device__ __forceinline__ void attn_worker(const MixP& P, char* lds, volatile LAS unsigned* bcast, int tid) {
    for (;;) {
        if (tid == 0) bcast[0] = __hip_atomic_fetch_add(P.aq, 1u, RLX_AGENT);
        __syncthreads();
        const unsigned idx = bcast[0];
        __syncthreads();
        if (idx >= 512u) break;
        const int qb = 15 - (int)(idx >> 5), bh = (int)(idx & 31u);
        attn_group(P, bh >> 2, bh & 3, qb, lds);
    }
}

constexpr int HG_QH = 0, HG_QT = 17408, HG_KT = 34816, HG_KHT = 52224, HG_VV = 70656, HG_OG = 88064, HG_AM = 105472, HG_BQ = 114688, HG_SS = 116736, HG_DD = 118784, HG_END = 119296;
constexpr int HS = 272, HS2 = 144;
__device__ __forceinline__ s16x4 tr_rd(unsigned addr) { s16x4 r; asm volatile("ds_read_b64_tr_b16 %0, %1\n\ts_waitcnt lgkmcnt(0)" : "=&v"(r) : "v"(addr) : "memory"); return r; }
__device__ __forceinline__ void hgrn_unit(const MixP& P, int b, int h, LAS unsigned char* lds) {
    int tid_ = threadIdx.x; asm volatile("" : "+v"(tid_));
    const int tid = tid_, lane = tid & 63, w = __builtin_amdgcn_readfirstlane(tid >> 6), g = lane >> 4, li = lane & 15;
    const int kk_ = tid & 127, tq = tid >> 7;
    const float lb = P.hg_lb[h * 128 + kk_], oml = 1.0f - lb;
    LAS float* BQ = (LAS float*)(lds + HG_BQ); LAS float* SS = (LAS float*)(lds + HG_SS); LAS float* DD = (LAS float*)(lds + HG_DD);
    f32x4 Sacc[8];
#pragma unroll
    for (int i = 0; i < 8; ++i) Sacc[i] = (f32x4){0.f, 0.f, 0.f, 0.f};
    const unsigned ldsb = (unsigned)(uintptr_t)lds;
    const float ng = P.hg_norm_g[16 * w + li];
    v4u pf[8];
#define HG_LOADPF(cc) do { const size_t r0_ = (size_t)b * T + (size_t)(cc) * 64; _Pragma("unroll") for (int i_ = 0; i_ < 8; ++i_) { const int ix_ = tid + 512 * (i_ & 1); \
        pf[i_] = *(const v4u*)(P.proj + (r0_ + (ix_ >> 4)) * INW + (i_ >> 1) * 512 + h * 128 + (ix_ & 15) * 8); } } while (0)
#define LBAR() asm volatile("s_waitcnt lgkmcnt(0)\n\ts_barrier" ::: "memory")
    HG_LOADPF(0);
#pragma unroll 1
    for (int c = 0; c < 64; ++c) {
        const size_t row0 = (size_t)b * T + (size_t)c * 64;
#pragma unroll
        for (int i = 0; i < 8; ++i) { const int ix = tid + 512 * (i & 1); const int reg = (i >> 1) == 0 ? HG_QH : (i >> 1) == 1 ? HG_KT : (i >> 1) == 2 ? HG_VV : HG_OG;
            *(LAS v4u*)(lds + reg + (ix >> 4) * HS + (ix & 15) * 16) = pf[i]; }
        if (c < 63) HG_LOADPF(c + 1);
        LBAR();
        float cs[16], kv[16]; float run = 0.f;
#pragma unroll
        for (int i = 0; i < 16; ++i) { const float z = bf2f(*(const LAS unsigned short*)(lds + HG_KT + (16 * tq + i) * HS + kk_ * 2)); const float sg = sigmoidf_(z); const float f = lb + oml * sg;
            run += __logf(fmaxf(f, HG_F_MIN)); cs[i] = run; kv[i] = oml * (1.0f - sg); }
        BQ[tq * 128 + kk_] = run;
        LBAR();
        const float q0 = BQ[kk_], q1 = BQ[128 + kk_], q2 = BQ[256 + kk_], q3 = BQ[384 + kk_];
        const float off = (tq > 0 ? q0 : 0.f) + (tq > 1 ? q1 : 0.f) + (tq > 2 ? q2 : 0.f);
        const float blast = (q0 + q1) + (q2 + q3), ref = q0 + q1;
        if (tq == 0) DD[kk_] = __expf(blast);
#pragma unroll
        for (int i = 0; i < 16; ++i) { const int t = 16 * tq + i; const float bt = off + cs[i];
            const float q = bf2f(*(const LAS unsigned short*)(lds + HG_QH + t * HS + kk_ * 2));
            *(LAS unsigned short*)(lds + HG_QH + t * HS + kk_ * 2) = (unsigned short)f2bf(q * __expf(bt));
            *(LAS unsigned short*)(lds + HG_QT + t * HS + kk_ * 2) = (unsigned short)f2bf(q * __expf(fminf(bt - ref, 60.f)));
            *(LAS unsigned short*)(lds + HG_KT + t * HS + kk_ * 2) = (unsigned short)f2bf(kv[i] * __expf(fminf(ref - bt, 60.f)));
            *(LAS unsigned short*)(lds + HG_KHT + kk_ * HS2 + t * 2) = (unsigned short)f2bf(kv[i] * __expf(blast - bt));
            }
        LBAR();
        {   const int mt = w >> 1;
#pragma unroll
            for (int j = 0; j < 2; ++j) { const int st = 2 * (w & 1) + j; f32x4 a = (f32x4){0.f, 0.f, 0.f, 0.f};
#pragma unroll
                for (int ks = 0; ks < 4; ++ks) { const bf16x8 fa = *(const LAS bf16x8*)(lds + HG_KT + (16 * st + li) * HS + ks * 64 + g * 16);
                    const bf16x8 fb = *(const LAS bf16x8*)(lds + HG_QT + (16 * mt + li) * HS + ks * 64 + g * 16);
                    a = __builtin_amdgcn_mfma_f32_16x16x32_bf16(fa, fb, a, 0, 0, 0); }
                const int tt = 16 * mt + li, s0 = 16 * st + 4 * g;
                v2u wv; wv.x = pk2(s0 <= tt ? a[0] : 0.f, s0 + 1 <= tt ? a[1] : 0.f); wv.y = pk2(s0 + 2 <= tt ? a[2] : 0.f, s0 + 3 <= tt ? a[3] : 0.f);
                *(LAS v2u*)(lds + HG_AM + tt * HS2 + s0 * 2) = wv; }
        }
        LBAR();
        bf16x8 vf[2];
        {   const int q = li >> 2, p = li & 3;
#pragma unroll
            for (int ks = 0; ks < 2; ++ks) { const unsigned a0 = ldsb + HG_VV + (32 * ks + 8 * g + q) * HS + (16 * w + 4 * p) * 2;
                const s16x4 lo = tr_rd(a0), hi = tr_rd(a0 + 4 * HS);
                vf[ks] = (bf16x8){lo[0], lo[1], lo[2], lo[3], hi[0], hi[1], hi[2], hi[3]}; } }
        bf16x8 sb[4];
#pragma unroll
        for (int s = 0; s < 4; ++s) { v4u x; x.x = pk2(Sacc[2 * s][0], Sacc[2 * s][1]); x.y = pk2(Sacc[2 * s][2], Sacc[2 * s][3]); x.z = pk2(Sacc[2 * s + 1][0], Sacc[2 * s + 1][1]); x.w = pk2(Sacc[2 * s + 1][2], Sacc[2 * s + 1][3]);
            sb[s] = __builtin_bit_cast(bf16x8, x); }
        f32x4 o[4];
#pragma unroll
        for (int mt = 0; mt < 4; ++mt) { f32x4 a = (f32x4){0.f, 0.f, 0.f, 0.f};
#pragma unroll
            for (int ks = 0; ks < 2; ++ks) { const bf16x8 fa = *(const LAS bf16x8*)(lds + HG_AM + (16 * mt + li) * HS2 + ks * 64 + g * 16);
                a = __builtin_amdgcn_mfma_f32_16x16x32_bf16(fa, vf[ks], a, 0, 0, 0); }
#pragma unroll
            for (int s = 0; s < 4; ++s) { const LAS unsigned char* qp = lds + HG_QH + (16 * mt + li) * HS + (32 * s + 4 * g) * 2;
                const v2u lo = *(const LAS v2u*)qp, hi = *(const LAS v2u*)(qp + 32);
                v4u x; x.x = lo.x; x.y = lo.y; x.z = hi.x; x.w = hi.y;
                a = __builtin_amdgcn_mfma_f32_16x16x32_bf16(__builtin_bit_cast(bf16x8, x), sb[s], a, 0, 0, 0); }
            o[mt] = a; }
#pragma unroll
        for (int kt = 0; kt < 8; ++kt) { const f32x4 d = *(const LAS f32x4*)(DD + 16 * kt + 4 * g); f32x4 a = Sacc[kt] * d;
#pragma unroll
            for (int ks = 0; ks < 2; ++ks) { const bf16x8 fa = *(const LAS bf16x8*)(lds + HG_KHT + (16 * kt + li) * HS2 + ks * 64 + g * 16);
                a = __builtin_amdgcn_mfma_f32_16x16x32_bf16(fa, vf[ks], a, 0, 0, 0); }
            Sacc[kt] = a; }
#pragma unroll
        for (int mt = 0; mt < 4; ++mt)
#pragma unroll
            for (int r = 0; r < 4; ++r) { float s = o[mt][r] * o[mt][r]; s += __shfl_xor(s, 1); s += __shfl_xor(s, 2); s += __shfl_xor(s, 4); s += __shfl_xor(s, 8);
                if (li == 0) SS[(16 * mt + 4 * g + r) * 8 + w] = s; }
        LBAR();
#pragma unroll
        for (int mt = 0; mt < 4; ++mt)
#pragma unroll
            for (int r = 0; r < 4; ++r) { const int t = 16 * mt + 4 * g + r; const f32x4 s0 = *(const LAS f32x4*)(SS + t * 8), s1 = *(const LAS f32x4*)(SS + t * 8 + 4);
                const float ss = ((s0[0] + s0[1]) + (s0[2] + s0[3])) + ((s1[0] + s1[1]) + (s1[2] + s1[3]));
                const float rs = rsqrtf(ss * (1.0f / 128.0f) + RMS_EPS);
                const float og = bf2f(*(const LAS unsigned short*)(lds + HG_OG + t * HS + (16 * w + li) * 2));
                const float y = o[mt][r] * rs * ng * (og * sigmoidf_(og));
                P.ocat[(row0 + t) * 1536 + h * 128 + 16 * w + li] = (unsigned short)f2bf(y); }
        LBAR();
    }
}
#undef HG_LOADPF

constexpr int RS = 144;
constexpr int RW_RT = 0, RW_AT = 9216, RW_BT = 18432, RW_KT = 27648, RW_ATT = 36864, RW_BHT = 46080, RW_KHT = 55296, RW_VTT = 64512, RW_G = 73728,
              RW_X = 82944,
              RW_LW = RW_X, RW_A1 = RW_X + 17408, RW_WW = RW_X, RW_O = RW_X + 9216,
              RW_AAB = 109568, RW_AAKT = RW_AAB + 4096, RW_ARB = RW_AAKT + 2048, RW_ARK = RW_ARB + 2048, RW_TM = RW_ARK + 2048, RW_TAM = RW_TM + 2048,
              RW_GC = RW_TAM + 2048, RW_BON = RW_GC + 1024, RW_CST = RW_BON + 256, RW_END2 = RW_CST + 3072,
              RW_TW = RW_RT, RW_AD = RW_AT, RW_SG = RW_BT;
static_assert(RW_END2 <= 131072, "rwkv lds");
__device__ __forceinline__ void rwkv_unit(const MixP& P, int b, int h, LAS unsigned char* lds) {
    int tid0_ = threadIdx.x; asm volatile("" : "+v"(tid0_));
    const int hc = h * 64;
    int tid = tid0_, lane = tid & 63, g = lane >> 4, li = lane & 15, tt = tid >> 3, sg = tid & 7, c0 = sg * 8;
    const int w = __builtin_amdgcn_readfirstlane(tid >> 6);
    LAS float* LW = (LAS float*)(lds + RW_LW); LAS float* O = (LAS float*)(lds + RW_O); LAS float* GC = (LAS float*)(lds + RW_GC); LAS float* BON = (LAS float*)(lds + RW_BON);
    LAS float* AAB = (LAS float*)(lds + RW_AAB);
    const unsigned ldsb = (unsigned)(uintptr_t)lds;
    f32x4 St[4];
#pragma unroll
    for (int i = 0; i < 4; ++i) St[i] = (f32x4){0.f, 0.f, 0.f, 0.f};
    LAS float* CST = (LAS float*)(lds + RW_CST);
    for (int e = tid; e < 768; e += NTHR) { float v;
        if (e < 192) v = P.rw_mu[(e >> 6) * 512 + hc + (e & 63)]; else if (e < 448) v = P.rw_mu[1536 + (e - 192)];
        else { const int q = (e - 448) >> 6, c = (e - 448) & 63; const float* src = q == 0 ? P.rw_k_k : q == 1 ? P.rw_k_a : q == 2 ? P.rw_r_k : q == 3 ? P.rw_gn_g : P.rw_gn_b; v = src[hc + c]; }
        CST[e] = v; }
    LBAR();
#define LD8(dst, off) do { const f32x4 a_ = *(const LAS f32x4*)(CST + (off)), b_ = *(const LAS f32x4*)(CST + (off) + 4); _Pragma("unroll") for (int q_ = 0; q_ < 4; ++q_) { dst[q_] = a_[q_]; dst[4 + q_] = b_[q_]; } } while (0)
    const int lmt = w >> 1;
    float w0c[2], a0c[2];
#pragma unroll
    for (int n = 0; n < 2; ++n) { const int cc = 16 * (2 * (w & 1) + n) + li; w0c[n] = P.rw_w0[hc + cc]; a0c[n] = P.rw_a0[hc + cc]; }
    v4u cur[7], prv[7];
    {   const bf16* src = P.proj + ((size_t)b * T + tt) * INW;
        cur[0] = *(const v4u*)(src + C_RWR + hc + c0); cur[1] = *(const v4u*)(src + C_RWK + hc + c0); cur[2] = *(const v4u*)(src + C_RWV + hc + c0); cur[3] = *(const v4u*)(src + C_RWWD + c0); cur[4] = *(const v4u*)(src + C_RWAD + c0);
        cur[5] = *(const v4u*)(src + C_RWGD + sg * 16); cur[6] = *(const v4u*)(src + C_RWGD + sg * 16 + 8);
        if (tt > 0) { const bf16* sp = src - INW; prv[0] = *(const v4u*)(sp + C_RWR + hc + c0); prv[1] = *(const v4u*)(sp + C_RWK + hc + c0); prv[2] = *(const v4u*)(sp + C_RWV + hc + c0); prv[3] = *(const v4u*)(sp + C_RWWD + c0); prv[4] = *(const v4u*)(sp + C_RWAD + c0);
            prv[5] = *(const v4u*)(sp + C_RWGD + sg * 16); prv[6] = *(const v4u*)(sp + C_RWGD + sg * 16 + 8); }
        else {
#pragma unroll
            for (int i = 0; i < 7; ++i) prv[i] = (v4u){0u, 0u, 0u, 0u}; } }
#pragma unroll 1
    for (int blk = 0; blk < 64; ++blk) {
        const size_t row0 = (size_t)b * T + (size_t)blk * 64;
        { int t_ = tid0_; asm volatile("" : "+v"(t_)); tid = t_; lane = tid & 63; g = lane >> 4; li = lane & 15; tt = tid >> 3; sg = tid & 7; c0 = sg * 8; }
        bf16x8 bwf[2][2], baf[2][2], bgf[2][4];
#pragma unroll
        for (int n = 0; n < 2; ++n) { const int cc = 16 * (2 * (w & 1) + n) + li;
#pragma unroll
            for (int ks = 0; ks < 2; ++ks) { bwf[n][ks] = *(const bf16x8*)(P.wupT + (size_t)(hc + cc) * 64 + ks * 32 + g * 8); baf[n][ks] = *(const bf16x8*)(P.aupT + (size_t)(hc + cc) * 64 + ks * 32 + g * 8); }
#pragma unroll
            for (int ks = 0; ks < 4; ++ks) bgf[n][ks] = *(const bf16x8*)(P.gupT + (size_t)(hc + cc) * 128 + ks * 32 + g * 8); }
        float rr[8], k1[8], vv[8];
        {   float xw[8], xa[8], xg[16];
#define SHIFT8(dst, ci, muv) do { const unsigned cw_[4] = {cur[ci].x, cur[ci].y, cur[ci].z, cur[ci].w}, pw_[4] = {prv[ci].x, prv[ci].y, prv[ci].z, prv[ci].w}; \
            _Pragma("unroll") for (int q_ = 0; q_ < 4; ++q_) { const float c_lo = bflo(cw_[q_]), c_hi = bfhi(cw_[q_]); dst[2 * q_] = c_lo + (bflo(pw_[q_]) - c_lo) * muv[2 * q_]; dst[2 * q_ + 1] = c_hi + (bfhi(pw_[q_]) - c_hi) * muv[2 * q_ + 1]; } } while (0)
            float mu_[8];
            LD8(mu_, c0); SHIFT8(rr, 0, mu_); LD8(mu_, 64 + c0); SHIFT8(k1, 1, mu_); LD8(mu_, 128 + c0); SHIFT8(vv, 2, mu_); LD8(mu_, 192 + c0); SHIFT8(xw, 3, mu_); LD8(mu_, 256 + c0); SHIFT8(xa, 4, mu_);
            { float* xg0 = xg; float* xg1 = xg + 8; LD8(mu_, 320 + sg * 16); SHIFT8(xg0, 5, mu_); LD8(mu_, 328 + sg * 16); SHIFT8(xg1, 6, mu_); }
#undef SHIFT8
            v4u o;
            o.x = pk2a(tanh_fast(xw[0]), tanh_fast(xw[1])); o.y = pk2a(tanh_fast(xw[2]), tanh_fast(xw[3])); o.z = pk2a(tanh_fast(xw[4]), tanh_fast(xw[5])); o.w = pk2a(tanh_fast(xw[6]), tanh_fast(xw[7]));
            *(LAS v4u*)(lds + RW_TW + tt * RS + c0 * 2) = o;
            o.x = pk2a(xa[0], xa[1]); o.y = pk2a(xa[2], xa[3]); o.z = pk2a(xa[4], xa[5]); o.w = pk2a(xa[6], xa[7]);
            *(LAS v4u*)(lds + RW_AD + tt * RS + c0 * 2) = o;
            o.x = pk2a(sigmoidf_(xg[0]), sigmoidf_(xg[1])); o.y = pk2a(sigmoidf_(xg[2]), sigmoidf_(xg[3])); o.z = pk2a(sigmoidf_(xg[4]), sigmoidf_(xg[5])); o.w = pk2a(sigmoidf_(xg[6]), sigmoidf_(xg[7]));
            *(LAS v4u*)(lds + RW_SG + tt * 272 + sg * 32) = o;
            o.x = pk2a(sigmoidf_(xg[8]), sigmoidf_(xg[9])); o.y = pk2a(sigmoidf_(xg[10]), sigmoidf_(xg[11])); o.z = pk2a(sigmoidf_(xg[12]), sigmoidf_(xg[13])); o.w = pk2a(sigmoidf_(xg[14]), sigmoidf_(xg[15]));
            *(LAS v4u*)(lds + RW_SG + tt * 272 + sg * 32 + 16) = o;
        }
        LBAR();
#pragma unroll
        for (int n = 0; n < 2; ++n) { const int ntile = 2 * (w & 1) + n, cc = 16 * ntile + li;
            f32x4 aw = (f32x4){0.f, 0.f, 0.f, 0.f}, aa = aw, ag = aw;
#pragma unroll
            for (int ks = 0; ks < 2; ++ks) { const bf16x8 f1 = *(const LAS bf16x8*)(lds + RW_TW + (16 * lmt + li) * RS + ks * 64 + g * 16), f2 = *(const LAS bf16x8*)(lds + RW_AD + (16 * lmt + li) * RS + ks * 64 + g * 16);
                aw = __builtin_amdgcn_mfma_f32_16x16x32_bf16(f1, bwf[n][ks], aw, 0, 0, 0); aa = __builtin_amdgcn_mfma_f32_16x16x32_bf16(f2, baf[n][ks], aa, 0, 0, 0); }
#pragma unroll
            for (int ks = 0; ks < 4; ++ks) { const bf16x8 f3 = *(const LAS bf16x8*)(lds + RW_SG + (16 * lmt + li) * 272 + ks * 64 + g * 16);
                ag = __builtin_amdgcn_mfma_f32_16x16x32_bf16(f3, bgf[n][ks], ag, 0, 0, 0); }
#pragma unroll
            for (int r = 0; r < 4; ++r) { const int t = 16 * lmt + 4 * g + r; const float z = -(w0c[n] + aw[r]);
                const float sp = fmaxf(z, 0.f) + __logf(1.0f + __expf(-fabsf(z)));
                LW[t * 68 + cc] = -__expf(-sp - 0.5f);
                *(LAS unsigned short*)(lds + RW_A1 + t * RS + cc * 2) = (unsigned short)f2bf(sigmoidf_(a0c[n] + aa[r]));
                *(LAS unsigned short*)(lds + RW_G + t * RS + cc * 2) = (unsigned short)f2bf(ag[r]); }
        }
        LBAR();
        if (tid < 256) { const int j = tid >> 6, c = tid & 63; float run = 0.f;
#pragma unroll
            for (int i = 0; i < 16; ++i) { run += LW[(16 * j + i) * 68 + c]; LW[(16 * j + i) * 68 + c] = run; }
            GC[j * 64 + c] = __expf(run); }
        LBAR();
        {   float a[8], clt[8], clm[8], clc[8];
            { const v4u av = *(const LAS v4u*)(lds + RW_A1 + tt * RS + c0 * 2); a[0] = bflo(av.x); a[1] = bfhi(av.x); a[2] = bflo(av.y); a[3] = bfhi(av.y); a[4] = bflo(av.z); a[5] = bfhi(av.z); a[6] = bflo(av.w); a[7] = bfhi(av.w); }
            const int tl = tt & 15, tC = (tt | 15);
            { const f32x4 x0 = *(const LAS f32x4*)(LW + tt * 68 + c0), x1 = *(const LAS f32x4*)(LW + tt * 68 + c0 + 4), y0 = *(const LAS f32x4*)(LW + tC * 68 + c0), y1 = *(const LAS f32x4*)(LW + tC * 68 + c0 + 4);
              f32x4 z0 = (f32x4){0.f, 0.f, 0.f, 0.f}, z1 = z0; if (tl > 0) { z0 = *(const LAS f32x4*)(LW + (tt - 1) * 68 + c0); z1 = *(const LAS f32x4*)(LW + (tt - 1) * 68 + c0 + 4); }
#pragma unroll
              for (int j = 0; j < 4; ++j) { clt[j] = x0[j]; clt[4 + j] = x1[j]; clc[j] = y0[j]; clc[4 + j] = y1[j]; clm[j] = z0[j]; clm[4 + j] = z1[j]; } }
            float kk[8], kkc[8], kac[8], rkc[8]; float ss = 0.f;
            LD8(kkc, 448 + c0); LD8(kac, 512 + c0); LD8(rkc, 576 + c0);
#pragma unroll
            for (int j = 0; j < 8; ++j) { kk[j] = k1[j] * kkc[j]; ss += kk[j] * kk[j]; }
            ss += __shfl_xor(ss, 1); ss += __shfl_xor(ss, 2); ss += __shfl_xor(ss, 4);
            const float inv = rsqrtf(fmaxf(ss, 1e-12f)); float bon = 0.f;
            float rt[8], at[8], bt[8], kt[8], bh[8], kh[8];
#pragma unroll
            for (int j = 0; j < 8; ++j) { const float kn = kk[j] * inv, k2 = k1[j] * (1.0f + (a[j] - 1.0f) * kac[j]); const float av = -kn, bv = kn * a[j];
                const float ig = __expf(-clt[j]), gh = __expf(clc[j] - clt[j]);
                rt[j] = rr[j] * __expf(clt[j]); at[j] = av * __expf(clm[j]); bt[j] = bv * ig; kt[j] = k2 * ig; bh[j] = bv * gh; kh[j] = k2 * gh; bon += rr[j] * k2 * rkc[j]; }
            bon += __shfl_xor(bon, 1); bon += __shfl_xor(bon, 2); bon += __shfl_xor(bon, 4);
            if (sg == 0) BON[tt] = bon;
            v4u o;
#define PK8(src) (o.x = pk2a(src[0], src[1]), o.y = pk2a(src[2], src[3]), o.z = pk2a(src[4], src[5]), o.w = pk2a(src[6], src[7]), o)
            *(LAS v4u*)(lds + RW_RT + tt * RS + c0 * 2) = PK8(rt); *(LAS v4u*)(lds + RW_AT + tt * RS + c0 * 2) = PK8(at); *(LAS v4u*)(lds + RW_BT + tt * RS + c0 * 2) = PK8(bt); *(LAS v4u*)(lds + RW_KT + tt * RS + c0 * 2) = PK8(kt);
            *(LAS v4u*)(lds + RW_BHT + tt * RS + c0 * 2) = PK8(bh); *(LAS v4u*)(lds + RW_KHT + tt * RS + c0 * 2) = PK8(kh); *(LAS v4u*)(lds + RW_VTT + tt * RS + c0 * 2) = PK8(vv);
#undef PK8
        }
        LBAR();
        {   const int j = w >> 1; const int rowb = (16 * j + li) * RS;
            bf16x8 fat[2], fbt[2], fkt[2], frt[2];
#pragma unroll
            for (int ks = 0; ks < 2; ++ks) { fbt[ks] = *(const LAS bf16x8*)(lds + RW_BT + rowb + ks * 64 + g * 16); fkt[ks] = *(const LAS bf16x8*)(lds + RW_KT + rowb + ks * 64 + g * 16);
                if ((w & 1) == 0) fat[ks] = *(const LAS bf16x8*)(lds + RW_AT + rowb + ks * 64 + g * 16); else frt[ks] = *(const LAS bf16x8*)(lds + RW_RT + rowb + ks * 64 + g * 16); }
            if ((w & 1) == 0) {
                f32x4 x = (f32x4){0.f, 0.f, 0.f, 0.f}, y = x;
#pragma unroll
                for (int ks = 0; ks < 2; ++ks) { x = __builtin_amdgcn_mfma_f32_16x16x32_bf16(fbt[ks], fat[ks], x, 0, 0, 0);
                    y = __builtin_amdgcn_mfma_f32_16x16x32_bf16(fat[ks], fkt[ks], y, 0, 0, 0); }
                f32x4 xm; v2u ym;
#pragma unroll
                for (int r = 0; r < 4; ++r) xm[r] = (4 * g + r < li) ? x[r] : 0.f;
                *(LAS f32x4*)(AAB + (j * 16 + li) * 16 + 4 * g) = xm;
                ym.x = pk2(li < 4 * g ? y[0] : 0.f, li < 4 * g + 1 ? y[1] : 0.f); ym.y = pk2(li < 4 * g + 2 ? y[2] : 0.f, li < 4 * g + 3 ? y[3] : 0.f);
                *(LAS v2u*)(lds + RW_AAKT + (j * 16 + li) * 32 + 8 * g) = ym;
            } else {
                f32x4 x = (f32x4){0.f, 0.f, 0.f, 0.f}, y = x;
#pragma unroll
                for (int ks = 0; ks < 2; ++ks) { x = __builtin_amdgcn_mfma_f32_16x16x32_bf16(fbt[ks], frt[ks], x, 0, 0, 0);
                    y = __builtin_amdgcn_mfma_f32_16x16x32_bf16(fkt[ks], frt[ks], y, 0, 0, 0); }
                v2u xm, ym;
                xm.x = pk2(4 * g <= li ? x[0] : 0.f, 4 * g + 1 <= li ? x[1] : 0.f); xm.y = pk2(4 * g + 2 <= li ? x[2] : 0.f, 4 * g + 3 <= li ? x[3] : 0.f);
                ym.x = pk2(4 * g <= li ? y[0] : 0.f, 4 * g + 1 <= li ? y[1] : 0.f); ym.y = pk2(4 * g + 2 <= li ? y[2] : 0.f, 4 * g + 3 <= li ? y[3] : 0.f);
                *(LAS v2u*)(lds + RW_ARB + (j * 16 + li) * 32 + 8 * g) = xm; *(LAS v2u*)(lds + RW_ARK + (j * 16 + li) * 32 + 8 * g) = ym;
            }
        }
        LBAR();
        if (w == 0) { const int j = g, col = li; float x[16];
#pragma unroll
            for (int t = 0; t < 16; ++t) { float s = (t == col) ? 1.f : 0.f;
#pragma unroll
                for (int q = 0; q < (t + 3) / 4; ++q) { const f32x4 av = *(const LAS f32x4*)(AAB + (j * 16 + t) * 16 + 4 * q);
#pragma unroll
                    for (int e = 0; e < 4; ++e) if (4 * q + e < t) s += av[e] * x[4 * q + e]; }
                x[t] = s; *(LAS unsigned short*)(lds + RW_TM + (j * 16 + t) * 32 + col * 2) = (unsigned short)f2bf(s); } }
        LBAR();
        {   const int j = w >> 1; const bf16x8 zf = (bf16x8){0, 0, 0, 0, 0, 0, 0, 0};
            const bf16x8 ft = (g < 2) ? *(const LAS bf16x8*)(lds + RW_TM + (j * 16 + li) * 32 + g * 16) : zf;
#pragma unroll
            for (int n = 0; n < 2; ++n) { const int ct = 2 * (w & 1) + n;
                bf16x8 fa; { const unsigned a0_ = ldsb + RW_AT + (16 * j + 8 * (g & 1) + (li >> 2)) * RS + (16 * ct + 4 * (li & 3)) * 2; s16x4 lo_, hi_;
                    asm volatile("ds_read_b64_tr_b16 %0, %2\n\tds_read_b64_tr_b16 %1, %2 offset:576\n\ts_waitcnt lgkmcnt(0)" : "=&v"(lo_), "=&v"(hi_) : "v"(a0_) : "memory");
                    fa = (g < 2) ? (bf16x8){lo_[0], lo_[1], lo_[2], lo_[3], hi_[0], hi_[1], hi_[2], hi_[3]} : zf; }
                f32x4 x = __builtin_amdgcn_mfma_f32_16x16x32_bf16(fa, ft, (f32x4){0.f, 0.f, 0.f, 0.f}, 0, 0, 0);
                v2u xm; xm.x = pk2(x[0], x[1]); xm.y = pk2(x[2], x[3]);
                *(LAS v2u*)(lds + RW_WW + (16 * j + li) * RS + (16 * ct + 4 * g) * 2) = xm; }
            if ((w & 1) == 0) { const bf16x8 fa = (g < 2) ? *(const LAS bf16x8*)(lds + RW_AAKT + (j * 16 + li) * 32 + g * 16) : zf;
                f32x4 x = __builtin_amdgcn_mfma_f32_16x16x32_bf16(fa, ft, (f32x4){0.f, 0.f, 0.f, 0.f}, 0, 0, 0);
                v2u xm; xm.x = pk2(x[0], x[1]); xm.y = pk2(x[2], x[3]);
                *(LAS v2u*)(lds + RW_TAM + (j * 16 + li) * 32 + 8 * g) = xm; }
        }
        LBAR();
        if (blk < 63) { const bf16* src = P.proj + (row0 + 64 + tt) * INW; const bf16* sp = src - INW;
            cur[0] = *(const v4u*)(src + C_RWR + hc + c0); cur[1] = *(const v4u*)(src + C_RWK + hc + c0); cur[2] = *(const v4u*)(src + C_RWV + hc + c0); cur[3] = *(const v4u*)(src + C_RWWD + c0); cur[4] = *(const v4u*)(src + C_RWAD + c0);
            cur[5] = *(const v4u*)(src + C_RWGD + sg * 16); cur[6] = *(const v4u*)(src + C_RWGD + sg * 16 + 8);
            prv[0] = *(const v4u*)(sp + C_RWR + hc + c0); prv[1] = *(const v4u*)(sp + C_RWK + hc + c0); prv[2] = *(const v4u*)(sp + C_RWV + hc + c0); prv[3] = *(const v4u*)(sp + C_RWWD + c0); prv[4] = *(const v4u*)(sp + C_RWAD + c0);
            prv[5] = *(const v4u*)(sp + C_RWGD + sg * 16); prv[6] = *(const v4u*)(sp + C_RWGD + sg * 16 + 8); }
        if (w < 4) {
#pragma unroll 1
            for (int j = 0; j < 4; ++j) {
                bf16x8 sb[2];
#pragma unroll
                for (int s = 0; s < 2; ++s) { v4u x; x.x = pk2(St[2 * s][0], St[2 * s][1]); x.y = pk2(St[2 * s][2], St[2 * s][3]); x.z = pk2(St[2 * s + 1][0], St[2 * s + 1][1]); x.w = pk2(St[2 * s + 1][2], St[2 * s + 1][3]); sb[s] = __builtin_bit_cast(bf16x8, x); }
                v2u vf, bhf[4], khf[4];
                {   const unsigned rb_ = (16 * j + 4 * g + (li >> 2)) * RS + 4 * (li & 3) * 2; const unsigned av_ = ldsb + RW_VTT + rb_ + 32 * w, ab_ = ldsb + RW_BHT + rb_, ak_ = ldsb + RW_KHT + rb_;
                    asm volatile("ds_read_b64_tr_b16 %0, %9\n\tds_read_b64_tr_b16 %1, %10\n\tds_read_b64_tr_b16 %2, %10 offset:32\n\tds_read_b64_tr_b16 %3, %10 offset:64\n\tds_read_b64_tr_b16 %4, %10 offset:96\n\t"
                                 "ds_read_b64_tr_b16 %5, %11\n\tds_read_b64_tr_b16 %6, %11 offset:32\n\tds_read_b64_tr_b16 %7, %11 offset:64\n\tds_read_b64_tr_b16 %8, %11 offset:96\n\ts_waitcnt lgkmcnt(0)"
                                 : "=&v"(vf), "=&v"(bhf[0]), "=&v"(bhf[1]), "=&v"(bhf[2]), "=&v"(bhf[3]), "=&v"(khf[0]), "=&v"(khf[1]), "=&v"(khf[2]), "=&v"(khf[3]) : "v"(av_), "v"(ab_), "v"(ak_) : "memory"); }
                const int trow = (16 * j + li) * RS;
                f32x4 u = (f32x4){0.f, 0.f, 0.f, 0.f}, o = u;
#pragma unroll
                for (int s = 0; s < 2; ++s) { const v2u lo = *(const LAS v2u*)(lds + RW_WW + trow + (32 * s + 4 * g) * 2), hi = *(const LAS v2u*)(lds + RW_WW + trow + (32 * s + 16 + 4 * g) * 2);
                    v4u x; x.x = lo.x; x.y = lo.y; x.z = hi.x; x.w = hi.y; u = __builtin_amdgcn_mfma_f32_16x16x32_bf16(__builtin_bit_cast(bf16x8, x), sb[s], u, 0, 0, 0);
                    const v2u lo2 = *(const LAS v2u*)(lds + RW_RT + trow + (32 * s + 4 * g) * 2), hi2 = *(const LAS v2u*)(lds + RW_RT + trow + (32 * s + 16 + 4 * g) * 2);
                    v4u y; y.x = lo2.x; y.y = lo2.y; y.z = hi2.x; y.w = hi2.y; o = __builtin_amdgcn_mfma_f32_16x16x32_bf16(__builtin_bit_cast(bf16x8, y), sb[s], o, 0, 0, 0); }
                {   const v2u ta = *(const LAS v2u*)(lds + RW_TAM + (j * 16 + li) * 32 + 8 * g);
                    v4u x; x.x = ta.x; x.y = ta.y; x.z = 0u; x.w = 0u; v4u y; y.x = vf.x; y.y = vf.y; y.z = 0u; y.w = 0u;
                    u = __builtin_amdgcn_mfma_f32_16x16x32_bf16(__builtin_bit_cast(bf16x8, x), __builtin_bit_cast(bf16x8, y), u, 0, 0, 0); }
                v4u b2; b2.x = pk2(u[0], u[1]); b2.y = pk2(u[2], u[3]); b2.z = vf.x; b2.w = vf.y;
                const bf16x8 b2f = __builtin_bit_cast(bf16x8, b2);
                {   const v2u rb = *(const LAS v2u*)(lds + RW_ARB + (j * 16 + li) * 32 + 8 * g), rk = *(const LAS v2u*)(lds + RW_ARK + (j * 16 + li) * 32 + 8 * g);
                    v4u x; x.x = rb.x; x.y = rb.y; x.z = rk.x; x.w = rk.y; o = __builtin_amdgcn_mfma_f32_16x16x32_bf16(__builtin_bit_cast(bf16x8, x), b2f, o, 0, 0, 0); }
#pragma unroll
                for (int r = 0; r < 4; ++r) O[(16 * j + 4 * g + r) * 68 + 16 * w + li] = o[r];
#pragma unroll
                for (int kt = 0; kt < 4; ++kt) { const f32x4 gc = *(const LAS f32x4*)(GC + j * 64 + 16 * kt + 4 * g);
                    v4u x; x.x = bhf[kt].x; x.y = bhf[kt].y; x.z = khf[kt].x; x.w = khf[kt].y;
                    St[kt] = __builtin_amdgcn_mfma_f32_16x16x32_bf16(__builtin_bit_cast(bf16x8, x), b2f, St[kt] * gc, 0, 0, 0); }
            }
        }
        LBAR();
        {   const f32x4 o0 = *(const LAS f32x4*)(O + tt * 68 + c0), o1 = *(const LAS f32x4*)(O + tt * 68 + c0 + 4); float ov[8];
#pragma unroll
            for (int j = 0; j < 4; ++j) { ov[j] = o0[j]; ov[4 + j] = o1[j]; }
            float s = 0.f;
#pragma unroll
            for (int j = 0; j < 8; ++j) s += ov[j];
            s += __shfl_xor(s, 1); s += __shfl_xor(s, 2); s += __shfl_xor(s, 4);
            const float mean = s * (1.0f / 64.0f); float q = 0.f;
#pragma unroll
            for (int j = 0; j < 8; ++j) { const float d = ov[j] - mean; q += d * d; }
            q += __shfl_xor(q, 1); q += __shfl_xor(q, 2); q += __shfl_xor(q, 4);
            const float rs = rsqrtf(q * (1.0f / 64.0f) + RW_GN_EPS), bon = BON[tt];
            const v4u gv = *(const LAS v4u*)(lds + RW_G + tt * RS + c0 * 2); const float gg[8] = {bflo(gv.x), bfhi(gv.x), bflo(gv.y), bfhi(gv.y), bflo(gv.z), bfhi(gv.z), bflo(gv.w), bfhi(gv.w)};
            float y[8], gng[8], gnb[8]; LD8(gng, 640 + c0); LD8(gnb, 704 + c0);
#pragma unroll
            for (int j = 0; j < 8; ++j) y[j] = ((ov[j] - mean) * rs * gng[j] + gnb[j] + bon * vv[j]) * gg[j];
            v4u wv; wv.x = pk2a(y[0], y[1]); wv.y = pk2a(y[2], y[3]); wv.z = pk2a(y[4], y[5]); wv.w = pk2a(y[6], y[7]);
            *(v4u*)(P.ocat + (row0 + tt) * 1536 + 1024 + hc + c0) = wv; }
        LBAR();
    }
#undef LD8
#undef LBAR
}
struct Args { const float* in[31]; float* out; unsigned char* ws; int ph_lo, ph_hi; };
typedef const __attribute__((address_space(4))) Args* ArgP;
struct Frame {
    LAS unsigned char* lds; volatile LAS unsigned* MISC; gu32* ctl;
    int tid, lane, wave, vcu, G, bx;
};
constexpr int SM_HGLB = 0;
constexpr int SM_LAM = 2048;

__device__ __forceinline__ void transpose_item(const float* W, int K, int N, bf16* WT, int k0, int n0, int drow0, LAS float* scr, int lane, int dp = 0) {
    if (dp == 0) dp = K;
#pragma unroll 8
    for (int i = 0; i < 32; ++i) { const int kk = 2 * i + (lane >> 5); scr[kk * 33 + (lane & 31)] = W[(size_t)(k0 + kk) * N + n0 + (lane & 31)]; }
    LDS_WAIT(); asm volatile("" ::: "memory");
    const int c = lane & 7;
#pragma unroll
    for (int j = 0; j < 4; ++j) { const int n = (lane >> 3) + 8 * j; const LAS float* s = scr + (8 * c) * 33 + n;
        v4u o; o.x = pk2(s[0 * 33], s[1 * 33]); o.y = pk2(s[2 * 33], s[3 * 33]); o.z = pk2(s[4 * 33], s[5 * 33]); o.w = pk2(s[6 * 33], s[7 * 33]);
        *(GAS v4u*)(WT + (size_t)(drow0 + n) * dp + k0 + 8 * c) = o; }
    LDS_WAIT(); asm volatile("" ::: "memory");
}
constexpr int CV_IN = 2688, CV_MG = 1536, CV_BR = 768, CV_OUT = 512, CV_EX = 4096, CV_TOTAL = CV_IN + CV_MG + CV_BR + CV_OUT + 3 * CV_EX;
__device__ __forceinline__ void conv_layer(const Frame& F, ArgP A, int l) {
    LAS float* scr = (LAS float*)(F.lds + F.wave * 16384);
    const int gw = F.vcu * NWAVES + F.wave, NGW = F.G * NWAVES;
    bf16* wa = (bf16*)(A->ws + WS_WA); bf16* we = (bf16*)(A->ws + WS_WE);
    for (int it = gw; it < CV_TOTAL; it += NGW) {
        int r = it;
        if (r < CV_IN) { const int kb = r / 168, nb = r % 168; transpose_item(A->in[4] + (size_t)l * DM * INW, DM, INW, wa + WA_IN / 2, 64 * kb, 32 * nb, 32 * nb, scr, F.lane); continue; } r -= CV_IN;
        if (r < CV_MG) { const int br = r / 512, q = r % 512, kb = q / 32, nb = q % 32; transpose_item(A->in[20] + ((size_t)l * 3 + br) * DM * DM, DM, DM, wa + WA_MERGE / 2 + (size_t)br * DM * UP_, 64 * kb, 32 * nb, 32 * nb, scr, F.lane, UP_); continue; } r -= CV_MG;
        if (r < CV_BR) { const int kb = r / 32, nb = r % 32; transpose_item(A->in[22] + (size_t)l * 1536 * DM, 1536, DM, wa + WA_BRANCH / 2, 64 * kb, 32 * nb, 32 * nb, scr, F.lane); continue; } r -= CV_BR;
        if (r < CV_OUT) { const int kb = r / 32, nb = r % 32; transpose_item(A->in[23] + (size_t)l * DM * DM, DM, DM, wa + WA_OUT / 2, 64 * kb, 32 * nb, 32 * nb, scr, F.lane); continue; } r -= CV_OUT;
        if (r < 2 * CV_EX) { const int up = r / CV_EX, q = r % CV_EX, e = q / 256, q2 = q % 256, kb = q2 / 16, nb = q2 % 16, n0 = 32 * nb;
            transpose_item(A->in[28 + up] + ((size_t)l * NE + e) * DM * DE, DM, DE, we + WE_GU / 2 + (size_t)e * DM * DM, 64 * kb, n0, (n0 >> 7) * 256 + up * 128 + (n0 & 127), scr, F.lane); continue; } r -= 2 * CV_EX;
        { const int e = r / 256, q2 = r % 256, kb = q2 / 32, nb = q2 % 32; transpose_item(A->in[30] + ((size_t)l * NE + e) * DE * DM, DE, DM, we + WE_DT / 2 + (size_t)e * DM * DE, 64 * kb, 32 * nb, 32 * nb, scr, F.lane); }
    }
}

__device__ __forceinline__ void phase_prologue(const Frame& F, ArgP A) {
    {   LAS float* cond = (LAS float*)(F.lds);
        float* modp = (float*)(A->ws + WS_MODP);
        for (int it = F.vcu; it < NL * 24 * 4; it += F.G) { const int l = it / 96, r = it % 96, nb = r / 4, kq = r % 4;
            __syncthreads();
            for (int e = F.tid; e < 8 * 256; e += NTHR) { const float cv = A->in[1][(e >> 8) * DM + kq * 256 + (e & 255)]; cond[e] = cv * sigmoidf_(cv); }
            __syncthreads();
            const int n = nb * 256 + (F.tid & 255), kh = F.tid >> 8; float acc[8];
#pragma unroll
            for (int b = 0; b < 8; ++b) acc[b] = 0.f;
            const float* wp = A->in[2] + ((size_t)l * DM + kq * 256 + kh * 128) * 6144 + n;
#pragma unroll 4
            for (int k = 0; k < 128; ++k) { const float wv = wp[(size_t)k * 6144];
#pragma unroll
                for (int b = 0; b < 8; ++b) acc[b] += cond[b * 256 + kh * 128 + k] * wv; }
            const int kp = kq * 2 + kh;
#pragma unroll
            for (int b = 0; b < 8; ++b) modp[(((size_t)kp * NL + l) * NB + b) * 6144 + n] = acc[b]; }
        __syncthreads();
    }
    conv_layer(F, A, 0);
    {   bf16* lo = (bf16*)(A->ws + WS_LORA); const int gt = F.vcu * NTHR + F.tid, NGT = F.G * NTHR;
        for (int e = gt; e < NL * 512 * 64; e += NGT) { const int l = e / 32768, r = e % 32768, c = r >> 6, j = r & 63;
            lo[(size_t)l * 131072 + c * 64 + j] = (bf16)f2bf(A->in[11][(size_t)l * 32768 + j * 512 + c]);
            lo[(size_t)l * 131072 + 32768 + c * 64 + j] = (bf16)f2bf(A->in[13][(size_t)l * 32768 + j * 512 + c]); }
        for (int e = gt; e < NL * 512 * 128; e += NGT) { const int l = e / 65536, r = e % 65536, c = r >> 7, j = r & 127;
            lo[(size_t)l * 131072 + 65536 + c * 128 + j] = (bf16)f2bf(A->in[14][(size_t)l * 65536 + j * 512 + c]); }
    }
    if (F.vcu == 0) { float* sm = (float*)(A->ws + WS_SMALL);
        { const int k = F.tid; float z[4], mx = -1e30f;
#pragma unroll
          for (int l = 0; l < 4; ++l) { z[l] = A->in[5][l * 512 + k]; mx = fmaxf(mx, z[l]); }
          float s = 0.f;
#pragma unroll
          for (int l = 0; l < 4; ++l) { z[l] = __expf(z[l] - mx); s += z[l]; }
          const float inv = 1.0f / s;
          sm[SM_HGLB + k] = 0.f; sm[SM_HGLB + 512 + k] = z[1] * inv; sm[SM_HGLB + 1024 + k] = (z[1] + z[2]) * inv; sm[SM_HGLB + 1536 + k] = (z[1] + z[2] + z[3]) * inv; }
        if (F.wave < 4) { const int l = F.wave; const float* dl = A->in[7] + l * 256;
            const float s1 = wave_sum(dl[F.lane] * dl[64 + F.lane]), s2 = wave_sum(dl[128 + F.lane] * dl[192 + F.lane]);
            const float li = 0.8f - 0.6f * expf(-0.3f * (float)l);
            if (F.lane == 0) { sm[SM_LAM + l] = expf(s1) - expf(s2) + li; sm[SM_LAM + 4 + l] = 1.0f - li; } }
    }
}
__device__ __forceinline__ float mod_from_partials(ArgP A, int l, int b, int n) {
    const float* mp = (const float*)(A->ws + WS_MODP) + ((size_t)l * NB + b) * 6144 + n; float s = A->in[3][l * 6144 + n];
#pragma unroll
    for (int kp = 0; kp < 8; ++kp) s += mp[(size_t)kp * NL * NB * 6144];
    return s;
}
__device__ __forceinline__ void phase_mod_u0(const Frame& F, ArgP A) {
    float* mod = (float*)(A->ws + WS_MOD);
    for (int e = F.vcu * NTHR + F.tid; e < NL * NB * 6144; e += F.G * NTHR) { const int l = e / (NB * 6144), r = e % (NB * 6144); mod[e] = mod_from_partials(A, l, r / 6144, r % 6144); }
    bf16* U = (bf16*)(A->ws + WS_U);
    for (int rb = F.vcu; rb < M / 128; rb += F.G) { const int b = rb / 32;
        float sh[16], sc[16];
#pragma unroll
        for (int j = 0; j < 4; ++j)
#pragma unroll
            for (int i = 0; i < 4; ++i) { const int c = 4 * F.lane + 256 * j + i; sh[j * 4 + i] = mod_from_partials(A, 0, b, c); sc[j * 4 + i] = 1.0f + mod_from_partials(A, 0, b, 1024 + c); }
        for (int i = 0; i < 16; ++i) { const size_t row = (size_t)rb * 128 + F.wave * 16 + i;
            const f32x4* xr = (const f32x4*)(A->in[0] + row * DM) + F.lane; v2u* ur = (v2u*)(U + row * UP_) + F.lane;
#pragma unroll
            for (int j = 0; j < 4; ++j) { const f32x4 v = xr[64 * j]; v2u w; w.x = pk2(v[0] * sc[j * 4 + 0] + sh[j * 4 + 0], v[1] * sc[j * 4 + 1] + sh[j * 4 + 1]); w.y = pk2(v[2] * sc[j * 4 + 2] + sh[j * 4 + 2], v[3] * sc[j * 4 + 3] + sh[j * 4 + 3]); ur[64 * j] = w; } }
    }
}

__device__ __forceinline__ void phase_ln1(const Frame& F, ArgP A, int l) {
    const float* mod = (const float*)(A->ws + WS_MOD);
    const bf16* MIX = (const bf16*)(A->ws + WS_MIX); bf16* U = (bf16*)(A->ws + WS_U);
    const float* xin = (l == 0) ? A->in[0] : A->out;
    LAS float* wrT = (LAS float*)(F.lds);
    LAS int* te = (LAS int*)(F.lds + 65536);
    LAS int* tbase = (LAS int*)(F.lds + 65536 + 1024);
    int* tokpos = (int*)(A->ws + WS_TOK); float* tokw = (float*)(A->ws + WS_TOK + (size_t)M * 8);
    __syncthreads();
    for (int e = F.tid; e < 16 * 1024; e += NTHR) { const int ex = e >> 10, k = e & 1023; wrT[e] = A->in[26][k * 16 + ex]; }
    __syncthreads();
    float rb_[16];
#pragma unroll
    for (int e = 0; e < 16; ++e) rb_[e] = A->in[27][e];
    for (int rb = F.vcu; rb < M / 128; rb += F.G) { const int b = rb / 32; const float* mb = mod + ((size_t)l * NB + b) * 6144;
        float g1[16], sh2[16], sc2[16], lg[16], lb[16];
#pragma unroll
        for (int j = 0; j < 4; ++j)
#pragma unroll
            for (int i = 0; i < 4; ++i) { const int c = 4 * F.lane + 256 * j + i, q = j * 4 + i; g1[q] = 1.0f + mb[2048 + c]; sh2[q] = mb[3072 + c]; sc2[q] = 1.0f + mb[4096 + c]; lg[q] = A->in[24][(l * 2 + 0) * DM + c]; lb[q] = A->in[25][(l * 2 + 0) * DM + c]; }
#pragma unroll 1
        for (int i = 0; i < 16; ++i) { const int tl = F.wave * 16 + i; const size_t row = (size_t)rb * 128 + tl;
            const f32x4* xr = (const f32x4*)(xin + row * DM) + F.lane; const v2u* mr = (const v2u*)(MIX + row * DM) + F.lane;
            float y[16]; float s = 0.f;
#pragma unroll
            for (int j = 0; j < 4; ++j) { const f32x4 v = xr[64 * j]; const v2u m2 = mr[64 * j];
                y[j * 4 + 0] = ALPHA * v[0] + g1[j * 4 + 0] * bflo(m2.x); y[j * 4 + 1] = ALPHA * v[1] + g1[j * 4 + 1] * bfhi(m2.x);
                y[j * 4 + 2] = ALPHA * v[2] + g1[j * 4 + 2] * bflo(m2.y); y[j * 4 + 3] = ALPHA * v[3] + g1[j * 4 + 3] * bfhi(m2.y);
                s += (y[j * 4] + y[j * 4 + 1]) + (y[j * 4 + 2] + y[j * 4 + 3]); }
            const float mean = wave_sum(s) * (1.0f / DM); float q = 0.f;
#pragma unroll
            for (int k = 0; k < 16; ++k) { y[k] -= mean; q += y[k] * y[k]; }
            const float rstd = rsqrtf(wave_sum(q) * (1.0f / DM) + LN_EPS);
            f32x4* xo = (f32x4*)(A->out + row * DM) + F.lane; v2u* ur = (v2u*)(U + row * UP_) + F.lane; float u2[16];
#pragma unroll
            for (int j = 0; j < 4; ++j) { f32x4 o;
#pragma unroll
                for (int k = 0; k < 4; ++k) { o[k] = y[j * 4 + k] * rstd * lg[j * 4 + k] + lb[j * 4 + k]; u2[j * 4 + k] = o[k] * sc2[j * 4 + k] + sh2[j * 4 + k]; }
                xo[64 * j] = o; v2u w; w.x = pk2(u2[j * 4], u2[j * 4 + 1]); w.y = pk2(u2[j * 4 + 2], u2[j * 4 + 3]); ur[64 * j] = w; }
            float sc[16]; float mx = -1e30f;
#pragma unroll
            for (int e = 0; e < 16; ++e) { float p = 0.f;
#pragma unroll
                for (int j = 0; j < 4; ++j) { const f32x4 wv = *(const LAS f32x4*)(wrT + e * 1024 + 4 * F.lane + 256 * j); p += (u2[j * 4] * wv[0] + u2[j * 4 + 1] * wv[1]) + (u2[j * 4 + 2] * wv[2] + u2[j * 4 + 3] * wv[3]); }
                sc[e] = wave_sum(p); mx = fmaxf(mx, sc[e]); }
            float den = 0.f;
#pragma unroll
            for (int e = 0; e < 16; ++e) { sc[e] = __expf(sc[e] - mx); den += sc[e]; }
            const float iden = 1.0f / den; float sel[16];
#pragma unroll
            for (int e = 0; e < 16; ++e) { sc[e] *= iden; sel[e] = sc[e] + rb_[e]; }
            int bg = 0; float bgs = -1e30f;
#pragma unroll
            for (int gq = 0; gq < 4; ++gq) { float m1 = -1e30f, m2 = -1e30f;
#pragma unroll
                for (int k = 0; k < 4; ++k) { const float v = sel[gq * 4 + k]; if (v > m1) { m2 = m1; m1 = v; } else if (v > m2) m2 = v; }
                const float gs = m1 + m2; if (gs > bgs) { bgs = gs; bg = gq; } }
            int i0 = 0, i1 = 0; float v0 = -1e30f, v1 = -1e30f, w0 = 0.f, w1 = 0.f;
#pragma unroll
            for (int e = 0; e < 16; ++e) { if ((e >> 2) == bg) { const float v = sel[e]; if (v > v0) { v1 = v0; i1 = i0; w1 = w0; v0 = v; i0 = e; w0 = sc[e]; } else if (v > v1) { v1 = v; i1 = e; w1 = sc[e]; } } }
            const float iw = 1.0f / (w0 + w1);
            if (F.lane == 0) { te[tl * 2] = i0; te[tl * 2 + 1] = i1; tokw[row * 2] = w0 * iw; tokw[row * 2 + 1] = w1 * iw; }
        }
        __syncthreads();
        if (F.tid < 16) { int n = 0; for (int k = 0; k < 256; ++k) n += (te[k] == F.tid) ? 1 : 0;
            tbase[F.tid] = (int)__hip_atomic_fetch_add(F.ctl + CW_ECNT + 64 * l + F.tid, (unsigned)n, RLX_AGENT);
            int p = tbase[F.tid];
            for (int k = 0; k < 256; ++k) if (te[k] == F.tid) { tokpos[(size_t)rb * 256 + k] = (F.tid << 24) | p; ++p; } }
        __syncthreads();
    }
}
__device__ __forceinline__ void load_hb(const Frame& F, int l, volatile LAS int* hb, int c) {
    __syncthreads();
    if (F.tid == 0) { int acc = 0; for (int e = 0; e < 16; ++e) { hb[e] = acc; const int cn = (int)__hip_atomic_load(F.ctl + CW_ECNT + 64 * l + e, RLX_AGENT); acc += (cn + 255) & ~255; } hb[16] = acc; hb[17] = acc >> 8;
        const int nun = (acc >> 8) * 4; int n = 0;
        for (int L = c; L < nun && n < 12; L += F.G) { const int j = L >> 2, pn = L & 3; int e = 0; for (int k = 1; k < 16; ++k) e = (hb[k] <= j * 256) ? k : e; hb[19 + n] = (j << 8) | (pn << 4) | e; ++n; }
        hb[18] = n; }
    __syncthreads();
}
__device__ __forceinline__ void phase_scatter(const Frame& F, ArgP A, int l) {
    volatile LAS int* hb = (volatile LAS int*)(F.lds + 4096);
    load_hb(F, l, hb, 0);
    const int* tokpos = (const int*)(A->ws + WS_TOK); int* tokrow = (int*)(A->ws + WS_TOK + (size_t)M * 16);
    const bf16* U = (const bf16*)(A->ws + WS_U); bf16* AS = (bf16*)(A->ws + WS_AS);
    for (int rb = F.vcu; rb < M / 128; rb += F.G) {
        for (int i = 0; i < 32; ++i) { const int k = F.wave * 32 + i; const size_t idx = (size_t)rb * 256 + k; const int tp = tokpos[idx]; const int e = tp >> 24, pos = tp & 0xffffff;
            const int row = hb[e] + pos; const size_t tok = idx >> 1;
            const v4u* src = (const v4u*)(U + tok * UP_) + F.lane; v4u* dst = (v4u*)(AS + (size_t)row * DM) + F.lane;
            const v4u a = src[0], c = src[64]; dst[0] = a; dst[64] = c;
            if (F.lane == 0) tokrow[idx] = row; }
    }
}
__device__ __forceinline__ void phase_ln2(const Frame& F, ArgP A, int l) {
    const float* mod = (const float*)(A->ws + WS_MOD);
    const bf16* Y = (const bf16*)(A->ws + WS_Y); bf16* U = (bf16*)(A->ws + WS_U);
    const int* tokrow = (const int*)(A->ws + WS_TOK + (size_t)M * 16); const float* tokw = (const float*)(A->ws + WS_TOK + (size_t)M * 8);
    for (int rb = F.vcu; rb < M / 128; rb += F.G) { const int b = rb / 32; const float* mb = mod + ((size_t)l * NB + b) * 6144; const float* mn = mod + ((size_t)(l < NL - 1 ? l + 1 : l) * NB + b) * 6144;
        float g2[16], sh1[16], sc1[16], lg[16], lb[16];
#pragma unroll
        for (int j = 0; j < 4; ++j)
#pragma unroll
            for (int i = 0; i < 4; ++i) { const int c = 4 * F.lane + 256 * j + i, q = j * 4 + i; g2[q] = 1.0f + mb[5120 + c]; sh1[q] = mn[c]; sc1[q] = 1.0f + mn[1024 + c]; lg[q] = A->in[24][(l * 2 + 1) * DM + c]; lb[q] = A->in[25][(l * 2 + 1) * DM + c]; }
#pragma unroll 1
        for (int i = 0; i < 16; ++i) { const size_t row = (size_t)rb * 128 + F.wave * 16 + i;
            const int r0 = tokrow[row * 2], r1 = tokrow[row * 2 + 1]; const float w0 = tokw[row * 2], w1 = tokw[row * 2 + 1];
            const f32x4* xr = (const f32x4*)(A->out + row * DM) + F.lane; const v2u* y0 = (const v2u*)(Y + (size_t)r0 * DM) + F.lane; const v2u* y1 = (const v2u*)(Y + (size_t)r1 * DM) + F.lane;
            float y[16]; float s = 0.f;
#pragma unroll
            for (int j = 0; j < 4; ++j) { const f32x4 v = xr[64 * j]; const v2u a = y0[64 * j], c = y1[64 * j];
                y[j * 4 + 0] = ALPHA * v[0] + g2[j * 4 + 0] * (w0 * bflo(a.x) + w1 * bflo(c.x)); y[j * 4 + 1] = ALPHA * v[1] + g2[j * 4 + 1] * (w0 * bfhi(a.x) + w1 * bfhi(c.x));
                y[j * 4 + 2] = ALPHA * v[2] + g2[j * 4 + 2] * (w0 * bflo(a.y) + w1 * bflo(c.y)); y[j * 4 + 3] = ALPHA * v[3] + g2[j * 4 + 3] * (w0 * bfhi(a.y) + w1 * bfhi(c.y));
                s += (y[j * 4] + y[j * 4 + 1]) + (y[j * 4 + 2] + y[j * 4 + 3]); }
            const float mean = wave_sum(s) * (1.0f / DM); float q = 0.f;
#pragma unroll
            for (int k = 0; k < 16; ++k) { y[k] -= mean; q += y[k] * y[k]; }
            const float rstd = rsqrtf(wave_sum(q) * (1.0f / DM) + LN_EPS);
            f32x4* xo = (f32x4*)(A->out + row * DM) + F.lane; v2u* ur = (v2u*)(U + row * UP_) + F.lane;
#pragma unroll
            for (int j = 0; j < 4; ++j) { f32x4 o; float u[4];
#pragma unroll
                for (int k = 0; k < 4; ++k) { o[k] = y[j * 4 + k] * rstd * lg[j * 4 + k] + lb[j * 4 + k]; u[k] = o[k] * sc1[j * 4 + k] + sh1[j * 4 + k]; }
                xo[64 * j] = o; if (l < NL - 1) { v2u w; w.x = pk2(u[0], u[1]); w.y = pk2(u[2], u[3]); ur[64 * j] = w; } }
        }
    }
}
struct SchedProj {
    static constexpr unsigned LDA = UP_ * 2, LDB = 2048; static constexpr int NT = 16; static constexpr bool VARNT = false;
    const char* U; const char* W; int G, c;
    __device__ __forceinline__ bool next(int i, pg8::GUnit& u, pg8::GOps& o) const { int pm, pn; if (!pg8::static_tile(M / 256, INW / 256, G, c, i, pm, pn)) return false;
        o.A = U + (size_t)pm * 256 * LDA; o.B = W + (size_t)pn * 256 * 2048; u.kind = 0; u.r0 = pm * 256; u.c0 = pn * 256; u.aux = (pn == 8 || pn == 9) ? 1 : 0; return true; }
};
struct SchedBranch {
    static constexpr unsigned LDA = 3072, LDB = 3072; static constexpr int NT = 16; static constexpr bool VARNT = true;
    const char* U; const char* WM; const char* OC; const char* WB; int G, c;
    __device__ __forceinline__ bool next(int i, pg8::GUnit& u, pg8::GOps& o) const { int pm, pn; if (!pg8::static_tile(M / 256, 4, G, c, i >> 2, pm, pn)) return false; const int sub = i & 3;
        u.r0 = pm * 256; u.c0 = pn * 256;
        if (sub < 3) { o.A = U + (size_t)pm * 256 * 3072; o.B = WM + ((size_t)sub * 1024 + pn * 256) * 3072; o.nt = 16; u.kind = 1; u.aux = sub; }
        else { o.A = OC + (size_t)pm * 256 * 3072; o.B = WB + (size_t)pn * 256 * 3072; o.nt = 24; u.kind = 2; u.aux = 0; }
        return true; }
};
struct SchedOut {
    static constexpr unsigned LDA = 2048, LDB = 2048; static constexpr int NT = 16; static constexpr bool VARNT = false;
    const char* Am; const char* W; int G, c;
    __device__ __forceinline__ bool next(int i, pg8::GUnit& u, pg8::GOps& o) const { int pm, pn; if (!pg8::static_tile(M / 256, 4, G, c, i, pm, pn)) return false;
        o.A = Am + (size_t)pm * 256 * 2048; o.B = W + (size_t)pn * 256 * 2048; u.kind = 0; u.r0 = pm * 256; u.c0 = pn * 256; u.aux = 0; return true; }
};
template <int UP> struct SchedMoe {
    static constexpr unsigned LDA = UP ? 2048 : 1024, LDB = LDA; static constexpr int NT = UP ? 16 : 8; static constexpr bool VARNT = false;
    const char* Am; const char* W; volatile LAS int* hb;
    __device__ __forceinline__ bool next(int i, pg8::GUnit& u, pg8::GOps& o) const { const int n = __builtin_amdgcn_readfirstlane(hb[18]); if (i >= n) return false;
        const int pk = __builtin_amdgcn_readfirstlane(hb[19 + i]); const int j = pk >> 8, pn = (pk >> 4) & 15, e = pk & 15;
        u.r0 = j * 256; u.aux = 0; u.kind = UP ? 3 : 0; u.c0 = UP ? pn * 128 : pn * 256;
        o.A = Am + (size_t)j * 256 * LDA; o.B = W + ((size_t)e * 1024 + pn * 256) * LDB;
        return true; }
};

constexpr int NPH = 2 + 9 * NL;
#ifndef PH_MASK
#define PH_MASK 0xffff
#endif
#define PHM(b) ((PH_MASK >> (b)) & 1)
#ifndef RPT_MASK
#define RPT_MASK 0
#endif
#define RPT(b) (1 + ((RPT_MASK >> (b)) & 1))
__global__ void __launch_bounds__(NTHR, 2) hybrid_fwd(Args args) {
    extern __shared__ __attribute__((aligned(16))) unsigned char lds[];
    Frame F; unsigned char* ws; ArgP A;
#define FRESH() do { int t_ = threadIdx.x; asm volatile("" : "+v"(t_)); { unsigned long long p_ = (unsigned long long)__builtin_amdgcn_kernarg_segment_ptr(); asm volatile("" : "+s"(p_)); A = (ArgP)p_; } ws = A->ws; \
        F.lds = (LAS unsigned char*)lds; F.MISC = (volatile LAS unsigned*)(F.lds + MISC_OFF); F.tid = t_; F.lane = t_ & 63; F.wave = __builtin_amdgcn_readfirstlane(t_ >> 6); \
        { int g_ = gridDim.x, b_ = blockIdx.x; asm volatile("" : "+s"(g_), "+s"(b_)); F.G = g_; F.bx = b_; F.vcu = (g_ % 8 == 0) ? (b_ % 8) * (g_ / 8) + b_ / 8 : b_; } F.ctl = (gu32*)(ws + WS_CTL); } while (0)
    FRESH();
    for (int u = F.tid; u < (LDS_BYTES - LDSCTL_OFF) / 4; u += NTHR) ((LAS unsigned*)(F.lds + LDSCTL_OFF))[u] = 0u;
    __syncthreads();
    XcdBarrier bar; bar.bar = (unsigned*)(ws + WS_CTL) + CW_BAR; bar.x = 0; bar.st = nullptr;
    if (!MK_PER_PHASE) bar = xcd_barrier_post((unsigned*)(ws + WS_CTL) + CW_BAR, F.MISC + 8);
    const int lo = A->ph_lo, hi = A->ph_hi;
#define IN(k) (lo <= (k) && (k) < hi)
#define SEAM(k) do { if (IN(k) && IN((k) + 1)) xcd_barrier(bar); } while (0)

    if (PHM(0) && IN(0)) { FRESH(); phase_prologue(F, A); SEAM(0); }
    if (PHM(1) && IN(1)) { FRESH(); phase_mod_u0(F, A); SEAM(1); }

#pragma unroll 1
    for (int l = 0; l < NL; ++l) {
        const int pb = 2 + 9 * l;
        if (PHM(2) && IN(pb + 0)) {
            FRESH(); const char* WA = (const char*)(ws + WS_WA); const char* WE = (const char*)(ws + WS_WE); (void)WA; (void)WE;
            SchedProj S{(const char*)(ws + WS_U), WA + WA_IN, F.G, F.bx};
            pg8::Epi<1> E{(bf16*)(ws + WS_PROJ), INW, C2Q, nullptr, nullptr};
            for (int rep = 0; rep < RPT(2); ++rep) pg8::gemm_phase<false>(F.lds, S, E);
            SEAM(pb + 0);
        }
        if (IN(pb + 1)) {
            FRESH();
            const float* sm = (const float*)(ws + WS_SMALL);
            MixP P;
            P.proj = (const bf16*)(ws + WS_PROJ); P.ocat = (bf16*)(ws + WS_OCAT); P.oatt = (bf16*)(ws + WS_OATT);
            P.hg_lb = sm + SM_HGLB + l * 512; P.hg_norm_g = A->in[6] + l * 128; P.lam = sm[SM_LAM + l]; P.one_m_lam_init = sm[SM_LAM + 4 + l]; P.da_subln_g = A->in[8] + l * 128;
            P.rw_mu = A->in[9] + l * 1792; P.rw_w0 = A->in[10] + l * 512; P.rw_a0 = A->in[12] + l * 512; P.rw_k_k = A->in[15] + l * 512; P.rw_k_a = A->in[16] + l * 512;
            P.rw_r_k = A->in[17] + l * 512; P.rw_gn_g = A->in[18] + l * 512; P.rw_gn_b = A->in[19] + l * 512;
            const bf16* lo_ = (const bf16*)(ws + WS_LORA) + (size_t)l * 131072; P.wupT = lo_; P.aupT = lo_ + 32768; P.gupT = lo_ + 65536;
            P.aq = F.ctl + CW_AQ + 64 * l;
            if (F.G >= 128) {
                if (PHM(3) && F.vcu < 64) { for (int rep = 0; rep < RPT(3); ++rep) rwkv_unit(P, F.vcu >> 3, F.vcu & 7, F.lds); }
                else if (PHM(4) && F.vcu < 96) { for (int rep = 0; rep < RPT(4); ++rep) hgrn_unit(P, (F.vcu - 64) >> 2, (F.vcu - 64) & 3, F.lds); }
                else if (PHM(5)) { for (int rep = 0; rep < RPT(5); ++rep) { P.aq = F.ctl + CW_AQ + 64 * l + 32 * rep; attn_worker(P, (char*)lds, F.MISC + 16, F.tid); } }
            }
            SEAM(pb + 1);
        }
        if (PHM(6) && IN(pb + 2)) {
            FRESH(); const char* WA = (const char*)(ws + WS_WA); const char* WE = (const char*)(ws + WS_WE); (void)WA; (void)WE;
            SchedBranch S{(const char*)(ws + WS_U), WA + WA_MERGE, (const char*)(ws + WS_OCAT), WA + WA_BRANCH, F.G, F.bx};
            pg8::Epi<6> E{(bf16*)(ws + WS_MERGED), DM, 1.0f, A->in[21] + (size_t)l * 3 * DM, (v4u*)(ws + WS_GSCR) + (size_t)F.bx * 3 * 16 * 512};
            for (int rep = 0; rep < RPT(6); ++rep) pg8::gemm_phase<false>(F.lds, S, E);
            SEAM(pb + 2);
        }
        if (PHM(7) && IN(pb + 3)) {
            FRESH(); const char* WA = (const char*)(ws + WS_WA); const char* WE = (const char*)(ws + WS_WE); (void)WA; (void)WE;
            SchedOut S{(const char*)(ws + WS_MERGED), WA + WA_OUT, F.G, F.bx};
            pg8::Epi<1> E{(bf16*)(ws + WS_MIX), DM, 1.0f, nullptr, nullptr};
            for (int rep = 0; rep < RPT(7); ++rep) pg8::gemm_phase<false>(F.lds, S, E);
            SEAM(pb + 3);
        }
        if (PHM(8) && IN(pb + 4)) { FRESH(); phase_ln1(F, A, l); SEAM(pb + 4); }
        if (PHM(9) && IN(pb + 5)) { FRESH(); for (int rep = 0; rep < RPT(9); ++rep) phase_scatter(F, A, l); SEAM(pb + 5); }
        if (PHM(10) && IN(pb + 6)) {
            FRESH(); const char* WA = (const char*)(ws + WS_WA); const char* WE = (const char*)(ws + WS_WE); (void)WA; (void)WE;
            volatile LAS int* hb = (volatile LAS int*)(F.lds + LDSCTL_OFF + 128);
            load_hb(F, l, hb, F.bx);
            SchedMoe<1> S{(const char*)(ws + WS_AS), WE + WE_GU, hb};
            pg8::Epi<8> E{(bf16*)(ws + WS_H), DE, 1.0f, nullptr, nullptr};
            for (int rep = 0; rep < RPT(10); ++rep) pg8::gemm_phase<false>(F.lds, S, E);
            SEAM(pb + 6);
        }
        if (PHM(11) && IN(pb + 7)) {
            FRESH(); const char* WA = (const char*)(ws + WS_WA); const char* WE = (const char*)(ws + WS_WE); (void)WA; (void)WE;
            volatile LAS int* hb = (volatile LAS int*)(F.lds + LDSCTL_OFF + 128);
            load_hb(F, l, hb, F.bx);
            SchedMoe<0> S{(const char*)(ws + WS_H), WE + WE_DT, hb};
            pg8::Epi<1> E{(bf16*)(ws + WS_Y), DM, 1.0f, nullptr, nullptr};
            for (int rep = 0; rep < RPT(11); ++rep) pg8::gemm_phase<false>(F.lds, S, E);
            SEAM(pb + 7);
        }
        if (PHM(12) && IN(pb + 8)) { FRESH(); if (l < NL - 1) conv_layer(F, A, l + 1); phase_ln2(F, A, l); SEAM(pb + 8); }
    }
#undef IN
#undef SEAM
}

extern "C" void kernel_launch(void* const* d_in, const int* in_sizes, int n_in, void* d_out, int out_size, void* d_ws, size_t ws_size, hipStream_t stream) {
    static int grid = 0;
    if (grid == 0) {
        if (n_in != 31 || out_size != M * DM || ws_size < WS_END) { fprintf(stderr, "kernel_launch: unexpected shapes (n_in %d, out %d, ws %zu < %zu); nothing launched\n", n_in, out_size, ws_size, (size_t)WS_END); grid = -1; return; }
        int dev = 0, cus = 0, per_cu = 0;
        if (hipGetDevice(&dev) != hipSuccess || hipDeviceGetAttribute(&cus, hipDeviceAttributeMultiprocessorCount, dev) != hipSuccess) { grid = -1; return; }
        if (hipFuncSetAttribute((const void*)hybrid_fwd, hipFuncAttributeMaxDynamicSharedMemorySize, LDS_BYTES) != hipSuccess) { fprintf(stderr, "kernel_launch: hipFuncSetAttribute failed\n"); grid = -1; return; }
        if (hipOccupancyMaxActiveBlocksPerMultiprocessor(&per_cu, (const void*)hybrid_fwd, NTHR, LDS_BYTES) != hipSuccess || per_cu < 1) { fprintf(stderr, "kernel_launch: occupancy query reports %d\n", per_cu); }
        (void)hipGetLastError();
        grid = cus;
        if (grid > 256) grid = 256;
    }
    if (grid < 0) return;
    (void)hipMemsetAsync((char*)d_ws + WS_CTL, 0, CTL_ZERO_BYTES, stream);
    Args a{};
    for (int i = 0; i < 31; ++i) a.in[i] = (const float*)d_in[i];
    a.out = (float*)d_out; a.ws = (unsigned char*)d_ws;
#if MK_PER_PHASE
    for (int p = 0; p < NPH; ++p) { a.ph_lo = p; a.ph_hi = p + 1; hipLaunchKernelGGL(hybrid_fwd, dim3(grid), dim3(NTHR), LDS_BYTES, stream, a); }
#else
    a.ph_lo = 0; a.ph_hi = NPH; hipLaunchKernelGGL(hybrid_fwd, dim3(grid), dim3(NTHR), LDS_BYTES, stream, a);
#endif
}
```

```cpp
#include <hip/hip_runtime.h>
#include <hip/hip_bf16.h>
#include <cstdio>
#include <cstdint>

#ifndef MK_PER_PHASE
#define MK_PER_PHASE 0
#endif

#define GAS __attribute__((address_space(1)))
#define LAS __attribute__((address_space(3)))
typedef unsigned short bf16;
typedef unsigned v4u __attribute__((ext_vector_type(4)));
typedef unsigned v2u __attribute__((ext_vector_type(2)));
typedef float f32x4 __attribute__((ext_vector_type(4)));
typedef float f32x2 __attribute__((ext_vector_type(2)));
typedef float f32x16 __attribute__((ext_vector_type(16)));
typedef short bf16x8 __attribute__((ext_vector_type(8)));
typedef short s16x4 __attribute__((ext_vector_type(4)));
typedef GAS unsigned gu32;
#define RLX_AGENT __ATOMIC_RELAXED, __HIP_MEMORY_SCOPE_AGENT
#define LDS_WAIT() asm volatile("s_waitcnt lgkmcnt(0)" ::: "memory")
#define VM_WAIT() asm volatile("s_waitcnt vmcnt(0)" ::: "memory")

constexpr int DM = 1024, NB = 8, T = 4096, NL = 4, M = NB * T;
constexpr int INW = 5376;
constexpr int C_HGQ = 0, C_HGF = 512, C_HGI = 1024, C_HGO = 1536, C_DAQ = 2048, C_DAK = 2560, C_DAV = 3072, C_RW = 3584;
constexpr int C_RWR = C_RW, C_RWK = C_RW + 512, C_RWV = C_RW + 1024, C_RWWD = C_RW + 1536, C_RWAD = C_RW + 1600, C_RWGD = C_RW + 1664;
constexpr int NE = 16, DE = 512;
constexpr float ALPHA = 1.681792830507429f;
constexpr float LN_EPS = 1e-5f, RMS_EPS = 1e-6f, RW_GN_EPS = 64e-5f, HG_F_MIN = 1e-6f;
constexpr float LOG2E = 1.4426950408889634f;
constexpr float C2Q = 0.125f * LOG2E;

constexpr size_t MiB = 1u << 20;
constexpr size_t WS_CTL = 0, CTL_ZERO_BYTES = 1 * MiB;
constexpr size_t WS_MODP = 1 * MiB;
constexpr size_t WS_MOD = 7 * MiB;
constexpr size_t WS_SMALL = 8 * MiB;
constexpr size_t WS_TOK = 9 * MiB;
constexpr size_t WS_LORA = 11 * MiB;
constexpr int UP_ = 1536;
constexpr size_t WS_WA = 12 * MiB;
constexpr size_t WA_IN = 0, WA_MERGE = (size_t)INW * DM * 2, WA_BRANCH = WA_MERGE + (size_t)3 * DM * UP_ * 2, WA_OUT = WA_BRANCH + (size_t)DM * 1536 * 2, WA_END = WA_OUT + (size_t)DM * DM * 2;
constexpr size_t WS_WE = 40 * MiB;
constexpr size_t WE_GU = 0, WE_DT = (size_t)32 * MiB;
constexpr size_t WS_U = 88 * MiB;
constexpr size_t WS_PROJ = 184 * MiB;
constexpr size_t WS_OCAT = 520 * MiB;
constexpr size_t WS_OATT = 616 * MiB;
constexpr size_t WS_END = 680 * MiB;
constexpr size_t WS_GSCR = WS_PROJ;
constexpr size_t WS_MERGED = WS_PROJ + 96 * MiB;
constexpr size_t WS_MIX = WS_PROJ + 160 * MiB;
constexpr size_t WS_AS = WS_PROJ;
constexpr size_t WS_H = WS_PROJ + 224 * MiB;
constexpr size_t WS_Y = WS_OCAT;
constexpr int MAXROWS = 2 * M + NE * 256;
static_assert(WA_END <= 28 * MiB, "WA");
static_assert((size_t)MAXROWS * 2048 <= 160 * MiB && (size_t)MAXROWS * 1024 <= 112 * MiB, "moe buffers");

constexpr int CW_TMO = 0, CW_CODE = 1;
constexpr int CW_BAR = 4096;
constexpr int CW_ECNT = 16384;
constexpr int CW_AQ = 20480;

constexpr int RING_BYTES = 131072;
constexpr int LDSCTL_OFF = RING_BYTES, MISC_OFF = LDSCTL_OFF + 320;
constexpr int LDS_BYTES = 147456;
constexpr int NWAVES = 8, NTHR = 512;

__device__ __forceinline__ unsigned f2bf(float f) { unsigned u = __builtin_bit_cast(unsigned, f); return (u + 0x7fffu + ((u >> 16) & 1u)) >> 16; }
__device__ __forceinline__ unsigned pk2(float lo, float hi) { return f2bf(lo) | (f2bf(hi) << 16); }
__device__ __forceinline__ unsigned pk2a(float lo, float hi) { unsigned r; asm("v_cvt_pk_bf16_f32 %0, %1, %2" : "=v"(r) : "v"(lo), "v"(hi)); return r; }
__device__ __forceinline__ float tanh_fast(float x) { return 1.0f - 2.0f * __builtin_amdgcn_rcpf(1.0f + __expf(2.0f * x)); }
__device__ __forceinline__ float bf2f(unsigned short b) { return __builtin_bit_cast(float, ((unsigned)b) << 16); }
__device__ __forceinline__ float bflo(unsigned w) { return __builtin_bit_cast(float, w << 16); }
__device__ __forceinline__ float bfhi(unsigned w) { return __builtin_bit_cast(float, w & 0xffff0000u); }
__device__ __forceinline__ unsigned cvt_pk_bf16(float lo, float hi) { unsigned r; asm volatile("v_cvt_pk_bf16_f32 %0, %1, %2" : "=v"(r) : "v"(lo), "v"(hi)); return r; }
__device__ __forceinline__ float sigmoidf_(float x) { return __builtin_amdgcn_rcpf(1.0f + __expf(-x)); }
__device__ __forceinline__ float wave_sum(float v) {
#pragma unroll
    for (int o = 1; o < 64; o <<= 1) v += __shfl_xor(v, o);
    return v;
}

#define XB_TMO      128
#define XB_XCNT(j)  (256  + 64 * (j))
#define XB_XSUB(j)  (1280 + 64 * (j))
#define XB_XGEN(j)  (2304 + 64 * (j))
#define XB_TOP      3328
#define XB_TOPGEN   3392
#define XCD_BAR_WORDS 3456
#define XB_SPIN_CAP (1u << 20)

__device__ __forceinline__ unsigned xb_ld(unsigned* p)              { return __hip_atomic_load(p, __ATOMIC_RELAXED, __HIP_MEMORY_SCOPE_AGENT); }
__device__ __forceinline__ unsigned xb_add(unsigned* p, unsigned v) { return __hip_atomic_fetch_add(p, v, __ATOMIC_RELAXED, __HIP_MEMORY_SCOPE_AGENT); }
__device__ __forceinline__ unsigned xb_xcc_id() { return (unsigned)__builtin_amdgcn_s_getreg((3 << 11) | 20) & 0xFu; }
#define XB_SPIN(cond, bar) do { unsigned _sp = 0; while (cond) { __builtin_amdgcn_s_sleep(1); \
    if ((++_sp & 255u) == 0u) { if (xb_ld(&(bar)[XB_TMO])) break; if (_sp > XB_SPIN_CAP) { atomicAdd(&(bar)[XB_TMO], 1u); break; } } } } while (0)

struct XcdBarrier { unsigned* bar; unsigned x; volatile LAS unsigned* st; };

__device__ __forceinline__ XcdBarrier xcd_barrier_post(unsigned* bar, volatile LAS unsigned* st) {
    XcdBarrier b; b.bar = bar; b.x = xb_xcc_id(); b.st = st;
    if (threadIdx.x == 0) (void)xb_add(&bar[XB_XCNT(b.x)], 1u);
    return b;
}
__device__ __forceinline__ void xcd_barrier_complete(unsigned* bar, unsigned x, unsigned& nloc, unsigned& nx) {
    const unsigned G = gridDim.x * gridDim.y * gridDim.z;
    unsigned sum, cnt, mine, sp = 0u;
    for (;;) {
        sum = 0u; cnt = 0u; mine = 0u;
#pragma unroll 1
        for (unsigned j = 0; j < 16; ++j) { const unsigned c = xb_ld(&bar[XB_XCNT(j)]); sum += c; cnt += (c > 0u) ? 1u : 0u; mine = (j == x) ? c : mine; }
        if (sum == G) break;
        __builtin_amdgcn_s_sleep(1);
        if ((++sp & 255u) == 0u) { if (xb_ld(&bar[XB_TMO])) break; if (sp > XB_SPIN_CAP) { atomicAdd(&bar[XB_TMO], 1u); break; } }
    }
    nloc = mine > 0u ? mine : 1u; nx = cnt > 0u ? cnt : 1u;
}
__device__ __forceinline__ void xcd_barrier(const XcdBarrier& b) {
    asm volatile("s_waitcnt vmcnt(0)" ::: "memory");
    __syncthreads();
    if (threadIdx.x == 0) {
        unsigned* bar = b.bar;
        __builtin_amdgcn_s_waitcnt(0);
        unsigned nloc = b.st[0], nx = b.st[1];
        if (nloc == 0u) { xcd_barrier_complete(bar, b.x, nloc, nx); b.st[0] = nloc; b.st[1] = nx; }
        const unsigned old = xb_add(&bar[XB_XSUB(b.x)], 1u);
        const unsigned gen = old / nloc;
        if (old + 1u == (gen + 1u) * nloc) {
            __builtin_amdgcn_fence(__ATOMIC_RELEASE, "agent");
            asm volatile("s_waitcnt vmcnt(0)" ::: "memory");
            const unsigned og = xb_add(&bar[XB_TOP], 1u);
            const unsigned tg = og / nx;
            if (og + 1u == (tg + 1u) * nx) xb_add(&bar[XB_TOPGEN], 1u);
            else XB_SPIN(xb_ld(&bar[XB_TOPGEN]) == tg, bar);
            __builtin_amdgcn_fence(__ATOMIC_ACQUIRE, "agent");
            xb_add(&bar[XB_XGEN(b.x)], 1u);
            asm volatile("s_waitcnt vmcnt(0)" ::: "memory");
        } else {
            XB_SPIN(xb_ld(&bar[XB_XGEN(b.x)]) == gen, bar);
            __builtin_amdgcn_fence(__ATOMIC_ACQUIRE, "agent");
            asm volatile("s_waitcnt vmcnt(0)" ::: "memory");
        }
    }
    __syncthreads();
}
namespace pg8 {
#define PG8_LAS __attribute__((address_space(3)))
constexpr int BM = 256, BK = 64, HALF = 128, HTB = HALF * BK * 2, STAGE_BYTES = 8 * HTB, NXCD = 8, WGM = 8;
__host__ __device__ __forceinline__ int lds_byte(int r, int c) { const int st = (r >> 4) * 2 + (c >> 5), rr = r & 15, cc = c & 31, ob = rr * 64 + cc * 2; return st * 1024 + (ob ^ (((ob >> 9) & 1) << 5)); }
__host__ __device__ __forceinline__ void stage_rc(int b, int& R, int& C) { const int st = b / 1024, sb = b % 1024, swz = sb ^ (((sb >> 9) & 1) << 5); R = (st >> 1) * 16 + swz / 64; C = (st & 1) * 32 + (swz % 64) / 2; }
__host__ __device__ __forceinline__ int perm32(int rho) { const int n = rho >> 4, i = rho & 15; return 8 * (i >> 2) + 4 * n + (i & 3); }

struct GUnit {
    int kind;
    int r0, c0;
    int aux;
};
struct GOps {
    const char* A; const char* B; unsigned lda, ldb; int nt;
};
__device__ __forceinline__ bool static_tile(int nM, int nN, int G, int c, int i, int& pm, int& pn) {
    const int nwg = nM * nN; const long L = (long)i * G + c; if (L >= nwg) return false;
    int wgid = (int)L; { const int q = nwg / NXCD, r = nwg % NXCD, xcd = wgid % NXCD, off = wgid / NXCD; wgid = (xcd < r ? xcd * (q + 1) : r * (q + 1) + (xcd - r) * q) + off; }
    const int nig = WGM * nN, gid = wgid / nig, fm = gid * WGM, gsz = (nM - fm) < WGM ? (nM - fm) : WGM;
    pm = fm + ((wgid % nig) % gsz); pn = (wgid % nig) / gsz; return true;
}

template <bool VARLD, class Sched, class Epi>
__device__ __forceinline__ void gemm_phase(PG8_LAS unsigned char* lds, const Sched& S, const Epi& E) {
    int tid_ = threadIdx.x; asm volatile("" : "+v"(tid_));
    const int tid = tid_, wid = __builtin_amdgcn_readfirstlane(tid >> 6), lane = tid & 63, wr = wid >> 2, wc = wid & 3, fr = lane & 15, fq = lane >> 4;
    int R0, C0, R1, C1; stage_rc(tid * 16, R0, C0); stage_rc(tid * 16 + 8192, R1, C1);
    const int Rb0 = (R0 & ~31) + perm32(R0 & 31), Rb1 = (R1 & ~31) + perm32(R1 & 31);
    const unsigned ldsw = (unsigned)wid * 1024u;
    const int aoff = lds_byte(wr * 64 + fr, fq * 8), boff = lds_byte(wc * 32 + fr, fq * 8);
#define PG8_SA(b, h) (((b) * 2 + (h)) * HTB)
#define PG8_SB(b, h) ((4 + (b) * 2 + (h)) * HTB)
#define PG8_STAGE(bufoff, gbase, v0, v1) do { \
        __builtin_amdgcn_global_load_lds((const unsigned*)((const char*)(gbase) + (v0)), (PG8_LAS unsigned*)(lds + (bufoff) + ldsw), 16, 0, 0); \
        __builtin_amdgcn_global_load_lds((const unsigned*)((const char*)(gbase) + (v1)), (PG8_LAS unsigned*)(lds + (bufoff) + ldsw + 8192), 16, 0, 0); } while (0)
#define PG8_LDA(dst, b, h) do { _Pragma("unroll") for (int m = 0; m < 4; ++m) _Pragma("unroll") for (int k = 0; k < 2; ++k) dst[m][k] = *(const PG8_LAS bf16x8*)(lds + PG8_SA(b, h) + aoff + m * 2048 + k * 1024); } while (0)
#define PG8_LDB(dst, b, h) do { _Pragma("unroll") for (int n = 0; n < 2; ++n) _Pragma("unroll") for (int k = 0; k < 2; ++k) dst[n][k] = *(const PG8_LAS bf16x8*)(lds + PG8_SB(b, h) + boff + n * 2048 + k * 1024); } while (0)
#define PG8_MMA(ai, bj, At, Bt) do { __builtin_amdgcn_s_setprio(1); _Pragma("unroll") for (int m = 0; m < 4; ++m) _Pragma("unroll") for (int n = 0; n < 2; ++n) _Pragma("unroll") for (int k = 0; k < 2; ++k) \
        acc[ai][bj][m][n] = __builtin_amdgcn_mfma_f32_16x16x32_bf16(Bt[n][k], At[m][k], acc[ai][bj][m][n], 0, 0, 0); __builtin_amdgcn_s_setprio(0); } while (0)
#define PG8_WAIT_V(n) asm volatile("s_waitcnt vmcnt(" #n ")" ::: "memory")
#define PG8_WAIT_L(n) asm volatile("s_waitcnt lgkmcnt(" #n ")" ::: "memory")
#define PG8_BAR __builtin_amdgcn_s_barrier()
#define PG8_SCHED __builtin_amdgcn_sched_barrier(0)
    GUnit cur, nxt; GOps co, no_; int ui = 0;
    if (!S.next(0, cur, co)) return;
    f32x4 acc[2][2][4][2];
#pragma unroll
    for (int a = 0; a < 2; ++a)
#pragma unroll
        for (int b = 0; b < 2; ++b)
#pragma unroll
            for (int m = 0; m < 4; ++m)
#pragma unroll
                for (int n = 0; n < 2; ++n) acc[a][b][m][n] = (f32x4){0.f, 0.f, 0.f, 0.f};
    bf16x8 At[4][2], B0[2][2], B1[2][2];
    const char* cA = co.A; const char* cB = co.B;
    unsigned ldA = VARLD ? co.lda : Sched::LDA, ldB = VARLD ? co.ldb : Sched::LDB; int nt = (VARLD || Sched::VARNT) ? co.nt : Sched::NT;
    unsigned vA0 = (unsigned)R0 * ldA + (unsigned)C0 * 2u, vA1 = (unsigned)R1 * ldA + (unsigned)C1 * 2u;
    unsigned vB0 = (unsigned)Rb0 * ldB + (unsigned)C0 * 2u, vB1 = (unsigned)Rb1 * ldB + (unsigned)C1 * 2u;
    unsigned hA = (unsigned)HALF * ldA, hB = (unsigned)HALF * ldB;
    PG8_STAGE(PG8_SB(0, 0), cB, vB0, vB1); PG8_STAGE(PG8_SB(0, 1), cB + hB, vB0, vB1); PG8_STAGE(PG8_SA(0, 0), cA, vA0, vA1); PG8_STAGE(PG8_SA(0, 1), cA + hA, vA0, vA1);
    if (wr == 1) PG8_BAR;
    PG8_WAIT_V(2); PG8_BAR;
    PG8_STAGE(PG8_SB(1, 0), cB + 128, vB0, vB1); PG8_STAGE(PG8_SA(1, 0), cA + 128, vA0, vA1); PG8_STAGE(PG8_SB(1, 1), cB + hB + 128, vB0, vB1);
    PG8_WAIT_V(6); PG8_BAR;
    for (;;) {
        const bool has_next = S.next(ui + 1, nxt, no_);
        const char* nA = has_next ? no_.A : cA; const char* nB = has_next ? no_.B : cB;
        const unsigned nlda = (VARLD && has_next) ? no_.lda : ldA, nldb = (VARLD && has_next) ? no_.ldb : ldB;
        const int nnt = ((VARLD || Sched::VARNT) && has_next) ? no_.nt : nt;
        for (int t = 0; t < nt; t += 2) {
            const bool last = (t == nt - 2);
            if (Epi::HAS_MID) { PG8_SCHED; E.mid(acc, cur, t, wr, wc, fr, fq); PG8_SCHED; }
            const char* a1 = cA + (size_t)(t + 1) * 128;
            const char* a2 = last ? nA : cA + (size_t)(t + 2) * 128; const char* b2 = last ? nB : cB + (size_t)(t + 2) * 128;
            const char* a3 = a2 + 128; const char* b3 = b2 + 128;
            unsigned xA0 = vA0, xA1 = vA1, xB0 = vB0, xB1 = vB1, xhA = hA, xhB = hB;
            if (VARLD && last) { xA0 = (unsigned)R0 * nlda + (unsigned)C0 * 2u; xA1 = (unsigned)R1 * nlda + (unsigned)C1 * 2u; xB0 = (unsigned)Rb0 * nldb + (unsigned)C0 * 2u; xB1 = (unsigned)Rb1 * nldb + (unsigned)C1 * 2u; xhA = (unsigned)HALF * nlda; xhB = (unsigned)HALF * nldb; }
            PG8_LDB(B0, 0, 0); PG8_LDB(B1, 0, 1); PG8_SCHED; PG8_LDA(At, 0, 0); PG8_STAGE(PG8_SA(1, 1), a1 + hA, vA0, vA1);
            PG8_WAIT_V(8); PG8_WAIT_L(0); PG8_BAR; PG8_MMA(0, 0, At, B0); PG8_MMA(0, 1, At, B1); PG8_BAR; PG8_SCHED;
            PG8_LDA(At, 0, 1); PG8_STAGE(PG8_SB(0, 0), b2, xB0, xB1); PG8_STAGE(PG8_SB(0, 1), b2 + xhB, xB0, xB1); PG8_STAGE(PG8_SA(0, 0), a2, xA0, xA1);
            PG8_WAIT_V(8); PG8_WAIT_L(0); PG8_BAR; PG8_MMA(1, 0, At, B0); PG8_MMA(1, 1, At, B1); PG8_BAR; PG8_SCHED;
            PG8_LDB(B0, 1, 0); PG8_LDB(B1, 1, 1); PG8_SCHED; PG8_LDA(At, 1, 0); PG8_STAGE(PG8_SA(0, 1), a2 + xhA, xA0, xA1);
            PG8_WAIT_V(8); PG8_WAIT_L(0); PG8_BAR; PG8_MMA(0, 0, At, B0); PG8_MMA(0, 1, At, B1); PG8_BAR; PG8_SCHED;
            PG8_LDA(At, 1, 1); PG8_STAGE(PG8_SB(1, 0), b3, xB0, xB1); PG8_STAGE(PG8_SB(1, 1), b3 + xhB, xB0, xB1); PG8_STAGE(PG8_SA(1, 0), a3, xA0, xA1);
            PG8_WAIT_V(8); PG8_WAIT_L(0); PG8_BAR; PG8_MMA(1, 0, At, B0); PG8_MMA(1, 1, At, B1); PG8_BAR; PG8_SCHED;
        }
        if (wr == 0) PG8_BAR;
        PG8_SCHED; E(acc, cur, wr, wc, fr, fq); PG8_SCHED;
        if (!has_next) break;
#pragma unroll
        for (int a = 0; a < 2; ++a)
#pragma unroll
            for (int b = 0; b < 2; ++b)
#pragma unroll
                for (int m = 0; m < 4; ++m)
#pragma unroll
                    for (int n = 0; n < 2; ++n) acc[a][b][m][n] = (f32x4){0.f, 0.f, 0.f, 0.f};
        cur = nxt; cA = nA; cB = nB; ++ui;
        if (VARLD || Sched::VARNT) nt = nnt;
        if (VARLD) { ldA = nlda; ldB = nldb; vA0 = (unsigned)R0 * ldA + (unsigned)C0 * 2u; vA1 = (unsigned)R1 * ldA + (unsigned)C1 * 2u; vB0 = (unsigned)Rb0 * ldB + (unsigned)C0 * 2u; vB1 = (unsigned)Rb1 * ldB + (unsigned)C1 * 2u; hA = (unsigned)HALF * ldA; hB = (unsigned)HALF * ldB; }
        if (wr == 1) PG8_BAR;
    }
    PG8_WAIT_V(0);
    PG8_BAR;
#undef PG8_SA
#undef PG8_SB
#undef PG8_STAGE
#undef PG8_LDA
#undef PG8_LDB
#undef PG8_MMA
#undef PG8_WAIT_V
#undef PG8_WAIT_L
#undef PG8_BAR
#undef PG8_SCHED
}

template <int KM> struct Epi {
    static constexpr bool HAS_MID = (KM & 4) != 0;
    bf16* O; int ldc;
    float scale;
    const float* bias;
    v4u* gscr;
    __device__ __forceinline__ void mid(f32x4 (&acc)[2][2][4][2], const GUnit& u, int t, int wr, int wc, int fr, int fq) const {
        if (!(KM & 4) || u.kind != 2 || (t != 8 && t != 16)) return;
        const int sa = (t == 8) ? 0 : 1;
        const v4u* ga = gscr + ((size_t)sa * 512 + ((wr * 4 + wc) * 64 + fq * 16 + fr)) * 16; asm volatile("" : "+v"(ga)); const v4u* gb = ga + 16 * 512; asm volatile("" : "+v"(gb));
#pragma unroll
        for (int ai = 0; ai < 2; ++ai)
#pragma unroll
            for (int m = 0; m < 4; ++m) {
#pragma unroll
                for (int bj = 0; bj < 2; ++bj) { const int q = (ai * 4 + m) * 2 + bj; const v4u x = ga[q], y = gb[q];
                    f32x4 r0, r1;
                    r0[0] = bflo(x.x) * __builtin_amdgcn_rcpf(bflo(y.x)); r0[1] = bfhi(x.x) * __builtin_amdgcn_rcpf(bfhi(y.x)); r0[2] = bflo(x.y) * __builtin_amdgcn_rcpf(bflo(y.y)); r0[3] = bfhi(x.y) * __builtin_amdgcn_rcpf(bfhi(y.y));
                    r1[0] = bflo(x.z) * __builtin_amdgcn_rcpf(bflo(y.z)); r1[1] = bfhi(x.z) * __builtin_amdgcn_rcpf(bfhi(y.z)); r1[2] = bflo(x.w) * __builtin_amdgcn_rcpf(bflo(y.w)); r1[3] = bfhi(x.w) * __builtin_amdgcn_rcpf(bfhi(y.w));
                    acc[ai][bj][m][0] *= r0; acc[ai][bj][m][1] *= r1; }
                asm volatile("" ::: "memory"); }
    }
    __device__ __forceinline__ void operator()(f32x4 (&acc)[2][2][4][2], const GUnit& u, int wr, int wc, int fr, int fq) const {
        if ((KM & 1) && u.kind == 0) {
            const float sc = u.aux ? scale : 1.0f;
            const int row0 = u.r0 + wr * 64 + fr, col0 = u.c0 + wc * 32 + 8 * fq;
#pragma unroll
            for (int ai = 0; ai < 2; ++ai)
#pragma unroll
                for (int m = 0; m < 4; ++m) { bf16* rowp = O + (size_t)(row0 + ai * HALF + m * 16) * ldc + col0;
#pragma unroll
                    for (int bj = 0; bj < 2; ++bj) { const f32x4 v0 = acc[ai][bj][m][0] * sc, v1 = acc[ai][bj][m][1] * sc;
                        v4u w; w.x = cvt_pk_bf16(v0[0], v0[1]); w.y = cvt_pk_bf16(v0[2], v0[3]); w.z = cvt_pk_bf16(v1[0], v1[1]); w.w = cvt_pk_bf16(v1[2], v1[3]);
                        *(v4u*)(rowp + bj * HALF) = w; } }
        } else if ((KM & 2) && u.kind == 1) {
            const int bcol0 = u.c0 + wc * 32 + 8 * fq; const float* bp = bias + u.aux * 1024 + bcol0;
            v4u* gs = gscr + ((size_t)u.aux * 512 + ((wr * 4 + wc) * 64 + fq * 16 + fr)) * 16; asm volatile("" : "+v"(gs));
#pragma unroll
            for (int bj = 0; bj < 2; ++bj) { const f32x4 b0 = *(const f32x4*)(bp + bj * HALF), b1 = *(const f32x4*)(bp + bj * HALF + 4);
#pragma unroll
                for (int ai = 0; ai < 2; ++ai)
#pragma unroll
                    for (int m = 0; m < 4; ++m) { const f32x4 z0 = acc[ai][bj][m][0] + b0, z1 = acc[ai][bj][m][1] + b1; float g[8];
#pragma unroll
                        for (int j = 0; j < 4; ++j) { g[j] = fmaxf(sigmoidf_(z0[j]), 1e-30f); g[4 + j] = fmaxf(sigmoidf_(z1[j]), 1e-30f); }
                        v4u w; w.x = cvt_pk_bf16(g[0], g[1]); w.y = cvt_pk_bf16(g[2], g[3]); w.z = cvt_pk_bf16(g[4], g[5]); w.w = cvt_pk_bf16(g[6], g[7]);
                        gs[(ai * 4 + m) * 2 + bj] = w; } }
        } else if ((KM & 4) && u.kind == 2) {
            const v4u* gc = gscr + ((size_t)2 * 512 + ((wr * 4 + wc) * 64 + fq * 16 + fr)) * 16; asm volatile("" : "+v"(gc));
            const int row0 = u.r0 + wr * 64 + fr, col0 = u.c0 + wc * 32 + 8 * fq;
#pragma unroll
            for (int ai = 0; ai < 2; ++ai)
#pragma unroll
                for (int m = 0; m < 4; ++m) { bf16* rowp = O + (size_t)(row0 + ai * HALF + m * 16) * ldc + col0;
#pragma unroll
                    for (int bj = 0; bj < 2; ++bj) { const v4u y = gc[(ai * 4 + m) * 2 + bj]; const f32x4 a0 = acc[ai][bj][m][0], a1 = acc[ai][bj][m][1];
                        v4u w; w.x = cvt_pk_bf16(a0[0] * bflo(y.x), a0[1] * bfhi(y.x)); w.y = cvt_pk_bf16(a0[2] * bflo(y.y), a0[3] * bfhi(y.y));
                        w.z = cvt_pk_bf16(a1[0] * bflo(y.z), a1[1] * bfhi(y.z)); w.w = cvt_pk_bf16(a1[2] * bflo(y.w), a1[3] * bfhi(y.w));
                        *(v4u*)(rowp + bj * HALF) = w; }
                    asm volatile("" ::: "memory"); }
        } else if (KM & 8) {
            const int row0 = u.r0 + wr * 64 + fr, col0 = u.c0 + wc * 32 + 8 * fq;
#pragma unroll
            for (int ai = 0; ai < 2; ++ai)
#pragma unroll
                for (int m = 0; m < 4; ++m) { bf16* rowp = O + (size_t)(row0 + ai * HALF + m * 16) * ldc + col0; float hv[8];
#pragma unroll
                    for (int n = 0; n < 2; ++n)
#pragma unroll
                        for (int j = 0; j < 4; ++j) { const float gt = acc[ai][0][m][n][j], up = acc[ai][1][m][n][j]; hv[n * 4 + j] = gt * sigmoidf_(gt) * up; }
                    v4u w; w.x = cvt_pk_bf16(hv[0], hv[1]); w.y = cvt_pk_bf16(hv[2], hv[3]); w.z = cvt_pk_bf16(hv[4], hv[5]); w.w = cvt_pk_bf16(hv[6], hv[7]);
                    *(v4u*)rowp = w; }
        }
    }
};
}
namespace attn_body {
using bf16=__hip_bfloat16;
using bf16x8=__attribute__((ext_vector_type(8)))short;
using s16x4=__attribute__((ext_vector_type(4)))short;
using f32x16=__attribute__((ext_vector_type(16)))float;
using u32x4=__attribute__((ext_vector_type(4)))unsigned;
constexpr int SEQ=4096,D=64,PQ=5376,PO=1024;
constexpr int NW=8,QBLK=32,QB=QBLK*NW,KVBLK=64,NQB=SEQ/QB;
constexpr int ATTN_UNIT_ROWS=QB;
__device__ __forceinline__ int crow(int r,int hi){return (r&3)+8*(r>>2)+4*hi;}
#define SBAR() __builtin_amdgcn_sched_barrier(0)
__device__ __forceinline__ void cmask(f32x16&p0,f32x16&p1,int jb,int qrel,int hi){
  const float NEG=-INFINITY; int kb=64*jb+4*hi;
  #pragma unroll
  for(int r=0;r<16;++r){int kv=kb+(r&3)+8*(r>>2); if(kv>qrel)p0[r]=NEG; if(kv+32>qrel)p1[r]=NEG;}
}

constexpr int NSLOT=3, SLOTB=8192;
constexpr int LDS_K=0, LDS_V=NSLOT*SLOTB, LDS_WS=2*NSLOT*SLOTB, LDS_OST=LDS_WS+NW*64*4, LDS_BYTES=LDS_OST+NW*4096;
constexpr float C2=0.125f*1.4426950408889634f;
__device__ __forceinline__ void glds16(const void*gsrc,unsigned lds_dst){unsigned keep;
  asm volatile("s_mov_b32 %0, m0\n\ts_mov_b32 m0, %2\n\ts_nop 0\n\tglobal_load_lds_dwordx4 %1, off\n\ts_mov_b32 m0, %0":"=&s"(keep):"v"(gsrc),"s"(lds_dst):"memory");}
__device__ __forceinline__ float max3f(float a,float b,float c){float r;asm("v_max3_f32 %0, %1, %2, %3":"=v"(r):"v"(a),"v"(b),"v"(c));return r;}
__device__ __forceinline__ float max2f(float a,float b){float r;asm("v_max_f32_e32 %0, %1, %2":"=v"(r):"v"(a),"v"(b));return r;}
__device__ __forceinline__ float fadd_s(float a,float b){float r;asm("v_add_f32_e32 %0, %1, %2":"=v"(r):"v"(a),"v"(b));return r;}
__device__ __forceinline__ float fsub_s(float a,float b){float r;asm("v_sub_f32_e32 %0, %1, %2":"=v"(r):"v"(a),"v"(b));return r;}
typedef float f32x2_t __attribute__((ext_vector_type(2))); typedef __bf16 bf16x2_t __attribute__((ext_vector_type(2)));
__device__ __forceinline__ unsigned cvtpk_s(float lo,float hi){f32x2_t v={lo,hi};bf16x2_t b=__builtin_convertvector(v,bf16x2_t);return __builtin_bit_cast(unsigned,b);}
#define WAIT_BAR(N) asm volatile("s_waitcnt vmcnt(" #N ") lgkmcnt(0)\n\ts_barrier":::"memory")

__device__ __forceinline__ void qkt(f32x16&p0,f32x16&p1,const char*Kslot,const bf16x8*qr,int r32,int hi){ const f32x16 negm=f32x16{};
  const char*kb=Kslot+hi*1024+r32*16;
  #pragma unroll
  for(int d0=0;d0<4;++d0){
    const bf16x8 b0=*reinterpret_cast<const bf16x8*>(kb+d0*2048);
    const bf16x8 b1=*reinterpret_cast<const bf16x8*>(kb+d0*2048+512);
    if(d0==0){p0=__builtin_amdgcn_mfma_f32_32x32x16_bf16(b0,qr[0],negm,0,0,0);p1=__builtin_amdgcn_mfma_f32_32x32x16_bf16(b1,qr[0],negm,0,0,0);}
    else{p0=__builtin_amdgcn_mfma_f32_32x32x16_bf16(b0,qr[d0],p0,0,0,0);p1=__builtin_amdgcn_mfma_f32_32x32x16_bf16(b1,qr[d0],p1,0,0,0);}}
}
typedef __attribute__((address_space(3))) const char* lds_cptr;
typedef short v4i16_t __attribute__((ext_vector_type(4)));
__device__ __forceinline__ void kload8(bf16x8*kf,lds_cptr kp){
  kf[0]=*(const __attribute__((address_space(3))) bf16x8*)(kp);      kf[1]=*(const __attribute__((address_space(3))) bf16x8*)(kp+512);
  kf[2]=*(const __attribute__((address_space(3))) bf16x8*)(kp+2048); kf[3]=*(const __attribute__((address_space(3))) bf16x8*)(kp+2560);
  kf[4]=*(const __attribute__((address_space(3))) bf16x8*)(kp+4096); kf[5]=*(const __attribute__((address_space(3))) bf16x8*)(kp+4608);
  kf[6]=*(const __attribute__((address_space(3))) bf16x8*)(kp+6144); kf[7]=*(const __attribute__((address_space(3))) bf16x8*)(kp+6656);
}
__device__ __forceinline__ void kload2(bf16x8*kf,lds_cptr kp,int j){ kf[2*j]=*(const __attribute__((address_space(3))) bf16x8*)(kp+j*2048); kf[2*j+1]=*(const __attribute__((address_space(3))) bf16x8*)(kp+j*2048+512); }
__device__ __forceinline__ s16x4 vtr(lds_cptr p){ return __builtin_bit_cast(s16x4,__builtin_amdgcn_ds_read_tr16_b64_v4i16((__attribute__((address_space(3))) v4i16_t*)p)); }
__device__ __forceinline__ float rowmax(const f32x16&p0,const f32x16&p1){
  float a=max3f(p0[0],p0[1],p1[0]),b=max3f(p0[2],p0[3],p1[1]);a=max3f(a,p1[2],p1[3]);
  #pragma unroll
  for(int r=4;r<16;r+=4){a=max3f(a,p0[r],p0[r+1]);b=max3f(b,p0[r+2],p0[r+3]);a=max3f(a,p1[r],p1[r+1]);b=max3f(b,p1[r+2],p1[r+3]);}
  const float m=max2f(a,b);
  auto rr=__builtin_amdgcn_permlane32_swap(__float_as_uint(m),__float_as_uint(m),false,false);
  return max2f(__uint_as_float(rr[0]),__uint_as_float(rr[1]));
}
__device__ __forceinline__ void pv(f32x16*o,int vb,bf16x8 pa0,bf16x8 pa1,bf16x8 pa2,bf16x8 pa3){
  #pragma unroll
  for(int d0=0;d0<2;++d0){s16x4 lo[4],hi[4];
    #pragma unroll
    for(int ks=0;ks<4;++ks){
      asm volatile("ds_read_b64_tr_b16 %0,%1 offset:%c2":"=&v"(lo[ks]):"v"(vb),"i"(d0*4096+ks*1024):"memory");
      asm volatile("ds_read_b64_tr_b16 %0,%1 offset:%c2":"=&v"(hi[ks]):"v"(vb),"i"(d0*4096+ks*1024+512):"memory");}
    asm volatile("s_waitcnt lgkmcnt(0)":::"memory");SBAR();
    #define PK(k) (bf16x8){lo[k][0],lo[k][1],lo[k][2],lo[k][3],hi[k][0],hi[k][1],hi[k][2],hi[k][3]}
    o[d0]=__builtin_amdgcn_mfma_f32_32x32x16_bf16(pa0,PK(0),o[d0],0,0,0);
    o[d0]=__builtin_amdgcn_mfma_f32_32x32x16_bf16(pa1,PK(1),o[d0],0,0,0);
    o[d0]=__builtin_amdgcn_mfma_f32_32x32x16_bf16(pa2,PK(2),o[d0],0,0,0);
    o[d0]=__builtin_amdgcn_mfma_f32_32x32x16_bf16(pa3,PK(3),o[d0],0,0,0);
    #undef PK
  }
}

#ifndef ATTN_STORE16
#define ATTN_STORE16(p,v) (*(u32x4*)(p)=(v))
#endif
template<int THRL> __device__ __forceinline__ void attn_unit(int b,int qcol,int kcol,int vcol,int ocol,float slope2,int qb,const bf16*__restrict__ P,bf16*O,char*shm){
  int tid_=threadIdx.x; asm volatile("":"+v"(tid_));
  const int tid=tid_,lane=tid&63,r32=lane&31,hi=lane>>5; const int wid=__builtin_amdgcn_readfirstlane(tid>>6);
  const long rowbase=(long)b*SEQ; const int q0=qb*QB;
  const bf16*Qw=P+(rowbase+q0+wid*QBLK)*PQ+qcol;
  const bf16*Kh=P+rowbase*PQ+kcol,*Vh=P+rowbase*PQ+vcol;
  const unsigned lds0=(unsigned)(uintptr_t)shm;
  float*wsf=(float*)(shm+LDS_WS)+wid*64;
  const bf16*ksrc=Kh+(long)lane*PQ+wid*8;
  const bf16*vsrc=Vh+(long)(16*(wid&3)+(lane>>2))*PQ+(wid>>2)*32+(lane&3)*8;
  const unsigned kdst=lds0+LDS_K+wid*1024, vdst=lds0+LDS_V+wid*1024;
  #define DMA_K(t,slot) glds16(ksrc+(long)(t)*KVBLK*PQ,(unsigned)__builtin_amdgcn_readfirstlane(kdst+(slot)))
  #define DMA_V(t,slot) glds16(vsrc+(long)(t)*KVBLK*PQ,(unsigned)__builtin_amdgcn_readfirstlane(vdst+(slot)))
  const int vb0=(int)(lds0+LDS_V)+((lane>>4)&1)*32+(lane&3)*8+(4*hi+((lane&15)>>2))*64;
  const char*Kbase=shm+LDS_K; bf16x8 kf[8];
  const lds_cptr shm3=(lds_cptr)shm; const lds_cptr kp0=shm3+LDS_K+hi*1024+r32*16; const lds_cptr vp0=shm3+LDS_V+((lane>>4)&1)*32+(lane&3)*8+(4*hi+((lane&15)>>2))*64;
  const int NT=(q0+QB)/KVBLK;
  DMA_K(0,0);DMA_V(0,0);DMA_K(1,SLOTB);
  bf16x8 qr[4];
  #pragma unroll
  for(int d0=0;d0<4;++d0)qr[d0]=*reinterpret_cast<const bf16x8*>(&Qw[(long)r32*PQ+d0*16+hi*8]);
  float mhat=0.f,l_reg=0.f;f32x16 o[2];o[0]=f32x16{};o[1]=f32x16{};const f32x16 negm=f32x16{};
  const float sr1_=__builtin_bit_cast(float,__builtin_amdgcn_readfirstlane(__builtin_bit_cast(int,slope2))), sr2_=__builtin_bit_cast(float,__builtin_amdgcn_readfirstlane(__builtin_bit_cast(int,2.f*slope2))), sr3_=__builtin_bit_cast(float,__builtin_amdgcn_readfirstlane(__builtin_bit_cast(int,3.f*slope2)));
  const float hib=slope2*(float)(4*hi);
  #define ALIBI(P0,P1,t) do{ const float tm0_=slope2*(float)(64*(t))+hib-mhat; \
    _Pragma("unroll") for(int q_=0;q_<4;++q_){ const float a_=tm0_+(8.f*slope2)*(float)q_, b_=a_+32.f*slope2; \
      P0[4*q_]+=a_; P0[4*q_+1]=(P0[4*q_+1]+a_)+sr1_; P0[4*q_+2]=(P0[4*q_+2]+a_)+sr2_; P0[4*q_+3]=(P0[4*q_+3]+a_)+sr3_; \
      P1[4*q_]+=b_; P1[4*q_+1]=(P1[4*q_+1]+b_)+sr1_; P1[4*q_+2]=(P1[4*q_+2]+b_)+sr2_; P1[4*q_+3]=(P1[4*q_+3]+b_)+sr3_; } }while(0)
  const int qrel=wid*QBLK+r32;
  #define CMASK(P0,P1,t) do{int jb_=(t)-(NT-4); if(jb_>=0)cmask(P0,P1,jb_,qrel,hi);}while(0)
  bool resc=false;
  #define START(P0,P1) do{ const float rm=rowmax(P0,P1); resc=false; \
    { const float dl=rm; mhat=fadd_s(mhat,dl); \
      _Pragma("unroll") for(int r=0;r<16;++r){P0[r]=fsub_s(P0[r],dl);P1[r]=fsub_s(P1[r],dl);} \
      } \
    _Pragma("unroll") for(int r=0;r<16;++r)P0[r]=__builtin_amdgcn_exp2f(P0[r]); }while(0)
  #define RESC() do{ if(resc){ asm volatile("s_waitcnt lgkmcnt(0)":::"memory"); \
      _Pragma("unroll") for(int d_=0;d_<2;++d_) _Pragma("unroll") for(int r=0;r<16;++r)o[d_][r]*=wsf[crow(r,hi)]; } }while(0)
  f32x16 pA0,pA1,pB0,pB1;
  int sl_prev=0,sl_cur=0,sl_next=SLOTB;
  #define ROT() do{sl_prev=sl_cur;sl_cur=sl_next;sl_next=(sl_next==(NSLOT-1)*SLOTB)?0:sl_next+SLOTB;}while(0)
  DMA_K(2,2*SLOTB);
  WAIT_BAR(3);
  qkt(pA0,pA1,Kbase,qr,r32,hi);asm volatile("s_nop 15\n\ts_nop 7":"+v"(pA0),"+v"(pA1));ALIBI(pA0,pA1,0);asm volatile("":"+v"(pA0),"+v"(pA1));CMASK(pA0,pA1,0);
  START(pA0,pA1);
  _Pragma("unroll") for(int r=0;r<16;++r)pA1[r]=__builtin_amdgcn_exp2f(pA1[r]);
  WAIT_BAR(0);
  DMA_K(3,0);DMA_V(1,SLOTB);
  ROT();
  kload8(kf,kp0+sl_cur);
  WAIT_BAR(2);
  s16x4 vlo[8],vhi[8]; u32x4 pw0,pw1,pw2,pw3;
  #define PKW(P,B) cvtpk_s(P[B],P[B+1])
  #define PAF(k) __builtin_bit_cast(bf16x8,pw##k)
  #define VFR(i) (bf16x8){vlo[i][0],vlo[i][1],vlo[i][2],vlo[i][3],vhi[i][0],vhi[i][1],vhi[i][2],vhi[i][3]}
  #define PIN(x) asm volatile("":"+v"(x))
  #define MX3(a,b,c) __builtin_fmaxf(__builtin_fmaxf((a),(b)),(c))
  #define GAPA(MF,A0,A1,A2,A3,W0,W1,PW) do{ MF; sacc+=A0; sacc+=A1; sacc+=A2; sacc+=A3; PIN(sacc); W0; W1; PIN(PW); SBAR(); }while(0)
  #define EX(v) __builtin_amdgcn_exp2f(v)
  #define GAPB(MF,X,B) do{ MF; X[B]=EX(X[B]); X[B+1]=EX(X[B+1]); X[B+2]=EX(X[B+2]); X[B+3]=EX(X[B+3]); PIN(X); SBAR(); }while(0)
  #define VRD(i) do{ vlo[i]=vtr(vp_+(((i)>>2)*4096+((i)&3)*1024)); vhi[i]=vtr(vp_+(((i)>>2)*4096+((i)&3)*1024+512)); }while(0)
  #define KRD(G,j) do{ if(G){ kload2(kf,kp0+sl_next,j); SBAR(); } }while(0)
  #define STEP(C0,C1,P0,P1,t,GK,GV,GL) do{ SBAR(); \
    const lds_cptr vp_=vp0+sl_prev; \
    VRD(0); SBAR(); float sacc=(P0[0]+P0[1]); \
    GAPA(C0=__builtin_amdgcn_mfma_f32_32x32x16_bf16(kf[0],qr[0],negm,0,0,0), P0[2],P0[3],P0[4],P0[5],     pw0[0]=PKW(P0,0), pw0[1]=PKW(P0,2), pw0); \
    VRD(4); SBAR(); GAPA(C1=__builtin_amdgcn_mfma_f32_32x32x16_bf16(kf[1],qr[0],negm,0,0,0), P0[6],P0[7],P0[8],P0[9],     pw0[2]=PKW(P0,4), pw0[3]=PKW(P0,6), pw0); \
    VRD(1); SBAR(); GAPA(C0=__builtin_amdgcn_mfma_f32_32x32x16_bf16(kf[2],qr[1],C0,0,0,0),   P0[10],P0[11],P0[12],P0[13], pw1[0]=PKW(P0,8), pw1[1]=PKW(P0,10), pw1); \
    VRD(5); SBAR(); GAPA(C1=__builtin_amdgcn_mfma_f32_32x32x16_bf16(kf[3],qr[1],C1,0,0,0),   P0[14],P0[15],P1[0],P1[1],   pw1[2]=PKW(P0,12),pw1[3]=PKW(P0,14), pw1); \
    VRD(2); SBAR(); GAPA(C0=__builtin_amdgcn_mfma_f32_32x32x16_bf16(kf[4],qr[2],C0,0,0,0),   P1[2],P1[3],P1[4],P1[5],     pw2[0]=PKW(P1,0), pw2[1]=PKW(P1,2), pw2); \
    VRD(6); SBAR(); GAPA(C1=__builtin_amdgcn_mfma_f32_32x32x16_bf16(kf[5],qr[2],C1,0,0,0),   P1[6],P1[7],P1[8],P1[9],     pw2[2]=PKW(P1,4), pw2[3]=PKW(P1,6), pw2); \
    VRD(3); SBAR(); GAPA(C0=__builtin_amdgcn_mfma_f32_32x32x16_bf16(kf[6],qr[3],C0,0,0,0),   P1[10],P1[11],P1[12],P1[13], pw3[0]=PKW(P1,8), pw3[1]=PKW(P1,10), pw3); \
    VRD(7); SBAR(); GAPA(C1=__builtin_amdgcn_mfma_f32_32x32x16_bf16(kf[7],qr[3],C1,0,0,0),   P1[14],P1[15],0.f,0.f,       pw3[2]=PKW(P1,12),pw3[3]=PKW(P1,14), pw3); \
    l_reg+=sacc; \
    if(GK){DMA_K((t)+3,sl_cur);} if(GV){DMA_V((t)+1,sl_next);} \
    ALIBI(C0,C1,t); CMASK(C0,C1,t); \
    { float a=MX3(C0[0],C0[1],C1[0]),b=MX3(C0[2],C0[3],C1[1]); a=MX3(a,C1[2],C1[3]); \
      _Pragma("unroll") for(int r=4;r<16;r+=4){a=MX3(a,C0[r],C0[r+1]);b=MX3(b,C0[r+2],C0[r+3]);a=MX3(a,C1[r],C1[r+1]);b=MX3(b,C1[r+2],C1[r+3]);} \
      float rm=__builtin_fmaxf(a,b); { auto rr=__builtin_amdgcn_permlane32_swap(__float_as_uint(rm),__float_as_uint(rm),false,false); rm=__builtin_fmaxf(__uint_as_float(rr[0]),__uint_as_float(rr[1])); } \
      resc=false; \
      if(__builtin_expect(__any(rm>(float)THRL),0)){ const float dl=__builtin_fmaxf(rm,0.f); mhat+=dl; \
        _Pragma("unroll") for(int r=0;r<16;++r){C0[r]-=dl;C1[r]-=dl;} \
        const float f=__builtin_amdgcn_exp2f(-dl); l_reg*=f; if(hi==0)wsf[r32]=f; resc=true; } } \
    SBAR(); \
    GAPB(o[0]=__builtin_amdgcn_mfma_f32_32x32x16_bf16(PAF(0),VFR(0),o[0],0,0,0), C0,0); \
    GAPB(o[1]=__builtin_amdgcn_mfma_f32_32x32x16_bf16(PAF(0),VFR(4),o[1],0,0,0), C0,4); \
    KRD(GL,0); GAPB(o[0]=__builtin_amdgcn_mfma_f32_32x32x16_bf16(PAF(1),VFR(1),o[0],0,0,0), C0,8); \
    KRD(GL,1); GAPB(o[1]=__builtin_amdgcn_mfma_f32_32x32x16_bf16(PAF(1),VFR(5),o[1],0,0,0), C0,12); \
    KRD(GL,2); GAPB(o[0]=__builtin_amdgcn_mfma_f32_32x32x16_bf16(PAF(2),VFR(2),o[0],0,0,0), C1,0); \
    KRD(GL,3); GAPB(o[1]=__builtin_amdgcn_mfma_f32_32x32x16_bf16(PAF(2),VFR(6),o[1],0,0,0), C1,4); \
    GAPB(o[0]=__builtin_amdgcn_mfma_f32_32x32x16_bf16(PAF(3),VFR(3),o[0],0,0,0), C1,8); \
    GAPB(o[1]=__builtin_amdgcn_mfma_f32_32x32x16_bf16(PAF(3),VFR(7),o[1],0,0,0), C1,12); \
    }while(0)
  int t=1;
  #undef CMASK
  #define CMASK(P0,P1,t) do{}while(0)
  for(;t+5<NT;t+=2){
    STEP(pB0,pB1,pA0,pA1,t,true,true,true);     WAIT_BAR(2); RESC(); ROT();
    STEP(pA0,pA1,pB0,pB1,t+1,true,true,true);   WAIT_BAR(2); RESC(); ROT();
  }
  #undef CMASK
  #define CMASK(P0,P1,t) do{int jb_=(t)-(NT-4); if(jb_>=0)cmask(P0,P1,jb_,qrel,hi);}while(0)
  #define ENDW(tt) do{ if((tt)+3<NT){WAIT_BAR(2);} else if((tt)+2<NT){WAIT_BAR(1);} else {WAIT_BAR(0);} }while(0)
  for(;t+1<NT;t+=2){
    STEP(pB0,pB1,pA0,pA1,t,(t+3<NT),(t+1<NT),(t+1<NT));       ENDW(t);   RESC(); ROT();
    STEP(pA0,pA1,pB0,pB1,t+1,(t+4<NT),(t+2<NT),(t+2<NT));     ENDW(t+1); RESC(); ROT();
  }
  STEP(pB0,pB1,pA0,pA1,NT-1,false,false,false); RESC();
  { float sacc=pB0[0]+pB0[1]; _Pragma("unroll") for(int r=2;r<16;++r)sacc+=pB0[r]; _Pragma("unroll") for(int r=0;r<16;++r)sacc+=pB1[r]; l_reg+=sacc;
    pw0=(u32x4){PKW(pB0,0),PKW(pB0,2),PKW(pB0,4),PKW(pB0,6)};pw1=(u32x4){PKW(pB0,8),PKW(pB0,10),PKW(pB0,12),PKW(pB0,14)};pw2=(u32x4){PKW(pB1,0),PKW(pB1,2),PKW(pB1,4),PKW(pB1,6)};pw3=(u32x4){PKW(pB1,8),PKW(pB1,10),PKW(pB1,12),PKW(pB1,14)};
    SBAR(); pv(o,vb0+sl_cur,PAF(0),PAF(1),PAF(2),PAF(3)); }
  #undef PKW
  #undef PAF
  #undef VFR
  #undef PIN
  #undef MX3
  #undef GAPA
  #undef GAPB
  #undef EX
  #undef VRD
  #undef KRD
  #undef STEP
  #undef ENDW
  {auto rr=__builtin_amdgcn_permlane32_swap(__float_as_uint(l_reg),__float_as_uint(l_reg),false,false);l_reg=__uint_as_float(rr[0])+__uint_as_float(rr[1]);}
  if(hi==0)wsf[32+r32]=l_reg;asm volatile("s_waitcnt lgkmcnt(0)":::"memory");
  float rli[16];
  #pragma unroll
  for(int r=0;r<16;++r)rli[r]=__builtin_amdgcn_rcpf(wsf[32+crow(r,hi)]);
  bf16*Ow=O+(rowbase+q0+wid*QBLK)*PO+ocol;
  { bf16*stg=(bf16*)(shm+LDS_OST)+wid*2048;
    #pragma unroll
    for(int r=0;r<16;++r){const int orow=crow(r,hi);
      #pragma unroll
      for(int d0=0;d0<2;++d0)stg[orow*64+d0*32+r32]=__float2bfloat16(o[d0][r]*rli[r]);}
    asm volatile("s_waitcnt lgkmcnt(0)":::"memory");
    #pragma unroll
    for(int i=0;i<4;++i){const int row=i*8+(lane>>3),ch=lane&7; const u32x4 v=*(const u32x4*)(stg+row*64+ch*8); ATTN_STORE16(Ow+(long)row*PO+ch*8,v);} }
  asm volatile("s_waitcnt lgkmcnt(0)\n\ts_barrier":::"memory");
  #undef DMA_K
  #undef DMA_V
  #undef CMASK
  #undef START
  #undef RESC
  #undef ROT
  #undef ALIBI
}
constexpr int ATTN_LDS_BYTES=LDS_BYTES;
#undef SBAR
#undef WAIT_BAR
}
struct MixP {
    const bf16* proj; bf16* ocat; bf16* oatt;
    const float* hg_lb;
    const float* hg_norm_g;
    float lam, one_m_lam_init;
    const float* da_subln_g;
    const float *rw_mu, *rw_w0, *rw_a0, *rw_k_k, *rw_k_a, *rw_r_k, *rw_gn_g, *rw_gn_b;
    const bf16 *wupT, *aupT, *gupT;
    gu32* aq;
};

__device__ __forceinline__ void attn_group(const MixP& P, int b, int h, int qb, char* lds) {
    const float slope2 = exp2f(-2.0f * (float)(h + 1)) * LOG2E;
    const float s2 = __builtin_bit_cast(float, __builtin_amdgcn_readfirstlane(__builtin_bit_cast(int, slope2)));
    const attn_body::bf16* pr = (const attn_body::bf16*)P.proj; attn_body::bf16* oa = (attn_body::bf16*)P.oatt;
#pragma unroll 1
    for (int sub = 0; sub < 4; ++sub) {
        const int mp = sub >> 1, hf = sub & 1;
        attn_body::attn_unit<8>(b, C_DAQ + h * 128 + mp * 64, C_DAK + h * 128 + mp * 64, C_DAV + h * 128 + hf * 64, h * 256 + mp * 128 + hf * 64, s2, qb, pr, oa, lds);
    }
    VM_WAIT(); __syncthreads();
    {
        int tid_ = threadIdx.x; asm volatile("" : "+v"(tid_)); const int tid = tid_, row = tid >> 1, hf = tid & 1;
        const size_t grow = (size_t)b * T + (size_t)qb * 256 + row;
        const bf16* o0 = P.oatt + grow * 1024 + h * 256 + hf * 64; const bf16* o1 = o0 + 128;
        float v[64]; float ss = 0.f;
#pragma unroll
        for (int c = 0; c < 8; ++c) { const v4u x = __builtin_nontemporal_load((const v4u*)(o0) + c), y = __builtin_nontemporal_load((const v4u*)(o1) + c);
            const unsigned xs[4] = {x.x, x.y, x.z, x.w}, ys[4] = {y.x, y.y, y.z, y.w};
#pragma unroll
            for (int j = 0; j < 4; ++j) { const float a = bflo(xs[j]) - P.lam * bflo(ys[j]), d = bfhi(xs[j]) - P.lam * bfhi(ys[j]); v[c * 8 + 2 * j] = a; v[c * 8 + 2 * j + 1] = d; ss += a * a + d * d; } }
        ss += __shfl_xor(ss, 1);
        const float rs = rsqrtf(ss * (1.0f / 128.0f) + RMS_EPS) * P.one_m_lam_init;
        bf16* dst = P.ocat + grow * 1536 + 512 + h * 128 + hf * 64; const float* g = P.da_subln_g + hf * 64;
#pragma unroll
        for (int c = 0; c < 8; ++c) { v4u w; w.x = pk2(v[c * 8 + 0] * rs * g[c * 8 + 0], v[c * 8 + 1] * rs * g[c * 8 + 1]); w.y = pk2(v[c * 8 + 2] * rs * g[c * 8 + 2], v[c * 8 + 3] * rs * g[c * 8 + 3]);
            w.z = pk2(v[c * 8 + 4] * rs * g[c * 8 + 4], v[c * 8 + 5] * rs * g[c * 8 + 5]); w.w = pk2(v[c * 8 + 6] * rs * g[c * 8 + 6], v[c * 8 + 7] * rs * g[c * 8 + 7]);
            *((v4u*)dst + c) = w; }
    }
    __syncthreads();
}
__device__ __forceinline__ void attn_worker(const MixP& P, char* lds, volatile LAS unsigned* bcast, int tid) {
    for (;;) {
        if (tid == 0) bcast[0] = __hip_atomic_fetch_add(P.aq, 1u, RLX_AGENT);
        __syncthreads();
        const unsigned idx = bcast[0];
        __syncthreads();
        if (idx >= 512u) break;
        const int qb = 15 - (int)(idx >> 5), bh = (int)(idx & 31u);
        attn_group(P, bh >> 2, bh & 3, qb, lds);
    }
}

constexpr int HG_QH = 0, HG_QT = 17408, HG_KT = 34816, HG_KHT = 52224, HG_VV = 70656, HG_OG = 88064, HG_AM = 105472, HG_BQ = 114688, HG_SS = 116736, HG_DD = 118784, HG_END = 119296;
constexpr int HS = 272, HS2 = 144;
__device__ __forceinline__ s16x4 tr_rd(unsigned addr) { s16x4 r; asm volatile("ds_read_b64_tr_b16 %0, %1\n\ts_waitcnt lgkmcnt(0)" : "=&v"(r) : "v"(addr) : "memory"); return r; }
__device__ __forceinline__ void hgrn_unit(const MixP& P, int b, int h, LAS unsigned char* lds) {
    int tid_ = threadIdx.x; asm volatile("" : "+v"(tid_));
    const int tid = tid_, lane = tid & 63, w = __builtin_amdgcn_readfirstlane(tid >> 6), g = lane >> 4, li = lane & 15;
    const int kk_ = tid & 127, tq = tid >> 7;
    const float lb = P.hg_lb[h * 128 + kk_], oml = 1.0f - lb;
    LAS float* BQ = (LAS float*)(lds + HG_BQ); LAS float* SS = (LAS float*)(lds + HG_SS); LAS float* DD = (LAS float*)(lds + HG_DD);
    f32x4 Sacc[8];
#pragma unroll
    for (int i = 0; i < 8; ++i) Sacc[i] = (f32x4){0.f, 0.f, 0.f, 0.f};
    const unsigned ldsb = (unsigned)(uintptr_t)lds;
    const float ng = P.hg_norm_g[16 * w + li];
    v4u pf[8];
#define HG_LOADPF(cc) do { const size_t r0_ = (size_t)b * T + (size_t)(cc) * 64; _Pragma("unroll") for (int i_ = 0; i_ < 8; ++i_) { const int ix_ = tid + 512 * (i_ & 1); \
        pf[i_] = *(const v4u*)(P.proj + (r0_ + (ix_ >> 4)) * INW + (i_ >> 1) * 512 + h * 128 + (ix_ & 15) * 8); } } while (0)
#define LBAR() asm volatile("s_waitcnt lgkmcnt(0)\n\ts_barrier" ::: "memory")
    HG_LOADPF(0);
#pragma unroll 1
    for (int c = 0; c < 64; ++c) {
        const size_t row0 = (size_t)b * T + (size_t)c * 64;
#pragma unroll
        for (int i = 0; i < 8; ++i) { const int ix = tid + 512 * (i & 1); const int reg = (i >> 1) == 0 ? HG_QH : (i >> 1) == 1 ? HG_KT : (i >> 1) == 2 ? HG_VV : HG_OG;
            *(LAS v4u*)(lds + reg + (ix >> 4) * HS + (ix & 15) * 16) = pf[i]; }
        if (c < 63) HG_LOADPF(c + 1);
        LBAR();
        float cs[16], kv[16]; float run = 0.f;
#pragma unroll
        for (int i = 0; i < 16; ++i) { const float z = bf2f(*(const LAS unsigned short*)(lds + HG_KT + (16 * tq + i) * HS + kk_ * 2)); const float sg = sigmoidf_(z); const float f = lb + oml * sg;
            run += __logf(fmaxf(f, HG_F_MIN)); cs[i] = run; kv[i] = oml * (1.0f - sg); }
        BQ[tq * 128 + kk_] = run;
        LBAR();
        const float q0 = BQ[kk_], q1 = BQ[128 + kk_], q2 = BQ[256 + kk_], q3 = BQ[384 + kk_];
        const float off = (tq > 0 ? q0 : 0.f) + (tq > 1 ? q1 : 0.f) + (tq > 2 ? q2 : 0.f);
        const float blast = (q0 + q1) + (q2 + q3), ref = q0 + q1;
        if (tq == 0) DD[kk_] = __expf(blast);
#pragma unroll
        for (int i = 0; i < 16; ++i) { const int t = 16 * tq + i; const float bt = off + cs[i];
            const float q = bf2f(*(const LAS unsigned short*)(lds + HG_QH + t * HS + kk_ * 2));
            *(LAS unsigned short*)(lds + HG_QH + t * HS + kk_ * 2) = (unsigned short)f2bf(q * __expf(bt));
            *(LAS unsigned short*)(lds + HG_QT + t * HS + kk_ * 2) = (unsigned short)f2bf(q * __expf(fminf(bt - ref, 60.f)));
            *(LAS unsigned short*)(lds + HG_KT + t * HS + kk_ * 2) = (unsigned short)f2bf(kv[i] * __expf(fminf(ref - bt, 60.f)));
            *(LAS unsigned short*)(lds + HG_KHT + kk_ * HS2 + t * 2) = (unsigned short)f2bf(kv[i] * __expf(blast - bt));
            }
        LBAR();
        {   const int mt = w >> 1;
#pragma unroll
            for (int j = 0; j < 2; ++j) { const int st = 2 * (w & 1) + j; f32x4 a = (f32x4){0.f, 0.f, 0.f, 0.f};
#pragma unroll
                for (int ks = 0; ks < 4; ++ks) { const bf16x8 fa = *(const LAS bf16x8*)(lds + HG_KT + (16 * st + li) * HS + ks * 64 + g * 16);
                    const bf16x8 fb = *(const LAS bf16x8*)(lds + HG_QT + (16 * mt + li) * HS + ks * 64 + g * 16);
                    a = __builtin_amdgcn_mfma_f32_16x16x32_bf16(fa, fb, a, 0, 0, 0); }
                const int tt = 16 * mt + li, s0 = 16 * st + 4 * g;
                v2u wv; wv.x = pk2(s0 <= tt ? a[0] : 0.f, s0 + 1 <= tt ? a[1] : 0.f); wv.y = pk2(s0 + 2 <= tt ? a[2] : 0.f, s0 + 3 <= tt ? a[3] : 0.f);
                *(LAS v2u*)(lds + HG_AM + tt * HS2 + s0 * 2) = wv; }
        }
        LBAR();
        bf16x8 vf[2];
        {   const int q = li >> 2, p = li & 3;
#pragma unroll
            for (int ks = 0; ks < 2; ++ks) { const unsigned a0 = ldsb + HG_VV + (32 * ks + 8 * g + q) * HS + (16 * w + 4 * p) * 2;
                const s16x4 lo = tr_rd(a0), hi = tr_rd(a0 + 4 * HS);
                vf[ks] = (bf16x8){lo[0], lo[1], lo[2], lo[3], hi[0], hi[1], hi[2], hi[3]}; } }
        bf16x8 sb[4];
#pragma unroll
        for (int s = 0; s < 4; ++s) { v4u x; x.x = pk2(Sacc[2 * s][0], Sacc[2 * s][1]); x.y = pk2(Sacc[2 * s][2], Sacc[2 * s][3]); x.z = pk2(Sacc[2 * s + 1][0], Sacc[2 * s + 1][1]); x.w = pk2(Sacc[2 * s + 1][2], Sacc[2 * s + 1][3]);
            sb[s] = __builtin_bit_cast(bf16x8, x); }
        f32x4 o[4];
#pragma unroll
        for (int mt = 0; mt < 4; ++mt) { f32x4 a = (f32x4){0.f, 0.f, 0.f, 0.f};
#pragma unroll
            for (int ks = 0; ks < 2; ++ks) { const bf16x8 fa = *(const LAS bf16x8*)(lds + HG_AM + (16 * mt + li) * HS2 + ks * 64 + g * 16);
                a = __builtin_amdgcn_mfma_f32_16x16x32_bf16(fa, vf[ks], a, 0, 0, 0); }
#pragma unroll
            for (int s = 0; s < 4; ++s) { const LAS unsigned char* qp = lds + HG_QH + (16 * mt + li) * HS + (32 * s + 4 * g) * 2;
                const v2u lo = *(const LAS v2u*)qp, hi = *(const LAS v2u*)(qp + 32);
                v4u x; x.x = lo.x; x.y = lo.y; x.z = hi.x; x.w = hi.y;
                a = __builtin_amdgcn_mfma_f32_16x16x32_bf16(__builtin_bit_cast(bf16x8, x), sb[s], a, 0, 0, 0); }
            o[mt] = a; }
#pragma unroll
        for (int kt = 0; kt < 8; ++kt) { const f32x4 d = *(const LAS f32x4*)(DD + 16 * kt + 4 * g); f32x4 a = Sacc[kt] * d;
#pragma unroll
            for (int ks = 0; ks < 2; ++ks) { const bf16x8 fa = *(const LAS bf16x8*)(lds + HG_KHT + (16 * kt + li) * HS2 + ks * 64 + g * 16);
                a = __builtin_amdgcn_mfma_f32_16x16x32_bf16(fa, vf[ks], a, 0, 0, 0); }
            Sacc[kt] = a; }
#pragma unroll
        for (int mt = 0; mt < 4; ++mt)
#pragma unroll
            for (int r = 0; r < 4; ++r) { float s = o[mt][r] * o[mt][r]; s += __shfl_xor(s, 1); s += __shfl_xor(s, 2); s += __shfl_xor(s, 4); s += __shfl_xor(s, 8);
                if (li == 0) SS[(16 * mt + 4 * g + r) * 8 + w] = s; }
        LBAR();
#pragma unroll
        for (int mt = 0; mt < 4; ++mt)
#pragma unroll
            for (int r = 0; r < 4; ++r) { const int t = 16 * mt + 4 * g + r; const f32x4 s0 = *(const LAS f32x4*)(SS + t * 8), s1 = *(const LAS f32x4*)(SS + t * 8 + 4);
                const float ss = ((s0[0] + s0[1]) + (s0[2] + s0[3])) + ((s1[0] + s1[1]) + (s1[2] + s1[3]));
                const float rs = rsqrtf(ss * (1.0f / 128.0f) + RMS_EPS);
                const float og = bf2f(*(const LAS unsigned short*)(lds + HG_OG + t * HS + (16 * w + li) * 2));
                const float y = o[mt][r] * rs * ng * (og * sigmoidf_(og));
                P.ocat[(row0 + t) * 1536 + h * 128 + 16 * w + li] = (unsigned short)f2bf(y); }
        LBAR();
    }
}
#undef HG_LOADPF

constexpr int RS = 144;
constexpr int RW_RT = 0, RW_AT = 9216, RW_BT = 18432, RW_KT = 27648, RW_ATT = 36864, RW_BHT = 46080, RW_KHT = 55296, RW_VTT = 64512, RW_G = 73728,
              RW_X = 82944,
              RW_LW = RW_X, RW_A1 = RW_X + 17408, RW_WW = RW_X, RW_O = RW_X + 9216,
              RW_AAB = 109568, RW_AAKT = RW_AAB + 4096, RW_ARB = RW_AAKT + 2048, RW_ARK = RW_ARB + 2048, RW_TM = RW_ARK + 2048, RW_TAM = RW_TM + 2048,
              RW_GC = RW_TAM + 2048, RW_BON = RW_GC + 1024, RW_CST = RW_BON + 256, RW_END2 = RW_CST + 3072,
              RW_TW = RW_RT, RW_AD = RW_AT, RW_SG = RW_BT;
static_assert(RW_END2 <= 131072, "rwkv lds");
__device__ __forceinline__ void rwkv_unit(const MixP& P, int b, int h, LAS unsigned char* lds) {
    int tid0_ = threadIdx.x; asm volatile("" : "+v"(tid0_));
    const int hc = h * 64;
    int tid = tid0_, lane = tid & 63, g = lane >> 4, li = lane & 15, tt = tid >> 3, sg = tid & 7, c0 = sg * 8;
    const int w = __builtin_amdgcn_readfirstlane(tid >> 6);
    LAS float* LW = (LAS float*)(lds + RW_LW); LAS float* O = (LAS float*)(lds + RW_O); LAS float* GC = (LAS float*)(lds + RW_GC); LAS float* BON = (LAS float*)(lds + RW_BON);
    LAS float* AAB = (LAS float*)(lds + RW_AAB);
    const unsigned ldsb = (unsigned)(uintptr_t)lds;
    f32x4 St[4];
#pragma unroll
    for (int i = 0; i < 4; ++i) St[i] = (f32x4){0.f, 0.f, 0.f, 0.f};
    LAS float* CST = (LAS float*)(lds + RW_CST);
    for (int e = tid; e < 768; e += NTHR) { float v;
        if (e < 192) v = P.rw_mu[(e >> 6) * 512 + hc + (e & 63)]; else if (e < 448) v = P.rw_mu[1536 + (e - 192)];
        else { const int q = (e - 448) >> 6, c = (e - 448) & 63; const float* src = q == 0 ? P.rw_k_k : q == 1 ? P.rw_k_a : q == 2 ? P.rw_r_k : q == 3 ? P.rw_gn_g : P.rw_gn_b; v = src[hc + c]; }
        CST[e] = v; }
    LBAR();
#define LD8(dst, off) do { const f32x4 a_ = *(const LAS f32x4*)(CST + (off)), b_ = *(const LAS f32x4*)(CST + (off) + 4); _Pragma("unroll") for (int q_ = 0; q_ < 4; ++q_) { dst[q_] = a_[q_]; dst[4 + q_] = b_[q_]; } } while (0)
    const int lmt = w >> 1;
    float w0c[2], a0c[2];
#pragma unroll
    for (int n = 0; n < 2; ++n) { const int cc = 16 * (2 * (w & 1) + n) + li; w0c[n] = P.rw_w0[hc + cc]; a0c[n] = P.rw_a0[hc + cc]; }
    v4u cur[7], prv[7];
    {   const bf16* src = P.proj + ((size_t)b * T + tt) * INW;
        cur[0] = *(const v4u*)(src + C_RWR + hc + c0); cur[1] = *(const v4u*)(src + C_RWK + hc + c0); cur[2] = *(const v4u*)(src + C_RWV + hc + c0); cur[3] = *(const v4u*)(src + C_RWWD + c0); cur[4] = *(const v4u*)(src + C_RWAD + c0);
        cur[5] = *(const v4u*)(src + C_RWGD + sg * 16); cur[6] = *(const v4u*)(src + C_RWGD + sg * 16 + 8);
        if (tt > 0) { const bf16* sp = src - INW; prv[0] = *(const v4u*)(sp + C_RWR + hc + c0); prv[1] = *(const v4u*)(sp + C_RWK + hc + c0); prv[2] = *(const v4u*)(sp + C_RWV + hc + c0); prv[3] = *(const v4u*)(sp + C_RWWD + c0); prv[4] = *(const v4u*)(sp + C_RWAD + c0);
            prv[5] = *(const v4u*)(sp + C_RWGD + sg * 16); prv[6] = *(const v4u*)(sp + C_RWGD + sg * 16 + 8); }
        else {
#pragma unroll
            for (int i = 0; i < 7; ++i) prv[i] = (v4u){0u, 0u, 0u, 0u}; } }
#pragma unroll 1
    for (int blk = 0; blk < 64; ++blk) {
        const size_t row0 = (size_t)b * T + (size_t)blk * 64;
        { int t_ = tid0_; asm volatile("" : "+v"(t_)); tid = t_; lane = tid & 63; g = lane >> 4; li = lane & 15; tt = tid >> 3; sg = tid & 7; c0 = sg * 8; }
        bf16x8 bwf[2][2], baf[2][2], bgf[2][4];
#pragma unroll
        for (int n = 0; n < 2; ++n) { const int cc = 16 * (2 * (w & 1) + n) + li;
#pragma unroll
            for (int ks = 0; ks < 2; ++ks) { bwf[n][ks] = *(const bf16x8*)(P.wupT + (size_t)(hc + cc) * 64 + ks * 32 + g * 8); baf[n][ks] = *(const bf16x8*)(P.aupT + (size_t)(hc + cc) * 64 + ks * 32 + g * 8); }
#pragma unroll
            for (int ks = 0; ks < 4; ++ks) bgf[n][ks] = *(const bf16x8*)(P.gupT + (size_t)(hc + cc) * 128 + ks * 32 + g * 8); }
        float rr[8], k1[8], vv[8];
        {   float xw[8], xa[8], xg[16];
#define SHIFT8(dst, ci, muv) do { const unsigned cw_[4] = {cur[ci].x, cur[ci].y, cur[ci].z, cur[ci].w}, pw_[4] = {prv[ci].x, prv[ci].y, prv[ci].z, prv[ci].w}; \
            _Pragma("unroll") for (int q_ = 0; q_ < 4; ++q_) { const float c_lo = bflo(cw_[q_]), c_hi = bfhi(cw_[q_]); dst[2 * q_] = c_lo + (bflo(pw_[q_]) - c_lo) * muv[2 * q_]; dst[2 * q_ + 1] = c_hi + (bfhi(pw_[q_]) - c_hi) * muv[2 * q_ + 1]; } } while (0)
            float mu_[8];
            LD8(mu_, c0); SHIFT8(rr, 0, mu_); LD8(mu_, 64 + c0); SHIFT8(k1, 1, mu_); LD8(mu_, 128 + c0); SHIFT8(vv, 2, mu_); LD8(mu_, 192 + c0); SHIFT8(xw, 3, mu_); LD8(mu_, 256 + c0); SHIFT8(xa, 4, mu_);
            { float* xg0 = xg; float* xg1 = xg + 8; LD8(mu_, 320 + sg * 16); SHIFT8(xg0, 5, mu_); LD8(mu_, 328 + sg * 16); SHIFT8(xg1, 6, mu_); }
#undef SHIFT8
            v4u o;
            o.x = pk2a(tanh_fast(xw[0]), tanh_fast(xw[1])); o.y = pk2a(tanh_fast(xw[2]), tanh_fast(xw[3])); o.z = pk2a(tanh_fast(xw[4]), tanh_fast(xw[5])); o.w = pk2a(tanh_fast(xw[6]), tanh_fast(xw[7]));
            *(LAS v4u*)(lds + RW_TW + tt * RS + c0 * 2) = o;
            o.x = pk2a(xa[0], xa[1]); o.y = pk2a(xa[2], xa[3]); o.z = pk2a(xa[4], xa[5]); o.w = pk2a(xa[6], xa[7]);
            *(LAS v4u*)(lds + RW_AD + tt * RS + c0 * 2) = o;
            o.x = pk2a(sigmoidf_(xg[0]), sigmoidf_(xg[1])); o.y = pk2a(sigmoidf_(xg[2]), sigmoidf_(xg[3])); o.z = pk2a(sigmoidf_(xg[4]), sigmoidf_(xg[5])); o.w = pk2a(sigmoidf_(xg[6]), sigmoidf_(xg[7]));
            *(LAS v4u*)(lds + RW_SG + tt * 272 + sg * 32) = o;
            o.x = pk2a(sigmoidf_(xg[8]), sigmoidf_(xg[9])); o.y = pk2a(sigmoidf_(xg[10]), sigmoidf_(xg[11])); o.z = pk2a(sigmoidf_(xg[12]), sigmoidf_(xg[13])); o.w = pk2a(sigmoidf_(xg[14]), sigmoidf_(xg[15]));
            *(LAS v4u*)(lds + RW_SG + tt * 272 + sg * 32 + 16) = o;
        }
        LBAR();
#pragma unroll
        for (int n = 0; n < 2; ++n) { const int ntile = 2 * (w & 1) + n, cc = 16 * ntile + li;
            f32x4 aw = (f32x4){0.f, 0.f, 0.f, 0.f}, aa = aw, ag = aw;
#pragma unroll
            for (int ks = 0; ks < 2; ++ks) { const bf16x8 f1 = *(const LAS bf16x8*)(lds + RW_TW + (16 * lmt + li) * RS + ks * 64 + g * 16), f2 = *(const LAS bf16x8*)(lds + RW_AD + (16 * lmt + li) * RS + ks * 64 + g * 16);
                aw = __builtin_amdgcn_mfma_f32_16x16x32_bf16(f1, bwf[n][ks], aw, 0, 0, 0); aa = __builtin_amdgcn_mfma_f32_16x16x32_bf16(f2, baf[n][ks], aa, 0, 0, 0); }
#pragma unroll
            for (int ks = 0; ks < 4; ++ks) { const bf16x8 f3 = *(const LAS bf16x8*)(lds + RW_SG + (16 * lmt + li) * 272 + ks * 64 + g * 16);
                ag = __builtin_amdgcn_mfma_f32_16x16x32_bf16(f3, bgf[n][ks], ag, 0, 0, 0); }
#pragma unroll
            for (int r = 0; r < 4; ++r) { const int t = 16 * lmt + 4 * g + r; const float z = -(w0c[n] + aw[r]);
                const float sp = fmaxf(z, 0.f) + __logf(1.0f + __expf(-fabsf(z)));
                LW[t * 68 + cc] = -__expf(-sp - 0.5f);
                *(LAS unsigned short*)(lds + RW_A1 + t * RS + cc * 2) = (unsigned short)f2bf(sigmoidf_(a0c[n] + aa[r]));
                *(LAS unsigned short*)(lds + RW_G + t * RS + cc * 2) = (unsigned short)f2bf(ag[r]); }
        }
        LBAR();
        if (tid < 256) { const int j = tid >> 6, c = tid & 63; float run = 0.f;
#pragma unroll
            for (int i = 0; i < 16; ++i) { run += LW[(16 * j + i) * 68 + c]; LW[(16 * j + i) * 68 + c] = run; }
            GC[j * 64 + c] = __expf(run); }
        LBAR();
        {   float a[8], clt[8], clm[8], clc[8];
            { const v4u av = *(const LAS v4u*)(lds + RW_A1 + tt * RS + c0 * 2); a[0] = bflo(av.x); a[1] = bfhi(av.x); a[2] = bflo(av.y); a[3] = bfhi(av.y); a[4] = bflo(av.z); a[5] = bfhi(av.z); a[6] = bflo(av.w); a[7] = bfhi(av.w); }
            const int tl = tt & 15, tC = (tt | 15);
            { const f32x4 x0 = *(const LAS f32x4*)(LW + tt * 68 + c0), x1 = *(const LAS f32x4*)(LW + tt * 68 + c0 + 4), y0 = *(const LAS f32x4*)(LW + tC * 68 + c0), y1 = *(const LAS f32x4*)(LW + tC * 68 + c0 + 4);
              f32x4 z0 = (f32x4){0.f, 0.f, 0.f, 0.f}, z1 = z0; if (tl > 0) { z0 = *(const LAS f32x4*)(LW + (tt - 1) * 68 + c0); z1 = *(const LAS f32x4*)(LW + (tt - 1) * 68 + c0 + 4); }
#pragma unroll
              for (int j = 0; j < 4; ++j) { clt[j] = x0[j]; clt[4 + j] = x1[j]; clc[j] = y0[j]; clc[4 + j] = y1[j]; clm[j] = z0[j]; clm[4 + j] = z1[j]; } }
            float kk[8], kkc[8], kac[8], rkc[8]; float ss = 0.f;
            LD8(kkc, 448 + c0); LD8(kac, 512 + c0); LD8(rkc, 576 + c0);
#pragma unroll
            for (int j = 0; j < 8; ++j) { kk[j] = k1[j] * kkc[j]; ss += kk[j] * kk[j]; }
            ss += __shfl_xor(ss, 1); ss += __shfl_xor(ss, 2); ss += __shfl_xor(ss, 4);
            const float inv = rsqrtf(fmaxf(ss, 1e-12f)); float bon = 0.f;
            float rt[8], at[8], bt[8], kt[8], bh[8], kh[8];
#pragma unroll
            for (int j = 0; j < 8; ++j) { const float kn = kk[j] * inv, k2 = k1[j] * (1.0f + (a[j] - 1.0f) * kac[j]); const float av = -kn, bv = kn * a[j];
                const float ig = __expf(-clt[j]), gh = __expf(clc[j] - clt[j]);
                rt[j] = rr[j] * __expf(clt[j]); at[j] = av * __expf(clm[j]); bt[j] = bv * ig; kt[j] = k2 * ig; bh[j] = bv * gh; kh[j] = k2 * gh; bon += rr[j] * k2 * rkc[j]; }
            bon += __shfl_xor(bon, 1); bon += __shfl_xor(bon, 2); bon += __shfl_xor(bon, 4);
            if (sg == 0) BON[tt] = bon;
            v4u o;
#define PK8(src) (o.x = pk2a(src[0], src[1]), o.y = pk2a(src[2], src[3]), o.z = pk2a(src[4], src[5]), o.w = pk2a(src[6], src[7]), o)
            *(LAS v4u*)(lds + RW_RT + tt * RS + c0 * 2) = PK8(rt); *(LAS v4u*)(lds + RW_AT + tt * RS + c0 * 2) = PK8(at); *(LAS v4u*)(lds + RW_BT + tt * RS + c0 * 2) = PK8(bt); *(LAS v4u*)(lds + RW_KT + tt * RS + c0 * 2) = PK8(kt);
            *(LAS v4u*)(lds + RW_BHT + tt * RS + c0 * 2) = PK8(bh); *(LAS v4u*)(lds + RW_KHT + tt * RS + c0 * 2) = PK8(kh); *(LAS v4u*)(lds + RW_VTT + tt * RS + c0 * 2) = PK8(vv);
#undef PK8
        }
        LBAR();
        {   const int j = w >> 1; const int rowb = (16 * j + li) * RS;
            bf16x8 fat[2], fbt[2], fkt[2], frt[2];
#pragma unroll
            for (int ks = 0; ks < 2; ++ks) { fbt[ks] = *(const LAS bf16x8*)(lds + RW_BT + rowb + ks * 64 + g * 16); fkt[ks] = *(const LAS bf16x8*)(lds + RW_KT + rowb + ks * 64 + g * 16);
                if ((w & 1) == 0) fat[ks] = *(const LAS bf16x8*)(lds + RW_AT + rowb + ks * 64 + g * 16); else frt[ks] = *(const LAS bf16x8*)(lds + RW_RT + rowb + ks * 64 + g * 16); }
            if ((w & 1) == 0) {
                f32x4 x = (f32x4){0.f, 0.f, 0.f, 0.f}, y = x;
#pragma unroll
                for (int ks = 0; ks < 2; ++ks) { x = __builtin_amdgcn_mfma_f32_16x16x32_bf16(fbt[ks], fat[ks], x, 0, 0, 0);
                    y = __builtin_amdgcn_mfma_f32_16x16x32_bf16(fat[ks], fkt[ks], y, 0, 0, 0); }
                f32x4 xm; v2u ym;
#pragma unroll
                for (int r = 0; r < 4; ++r) xm[r] = (4 * g + r < li) ? x[r] : 0.f;
                *(LAS f32x4*)(AAB + (j * 16 + li) * 16 + 4 * g) = xm;
                ym.x = pk2(li < 4 * g ? y[0] : 0.f, li < 4 * g + 1 ? y[1] : 0.f); ym.y = pk2(li < 4 * g + 2 ? y[2] : 0.f, li < 4 * g + 3 ? y[3] : 0.f);
                *(LAS v2u*)(lds + RW_AAKT + (j * 16 + li) * 32 + 8 * g) = ym;
            } else {
                f32x4 x = (f32x4){0.f, 0.f, 0.f, 0.f}, y = x;
#pragma unroll
                for (int ks = 0; ks < 2; ++ks) { x = __builtin_amdgcn_mfma_f32_16x16x32_bf16(fbt[ks], frt[ks], x, 0, 0, 0);
                    y = __builtin_amdgcn_mfma_f32_16x16x32_bf16(fkt[ks], frt[ks], y, 0, 0, 0); }
                v2u xm, ym;
                xm.x = pk2(4 * g <= li ? x[0] : 0.f, 4 * g + 1 <= li ? x[1] : 0.f); xm.y = pk2(4 * g + 2 <= li ? x[2] : 0.f, 4 * g + 3 <= li ? x[3] : 0.f);
                ym.x = pk2(4 * g <= li ? y[0] : 0.f, 4 * g + 1 <= li ? y[1] : 0.f); ym.y = pk2(4 * g + 2 <= li ? y[2] : 0.f, 4 * g + 3 <= li ? y[3] : 0.f);
                *(LAS v2u*)(lds + RW_ARB + (j * 16 + li) * 32 + 8 * g) = xm; *(LAS v2u*)(lds + RW_ARK + (j * 16 + li) * 32 + 8 * g) = ym;
            }
        }
        LBAR();
        if (w == 0) { const int j = g, col = li; float x[16];
#pragma unroll
            for (int t = 0; t < 16; ++t) { float s = (t == col) ? 1.f : 0.f;
#pragma unroll
                for (int q = 0; q < (t + 3) / 4; ++q) { const f32x4 av = *(const LAS f32x4*)(AAB + (j * 16 + t) * 16 + 4 * q);
#pragma unroll
                    for (int e = 0; e < 4; ++e) if (4 * q + e < t) s += av[e] * x[4 * q + e]; }
                x[t] = s; *(LAS unsigned short*)(lds + RW_TM + (j * 16 + t) * 32 + col * 2) = (unsigned short)f2bf(s); } }
        LBAR();
        {   const int j = w >> 1; const bf16x8 zf = (bf16x8){0, 0, 0, 0, 0, 0, 0, 0};
            const bf16x8 ft = (g < 2) ? *(const LAS bf16x8*)(lds + RW_TM + (j * 16 + li) * 32 + g * 16) : zf;
#pragma unroll
            for (int n = 0; n < 2; ++n) { const int ct = 2 * (w & 1) + n;
                bf16x8 fa; { const unsigned a0_ = ldsb + RW_AT + (16 * j + 8 * (g & 1) + (li >> 2)) * RS + (16 * ct + 4 * (li & 3)) * 2; s16x4 lo_, hi_;
                    asm volatile("ds_read_b64_tr_b16 %0, %2\n\tds_read_b64_tr_b16 %1, %2 offset:576\n\ts_waitcnt lgkmcnt(0)" : "=&v"(lo_), "=&v"(hi_) : "v"(a0_) : "memory");
                    fa = (g < 2) ? (bf16x8){lo_[0], lo_[1], lo_[2], lo_[3], hi_[0], hi_[1], hi_[2], hi_[3]} : zf; }
                f32x4 x = __builtin_amdgcn_mfma_f32_16x16x32_bf16(fa, ft, (f32x4){0.f, 0.f, 0.f, 0.f}, 0, 0, 0);
                v2u xm; xm.x = pk2(x[0], x[1]); xm.y = pk2(x[2], x[3]);
                *(LAS v2u*)(lds + RW_WW + (16 * j + li) * RS + (16 * ct + 4 * g) * 2) = xm; }
            if ((w & 1) == 0) { const bf16x8 fa = (g < 2) ? *(const LAS bf16x8*)(lds + RW_AAKT + (j * 16 + li) * 32 + g * 16) : zf;
                f32x4 x = __builtin_amdgcn_mfma_f32_16x16x32_bf16(fa, ft, (f32x4){0.f, 0.f, 0.f, 0.f}, 0, 0, 0);
                v2u xm; xm.x = pk2(x[0], x[1]); xm.y = pk2(x[2], x[3]);
                *(LAS v2u*)(lds + RW_TAM + (j * 16 + li) * 32 + 8 * g) = xm; }
        }
        LBAR();
        if (blk < 63) { const bf16* src = P.proj + (row0 + 64 + tt) * INW; const bf16* sp = src - INW;
            cur[0] = *(const v4u*)(src + C_RWR + hc + c0); cur[1] = *(const v4u*)(src + C_RWK + hc + c0); cur[2] = *(const v4u*)(src + C_RWV + hc + c0); cur[3] = *(const v4u*)(src + C_RWWD + c0); cur[4] = *(const v4u*)(src + C_RWAD + c0);
            cur[5] = *(const v4u*)(src + C_RWGD + sg * 16); cur[6] = *(const v4u*)(src + C_RWGD + sg * 16 + 8);
            prv[0] = *(const v4u*)(sp + C_RWR + hc + c0); prv[1] = *(const v4u*)(sp + C_RWK + hc + c0); prv[2] = *(const v4u*)(sp + C_RWV + hc + c0); prv[3] = *(const v4u*)(sp + C_RWWD + c0); prv[4] = *(const v4u*)(sp + C_RWAD + c0);
            prv[5] = *(const v4u*)(sp + C_RWGD + sg * 16); prv[6] = *(const v4u*)(sp + C_RWGD + sg * 16 + 8); }
        if (w < 4) {
#pragma unroll 1
            for (int j = 0; j < 4; ++j) {
                bf16x8 sb[2];
#pragma unroll
                for (int s = 0; s < 2; ++s) { v4u x; x.x = pk2(St[2 * s][0], St[2 * s][1]); x.y = pk2(St[2 * s][2], St[2 * s][3]); x.z = pk2(St[2 * s + 1][0], St[2 * s + 1][1]); x.w = pk2(St[2 * s + 1][2], St[2 * s + 1][3]); sb[s] = __builtin_bit_cast(bf16x8, x); }
                v2u vf, bhf[4], khf[4];
                {   const unsigned rb_ = (16 * j + 4 * g + (li >> 2)) * RS + 4 * (li & 3) * 2; const unsigned av_ = ldsb + RW_VTT + rb_ + 32 * w, ab_ = ldsb + RW_BHT + rb_, ak_ = ldsb + RW_KHT + rb_;
                    asm volatile("ds_read_b64_tr_b16 %0, %9\n\tds_read_b64_tr_b16 %1, %10\n\tds_read_b64_tr_b16 %2, %10 offset:32\n\tds_read_b64_tr_b16 %3, %10 offset:64\n\tds_read_b64_tr_b16 %4, %10 offset:96\n\t"
                                 "ds_read_b64_tr_b16 %5, %11\n\tds_read_b64_tr_b16 %6, %11 offset:32\n\tds_read_b64_tr_b16 %7, %11 offset:64\n\tds_read_b64_tr_b16 %8, %11 offset:96\n\ts_waitcnt lgkmcnt(0)"
                                 : "=&v"(vf), "=&v"(bhf[0]), "=&v"(bhf[1]), "=&v"(bhf[2]), "=&v"(bhf[3]), "=&v"(khf[0]), "=&v"(khf[1]), "=&v"(khf[2]), "=&v"(khf[3]) : "v"(av_), "v"(ab_), "v"(ak_) : "memory"); }
                const int trow = (16 * j + li) * RS;
                f32x4 u = (f32x4){0.f, 0.f, 0.f, 0.f}, o = u;
#pragma unroll
                for (int s = 0; s < 2; ++s) { const v2u lo = *(const LAS v2u*)(lds + RW_WW + trow + (32 * s + 4 * g) * 2), hi = *(const LAS v2u*)(lds + RW_WW + trow + (32 * s + 16 + 4 * g) * 2);
                    v4u x; x.x = lo.x; x.y = lo.y; x.z = hi.x; x.w = hi.y; u = __builtin_amdgcn_mfma_f32_16x16x32_bf16(__builtin_bit_cast(bf16x8, x), sb[s], u, 0, 0, 0);
                    const v2u lo2 = *(const LAS v2u*)(lds + RW_RT + trow + (32 * s + 4 * g) * 2), hi2 = *(const LAS v2u*)(lds + RW_RT + trow + (32 * s + 16 + 4 * g) * 2);
                    v4u y; y.x = lo2.x; y.y = lo2.y; y.z = hi2.x; y.w = hi2.y; o = __builtin_amdgcn_mfma_f32_16x16x32_bf16(__builtin_bit_cast(bf16x8, y), sb[s], o, 0, 0, 0); }
                {   const v2u ta = *(const LAS v2u*)(lds + RW_TAM + (j * 16 + li) * 32 + 8 * g);
                    v4u x; x.x = ta.x; x.y = ta.y; x.z = 0u; x.w = 0u; v4u y; y.x = vf.x; y.y = vf.y; y.z = 0u; y.w = 0u;
                    u = __builtin_amdgcn_mfma_f32_16x16x32_bf16(__builtin_bit_cast(bf16x8, x), __builtin_bit_cast(bf16x8, y), u, 0, 0, 0); }
                v4u b2; b2.x = pk2(u[0], u[1]); b2.y = pk2(u[2], u[3]); b2.z = vf.x; b2.w = vf.y;
                const bf16x8 b2f = __builtin_bit_cast(bf16x8, b2);
                {   const v2u rb = *(const LAS v2u*)(lds + RW_ARB + (j * 16 + li) * 32 + 8 * g), rk = *(const LAS v2u*)(lds + RW_ARK + (j * 16 + li) * 32 + 8 * g);
                    v4u x; x.x = rb.x; x.y = rb.y; x.z = rk.x; x.w = rk.y; o = __builtin_amdgcn_mfma_f32_16x16x32_bf16(__builtin_bit_cast(bf16x8, x), b2f, o, 0, 0, 0); }
#pragma unroll
                for (int r = 0; r < 4; ++r) O[(16 * j + 4 * g + r) * 68 + 16 * w + li] = o[r];
#pragma unroll
                for (int kt = 0; kt < 4; ++kt) { const f32x4 gc = *(const LAS f32x4*)(GC + j * 64 + 16 * kt + 4 * g);
                    v4u x; x.x = bhf[kt].x; x.y = bhf[kt].y; x.z = khf[kt].x; x.w = khf[kt].y;
                    St[kt] = __builtin_amdgcn_mfma_f32_16x16x32_bf16(__builtin_bit_cast(bf16x8, x), b2f, St[kt] * gc, 0, 0, 0); }
            }
        }
        LBAR();
        {   const f32x4 o0 = *(const LAS f32x4*)(O + tt * 68 + c0), o1 = *(const LAS f32x4*)(O + tt * 68 + c0 + 4); float ov[8];
#pragma unroll
            for (int j = 0; j < 4; ++j) { ov[j] = o0[j]; ov[4 + j] = o1[j]; }
            float s = 0.f;
#pragma unroll
            for (int j = 0; j < 8; ++j) s += ov[j];
            s += __shfl_xor(s, 1); s += __shfl_xor(s, 2); s += __shfl_xor(s, 4);
            const float mean = s * (1.0f / 64.0f); float q = 0.f;
#pragma unroll
            for (int j = 0; j < 8; ++j) { const float d = ov[j] - mean; q += d * d; }
            q += __shfl_xor(q, 1); q += __shfl_xor(q, 2); q += __shfl_xor(q, 4);
            const float rs = rsqrtf(q * (1.0f / 64.0f) + RW_GN_EPS), bon = BON[tt];
            const v4u gv = *(const LAS v4u*)(lds + RW_G + tt * RS + c0 * 2); const float gg[8] = {bflo(gv.x), bfhi(gv.x), bflo(gv.y), bfhi(gv.y), bflo(gv.z), bfhi(gv.z), bflo(gv.w), bfhi(gv.w)};
            float y[8], gng[8], gnb[8]; LD8(gng, 640 + c0); LD8(gnb, 704 + c0);
#pragma unroll
            for (int j = 0; j < 8; ++j) y[j] = ((ov[j] - mean) * rs * gng[j] + gnb[j] + bon * vv[j]) * gg[j];
            v4u wv; wv.x = pk2a(y[0], y[1]); wv.y = pk2a(y[2], y[3]); wv.z = pk2a(y[4], y[5]); wv.w = pk2a(y[6], y[7]);
            *(v4u*)(P.ocat + (row0 + tt) * 1536 + 1024 + hc + c0) = wv; }
        LBAR();
    }
#undef LD8
#undef LBAR
}
struct Args { const float* in[31]; float* out; unsigned char* ws; int ph_lo, ph_hi; };
typedef const __attribute__((address_space(4))) Args* ArgP;
struct Frame {
    LAS unsigned char* lds; volatile LAS unsigned* MISC; gu32* ctl;
    int tid, lane, wave, vcu, G, bx;
};
constexpr int SM_HGLB = 0;
constexpr int SM_LAM = 2048;

__device__ __forceinline__ void transpose_item(const float* W, int K, int N, bf16* WT, int k0, int n0, int drow0, LAS float* scr, int lane, int dp = 0) {
    if (dp == 0) dp = K;
#pragma unroll 8
    for (int i = 0; i < 32; ++i) { const int kk = 2 * i + (lane >> 5); scr[kk * 33 + (lane & 31)] = W[(size_t)(k0 + kk) * N + n0 + (lane & 31)]; }
    LDS_WAIT(); asm volatile("" ::: "memory");
    const int c = lane & 7;
#pragma unroll
    for (int j = 0; j < 4; ++j) { const int n = (lane >> 3) + 8 * j; const LAS float* s = scr + (8 * c) * 33 + n;
        v4u o; o.x = pk2(s[0 * 33], s[1 * 33]); o.y = pk2(s[2 * 33], s[3 * 33]); o.z = pk2(s[4 * 33], s[5 * 33]); o.w = pk2(s[6 * 33], s[7 * 33]);
        *(GAS v4u*)(WT + (size_t)(drow0 + n) * dp + k0 + 8 * c) = o; }
    LDS_WAIT(); asm volatile("" ::: "memory");
}
constexpr int CV_IN = 2688, CV_MG = 1536, CV_BR = 768, CV_OUT = 512, CV_EX = 4096, CV_TOTAL = CV_IN + CV_MG + CV_BR + CV_OUT + 3 * CV_EX;
__device__ __forceinline__ void conv_layer(const Frame& F, ArgP A, int l) {
    LAS float* scr = (LAS float*)(F.lds + F.wave * 16384);
    const int gw = F.vcu * NWAVES + F.wave, NGW = F.G * NWAVES;
    bf16* wa = (bf16*)(A->ws + WS_WA); bf16* we = (bf16*)(A->ws + WS_WE);
    for (int it = gw; it < CV_TOTAL; it += NGW) {
        int r = it;
        if (r < CV_IN) { const int kb = r / 168, nb = r % 168; transpose_item(A->in[4] + (size_t)l * DM * INW, DM, INW, wa + WA_IN / 2, 64 * kb, 32 * nb, 32 * nb, scr, F.lane); continue; } r -= CV_IN;
        if (r < CV_MG) { const int br = r / 512, q = r % 512, kb = q / 32, nb = q % 32; transpose_item(A->in[20] + ((size_t)l * 3 + br) * DM * DM, DM, DM, wa + WA_MERGE / 2 + (size_t)br * DM * UP_, 64 * kb, 32 * nb, 32 * nb, scr, F.lane, UP_); continue; } r -= CV_MG;
        if (r < CV_BR) { const int kb = r / 32, nb = r % 32; transpose_item(A->in[22] + (size_t)l * 1536 * DM, 1536, DM, wa + WA_BRANCH / 2, 64 * kb, 32 * nb, 32 * nb, scr, F.lane); continue; } r -= CV_BR;
        if (r < CV_OUT) { const int kb = r / 32, nb = r % 32; transpose_item(A->in[23] + (size_t)l * DM * DM, DM, DM, wa + WA_OUT / 2, 64 * kb, 32 * nb, 32 * nb, scr, F.lane); continue; } r -= CV_OUT;
        if (r < 2 * CV_EX) { const int up = r / CV_EX, q = r % CV_EX, e = q / 256, q2 = q % 256, kb = q2 / 16, nb = q2 % 16, n0 = 32 * nb;
            transpose_item(A->in[28 + up] + ((size_t)l * NE + e) * DM * DE, DM, DE, we + WE_GU / 2 + (size_t)e * DM * DM, 64 * kb, n0, (n0 >> 7) * 256 + up * 128 + (n0 & 127), scr, F.lane); continue; } r -= 2 * CV_EX;
        { const int e = r / 256, q2 = r % 256, kb = q2 / 32, nb = q2 % 32; transpose_item(A->in[30] + ((size_t)l * NE + e) * DE * DM, DE, DM, we + WE_DT / 2 + (size_t)e * DM * DE, 64 * kb, 32 * nb, 32 * nb, scr, F.lane); }
    }
}

__device__ __forceinline__ void phase_prologue(const Frame& F, ArgP A) {
    {   LAS float* cond = (LAS float*)(F.lds);
        float* modp = (float*)(A->ws + WS_MODP);
        for (int it = F.vcu; it < NL * 24 * 4; it += F.G) { const int l = it / 96, r = it % 96, nb = r / 4, kq = r % 4;
            __syncthreads();
            for (int e = F.tid; e < 8 * 256; e += NTHR) { const float cv = A->in[1][(e >> 8) * DM + kq * 256 + (e & 255)]; cond[e] = cv * sigmoidf_(cv); }
            __syncthreads();
            const int n = nb * 256 + (F.tid & 255), kh = F.tid >> 8; float acc[8];
#pragma unroll
            for (int b = 0; b < 8; ++b) acc[b] = 0.f;
            const float* wp = A->in[2] + ((size_t)l * DM + kq * 256 + kh * 128) * 6144 + n;
#pragma unroll 4
            for (int k = 0; k < 128; ++k) { const float wv = wp[(size_t)k * 6144];
#pragma unroll
                for (int b = 0; b < 8; ++b) acc[b] += cond[b * 256 + kh * 128 + k] * wv; }
            const int kp = kq * 2 + kh;
#pragma unroll
            for (int b = 0; b < 8; ++b) modp[(((size_t)kp * NL + l) * NB + b) * 6144 + n] = acc[b]; }
        __syncthreads();
    }
    conv_layer(F, A, 0);
    {   bf16* lo = (bf16*)(A->ws + WS_LORA); const int gt = F.vcu * NTHR + F.tid, NGT = F.G * NTHR;
        for (int e = gt; e < NL * 512 * 64; e += NGT) { const int l = e / 32768, r = e % 32768, c = r >> 6, j = r & 63;
            lo[(size_t)l * 131072 + c * 64 + j] = (bf16)f2bf(A->in[11][(size_t)l * 32768 + j * 512 + c]);
            lo[(size_t)l * 131072 + 32768 + c * 64 + j] = (bf16)f2bf(A->in[13][(size_t)l * 32768 + j * 512 + c]); }
        for (int e = gt; e < NL * 512 * 128; e += NGT) { const int l = e / 65536, r = e % 65536, c = r >> 7, j = r & 127;
            lo[(size_t)l * 131072 + 65536 + c * 128 + j] = (bf16)f2bf(A->in[14][(size_t)l * 65536 + j * 512 + c]); }
    }
    if (F.vcu == 0) { float* sm = (float*)(A->ws + WS_SMALL);
        { const int k = F.tid; float z[4], mx = -1e30f;
#pragma unroll
          for (int l = 0; l < 4; ++l) { z[l] = A->in[5][l * 512 + k]; mx = fmaxf(mx, z[l]); }
          float s = 0.f;
#pragma unroll
          for (int l = 0; l < 4; ++l) { z[l] = __expf(z[l] - mx); s += z[l]; }
          const float inv = 1.0f / s;
          sm[SM_HGLB + k] = 0.f; sm[SM_HGLB + 512 + k] = z[1] * inv; sm[SM_HGLB + 1024 + k] = (z[1] + z[2]) * inv; sm[SM_HGLB + 1536 + k] = (z[1] + z[2] + z[3]) * inv; }
        if (F.wave < 4) { const int l = F.wave; const float* dl = A->in[7] + l * 256;
            const float s1 = wave_sum(dl[F.lane] * dl[64 + F.lane]), s2 = wave_sum(dl[128 + F.lane] * dl[192 + F.lane]);
            const float li = 0.8f - 0.6f * expf(-0.3f * (float)l);
            if (F.lane == 0) { sm[SM_LAM + l] = expf(s1) - expf(s2) + li; sm[SM_LAM + 4 + l] = 1.0f - li; } }
    }
}
__device__ __forceinline__ float mod_from_partials(ArgP A, int l, int b, int n) {
    const float* mp = (const float*)(A->ws + WS_MODP) + ((size_t)l * NB + b) * 6144 + n; float s = A->in[3][l * 6144 + n];
#pragma unroll
    for (int kp = 0; kp < 8; ++kp) s += mp[(size_t)kp * NL * NB * 6144];
    return s;
}
__device__ __forceinline__ void phase_mod_u0(const Frame& F, ArgP A) {
    float* mod = (float*)(A->ws + WS_MOD);
    for (int e = F.vcu * NTHR + F.tid; e < NL * NB * 6144; e += F.G * NTHR) { const int l = e / (NB * 6144), r = e % (NB * 6144); mod[e] = mod_from_partials(A, l, r / 6144, r % 6144); }
    bf16* U = (bf16*)(A->ws + WS_U);
    for (int rb = F.vcu; rb < M / 128; rb += F.G) { const int b = rb / 32;
        float sh[16], sc[16];
#pragma unroll
        for (int j = 0; j < 4; ++j)
#pragma unroll
            for (int i = 0; i < 4; ++i) { const int c = 4 * F.lane + 256 * j + i; sh[j * 4 + i] = mod_from_partials(A, 0, b, c); sc[j * 4 + i] = 1.0f + mod_from_partials(A, 0, b, 1024 + c); }
        for (int i = 0; i < 16; ++i) { const size_t row = (size_t)rb * 128 + F.wave * 16 + i;
            const f32x4* xr = (const f32x4*)(A->in[0] + row * DM) + F.lane; v2u* ur = (v2u*)(U + row * UP_) + F.lane;
#pragma unroll
            for (int j = 0; j < 4; ++j) { const f32x4 v = xr[64 * j]; v2u w; w.x = pk2(v[0] * sc[j * 4 + 0] + sh[j * 4 + 0], v[1] * sc[j * 4 + 1] + sh[j * 4 + 1]); w.y = pk2(v[2] * sc[j * 4 + 2] + sh[j * 4 + 2], v[3] * sc[j * 4 + 3] + sh[j * 4 + 3]); ur[64 * j] = w; } }
    }
}

__device__ __forceinline__ void phase_ln1(const Frame& F, ArgP A, int l) {
    const float* mod = (const float*)(A->ws + WS_MOD);
    const bf16* MIX = (const bf16*)(A->ws + WS_MIX); bf16* U = (bf16*)(A->ws + WS_U);
    const float* xin = (l == 0) ? A->in[0] : A->out;
    LAS float* wrT = (LAS float*)(F.lds);
    LAS int* te = (LAS int*)(F.lds + 65536);
    LAS int* tbase = (LAS int*)(F.lds + 65536 + 1024);
    int* tokpos = (int*)(A->ws + WS_TOK); float* tokw = (float*)(A->ws + WS_TOK + (size_t)M * 8);
    __syncthreads();
    for (int e = F.tid; e < 16 * 1024; e += NTHR) { const int ex = e >> 10, k = e & 1023; wrT[e] = A->in[26][k * 16 + ex]; }
    __syncthreads();
    float rb_[16];
#pragma unroll
    for (int e = 0; e < 16; ++e) rb_[e] = A->in[27][e];
    for (int rb = F.vcu; rb < M / 128; rb += F.G) { const int b = rb / 32; const float* mb = mod + ((size_t)l * NB + b) * 6144;
        float g1[16], sh2[16], sc2[16], lg[16], lb[16];
#pragma unroll
        for (int j = 0; j < 4; ++j)
#pragma unroll
            for (int i = 0; i < 4; ++i) { const int c = 4 * F.lane + 256 * j + i, q = j * 4 + i; g1[q] = 1.0f + mb[2048 + c]; sh2[q] = mb[3072 + c]; sc2[q] = 1.0f + mb[4096 + c]; lg[q] = A->in[24][(l * 2 + 0) * DM + c]; lb[q] = A->in[25][(l * 2 + 0) * DM + c]; }
#pragma unroll 1
        for (int i = 0; i < 16; ++i) { const int tl = F.wave * 16 + i; const size_t row = (size_t)rb * 128 + tl;
            const f32x4* xr = (const f32x4*)(xin + row * DM) + F.lane; const v2u* mr = (const v2u*)(MIX + row * DM) + F.lane;
            float y[16]; float s = 0.f;
#pragma unroll
            for (int j = 0; j < 4; ++j) { const f32x4 v = xr[64 * j]; const v2u m2 = mr[64 * j];
                y[j * 4 + 0] = ALPHA * v[0] + g1[j * 4 + 0] * bflo(m2.x); y[j * 4 + 1] = ALPHA * v[1] + g1[j * 4 + 1] * bfhi(m2.x);
                y[j * 4 + 2] = ALPHA * v[2] + g1[j * 4 + 2] * bflo(m2.y); y[j * 4 + 3] = ALPHA * v[3] + g1[j * 4 + 3] * bfhi(m2.y);
                s += (y[j * 4] + y[j * 4 + 1]) + (y[j * 4 + 2] + y[j * 4 + 3]); }
            const float mean = wave_sum(s) * (1.0f / DM); float q = 0.f;
#pragma unroll
            for (int k = 0; k < 16; ++k) { y[k] -= mean; q += y[k] * y[k]; }
            const float rstd = rsqrtf(wave_sum(q) * (1.0f / DM) + LN_EPS);
            f32x4* xo = (f32x4*)(A->out + row * DM) + F.lane; v2u* ur = (v2u*)(U + row * UP_) + F.lane; float u2[16];
#pragma unroll
            for (int j = 0; j < 4; ++j) { f32x4 o;
#pragma unroll
                for (int k = 0; k < 4; ++k) { o[k] = y[j * 4 + k] * rstd * lg[j * 4 + k] + lb[j * 4 + k]; u2[j * 4 + k] = o[k] * sc2[j * 4 + k] + sh2[j * 4 + k]; }
                xo[64 * j] = o; v2u w; w.x = pk2(u2[j * 4], u2[j * 4 + 1]); w.y = pk2(u2[j * 4 + 2], u2[j * 4 + 3]); ur[64 * j] = w; }
            float sc[16]; float mx = -1e30f;
#pragma unroll
            for (int e = 0; e < 16; ++e) { float p = 0.f;
#pragma unroll
                for (int j = 0; j < 4; ++j) { const f32x4 wv = *(const LAS f32x4*)(wrT + e * 1024 + 4 * F.lane + 256 * j); p += (u2[j * 4] * wv[0] + u2[j * 4 + 1] * wv[1]) + (u2[j * 4 + 2] * wv[2] + u2[j * 4 + 3] * wv[3]); }
                sc[e] = wave_sum(p); mx = fmaxf(mx, sc[e]); }
            float den = 0.f;
#pragma unroll
            for (int e = 0; e < 16; ++e) { sc[e] = __expf(sc[e] - mx); den += sc[e]; }
            const float iden = 1.0f / den; float sel[16];
#pragma unroll
            for (int e = 0; e < 16; ++e) { sc[e] *= iden; sel[e] = sc[e] + rb_[e]; }
            int bg = 0; float bgs = -1e30f;
#pragma unroll
            for (int gq = 0; gq < 4; ++gq) { float m1 = -1e30f, m2 = -1e30f;
#pragma unroll
                for (int k = 0; k < 4; ++k) { const float v = sel[gq * 4 + k]; if (v > m1) { m2 = m1; m1 = v; } else if (v > m2) m2 = v; }
                const float gs = m1 + m2; if (gs > bgs) { bgs = gs; bg = gq; } }
            int i0 = 0, i1 = 0; float v0 = -1e30f, v1 = -1e30f, w0 = 0.f, w1 = 0.f;
#pragma unroll
            for (int e = 0; e < 16; ++e) { if ((e >> 2) == bg) { const float v = sel[e]; if (v > v0) { v1 = v0; i1 = i0; w1 = w0; v0 = v; i0 = e; w0 = sc[e]; } else if (v > v1) { v1 = v; i1 = e; w1 = sc[e]; } } }
            const float iw = 1.0f / (w0 + w1);
            if (F.lane == 0) { te[tl * 2] = i0; te[tl * 2 + 1] = i1; tokw[row * 2] = w0 * iw; tokw[row * 2 + 1] = w1 * iw; }
        }
        __syncthreads();
        if (F.tid < 16) { int n = 0; for (int k = 0; k < 256; ++k) n += (te[k] == F.tid) ? 1 : 0;
            tbase[F.tid] = (int)__hip_atomic_fetch_add(F.ctl + CW_ECNT + 64 * l + F.tid, (unsigned)n, RLX_AGENT);
            int p = tbase[F.tid];
            for (int k = 0; k < 256; ++k) if (te[k] == F.tid) { tokpos[(size_t)rb * 256 + k] = (F.tid << 24) | p; ++p; } }
        __syncthreads();
    }
}
__device__ __forceinline__ void load_hb(const Frame& F, int l, volatile LAS int* hb, int c) {
    __syncthreads();
    if (F.tid == 0) { int acc = 0; for (int e = 0; e < 16; ++e) { hb[e] = acc; const int cn = (int)__hip_atomic_load(F.ctl + CW_ECNT + 64 * l + e, RLX_AGENT); acc += (cn + 255) & ~255; } hb[16] = acc; hb[17] = acc >> 8;
        const int nun = (acc >> 8) * 4; int n = 0;
        for (int L = c; L < nun && n < 12; L += F.G) { const int j = L >> 2, pn = L & 3; int e = 0; for (int k = 1; k < 16; ++k) e = (hb[k] <= j * 256) ? k : e; hb[19 + n] = (j << 8) | (pn << 4) | e; ++n; }
        hb[18] = n; }
    __syncthreads();
}
__device__ __forceinline__ void phase_scatter(const Frame& F, ArgP A, int l) {
    volatile LAS int* hb = (volatile LAS int*)(F.lds + 4096);
    load_hb(F, l, hb, 0);
    const int* tokpos = (const int*)(A->ws + WS_TOK); int* tokrow = (int*)(A->ws + WS_TOK + (size_t)M * 16);
    const bf16* U = (const bf16*)(A->ws + WS_U); bf16* AS = (bf16*)(A->ws + WS_AS);
    for (int rb = F.vcu; rb < M / 128; rb += F.G) {
        for (int i = 0; i < 32; ++i) { const int k = F.wave * 32 + i; const size_t idx = (size_t)rb * 256 + k; const int tp = tokpos[idx]; const int e = tp >> 24, pos = tp & 0xffffff;
            const int row = hb[e] + pos; const size_t tok = idx >> 1;
            const v4u* src = (const v4u*)(U + tok * UP_) + F.lane; v4u* dst = (v4u*)(AS + (size_t)row * DM) + F.lane;
            const v4u a = src[0], c = src[64]; dst[0] = a; dst[64] = c;
            if (F.lane == 0) tokrow[idx] = row; }
    }
}
__device__ __forceinline__ void phase_ln2(const Frame& F, ArgP A, int l) {
    const float* mod = (const float*)(A->ws + WS_MOD);
    const bf16* Y = (const bf16*)(A->ws + WS_Y); bf16* U = (bf16*)(A->ws + WS_U);
    const int* tokrow = (const int*)(A->ws + WS_TOK + (size_t)M * 16); const float* tokw = (const float*)(A->ws + WS_TOK + (size_t)M * 8);
    for (int rb = F.vcu; rb < M / 128; rb += F.G) { const int b = rb / 32; const float* mb = mod + ((size_t)l * NB + b) * 6144; const float* mn = mod + ((size_t)(l < NL - 1 ? l + 1 : l) * NB + b) * 6144;
        const size_t rw0 = (size_t)rb * 128 + F.wave * 16;
        int myr0 = 0, myr1 = 0; float myw0 = 0.f, myw1 = 0.f;
        if (F.lane < 16) { myr0 = tokrow[(rw0 + F.lane) * 2]; myr1 = tokrow[(rw0 + F.lane) * 2 + 1]; myw0 = tokw[(rw0 + F.lane) * 2]; myw1 = tokw[(rw0 + F.lane) * 2 + 1]; }
        float g2[16], sh1[16], sc1[16], lg[16], lb[16];
#pragma unroll
        for (int j = 0; j < 4; ++j)
#pragma unroll
            for (int i = 0; i < 4; ++i) { const int c = 4 * F.lane + 256 * j + i, q = j * 4 + i; g2[q] = 1.0f + mb[5120 + c]; sh1[q] = mn[c]; sc1[q] = 1.0f + mn[1024 + c]; lg[q] = A->in[24][(l * 2 + 1) * DM + c]; lb[q] = A->in[25][(l * 2 + 1) * DM + c]; }
        f32x4 xv[4]; v2u ya[4], yc[4];
#define LN2_LOAD(i_) do { const int r0_ = __builtin_amdgcn_readlane(myr0, (i_)), r1_ = __builtin_amdgcn_readlane(myr1, (i_)); \
        const f32x4* xr_ = (const f32x4*)(A->out + (rw0 + (i_)) * DM) + F.lane; const v2u* y0_ = (const v2u*)(Y + (size_t)r0_ * DM) + F.lane; const v2u* y1_ = (const v2u*)(Y + (size_t)r1_ * DM) + F.lane; \
        _Pragma("unroll") for (int j_ = 0; j_ < 4; ++j_) { xv[j_] = xr_[64 * j_]; ya[j_] = y0_[64 * j_]; yc[j_] = y1_[64 * j_]; } } while (0)
        LN2_LOAD(0);
#pragma unroll
        for (int i = 0; i < 16; ++i) { const size_t row = rw0 + i;
            const float w0 = __builtin_bit_cast(float, __builtin_amdgcn_readlane(__builtin_bit_cast(int, myw0), i)), w1 = __builtin_bit_cast(float, __builtin_amdgcn_readlane(__builtin_bit_cast(int, myw1), i));
            float y[16]; float s = 0.f;
#pragma unroll
            for (int j = 0; j < 4; ++j) { const f32x4 v = xv[j]; const v2u a = ya[j], c = yc[j];
                y[j * 4 + 0] = ALPHA * v[0] + g2[j * 4 + 0] * (w0 * bflo(a.x) + w1 * bflo(c.x)); y[j * 4 + 1] = ALPHA * v[1] + g2[j * 4 + 1] * (w0 * bfhi(a.x) + w1 * bfhi(c.x));
                y[j * 4 + 2] = ALPHA * v[2] + g2[j * 4 + 2] * (w0 * bflo(a.y) + w1 * bflo(c.y)); y[j * 4 + 3] = ALPHA * v[3] + g2[j * 4 + 3] * (w0 * bfhi(a.y) + w1 * bfhi(c.y));
                s += (y[j * 4] + y[j * 4 + 1]) + (y[j * 4 + 2] + y[j * 4 + 3]); }
            if (i < 15) LN2_LOAD(i + 1);
            const float mean = wave_sum(s) * (1.0f / DM); float q = 0.f;
#pragma unroll
            for (int k = 0; k < 16; ++k) { y[k] -= mean; q += y[k] * y[k]; }
            const float rstd = rsqrtf(wave_sum(q) * (1.0f / DM) + LN_EPS);
            f32x4* xo = (f32x4*)(A->out + row * DM) + F.lane; v2u* ur = (v2u*)(U + row * UP_) + F.lane;
#pragma unroll
            for (int j = 0; j < 4; ++j) { f32x4 o; float u[4];
#pragma unroll
                for (int k = 0; k < 4; ++k) { o[k] = y[j * 4 + k] * rstd * lg[j * 4 + k] + lb[j * 4 + k]; u[k] = o[k] * sc1[j * 4 + k] + sh1[j * 4 + k]; }
                xo[64 * j] = o; if (l < NL - 1) { v2u w; w.x = pk2a(u[0], u[1]); w.y = pk2a(u[2], u[3]); ur[64 * j] = w; } }
        }
#undef LN2_LOAD
    }
}
struct SchedProj {
    static constexpr unsigned LDA = UP_ * 2, LDB = 2048; static constexpr int NT = 16; static constexpr bool VARNT = false;
    const char* U; const char* W; int G, c;
    __device__ __forceinline__ bool next(int i, pg8::GUnit& u, pg8::GOps& o) const { int pm, pn; if (!pg8::static_tile(M / 256, INW / 256, G, c, i, pm, pn)) return false;
        o.A = U + (size_t)pm * 256 * LDA; o.B = W + (size_t)pn * 256 * 2048; u.kind = 0; u.r0 = pm * 256; u.c0 = pn * 256; u.aux = (pn == 8 || pn == 9) ? 1 : 0; return true; }
};
struct SchedBranch {
    static constexpr unsigned LDA = 3072, LDB = 3072; static constexpr int NT = 16; static constexpr bool VARNT = true;
    const char* U; const char* WM; const char* OC; const char* WB; int G, c;
    __device__ __forceinline__ bool next(int i, pg8::GUnit& u, pg8::GOps& o) const { int pm, pn; if (!pg8::static_tile(M / 256, 4, G, c, i >> 2, pm, pn)) return false; const int sub = i & 3;
        u.r0 = pm * 256; u.c0 = pn * 256;
        if (sub < 3) { o.A = U + (size_t)pm * 256 * 3072; o.B = WM + ((size_t)sub * 1024 + pn * 256) * 3072; o.nt = 16; u.kind = 1; u.aux = sub; }
        else { o.A = OC + (size_t)pm * 256 * 3072; o.B = WB + (size_t)pn * 256 * 3072; o.nt = 24; u.kind = 2; u.aux = 0; }
        return true; }
};
struct SchedOut {
    static constexpr unsigned LDA = 2048, LDB = 2048; static constexpr int NT = 16; static constexpr bool VARNT = false;
    const char* Am; const char* W; int G, c;
    __device__ __forceinline__ bool next(int i, pg8::GUnit& u, pg8::GOps& o) const { int pm, pn; if (!pg8::static_tile(M / 256, 4, G, c, i, pm, pn)) return false;
        o.A = Am + (size_t)pm * 256 * 2048; o.B = W + (size_t)pn * 256 * 2048; u.kind = 0; u.r0 = pm * 256; u.c0 = pn * 256; u.aux = 0; return true; }
};
template <int UP> struct SchedMoe {
    static constexpr unsigned LDA = UP ? 2048 : 1024, LDB = LDA; static constexpr int NT = UP ? 16 : 8; static constexpr bool VARNT = false;
    const char* Am; const char* W; volatile LAS int* hb;
    __device__ __forceinline__ bool next(int i, pg8::GUnit& u, pg8::GOps& o) const { const int n = __builtin_amdgcn_readfirstlane(hb[18]); if (i >= n) return false;
        const int pk = __builtin_amdgcn_readfirstlane(hb[19 + i]); const int j = pk >> 8, pn = (pk >> 4) & 15, e = pk & 15;
        u.r0 = j * 256; u.aux = 0; u.kind = UP ? 3 : 0; u.c0 = UP ? pn * 128 : pn * 256;
        o.A = Am + (size_t)j * 256 * LDA; o.B = W + ((size_t)e * 1024 + pn * 256) * LDB;
        return true; }
};

constexpr int NPH = 2 + 9 * NL;
#ifndef PH_MASK
#define PH_MASK 0xffff
#endif
#define PHM(b) ((PH_MASK >> (b)) & 1)
#ifndef RPT_MASK
#define RPT_MASK 0
#endif
#define RPT(b) (1 + ((RPT_MASK >> (b)) & 1))
__global__ void __launch_bounds__(NTHR, 2) hybrid_fwd(Args args) {
    extern __shared__ __attribute__((aligned(16))) unsigned char lds[];
    Frame F; unsigned char* ws; ArgP A;
#define FRESH() do { int t_ = threadIdx.x; asm volatile("" : "+v"(t_)); { unsigned long long p_ = (unsigned long long)__builtin_amdgcn_kernarg_segment_ptr(); asm volatile("" : "+s"(p_)); A = (ArgP)p_; } ws = A->ws; \
        F.lds = (LAS unsigned char*)lds; F.MISC = (volatile LAS unsigned*)(F.lds + MISC_OFF); F.tid = t_; F.lane = t_ & 63; F.wave = __builtin_amdgcn_readfirstlane(t_ >> 6); \
        { int g_ = gridDim.x, b_ = blockIdx.x; asm volatile("" : "+s"(g_), "+s"(b_)); F.G = g_; F.bx = b_; F.vcu = (g_ % 8 == 0) ? (b_ % 8) * (g_ / 8) + b_ / 8 : b_; } F.ctl = (gu32*)(ws + WS_CTL); } while (0)
    FRESH();
    for (int u = F.tid; u < (LDS_BYTES - LDSCTL_OFF) / 4; u += NTHR) ((LAS unsigned*)(F.lds + LDSCTL_OFF))[u] = 0u;
    __syncthreads();
    XcdBarrier bar; bar.bar = (unsigned*)(ws + WS_CTL) + CW_BAR; bar.x = 0; bar.st = nullptr;
    if (!MK_PER_PHASE) bar = xcd_barrier_post((unsigned*)(ws + WS_CTL) + CW_BAR, F.MISC + 8);
    const int lo = A->ph_lo, hi = A->ph_hi;
#define IN(k) (lo <= (k) && (k) < hi)
#define SEAM(k) do { if (IN(k) && IN((k) + 1)) xcd_barrier(bar); } while (0)

    if (PHM(0) && IN(0)) { FRESH(); phase_prologue(F, A); SEAM(0); }
    if (PHM(1) && IN(1)) { FRESH(); phase_mod_u0(F, A); SEAM(1); }

#pragma unroll 1
    for (int l = 0; l < NL; ++l) {
        const int pb = 2 + 9 * l;
        if (PHM(2) && IN(pb + 0)) {
            FRESH(); const char* WA = (const char*)(ws + WS_WA); const char* WE = (const char*)(ws + WS_WE); (void)WA; (void)WE;
            SchedProj S{(const char*)(ws + WS_U), WA + WA_IN, F.G, F.bx};
            pg8::Epi<1> E{(bf16*)(ws + WS_PROJ), INW, C2Q, nullptr, nullptr};
            for (int rep = 0; rep < RPT(2); ++rep) pg8::gemm_phase<false>(F.lds, S, E);
            SEAM(pb + 0);
        }
        if (IN(pb + 1)) {
            FRESH();
            const float* sm = (const float*)(ws + WS_SMALL);
            MixP P;
            P.proj = (const bf16*)(ws + WS_PROJ); P.ocat = (bf16*)(ws + WS_OCAT); P.oatt = (bf16*)(ws + WS_OATT);
            P.hg_lb = sm + SM_HGLB + l * 512; P.hg_norm_g = A->in[6] + l * 128; P.lam = sm[SM_LAM + l]; P.one_m_lam_init = sm[SM_LAM + 4 + l]; P.da_subln_g = A->in[8] + l * 128;
            P.rw_mu = A->in[9] + l * 1792; P.rw_w0 = A->in[10] + l * 512; P.rw_a0 = A->in[12] + l * 512; P.rw_k_k = A->in[15] + l * 512; P.rw_k_a = A->in[16] + l * 512;
            P.rw_r_k = A->in[17] + l * 512; P.rw_gn_g = A->in[18] + l * 512; P.rw_gn_b = A->in[19] + l * 512;
            const bf16* lo_ = (const bf16*)(ws + WS_LORA) + (size_t)l * 131072; P.wupT = lo_; P.aupT = lo_ + 32768; P.gupT = lo_ + 65536;
            P.aq = F.ctl + CW_AQ + 64 * l;
            if (F.G >= 128) {
                if (PHM(3) && F.vcu < 64) { for (int rep = 0; rep < RPT(3); ++rep) rwkv_unit(P, F.vcu >> 3, F.vcu & 7, F.lds); }
                else if (PHM(4) && F.vcu < 96) { for (int rep = 0; rep < RPT(4); ++rep) hgrn_unit(P, (F.vcu - 64) >> 2, (F.vcu - 64) & 3, F.lds); }
                else if (PHM(5)) { for (int rep = 0; rep < RPT(5); ++rep) { P.aq = F.ctl + CW_AQ + 64 * l + 32 * rep; attn_worker(P, (char*)lds, F.MISC + 16, F.tid); } }
            }
            SEAM(pb + 1);
        }
        if (PHM(6) && IN(pb + 2)) {
            FRESH(); const char* WA = (const char*)(ws + WS_WA); const char* WE = (const char*)(ws + WS_WE); (void)WA; (void)WE;
            SchedBranch S{(const char*)(ws + WS_U), WA + WA_MERGE, (const char*)(ws + WS_OCAT), WA + WA_BRANCH, F.G, F.bx};
            pg8::Epi<6> E{(bf16*)(ws + WS_MERGED), DM, 1.0f, A->in[21] + (size_t)l * 3 * DM, (v4u*)(ws + WS_GSCR) + (size_t)F.bx * 3 * 16 * 512};
            for (int rep = 0; rep < RPT(6); ++rep) pg8::gemm_phase<false>(F.lds, S, E);
            SEAM(pb + 2);
        }
        if (PHM(7) && IN(pb + 3)) {
            FRESH(); const char* WA = (const char*)(ws + WS_WA); const char* WE = (const char*)(ws + WS_WE); (void)WA; (void)WE;
            SchedOut S{(const char*)(ws + WS_MERGED), WA + WA_OUT, F.G, F.bx};
            pg8::Epi<1> E{(bf16*)(ws + WS_MIX), DM, 1.0f, nullptr, nullptr};
            for (int rep = 0; rep < RPT(7); ++rep) pg8::gemm_phase<false>(F.lds, S, E);
            SEAM(pb + 3);
        }
        if (PHM(8) && IN(pb + 4)) { FRESH(); phase_ln1(F, A, l); SEAM(pb + 4); }
        if (PHM(9) && IN(pb + 5)) { FRESH(); for (int rep = 0; rep < RPT(9); ++rep) phase_scatter(F, A, l); SEAM(pb + 5); }
        if (PHM(10) && IN(pb + 6)) {
            FRESH(); const char* WA = (const char*)(ws + WS_WA); const char* WE = (const char*)(ws + WS_WE); (void)WA; (void)WE;
            volatile LAS int* hb = (volatile LAS int*)(F.lds + LDSCTL_OFF + 128);
            load_hb(F, l, hb, F.bx);
            SchedMoe<1> S{(const char*)(ws + WS_AS), WE + WE_GU, hb};
            pg8::Epi<8> E{(bf16*)(ws + WS_H), DE, 1.0f, nullptr, nullptr};
            for (int rep = 0; rep < RPT(10); ++rep) pg8::gemm_phase<false>(F.lds, S, E);
            SEAM(pb + 6);
        }
        if (PHM(11) && IN(pb + 7)) {
            FRESH(); const char* WA = (const char*)(ws + WS_WA); const char* WE = (const char*)(ws + WS_WE); (void)WA; (void)WE;
            volatile LAS int* hb = (volatile LAS int*)(F.lds + LDSCTL_OFF + 128);
            load_hb(F, l, hb, F.bx);
            SchedMoe<0> S{(const char*)(ws + WS_H), WE + WE_DT, hb};
            pg8::Epi<1> E{(bf16*)(ws + WS_Y), DM, 1.0f, nullptr, nullptr};
            for (int rep = 0; rep < RPT(11); ++rep) pg8::gemm_phase<false>(F.lds, S, E);
            SEAM(pb + 7);
        }
        if (PHM(12) && IN(pb + 8)) { FRESH(); if (l < NL - 1) conv_layer(F, A, l + 1); phase_ln2(F, A, l); SEAM(pb + 8); }
    }
#undef IN
#undef SEAM
}

extern "C" void kernel_launch(void* const* d_in, const int* in_sizes, int n_in, void* d_out, int out_size, void* d_ws, size_t ws_size, hipStream_t stream) {
    static int grid = 0;
    if (grid == 0) {
        if (n_in != 31 || out_size != M * DM || ws_size < WS_END) { fprintf(stderr, "kernel_launch: unexpected shapes (n_in %d, out %d, ws %zu < %zu); nothing launched\n", n_in, out_size, ws_size, (size_t)WS_END); grid = -1; return; }
        int dev = 0, cus = 0, per_cu = 0;
        if (hipGetDevice(&dev) != hipSuccess || hipDeviceGetAttribute(&cus, hipDeviceAttributeMultiprocessorCount, dev) != hipSuccess) { grid = -1; return; }
        if (hipFuncSetAttribute((const void*)hybrid_fwd, hipFuncAttributeMaxDynamicSharedMemorySize, LDS_BYTES) != hipSuccess) { fprintf(stderr, "kernel_launch: hipFuncSetAttribute failed\n"); grid = -1; return; }
        if (hipOccupancyMaxActiveBlocksPerMultiprocessor(&per_cu, (const void*)hybrid_fwd, NTHR, LDS_BYTES) != hipSuccess || per_cu < 1) { fprintf(stderr, "kernel_launch: occupancy query reports %d\n", per_cu); }
        (void)hipGetLastError();
        grid = cus;
        if (grid > 256) grid = 256;
    }
    if (grid < 0) return;
    (void)hipMemsetAsync((char*)d_ws + WS_CTL, 0, CTL_ZERO_BYTES, stream);
    Args a{};
    for (int i = 0; i < 31; ++i) a.in[i] = (const float*)d_in[i];
    a.out = (float*)d_out; a.ws = (unsigned char*)d_ws;
#if MK_PER_PHASE
    for (int p = 0; p < NPH; ++p) { a.ph_lo = p; a.ph_hi = p + 1; hipLaunchKernelGGL(hybrid_fwd, dim3(grid), dim3(NTHR), LDS_BYTES, stream, a); }
#else
    a.ph_lo = 0; a.ph_hi = NPH; hipLaunchKernelGGL(hybrid_fwd, dim3(grid), dim3(NTHR), LDS_BYTES, stream, a);
#endif
}
```

```cpp
#include <hip/hip_runtime.h>
#include <hip/hip_bf16.h>
#include <cstdio>
#include <cstdint>

#ifndef MK_PER_PHASE
#define MK_PER_PHASE 0
#endif

#define GAS __attribute__((address_space(1)))
#define LAS __attribute__((address_space(3)))
typedef unsigned short bf16;
typedef unsigned v4u __attribute__((ext_vector_type(4)));
typedef unsigned v2u __attribute__((ext_vector_type(2)));
typedef float f32x4 __attribute__((ext_vector_type(4)));
typedef float f32x2 __attribute__((ext_vector_type(2)));
typedef float f32x16 __attribute__((ext_vector_type(16)));
typedef short bf16x8 __attribute__((ext_vector_type(8)));
typedef short s16x4 __attribute__((ext_vector_type(4)));
typedef GAS unsigned gu32;
#define RLX_AGENT __ATOMIC_RELAXED, __HIP_MEMORY_SCOPE_AGENT
#define LDS_WAIT() asm volatile("s_waitcnt lgkmcnt(0)" ::: "memory")
#define VM_WAIT() asm volatile("s_waitcnt vmcnt(0)" ::: "memory")
#define ST16_WT(p, v) asm volatile("global_store_dwordx4 %0, %1, off sc1\n\ts_nop 1" :: "v"(p), "v"(v) : "memory")

constexpr int DM = 1024, NB = 8, T = 4096, NL = 4, M = NB * T;
constexpr int INW = 5376;
constexpr int C_HGQ = 0, C_HGF = 512, C_HGI = 1024, C_HGO = 1536, C_DAQ = 2048, C_DAK = 2560, C_DAV = 3072, C_RW = 3584;
constexpr int C_RWR = C_RW, C_RWK = C_RW + 512, C_RWV = C_RW + 1024, C_RWWD = C_RW + 1536, C_RWAD = C_RW + 1600, C_RWGD = C_RW + 1664;
constexpr int NE = 16, DE = 512;
constexpr float ALPHA = 1.681792830507429f;
constexpr float LN_EPS = 1e-5f, RMS_EPS = 1e-6f, RW_GN_EPS = 64e-5f, HG_F_MIN = 1e-6f;
constexpr float LOG2E = 1.4426950408889634f;
constexpr float C2Q = 0.125f * LOG2E;

constexpr size_t MiB = 1u << 20;
constexpr size_t WS_CTL = 0, CTL_ZERO_BYTES = 1 * MiB;
constexpr size_t WS_MODP = 1 * MiB;
constexpr size_t WS_MOD = 7 * MiB;
constexpr size_t WS_SMALL = 8 * MiB;
constexpr size_t WS_TOK = 9 * MiB;
constexpr size_t WS_LORA = 11 * MiB;
constexpr int UP_ = 1536;
constexpr size_t WS_WA = 12 * MiB;
constexpr size_t WA_IN = 0, WA_MERGE = (size_t)INW * DM * 2, WA_BRANCH = WA_MERGE + (size_t)3 * DM * UP_ * 2, WA_OUT = WA_BRANCH + (size_t)DM * 1536 * 2, WA_END = WA_OUT + (size_t)DM * DM * 2;
constexpr size_t WS_WE = 40 * MiB;
constexpr size_t WE_GU = 0, WE_DT = (size_t)32 * MiB;
constexpr size_t WS_U = 88 * MiB;
constexpr size_t WS_PROJ = 184 * MiB;
constexpr size_t WS_OCAT = 520 * MiB;
constexpr size_t WS_OATT = 616 * MiB;
constexpr size_t WS_GATES = 680 * MiB;
constexpr size_t WS_END = 776 * MiB;
constexpr size_t WS_ACT = WS_U + 64 * MiB;
constexpr size_t WS_MERGED = WS_U;
constexpr size_t WS_MIX = WS_OATT;
constexpr size_t WS_AS = WS_PROJ;
constexpr size_t WS_H = WS_PROJ + 224 * MiB;
constexpr size_t WS_Y = WS_OCAT;
constexpr int MAXROWS = 2 * M + NE * 256;
static_assert(WA_END <= 28 * MiB, "WA");
static_assert((size_t)MAXROWS * 2048 <= 160 * MiB && (size_t)MAXROWS * 1024 <= 112 * MiB, "moe buffers");

constexpr int CW_TMO = 0, CW_CODE = 1;
constexpr int CW_BAR = 4096;
constexpr int CW_ECNT = 16384;
constexpr int CW_AQ = 20480;
constexpr int CW_RDY = 49152;
constexpr int CW_PRE = 49664;
constexpr int CW_ATOT = 50560;
constexpr int CW_PTOT = 50432;
constexpr int CW_MDN = 50688;
constexpr int CW_RDR = 51712;
constexpr int CW_NRM = 32768;

constexpr int RING_BYTES = 131072;
constexpr int LDSCTL_OFF = RING_BYTES, MISC_OFF = LDSCTL_OFF + 320;
constexpr int LDS_BYTES = 147456;
constexpr int NWAVES = 8, NTHR = 512;

typedef float f32x2_t_ __attribute__((ext_vector_type(2))); typedef __bf16 bf16x2_t_ __attribute__((ext_vector_type(2)));
__device__ __forceinline__ unsigned pk2(float lo, float hi) { const f32x2_t_ v = {lo, hi}; const bf16x2_t_ b = __builtin_convertvector(v, bf16x2_t_); return __builtin_bit_cast(unsigned, b); }
__device__ __forceinline__ unsigned pk2a(float lo, float hi) { return pk2(lo, hi); }
__device__ __forceinline__ unsigned f2bf(float f) { return pk2(f, 0.f) & 0xffffu; }
__device__ __forceinline__ float tanh_fast(float x) { return 1.0f - 2.0f * __builtin_amdgcn_rcpf(1.0f + __expf(2.0f * x)); }
__device__ __forceinline__ float bf2f(unsigned short b) { return __builtin_bit_cast(float, ((unsigned)b) << 16); }
__device__ __forceinline__ float bflo(unsigned w) { return __builtin_bit_cast(float, w << 16); }
__device__ __forceinline__ float bfhi(unsigned w) { return __builtin_bit_cast(float, w & 0xffff0000u); }
__device__ __forceinline__ unsigned cvt_pk_bf16(float lo, float hi) { unsigned r; asm volatile("v_cvt_pk_bf16_f32 %0, %1, %2" : "=v"(r) : "v"(lo), "v"(hi)); return r; }
__device__ __forceinline__ float sigmoidf_(float x) { return __builtin_amdgcn_rcpf(1.0f + __expf(-x)); }
#define DPPF(x, ctrl) __builtin_bit_cast(float, __builtin_amdgcn_update_dpp(0, __builtin_bit_cast(int, (x)), (ctrl), 0xf, 0xf, true))
__device__ __forceinline__ float sum4(float v) { v += DPPF(v, 0xB1); v += DPPF(v, 0x4E); return v; }
__device__ __forceinline__ float sum8(float v) { v = sum4(v); v += DPPF(v, 0x141); return v; }
__device__ __forceinline__ float sum16(float v) { v = sum8(v); v += DPPF(v, 0x140); return v; }
__device__ __forceinline__ float wave_sum(float v) { v = sum16(v); v += __shfl_xor(v, 16); v += __shfl_xor(v, 32); return v; }

#define XB_TMO      128
#define XB_XCNT(j)  (256  + 64 * (j))
#define XB_XSUB(j)  (1280 + 64 * (j))
#define XB_XGEN(j)  (2304 + 64 * (j))
#define XB_TOP      3328
#define XB_TOPGEN   3392
#define XCD_BAR_WORDS 3456
#define XB_SPIN_CAP (1u << 20)

__device__ __forceinline__ unsigned xb_ld(unsigned* p)              { return __hip_atomic_load(p, __ATOMIC_RELAXED, __HIP_MEMORY_SCOPE_AGENT); }
__device__ __forceinline__ unsigned xb_add(unsigned* p, unsigned v) { return __hip_atomic_fetch_add(p, v, __ATOMIC_RELAXED, __HIP_MEMORY_SCOPE_AGENT); }
__device__ __forceinline__ unsigned xb_xcc_id() { return (unsigned)__builtin_amdgcn_s_getreg((3 << 11) | 20) & 0xFu; }
#define XB_SPIN(cond, bar) do { unsigned _sp = 0; while (cond) { __builtin_amdgcn_s_sleep(1); \
    if ((++_sp & 255u) == 0u) { if (xb_ld(&(bar)[XB_TMO])) break; if (_sp > XB_SPIN_CAP) { atomicAdd(&(bar)[XB_TMO], 1u); break; } } } } while (0)

struct XcdBarrier { unsigned* bar; unsigned x; volatile LAS unsigned* st; };

__device__ __forceinline__ XcdBarrier xcd_barrier_post(unsigned* bar, volatile LAS unsigned* st) {
    XcdBarrier b; b.bar = bar; b.x = xb_xcc_id(); b.st = st;
    if (threadIdx.x == 0) (void)xb_add(&bar[XB_XCNT(b.x)], 1u);
    return b;
}
__device__ __forceinline__ void xcd_barrier_complete(unsigned* bar, unsigned x, unsigned& nloc, unsigned& nx) {
    const unsigned G = gridDim.x * gridDim.y * gridDim.z;
    unsigned sum, cnt, mine, sp = 0u;
    for (;;) {
        sum = 0u; cnt = 0u; mine = 0u;
#pragma unroll 1
        for (unsigned j = 0; j < 16; ++j) { const unsigned c = xb_ld(&bar[XB_XCNT(j)]); sum += c; cnt += (c > 0u) ? 1u : 0u; mine = (j == x) ? c : mine; }
        if (sum == G) break;
        __builtin_amdgcn_s_sleep(1);
        if ((++sp & 255u) == 0u) { if (xb_ld(&bar[XB_TMO])) break; if (sp > XB_SPIN_CAP) { atomicAdd(&bar[XB_TMO], 1u); break; } }
    }
    nloc = mine > 0u ? mine : 1u; nx = cnt > 0u ? cnt : 1u;
}
__device__ __forceinline__ void xcd_barrier(const XcdBarrier& b) {
    asm volatile("s_waitcnt vmcnt(0)" ::: "memory");
    __syncthreads();
    if (threadIdx.x == 0) {
        unsigned* bar = b.bar;
        __builtin_amdgcn_s_waitcnt(0);
        unsigned nloc = b.st[0], nx = b.st[1];
        if (nloc == 0u) { xcd_barrier_complete(bar, b.x, nloc, nx); b.st[0] = nloc; b.st[1] = nx; }
        const unsigned old = xb_add(&bar[XB_XSUB(b.x)], 1u);
        const unsigned gen = old / nloc;
        if (old + 1u == (gen + 1u) * nloc) {
            __builtin_amdgcn_fence(__ATOMIC_RELEASE, "agent");
            asm volatile("s_waitcnt vmcnt(0)" ::: "memory");
            const unsigned og = xb_add(&bar[XB_TOP], 1u);
            const unsigned tg = og / nx;
            if (og + 1u == (tg + 1u) * nx) xb_add(&bar[XB_TOPGEN], 1u);
            else XB_SPIN(xb_ld(&bar[XB_TOPGEN]) == tg, bar);
            __builtin_amdgcn_fence(__ATOMIC_ACQUIRE, "agent");
            xb_add(&bar[XB_XGEN(b.x)], 1u);
            asm volatile("s_waitcnt vmcnt(0)" ::: "memory");
        } else {
            XB_SPIN(xb_ld(&bar[XB_XGEN(b.x)]) == gen, bar);
            __builtin_amdgcn_fence(__ATOMIC_ACQUIRE, "agent");
            asm volatile("s_waitcnt vmcnt(0)" ::: "memory");
        }
    }
    __syncthreads();
}
namespace pg8 {
#define PG8_LAS __attribute__((address_space(3)))
constexpr int BM = 256, BK = 64, HALF = 128, HTB = HALF * BK * 2, STAGE_BYTES = 8 * HTB, NXCD = 8, WGM = 8;
__host__ __device__ __forceinline__ int lds_byte(int r, int c) { const int st = (r >> 4) * 2 + (c >> 5), rr = r & 15, cc = c & 31, ob = rr * 64 + cc * 2; return st * 1024 + (ob ^ (((ob >> 9) & 1) << 5)); }
__host__ __device__ __forceinline__ void stage_rc(int b, int& R, int& C) { const int st = b / 1024, sb = b % 1024, swz = sb ^ (((sb >> 9) & 1) << 5); R = (st >> 1) * 16 + swz / 64; C = (st & 1) * 32 + (swz % 64) / 2; }
__host__ __device__ __forceinline__ int perm32(int rho) { const int n = rho >> 4, i = rho & 15; return 8 * (i >> 2) + 4 * n + (i & 3); }

struct GUnit {
    int kind;
    int r0, c0;
    int aux;
};
struct GOps {
    const char* A; const char* B; unsigned lda, ldb; int nt;
};
__device__ __forceinline__ bool static_tile(int nM, int nN, int G, int c, int i, int& pm, int& pn) {
    const int nwg = nM * nN; const long L = (long)i * G + c; if (L >= nwg) return false;
    int wgid = (int)L; { const int q = nwg / NXCD, r = nwg % NXCD, xcd = wgid % NXCD, off = wgid / NXCD; wgid = (xcd < r ? xcd * (q + 1) : r * (q + 1) + (xcd - r) * q) + off; }
    const int nig = WGM * nN, gid = wgid / nig, fm = gid * WGM, gsz = (nM - fm) < WGM ? (nM - fm) : WGM;
    pm = fm + ((wgid % nig) % gsz); pn = (wgid % nig) / gsz; return true;
}

template <bool VARLD, bool GATHER, class Sched, class Epi>
__device__ __forceinline__ void gemm_phase(PG8_LAS unsigned char* lds, const Sched& S, const Epi& E) {
    int tid_ = threadIdx.x; asm volatile("" : "+v"(tid_));
    const int tid = tid_, wid = __builtin_amdgcn_readfirstlane(tid >> 6), lane = tid & 63, wr = wid >> 2, wc = wid & 3, fr = lane & 15, fq = lane >> 4;
    int R0, C0, R1, C1; stage_rc(tid * 16, R0, C0); stage_rc(tid * 16 + 8192, R1, C1);
    const int Rb0 = (R0 & ~31) + perm32(R0 & 31), Rb1 = (R1 & ~31) + perm32(R1 & 31);
    const unsigned ldsw = (unsigned)wid * 1024u;
    const int aoff = lds_byte(wr * 64 + fr, fq * 8), boff = lds_byte(wc * 32 + fr, fq * 8);
#define PG8_SA(b, h) (((b) * 2 + (h)) * HTB)
#define PG8_SB(b, h) ((4 + (b) * 2 + (h)) * HTB)
#define PG8_STAGE(bufoff, gbase, v0, v1) do { \
        __builtin_amdgcn_global_load_lds((const unsigned*)((const char*)(gbase) + (v0)), (PG8_LAS unsigned*)(lds + (bufoff) + ldsw), 16, 0, 0); \
        __builtin_amdgcn_global_load_lds((const unsigned*)((const char*)(gbase) + (v1)), (PG8_LAS unsigned*)(lds + (bufoff) + ldsw + 8192), 16, 0, 0); } while (0)
#define PG8_LDA(dst, b, h) do { _Pragma("unroll") for (int m = 0; m < 4; ++m) _Pragma("unroll") for (int k = 0; k < 2; ++k) dst[m][k] = *(const PG8_LAS bf16x8*)(lds + PG8_SA(b, h) + aoff + m * 2048 + k * 1024); } while (0)
#define PG8_LDB(dst, b, h) do { _Pragma("unroll") for (int n = 0; n < 2; ++n) _Pragma("unroll") for (int k = 0; k < 2; ++k) dst[n][k] = *(const PG8_LAS bf16x8*)(lds + PG8_SB(b, h) + boff + n * 2048 + k * 1024); } while (0)
#define PG8_MMA(ai, bj, At, Bt) do { __builtin_amdgcn_s_setprio(1); _Pragma("unroll") for (int m = 0; m < 4; ++m) _Pragma("unroll") for (int n = 0; n < 2; ++n) _Pragma("unroll") for (int k = 0; k < 2; ++k) \
        acc[ai][bj][m][n] = __builtin_amdgcn_mfma_f32_16x16x32_bf16(Bt[n][k], At[m][k], acc[ai][bj][m][n], 0, 0, 0); __builtin_amdgcn_s_setprio(0); } while (0)
#define PG8_WAIT_V(n) asm volatile("s_waitcnt vmcnt(" #n ")" ::: "memory")
#define PG8_WAIT_L(n) asm volatile("s_waitcnt lgkmcnt(" #n ")" ::: "memory")
#define PG8_BAR __builtin_amdgcn_s_barrier()
#define PG8_SCHED __builtin_amdgcn_sched_barrier(0)
    GUnit cur, nxt; GOps co, no_; int ui = 0;
    if (!S.next(0, cur, co)) return;
    f32x4 acc[2][2][4][2];
#pragma unroll
    for (int a = 0; a < 2; ++a)
#pragma unroll
        for (int b = 0; b < 2; ++b)
#pragma unroll
            for (int m = 0; m < 4; ++m)
#pragma unroll
                for (int n = 0; n < 2; ++n) acc[a][b][m][n] = (f32x4){0.f, 0.f, 0.f, 0.f};
    bf16x8 At[4][2], B0[2][2], B1[2][2];
    const char* cA = co.A; const char* cB = co.B;
    unsigned ldA = VARLD ? co.lda : Sched::LDA, ldB = VARLD ? co.ldb : Sched::LDB; int nt = (VARLD || Sched::VARNT) ? co.nt : Sched::NT;
    unsigned vA0 = (unsigned)R0 * ldA + (unsigned)C0 * 2u, vA1 = (unsigned)R1 * ldA + (unsigned)C1 * 2u;
    unsigned vB0 = (unsigned)Rb0 * ldB + (unsigned)C0 * 2u, vB1 = (unsigned)Rb1 * ldB + (unsigned)C1 * 2u;
    unsigned hA = (unsigned)HALF * ldA, hB = (unsigned)HALF * ldB;
    unsigned gC00 = 0, gC01 = 0, gC10 = 0, gC11 = 0, gN00 = 0, gN01 = 0, gN10 = 0, gN11 = 0;
    if constexpr (GATHER) { gC00 = S.arow(cur, R0) + (unsigned)C0 * 2u; gC01 = S.arow(cur, R1) + (unsigned)C1 * 2u; gC10 = S.arow(cur, HALF + R0) + (unsigned)C0 * 2u; gC11 = S.arow(cur, HALF + R1) + (unsigned)C1 * 2u; hA = 0; }
    PG8_STAGE(PG8_SB(0, 0), cB, vB0, vB1); PG8_STAGE(PG8_SB(0, 1), cB + hB, vB0, vB1); PG8_STAGE(PG8_SA(0, 0), cA, GATHER ? gC00 : vA0, GATHER ? gC01 : vA1); PG8_STAGE(PG8_SA(0, 1), cA + hA, GATHER ? gC10 : vA0, GATHER ? gC11 : vA1);
    if (wr == 1) PG8_BAR;
    PG8_WAIT_V(2); PG8_BAR;
    PG8_STAGE(PG8_SB(1, 0), cB + 128, vB0, vB1); PG8_STAGE(PG8_SA(1, 0), cA + 128, GATHER ? gC00 : vA0, GATHER ? gC01 : vA1); PG8_STAGE(PG8_SB(1, 1), cB + hB + 128, vB0, vB1);
    PG8_WAIT_V(6); PG8_BAR;
    for (;;) {
        const bool has_next = S.next(ui + 1, nxt, no_);
        const char* nA = has_next ? no_.A : cA; const char* nB = has_next ? no_.B : cB;
        const unsigned nlda = (VARLD && has_next) ? no_.lda : ldA, nldb = (VARLD && has_next) ? no_.ldb : ldB;
        const int nnt = ((VARLD || Sched::VARNT) && has_next) ? no_.nt : nt;
        if constexpr (GATHER) { if (has_next) { gN00 = S.arow(nxt, R0) + (unsigned)C0 * 2u; gN01 = S.arow(nxt, R1) + (unsigned)C1 * 2u; gN10 = S.arow(nxt, HALF + R0) + (unsigned)C0 * 2u; gN11 = S.arow(nxt, HALF + R1) + (unsigned)C1 * 2u; }
                      else { gN00 = gC00; gN01 = gC01; gN10 = gC10; gN11 = gC11; } }
        for (int t = 0; t < nt; t += 2) {
            const bool last = (t == nt - 2);
            if (Epi::HAS_MID) { PG8_SCHED; E.mid(acc, cur, t, wr, wc, fr, fq); PG8_SCHED; }
            const char* a1 = cA + (size_t)(t + 1) * 128;
            const char* a2 = last ? nA : cA + (size_t)(t + 2) * 128; const char* b2 = last ? nB : cB + (size_t)(t + 2) * 128;
            const char* a3 = a2 + 128; const char* b3 = b2 + 128;
            unsigned xA0 = vA0, xA1 = vA1, xB0 = vB0, xB1 = vB1, xhA = hA, xhB = hB;
            const unsigned s00 = GATHER ? (last ? gN00 : gC00) : 0u, s01 = GATHER ? (last ? gN01 : gC01) : 0u, s10 = GATHER ? (last ? gN10 : gC10) : 0u, s11 = GATHER ? (last ? gN11 : gC11) : 0u;
            if (VARLD && last) { xA0 = (unsigned)R0 * nlda + (unsigned)C0 * 2u; xA1 = (unsigned)R1 * nlda + (unsigned)C1 * 2u; xB0 = (unsigned)Rb0 * nldb + (unsigned)C0 * 2u; xB1 = (unsigned)Rb1 * nldb + (unsigned)C1 * 2u; xhA = (unsigned)HALF * nlda; xhB = (unsigned)HALF * nldb; }
            PG8_LDB(B0, 0, 0); PG8_LDB(B1, 0, 1); PG8_SCHED; PG8_LDA(At, 0, 0); PG8_STAGE(PG8_SA(1, 1), a1 + hA, GATHER ? gC10 : vA0, GATHER ? gC11 : vA1);
            PG8_WAIT_V(8); PG8_WAIT_L(0); PG8_BAR; PG8_MMA(0, 0, At, B0); PG8_MMA(0, 1, At, B1); PG8_BAR; PG8_SCHED;
            PG8_LDA(At, 0, 1); PG8_STAGE(PG8_SB(0, 0), b2, xB0, xB1); PG8_STAGE(PG8_SB(0, 1), b2 + xhB, xB0, xB1); PG8_STAGE(PG8_SA(0, 0), a2, GATHER ? s00 : xA0, GATHER ? s01 : xA1);
            PG8_WAIT_V(8); PG8_WAIT_L(0); PG8_BAR; PG8_MMA(1, 0, At, B0); PG8_MMA(1, 1, At, B1); PG8_BAR; PG8_SCHED;
            PG8_LDB(B0, 1, 0); PG8_LDB(B1, 1, 1); PG8_SCHED; PG8_LDA(At, 1, 0); PG8_STAGE(PG8_SA(0, 1), a2 + xhA, GATHER ? s10 : xA0, GATHER ? s11 : xA1);
            PG8_WAIT_V(8); PG8_WAIT_L(0); PG8_BAR; PG8_MMA(0, 0, At, B0); PG8_MMA(0, 1, At, B1); PG8_BAR; PG8_SCHED;
            PG8_LDA(At, 1, 1); PG8_STAGE(PG8_SB(1, 0), b3, xB0, xB1); PG8_STAGE(PG8_SB(1, 1), b3 + xhB, xB0, xB1); PG8_STAGE(PG8_SA(1, 0), a3, GATHER ? s00 : xA0, GATHER ? s01 : xA1);
            PG8_WAIT_V(8); PG8_WAIT_L(0); PG8_BAR; PG8_MMA(1, 0, At, B0); PG8_MMA(1, 1, At, B1); PG8_BAR; PG8_SCHED;
        }
        if (wr == 0) PG8_BAR;
        PG8_SCHED; E(acc, cur, wr, wc, fr, fq); PG8_SCHED;
        if (!has_next) break;
#pragma unroll
        for (int a = 0; a < 2; ++a)
#pragma unroll
            for (int b = 0; b < 2; ++b)
#pragma unroll
                for (int m = 0; m < 4; ++m)
#pragma unroll
                    for (int n = 0; n < 2; ++n) acc[a][b][m][n] = (f32x4){0.f, 0.f, 0.f, 0.f};
        cur = nxt; cA = nA; cB = nB; ++ui;
        if (GATHER) { gC00 = gN00; gC01 = gN01; gC10 = gN10; gC11 = gN11; }
        if (VARLD || Sched::VARNT) nt = nnt;
        if (VARLD) { ldA = nlda; ldB = nldb; vA0 = (unsigned)R0 * ldA + (unsigned)C0 * 2u; vA1 = (unsigned)R1 * ldA + (unsigned)C1 * 2u; vB0 = (unsigned)Rb0 * ldB + (unsigned)C0 * 2u; vB1 = (unsigned)Rb1 * ldB + (unsigned)C1 * 2u; hA = (unsigned)HALF * ldA; hB = (unsigned)HALF * ldB; }
        if (wr == 1) PG8_BAR;
    }
    PG8_WAIT_V(0);
    PG8_BAR;
#undef PG8_SA
#undef PG8_SB
#undef PG8_STAGE
#undef PG8_LDA
#undef PG8_LDB
#undef PG8_MMA
#undef PG8_WAIT_V
#undef PG8_WAIT_L
#undef PG8_BAR
#undef PG8_SCHED
}

__device__ __forceinline__ void unpack8(const v2u x, float (&f)[8]) {
    f[0] = (float)(x.x & 0xffu); f[1] = (float)((x.x >> 8) & 0xffu); f[2] = (float)((x.x >> 16) & 0xffu); f[3] = (float)(x.x >> 24);
    f[4] = (float)(x.y & 0xffu); f[5] = (float)((x.y >> 8) & 0xffu); f[6] = (float)((x.y >> 16) & 0xffu); f[7] = (float)(x.y >> 24); }
template <int KM> struct Epi {
    static constexpr bool HAS_MID = (KM & 4) != 0;
    bf16* O; int ldc;
    float scale;
    const float* bias;
    unsigned char* G;
    int gc0;
    float* nrm;
    gu32* rwait;
    __device__ __forceinline__ void mid(f32x4 (&acc)[2][2][4][2], const GUnit& u, int t, int wr, int wc, int fr, int fq) const {
        if ((KM & 4) && u.kind == 2 && t == 14 && rwait) {
            unsigned sp_ = 0; while (__hip_atomic_load(rwait, RLX_AGENT) < 8u) { __builtin_amdgcn_s_sleep(1); if (++sp_ > XB_SPIN_CAP) break; }
            __builtin_amdgcn_fence(__ATOMIC_ACQUIRE, "agent"); return; }
        if (!(KM & 4) || u.kind != 2 || (t != 8 && t != 16)) return;
        const int sa = (t == 8) ? 0 : 1;
        const unsigned char* gp = G + (size_t)(u.r0 + wr * 64 + fr) * 3072 + sa * 1024 + u.c0 + wc * 32 + 8 * fq;
#pragma unroll
        for (int ai = 0; ai < 2; ++ai) { v2u xs[4][2], ys[4][2];
#pragma unroll
            for (int m = 0; m < 4; ++m) { const unsigned char* rp = gp + (size_t)(ai * HALF + m * 16) * 3072; asm volatile("" : "+v"(rp));
#pragma unroll
                for (int bj = 0; bj < 2; ++bj) { xs[m][bj] = *(const v2u*)(rp + bj * HALF); ys[m][bj] = *(const v2u*)(rp + bj * HALF + 1024); } }
#pragma unroll
            for (int m = 0; m < 4; ++m)
#pragma unroll
                for (int bj = 0; bj < 2; ++bj) { float fa[8], fb[8]; unpack8(xs[m][bj], fa); unpack8(ys[m][bj], fb);
                    f32x4 r0, r1;
#pragma unroll
                    for (int j = 0; j < 4; ++j) { r0[j] = fa[j] * __builtin_amdgcn_rcpf(fb[j]); r1[j] = fa[4 + j] * __builtin_amdgcn_rcpf(fb[4 + j]); }
                    acc[ai][bj][m][0] *= r0; acc[ai][bj][m][1] *= r1; }
            asm volatile("" ::: "memory"); }
    }
    __device__ __forceinline__ void operator()(f32x4 (&acc)[2][2][4][2], const GUnit& u, int wr, int wc, int fr, int fq) const {
        if ((KM & 16) && u.kind == 4) {
            const float sc = u.aux ? scale : 1.0f;
            const int row0 = u.r0 + wr * 64 + fr, col0 = u.c0 + wc * 32 + 8 * fq;
            float mx[2] = {0.f, 0.f};
#pragma unroll
            for (int ai = 0; ai < 2; ++ai)
#pragma unroll
                for (int m = 0; m < 4; ++m) { bf16* rowp = O + (size_t)(row0 + ai * HALF + m * 16) * ldc + col0;
#pragma unroll
                    for (int bj = 0; bj < 2; ++bj) { const f32x4 v0 = acc[ai][bj][m][0] * sc, v1 = acc[ai][bj][m][1] * sc;
                        v4u w; w.x = cvt_pk_bf16(v0[0], v0[1]); w.y = cvt_pk_bf16(v0[2], v0[3]); w.z = cvt_pk_bf16(v1[0], v1[1]); w.w = cvt_pk_bf16(v1[2], v1[3]);
                        *(v4u*)(rowp + bj * HALF) = w;
                        float ss = (v0[0] * v0[0] + v0[1] * v0[1]) + (v0[2] * v0[2] + v0[3] * v0[3]) + (v1[0] * v1[0] + v1[1] * v1[1]) + (v1[2] * v1[2] + v1[3] * v1[3]);
                        ss += __shfl_xor(ss, 16); ss += __shfl_xor(ss, 32);
                        mx[bj] = fmaxf(mx[bj], ss); } }
#pragma unroll
            for (int bj = 0; bj < 2; ++bj) { float v = mx[bj]; v = fmaxf(v, DPPF(v, 0xB1)); v = fmaxf(v, DPPF(v, 0x4E)); v = fmaxf(v, DPPF(v, 0x141)); v = fmaxf(v, DPPF(v, 0x140));
                if (fr == 0 && fq == 0) nrm[(((u.r0 >> 8) * 16 + ((u.c0 - 2048) >> 6) + 2 * bj + (wc >> 1)) * 2 + (wc & 1)) * 2 + wr] = v; }
        } else if ((KM & 1) && u.kind == 0) {
            const float sc = u.aux ? scale : 1.0f;
            const int row0 = u.r0 + wr * 64 + fr, col0 = u.c0 + wc * 32 + 8 * fq;
#pragma unroll
            for (int ai = 0; ai < 2; ++ai)
#pragma unroll
                for (int m = 0; m < 4; ++m) { bf16* rowp = O + (size_t)(row0 + ai * HALF + m * 16) * ldc + col0;
#pragma unroll
                    for (int bj = 0; bj < 2; ++bj) { const f32x4 v0 = acc[ai][bj][m][0] * sc, v1 = acc[ai][bj][m][1] * sc;
                        v4u w; w.x = cvt_pk_bf16(v0[0], v0[1]); w.y = cvt_pk_bf16(v0[2], v0[3]); w.z = cvt_pk_bf16(v1[0], v1[1]); w.w = cvt_pk_bf16(v1[2], v1[3]);
                        *(v4u*)(rowp + bj * HALF) = w; } }
        } else if ((KM & 2) && u.kind == 1) {
            const int gcol0 = (u.c0 - gc0) + wc * 32 + 8 * fq; const float* bp = bias + gcol0;
            unsigned char* gp = G + (size_t)(u.r0 + wr * 64 + fr) * 3072 + gcol0;
#pragma unroll
            for (int bj = 0; bj < 2; ++bj) { const f32x4 b0 = *(const f32x4*)(bp + bj * HALF), b1 = *(const f32x4*)(bp + bj * HALF + 4);
#pragma unroll
                for (int ai = 0; ai < 2; ++ai)
#pragma unroll
                    for (int m = 0; m < 4; ++m) { const f32x4 z0 = acc[ai][bj][m][0] + b0, z1 = acc[ai][bj][m][1] + b1; unsigned q[8];
#pragma unroll
                        for (int j = 0; j < 4; ++j) { q[j] = (unsigned)fminf(fmaxf(sigmoidf_(z0[j]) * 255.0f + 0.5f, 1.0f), 255.0f); q[4 + j] = (unsigned)fminf(fmaxf(sigmoidf_(z1[j]) * 255.0f + 0.5f, 1.0f), 255.0f); }
                        v2u w; w.x = q[0] | (q[1] << 8) | (q[2] << 16) | (q[3] << 24); w.y = q[4] | (q[5] << 8) | (q[6] << 16) | (q[7] << 24);
                        *(v2u*)(gp + (size_t)(ai * HALF + m * 16) * 3072 + bj * HALF) = w; } }
        } else if ((KM & 4) && u.kind == 2) {
            const int row0 = u.r0 + wr * 64 + fr, col0 = u.c0 + wc * 32 + 8 * fq;
            const unsigned char* gp = G + (size_t)row0 * 3072 + 2048 + col0;
#pragma unroll
            for (int ai = 0; ai < 2; ++ai) { v2u ys[4][2];
#pragma unroll
                for (int m = 0; m < 4; ++m) { const unsigned char* rp = gp + (size_t)(ai * HALF + m * 16) * 3072; asm volatile("" : "+v"(rp)); ys[m][0] = *(const v2u*)rp; ys[m][1] = *(const v2u*)(rp + HALF); }
#pragma unroll
                for (int m = 0; m < 4; ++m) { bf16* rowp = O + (size_t)(row0 + ai * HALF + m * 16) * ldc + col0;
#pragma unroll
                    for (int bj = 0; bj < 2; ++bj) { float fy[8]; unpack8(ys[m][bj], fy); const f32x4 a0 = acc[ai][bj][m][0] * (1.0f / 255.0f), a1 = acc[ai][bj][m][1] * (1.0f / 255.0f);
                        v4u w; w.x = cvt_pk_bf16(a0[0] * fy[0], a0[1] * fy[1]); w.y = cvt_pk_bf16(a0[2] * fy[2], a0[3] * fy[3]);
                        w.z = cvt_pk_bf16(a1[0] * fy[4], a1[1] * fy[5]); w.w = cvt_pk_bf16(a1[2] * fy[6], a1[3] * fy[7]);
                        if (KM & 32) { bf16* d_ = rowp + bj * HALF; ST16_WT(d_, w); } else *(v4u*)(rowp + bj * HALF) = w; } }
                asm volatile("" ::: "memory"); }
        } else if (KM & 8) {
            const int row0 = u.r0 + wr * 64 + fr, col0 = u.c0 + wc * 32 + 8 * fq;
#pragma unroll
            for (int ai = 0; ai < 2; ++ai)
#pragma unroll
                for (int m = 0; m < 4; ++m) { bf16* rowp = O + (size_t)(row0 + ai * HALF + m * 16) * ldc + col0; float hv[8];
#pragma unroll
                    for (int n = 0; n < 2; ++n)
#pragma unroll
                        for (int j = 0; j < 4; ++j) { const float gt = acc[ai][0][m][n][j], up = acc[ai][1][m][n][j]; hv[n * 4 + j] = gt * sigmoidf_(gt) * up; }
                    v4u w; w.x = cvt_pk_bf16(hv[0], hv[1]); w.y = cvt_pk_bf16(hv[2], hv[3]); w.z = cvt_pk_bf16(hv[4], hv[5]); w.w = cvt_pk_bf16(hv[6], hv[7]);
                    *(v4u*)rowp = w; }
        }
    }
};
}
namespace attn_body {
using bf16=__hip_bfloat16;
using bf16x8=__attribute__((ext_vector_type(8)))short;
using s16x4=__attribute__((ext_vector_type(4)))short;
using f32x16=__attribute__((ext_vector_type(16)))float;
using u32x4=__attribute__((ext_vector_type(4)))unsigned;
constexpr int SEQ=4096,D=64,PQ=5376,PO=1024;
constexpr int NW=8,QBLK=32,QB=QBLK*NW,KVBLK=64,NQB=SEQ/QB;
constexpr int ATTN_UNIT_ROWS=QB;
__device__ __forceinline__ int crow(int r,int hi){return (r&3)+8*(r>>2)+4*hi;}
#define SBAR() __builtin_amdgcn_sched_barrier(0)
__device__ __forceinline__ void cmask(f32x16&p0,f32x16&p1,int jb,int qrel,int hi){
  const float NEG=-INFINITY; int kb=64*jb+4*hi;
  #pragma unroll
  for(int r=0;r<16;++r){int kv=kb+(r&3)+8*(r>>2); if(kv>qrel)p0[r]=NEG; if(kv+32>qrel)p1[r]=NEG;}
}

constexpr int NSLOT=3, SLOTB=8192;
constexpr int LDS_K=0, LDS_V=NSLOT*SLOTB, LDS_WS=3*NSLOT*SLOTB, LDS_OST=LDS_WS+NW*64*4, LDS_BYTES=LDS_OST+NW*4096;
constexpr float C2=0.125f*1.4426950408889634f;
__device__ __forceinline__ void glds16(const void*gsrc,unsigned lds_dst){unsigned keep;
  asm volatile("s_mov_b32 %0, m0\n\ts_mov_b32 m0, %2\n\ts_nop 0\n\tglobal_load_lds_dwordx4 %1, off\n\ts_mov_b32 m0, %0":"=&s"(keep):"v"(gsrc),"s"(lds_dst):"memory");}
__device__ __forceinline__ float max3f(float a,float b,float c){float r;asm("v_max3_f32 %0, %1, %2, %3":"=v"(r):"v"(a),"v"(b),"v"(c));return r;}
__device__ __forceinline__ float max2f(float a,float b){float r;asm("v_max_f32_e32 %0, %1, %2":"=v"(r):"v"(a),"v"(b));return r;}
__device__ __forceinline__ float fadd_s(float a,float b){float r;asm("v_add_f32_e32 %0, %1, %2":"=v"(r):"v"(a),"v"(b));return r;}
__device__ __forceinline__ float fsub_s(float a,float b){float r;asm("v_sub_f32_e32 %0, %1, %2":"=v"(r):"v"(a),"v"(b));return r;}
typedef float f32x2_t __attribute__((ext_vector_type(2))); typedef __bf16 bf16x2_t __attribute__((ext_vector_type(2)));
__device__ __forceinline__ unsigned cvtpk_s(float lo,float hi){f32x2_t v={lo,hi};bf16x2_t b=__builtin_convertvector(v,bf16x2_t);return __builtin_bit_cast(unsigned,b);}
#define WAIT_BAR(N) asm volatile("s_waitcnt vmcnt(" #N ") lgkmcnt(0)\n\ts_barrier":::"memory")

__device__ __forceinline__ void qkt(f32x16&p0,f32x16&p1,const char*Kslot,const bf16x8*qr,int r32,int hi){ const f32x16 negm=f32x16{};
  const char*kb=Kslot+hi*1024+r32*16;
  #pragma unroll
  for(int d0=0;d0<4;++d0){
    const bf16x8 b0=*reinterpret_cast<const bf16x8*>(kb+d0*2048);
    const bf16x8 b1=*reinterpret_cast<const bf16x8*>(kb+d0*2048+512);
    if(d0==0){p0=__builtin_amdgcn_mfma_f32_32x32x16_bf16(b0,qr[0],negm,0,0,0);p1=__builtin_amdgcn_mfma_f32_32x32x16_bf16(b1,qr[0],negm,0,0,0);}
    else{p0=__builtin_amdgcn_mfma_f32_32x32x16_bf16(b0,qr[d0],p0,0,0,0);p1=__builtin_amdgcn_mfma_f32_32x32x16_bf16(b1,qr[d0],p1,0,0,0);}}
}
typedef __attribute__((address_space(3))) const char* lds_cptr;
typedef short v4i16_t __attribute__((ext_vector_type(4)));
__device__ __forceinline__ void kload8(bf16x8*kf,lds_cptr kp){
  kf[0]=*(const __attribute__((address_space(3))) bf16x8*)(kp);      kf[1]=*(const __attribute__((address_space(3))) bf16x8*)(kp+512);
  kf[2]=*(const __attribute__((address_space(3))) bf16x8*)(kp+2048); kf[3]=*(const __attribute__((address_space(3))) bf16x8*)(kp+2560);
  kf[4]=*(const __attribute__((address_space(3))) bf16x8*)(kp+4096); kf[5]=*(const __attribute__((address_space(3))) bf16x8*)(kp+4608);
  kf[6]=*(const __attribute__((address_space(3))) bf16x8*)(kp+6144); kf[7]=*(const __attribute__((address_space(3))) bf16x8*)(kp+6656);
}
__device__ __forceinline__ void kload2(bf16x8*kf,lds_cptr kp,int j){ kf[2*j]=*(const __attribute__((address_space(3))) bf16x8*)(kp+j*2048); kf[2*j+1]=*(const __attribute__((address_space(3))) bf16x8*)(kp+j*2048+512); }
__device__ __forceinline__ s16x4 vtr(lds_cptr p){ return __builtin_bit_cast(s16x4,__builtin_amdgcn_ds_read_tr16_b64_v4i16((__attribute__((address_space(3))) v4i16_t*)p)); }
__device__ __forceinline__ float rowmax(const f32x16&p0,const f32x16&p1){
  float a=max3f(p0[0],p0[1],p1[0]),b=max3f(p0[2],p0[3],p1[1]);a=max3f(a,p1[2],p1[3]);
  #pragma unroll
  for(int r=4;r<16;r+=4){a=max3f(a,p0[r],p0[r+1]);b=max3f(b,p0[r+2],p0[r+3]);a=max3f(a,p1[r],p1[r+1]);b=max3f(b,p1[r+2],p1[r+3]);}
  const float m=max2f(a,b);
  auto rr=__builtin_amdgcn_permlane32_swap(__float_as_uint(m),__float_as_uint(m),false,false);
  return max2f(__uint_as_float(rr[0]),__uint_as_float(rr[1]));
}
__device__ __forceinline__ void pv(f32x16*o,int vb,bf16x8 pa0,bf16x8 pa1,bf16x8 pa2,bf16x8 pa3){
  #pragma unroll
  for(int d0=0;d0<4;++d0){s16x4 lo[4],hi[4];
    #pragma unroll
    for(int ks=0;ks<4;++ks){
      asm volatile("ds_read_b64_tr_b16 %0,%1 offset:%c2":"=&v"(lo[ks]):"v"(vb),"i"(d0*4096+ks*1024):"memory");
      asm volatile("ds_read_b64_tr_b16 %0,%1 offset:%c2":"=&v"(hi[ks]):"v"(vb),"i"(d0*4096+ks*1024+512):"memory");}
    asm volatile("s_waitcnt lgkmcnt(0)":::"memory");SBAR();
    #define PK(k) (bf16x8){lo[k][0],lo[k][1],lo[k][2],lo[k][3],hi[k][0],hi[k][1],hi[k][2],hi[k][3]}
    o[d0]=__builtin_amdgcn_mfma_f32_32x32x16_bf16(pa0,PK(0),o[d0],0,0,0);
    o[d0]=__builtin_amdgcn_mfma_f32_32x32x16_bf16(pa1,PK(1),o[d0],0,0,0);
    o[d0]=__builtin_amdgcn_mfma_f32_32x32x16_bf16(pa2,PK(2),o[d0],0,0,0);
    o[d0]=__builtin_amdgcn_mfma_f32_32x32x16_bf16(pa3,PK(3),o[d0],0,0,0);
    #undef PK
  }
}

#ifndef ATTN_STORE16
#define ATTN_STORE16(p,v) (*(u32x4*)(p)=(v))
#endif
template<int THRL> __device__ __forceinline__ void attn_unit(int b,int qcol,int kcol,int vcol,int ocol,float slope2,int qb,int t0,const bf16*__restrict__ P,bf16*O,char*shm){
  int tid_=threadIdx.x; asm volatile("":"+v"(tid_));
  const int tid=tid_,lane=tid&63,r32=lane&31,hi=lane>>5; const int wid=__builtin_amdgcn_readfirstlane(tid>>6);
  const long rowbase=(long)b*SEQ; const int q0=qb*QB;
  const bf16*Qw=P+(rowbase+q0+wid*QBLK)*PQ+qcol;
  const bf16*Kh=P+(rowbase+(long)t0*KVBLK)*PQ+kcol,*Vh=P+(rowbase+(long)t0*KVBLK)*PQ+vcol;
  const unsigned lds0=(unsigned)(uintptr_t)shm;
  float*wsf=(float*)(shm+LDS_WS)+wid*64;
  const bf16*ksrc=Kh+(long)lane*PQ+wid*8;
  const bf16*vsrc=Vh+(long)(16*(wid&3)+(lane>>2))*PQ+(wid>>2)*32+(lane&3)*8;
  const unsigned kdst=lds0+LDS_K+wid*1024, vdst=lds0+LDS_V+wid*1024;
  #define DMA_K(t,slot) glds16(ksrc+(long)(t)*KVBLK*PQ,(unsigned)__builtin_amdgcn_readfirstlane(kdst+(slot)))
  #define DMA_V(t,slot) do{ glds16(vsrc+(long)(t)*KVBLK*PQ,(unsigned)__builtin_amdgcn_readfirstlane(vdst+2*(slot))); glds16(vsrc+(long)(t)*KVBLK*PQ+64,(unsigned)__builtin_amdgcn_readfirstlane(vdst+2*(slot)+8192)); }while(0)
  const int vb0=(int)(lds0+LDS_V)+((lane>>4)&1)*32+(lane&3)*8+(4*hi+((lane&15)>>2))*64;
  const char*Kbase=shm+LDS_K; bf16x8 kf[8];
  const lds_cptr shm3=(lds_cptr)shm; const lds_cptr kp0=shm3+LDS_K+hi*1024+r32*16; const lds_cptr vp0=shm3+LDS_V+((lane>>4)&1)*32+(lane&3)*8+(4*hi+((lane&15)>>2))*64;
  const int NT=(q0+QB)/KVBLK-t0;
  DMA_K(0,0);DMA_V(0,0);DMA_K(1,SLOTB);
  bf16x8 qr[4];
  #pragma unroll
  for(int d0=0;d0<4;++d0)qr[d0]=*reinterpret_cast<const bf16x8*>(&Qw[(long)r32*PQ+d0*16+hi*8]);
  float mhat=0.f,l_reg=0.f;f32x16 o[4];o[0]=f32x16{};o[1]=f32x16{};o[2]=f32x16{};o[3]=f32x16{};const f32x16 negm=f32x16{};
  const float sr1_=__builtin_bit_cast(float,__builtin_amdgcn_readfirstlane(__builtin_bit_cast(int,slope2))), sr2_=__builtin_bit_cast(float,__builtin_amdgcn_readfirstlane(__builtin_bit_cast(int,2.f*slope2))), sr3_=__builtin_bit_cast(float,__builtin_amdgcn_readfirstlane(__builtin_bit_cast(int,3.f*slope2)));
  const float hib=slope2*(float)(4*hi);
  #define ALIBI(P0,P1,t) do{ const float tm0_=slope2*(float)(64*(t))+hib-mhat; \
    _Pragma("unroll") for(int q_=0;q_<4;++q_){ const float a_=tm0_+(8.f*slope2)*(float)q_, b_=a_+32.f*slope2; \
      P0[4*q_]+=a_; P0[4*q_+1]=(P0[4*q_+1]+a_)+sr1_; P0[4*q_+2]=(P0[4*q_+2]+a_)+sr2_; P0[4*q_+3]=(P0[4*q_+3]+a_)+sr3_; \
      P1[4*q_]+=b_; P1[4*q_+1]=(P1[4*q_+1]+b_)+sr1_; P1[4*q_+2]=(P1[4*q_+2]+b_)+sr2_; P1[4*q_+3]=(P1[4*q_+3]+b_)+sr3_; } }while(0)
  const int qrel=wid*QBLK+r32;
  #define CMASK(P0,P1,t) do{int jb_=(t)-(NT-4); if(jb_>=0)cmask(P0,P1,jb_,qrel,hi);}while(0)
  bool resc=false;
  #define START(P0,P1) do{ const float rm=rowmax(P0,P1); resc=false; \
    { const float dl=rm; mhat=fadd_s(mhat,dl); \
      _Pragma("unroll") for(int r=0;r<16;++r){P0[r]=fsub_s(P0[r],dl);P1[r]=fsub_s(P1[r],dl);} \
      } \
    _Pragma("unroll") for(int r=0;r<16;++r)P0[r]=__builtin_amdgcn_exp2f(P0[r]); }while(0)
  #define RESC() do{ if(resc){ asm volatile("s_waitcnt lgkmcnt(0)":::"memory"); \
      _Pragma("unroll") for(int d_=0;d_<4;++d_) _Pragma("unroll") for(int r=0;r<16;++r)o[d_][r]*=wsf[crow(r,hi)]; } }while(0)
  f32x16 pA0,pA1,pB0,pB1;
  int sl_prev=0,sl_cur=0,sl_next=SLOTB;
  #define ROT() do{sl_prev=sl_cur;sl_cur=sl_next;sl_next=(sl_next==(NSLOT-1)*SLOTB)?0:sl_next+SLOTB;}while(0)
  DMA_K(2,2*SLOTB);
  WAIT_BAR(4);
  qkt(pA0,pA1,Kbase,qr,r32,hi);asm volatile("s_nop 15\n\ts_nop 7":"+v"(pA0),"+v"(pA1));ALIBI(pA0,pA1,0);asm volatile("":"+v"(pA0),"+v"(pA1));CMASK(pA0,pA1,0);
  START(pA0,pA1);
  _Pragma("unroll") for(int r=0;r<16;++r)pA1[r]=__builtin_amdgcn_exp2f(pA1[r]);
  WAIT_BAR(0);
  DMA_K(3,0);DMA_V(1,SLOTB);
  ROT();
  kload8(kf,kp0+sl_cur);
  WAIT_BAR(3);
  s16x4 vlo[4],vhi[4]; u32x4 pw0,pw1,pw2,pw3;
  #define PKW(P,B) cvtpk_s(P[B],P[B+1])
  #define PAF(k) __builtin_bit_cast(bf16x8,pw##k)
  #define VFR(s) (bf16x8){vlo[s][0],vlo[s][1],vlo[s][2],vlo[s][3],vhi[s][0],vhi[s][1],vhi[s][2],vhi[s][3]}
  #define PIN(x) asm volatile("":"+v"(x))
  #define MX3(a,b,c) __builtin_fmaxf(__builtin_fmaxf((a),(b)),(c))
  #define GAPA(MF,A0,A1,A2,A3,W0,W1,PW) do{ MF; sacc+=A0; sacc+=A1; sacc+=A2; sacc+=A3; PIN(sacc); W0; W1; PIN(PW); SBAR(); }while(0)
  #define EX(v) __builtin_amdgcn_exp2f(v)
  #define GAPB(MF,X,B) do{ MF; X[B]=EX(X[B]); X[B+1]=EX(X[B+1]); PIN(X); SBAR(); }while(0)
  #define VRD(s,f) do{ vlo[s]=vtr(vp_+(((f)>>2)*4096+((f)&3)*1024)); vhi[s]=vtr(vp_+(((f)>>2)*4096+((f)&3)*1024+512)); }while(0)
  #define KRD(G,j) do{ if(G){ kload2(kf,kp0+sl_next,j); SBAR(); } }while(0)
  #define PVM(i,kq,X,B) do{ GAPB(o[(i)&3]=__builtin_amdgcn_mfma_f32_32x32x16_bf16(PAF(kq),VFR((i)&3),o[(i)&3],0,0,0), X,B); if((i)+4<16){ VRD((i)&3,4*(((i)+4)&3)+(((i)+4)>>2)); SBAR(); } }while(0)
  #define STEP(C0,C1,P0,P1,t,GK,GV,GL) do{ SBAR(); \
    const lds_cptr vp_=vp0+2*sl_prev; \
    float sacc=(P0[0]+P0[1]); \
    GAPA(C0=__builtin_amdgcn_mfma_f32_32x32x16_bf16(kf[0],qr[0],negm,0,0,0), P0[2],P0[3],P0[4],P0[5],     pw0[0]=PKW(P0,0), pw0[1]=PKW(P0,2), pw0); \
    GAPA(C1=__builtin_amdgcn_mfma_f32_32x32x16_bf16(kf[1],qr[0],negm,0,0,0), P0[6],P0[7],P0[8],P0[9],     pw0[2]=PKW(P0,4), pw0[3]=PKW(P0,6), pw0); \
    GAPA(C0=__builtin_amdgcn_mfma_f32_32x32x16_bf16(kf[2],qr[1],C0,0,0,0),   P0[10],P0[11],P0[12],P0[13], pw1[0]=PKW(P0,8), pw1[1]=PKW(P0,10), pw1); \
    GAPA(C1=__builtin_amdgcn_mfma_f32_32x32x16_bf16(kf[3],qr[1],C1,0,0,0),   P0[14],P0[15],P1[0],P1[1],   pw1[2]=PKW(P0,12),pw1[3]=PKW(P0,14), pw1); \
    VRD(0,0); SBAR(); GAPA(C0=__builtin_amdgcn_mfma_f32_32x32x16_bf16(kf[4],qr[2],C0,0,0,0),   P1[2],P1[3],P1[4],P1[5],     pw2[0]=PKW(P1,0), pw2[1]=PKW(P1,2), pw2); \
    VRD(1,4); SBAR(); GAPA(C1=__builtin_amdgcn_mfma_f32_32x32x16_bf16(kf[5],qr[2],C1,0,0,0),   P1[6],P1[7],P1[8],P1[9],     pw2[2]=PKW(P1,4), pw2[3]=PKW(P1,6), pw2); \
    VRD(2,8); SBAR(); GAPA(C0=__builtin_amdgcn_mfma_f32_32x32x16_bf16(kf[6],qr[3],C0,0,0,0),   P1[10],P1[11],P1[12],P1[13], pw3[0]=PKW(P1,8), pw3[1]=PKW(P1,10), pw3); \
    VRD(3,12); SBAR(); GAPA(C1=__builtin_amdgcn_mfma_f32_32x32x16_bf16(kf[7],qr[3],C1,0,0,0),   P1[14],P1[15],0.f,0.f,       pw3[2]=PKW(P1,12),pw3[3]=PKW(P1,14), pw3); \
    l_reg+=sacc; \
    if(GK){DMA_K((t)+3,sl_cur);} if(GV){DMA_V((t)+1,sl_next);} \
    ALIBI(C0,C1,t); CMASK(C0,C1,t); \
    { float a=MX3(C0[0],C0[1],C1[0]),b=MX3(C0[2],C0[3],C1[1]); a=MX3(a,C1[2],C1[3]); \
      _Pragma("unroll") for(int r=4;r<16;r+=4){a=MX3(a,C0[r],C0[r+1]);b=MX3(b,C0[r+2],C0[r+3]);a=MX3(a,C1[r],C1[r+1]);b=MX3(b,C1[r+2],C1[r+3]);} \
      float rm=__builtin_fmaxf(a,b); { auto rr=__builtin_amdgcn_permlane32_swap(__float_as_uint(rm),__float_as_uint(rm),false,false); rm=__builtin_fmaxf(__uint_as_float(rr[0]),__uint_as_float(rr[1])); } \
      resc=false; \
      if(__builtin_expect(__any(rm>(float)THRL),0)){ const float dl=__builtin_fmaxf(rm,0.f); mhat+=dl; \
        _Pragma("unroll") for(int r=0;r<16;++r){C0[r]-=dl;C1[r]-=dl;} \
        const float f=__builtin_amdgcn_exp2f(-dl); l_reg*=f; if(hi==0)wsf[r32]=f; resc=true; } } \
    SBAR(); \
    PVM(0,0,C0,0); PVM(1,0,C0,2); PVM(2,0,C0,4); PVM(3,0,C0,6); \
    KRD(GL,0); PVM(4,1,C0,8); PVM(5,1,C0,10); KRD(GL,1); PVM(6,1,C0,12); PVM(7,1,C0,14); \
    KRD(GL,2); PVM(8,2,C1,0); PVM(9,2,C1,2); KRD(GL,3); PVM(10,2,C1,4); PVM(11,2,C1,6); \
    PVM(12,3,C1,8); PVM(13,3,C1,10); PVM(14,3,C1,12); PVM(15,3,C1,14); \
    }while(0)
  int t=1;
  #undef CMASK
  #define CMASK(P0,P1,t) do{}while(0)
  for(;t+5<NT;t+=2){
    STEP(pB0,pB1,pA0,pA1,t,true,true,true);     WAIT_BAR(3); RESC(); ROT();
    STEP(pA0,pA1,pB0,pB1,t+1,true,true,true);   WAIT_BAR(3); RESC(); ROT();
  }
  #undef CMASK
  #define CMASK(P0,P1,t) do{int jb_=(t)-(NT-4); if(jb_>=0)cmask(P0,P1,jb_,qrel,hi);}while(0)
  #define ENDW(tt) do{ if((tt)+3<NT){WAIT_BAR(3);} else if((tt)+2<NT){WAIT_BAR(2);} else {WAIT_BAR(0);} }while(0)
  for(;t+1<NT;t+=2){
    STEP(pB0,pB1,pA0,pA1,t,(t+3<NT),(t+1<NT),(t+1<NT));       ENDW(t);   RESC(); ROT();
    STEP(pA0,pA1,pB0,pB1,t+1,(t+4<NT),(t+2<NT),(t+2<NT));     ENDW(t+1); RESC(); ROT();
  }
  STEP(pB0,pB1,pA0,pA1,NT-1,false,false,false); RESC();
  { float sacc=pB0[0]+pB0[1]; _Pragma("unroll") for(int r=2;r<16;++r)sacc+=pB0[r]; _Pragma("unroll") for(int r=0;r<16;++r)sacc+=pB1[r]; l_reg+=sacc;
    pw0=(u32x4){PKW(pB0,0),PKW(pB0,2),PKW(pB0,4),PKW(pB0,6)};pw1=(u32x4){PKW(pB0,8),PKW(pB0,10),PKW(pB0,12),PKW(pB0,14)};pw2=(u32x4){PKW(pB1,0),PKW(pB1,2),PKW(pB1,4),PKW(pB1,6)};pw3=(u32x4){PKW(pB1,8),PKW(pB1,10),PKW(pB1,12),PKW(pB1,14)};
    SBAR(); pv(o,vb0+2*sl_cur,PAF(0),PAF(1),PAF(2),PAF(3)); }
  #undef PKW
  #undef PAF
  #undef VFR
  #undef PIN
  #undef MX3
  #undef GAPA
  #undef GAPB
  #undef EX
  #undef VRD
  #undef KRD
  #undef PVM
  #undef STEP
  #undef ENDW
  {auto rr=__builtin_amdgcn_permlane32_swap(__float_as_uint(l_reg),__float_as_uint(l_reg),false,false);l_reg=__uint_as_float(rr[0])+__uint_as_float(rr[1]);}
  if(hi==0)wsf[32+r32]=l_reg;asm volatile("s_waitcnt lgkmcnt(0)":::"memory");
  float rli[16];
  #pragma unroll
  for(int r=0;r<16;++r)rli[r]=__builtin_amdgcn_rcpf(wsf[32+crow(r,hi)]);
  bf16*Ow=O+(rowbase+q0+wid*QBLK)*PO+ocol;
  { bf16*stg=(bf16*)(shm+LDS_OST)+wid*2048;
    #pragma unroll
    for(int hp=0;hp<2;++hp){
      #pragma unroll
      for(int r=0;r<16;++r){const int orow=crow(r,hi);
        #pragma unroll
        for(int d0=0;d0<2;++d0)stg[orow*64+d0*32+r32]=__float2bfloat16(o[2*hp+d0][r]*rli[r]);}
      asm volatile("s_waitcnt lgkmcnt(0)":::"memory");
      #pragma unroll
      for(int i=0;i<4;++i){const int row=i*8+(lane>>3),ch=lane&7; const u32x4 v=*(const u32x4*)(stg+row*64+ch*8); ATTN_STORE16(Ow+(long)row*PO+hp*64+ch*8,v);}
      asm volatile("s_waitcnt lgkmcnt(0)":::"memory"); } }
  asm volatile("s_waitcnt lgkmcnt(0)\n\ts_barrier":::"memory");
  #undef DMA_K
  #undef DMA_V
  #undef CMASK
  #undef START
  #undef RESC
  #undef ROT
  #undef ALIBI
}
constexpr int ATTN_LDS_BYTES=LDS_BYTES;
#undef SBAR
#undef WAIT_BAR
}
struct MixP {
    const bf16* proj; bf16* ocat; bf16* oatt;
    const float* hg_lb;
    const float* hg_norm_g;
    const float* lamp;
    const float* da_subln_g;
    const float *rw_mu, *rw_w0, *rw_a0, *rw_k_k, *rw_k_a, *rw_r_k, *rw_gn_g, *rw_gn_b;
    const bf16 *wupT, *aupT, *gupT;
    gu32* aq;
    gu32* nrm;
    bf16* act;
    gu32* pre;
    gu32* ptot;
    gu32* atot;
    gu32* rdr;
    gu32* rdy;
};

__device__ __forceinline__ void attn_group(const MixP& P, int b, int h, int qb, char* lds) {
    const float slope2 = exp2f(-2.0f * (float)(h + 1)) * LOG2E;
    const float s2 = __builtin_bit_cast(float, __builtin_amdgcn_readfirstlane(__builtin_bit_cast(int, slope2)));
    const attn_body::bf16* pr = (const attn_body::bf16*)P.proj; attn_body::bf16* oa = (attn_body::bf16*)P.oatt;
    int t0m[2];
    {   const int lane_ = (int)(threadIdx.x & 63u), kb = lane_ & 15;
#pragma unroll
        for (int mp = 0; mp < 2; ++mp) {
            const gu32* nq = P.nrm + (((b * 16 + qb) * 16 + 2 * h + mp) * 4), * nk = P.nrm + (((b * 16 + (kb <= qb ? kb : qb)) * 16 + 8 + 2 * h + mp) * 4);
            const float q0_ = __uint_as_float(__hip_atomic_load(nq, RLX_AGENT)), q1_ = __uint_as_float(__hip_atomic_load(nq + 1, RLX_AGENT)), q2_ = __uint_as_float(__hip_atomic_load(nq + 2, RLX_AGENT)), q3_ = __uint_as_float(__hip_atomic_load(nq + 3, RLX_AGENT));
            const float k0_ = __uint_as_float(__hip_atomic_load(nk, RLX_AGENT)), k1_ = __uint_as_float(__hip_atomic_load(nk + 1, RLX_AGENT)), k2_ = __uint_as_float(__hip_atomic_load(nk + 2, RLX_AGENT)), k3_ = __uint_as_float(__hip_atomic_load(nk + 3, RLX_AGENT));
            const float qn = 1.01f * sqrtf(fmaxf(q0_, q1_) + fmaxf(q2_, q3_)), kn = 1.01f * sqrtf(fmaxf(k0_, k1_) + fmaxf(k2_, k3_));
            const float knq = __shfl(kn, qb);
            const bool skip = (kb < qb) && (qn * (kn + knq) - s2 * (float)(256 * (qb - kb) - 255) < -160.0f);
            const unsigned long long mk = __ballot(skip);
            const unsigned lowm = (unsigned)(mk & 0xffffull);
            t0m[mp] = __builtin_amdgcn_readfirstlane(4 * __builtin_ctz(~lowm));
        }
    }
#pragma unroll 1
    for (int mp = 0; mp < 2; ++mp)
        attn_body::attn_unit<30>(b, C_DAQ + h * 128 + mp * 64, C_DAK + h * 128 + mp * 64, C_DAV + h * 128, h * 256 + mp * 128, s2, qb, mp ? t0m[1] : t0m[0], pr, oa, lds);
    VM_WAIT(); __syncthreads();
    {
        int tid_ = threadIdx.x; asm volatile("" : "+v"(tid_)); const int tid = tid_, row = tid >> 1, hf = tid & 1;
        const float lam_ = P.lamp[0], oml_ = P.lamp[4];
        const size_t grow = (size_t)b * T + (size_t)qb * 256 + row;
        const bf16* o0 = P.oatt + grow * 1024 + h * 256 + hf * 64; const bf16* o1 = o0 + 128;
        float v[64]; float ss = 0.f;
#pragma unroll
        for (int c = 0; c < 8; ++c) { const v4u x = __builtin_nontemporal_load((const v4u*)(o0) + c), y = __builtin_nontemporal_load((const v4u*)(o1) + c);
            const unsigned xs[4] = {x.x, x.y, x.z, x.w}, ys[4] = {y.x, y.y, y.z, y.w};
#pragma unroll
            for (int j = 0; j < 4; ++j) { const float a = bflo(xs[j]) - lam_ * bflo(ys[j]), d = bfhi(xs[j]) - lam_ * bfhi(ys[j]); v[c * 8 + 2 * j] = a; v[c * 8 + 2 * j + 1] = d; ss += a * a + d * d; } }
        ss += DPPF(ss, 0xB1);
        const float rs = rsqrtf(ss * (1.0f / 128.0f) + RMS_EPS) * oml_;
        bf16* dst = P.ocat + grow * 1536 + 512 + h * 128 + hf * 64; const float* g = P.da_subln_g + hf * 64;
#pragma unroll
        for (int c = 0; c < 8; ++c) { v4u w; w.x = pk2(v[c * 8 + 0] * rs * g[c * 8 + 0], v[c * 8 + 1] * rs * g[c * 8 + 1]); w.y = pk2(v[c * 8 + 2] * rs * g[c * 8 + 2], v[c * 8 + 3] * rs * g[c * 8 + 3]);
            w.z = pk2(v[c * 8 + 4] * rs * g[c * 8 + 4], v[c * 8 + 5] * rs * g[c * 8 + 5]); w.w = pk2(v[c * 8 + 6] * rs * g[c * 8 + 6], v[c * 8 + 7] * rs * g[c * 8 + 7]);
            ST16_WT((v4u*)dst + c, w); }
    }
    VM_WAIT(); __syncthreads();
    if (threadIdx.x == 0) { (void)__hip_atomic_fetch_add(P.rdy + b * 16 + qb, 1u, RLX_AGENT); (void)__hip_atomic_fetch_add(P.ptot, 1u, RLX_AGENT); (void)__hip_atomic_fetch_add(P.atot, 1u, RLX_AGENT); }
}
__device__ __forceinline__ void attn_worker(const MixP& P, char* lds, volatile LAS unsigned* bcast, int tid) {
    for (;;) {
        if (tid == 0) bcast[0] = __hip_atomic_fetch_add(P.aq, 1u, RLX_AGENT);
        __syncthreads();
        const unsigned idx = bcast[0];
        __syncthreads();
        if (idx >= 512u) break;
        const int qb = 15 - (int)(idx >> 5), bh = (int)(idx & 31u);
        attn_group(P, bh >> 2, bh & 3, qb, lds);
    }
}

constexpr int HG_QH = 0, HG_QT = 17408, HG_KT = 34816, HG_KHT = 52224, HG_VV = 70656, HG_OG = 88064, HG_AM = 105472, HG_BQ = 114688, HG_SS = 116736, HG_DD = 118784, HG_END = 119296;
constexpr int HS = 272, HS2 = 144;
__device__ __forceinline__ s16x4 tr_rd(unsigned addr) { s16x4 r; asm volatile("ds_read_b64_tr_b16 %0, %1\n\ts_waitcnt lgkmcnt(0)" : "=&v"(r) : "v"(addr) : "memory"); return r; }
__device__ __forceinline__ void hgrn_unit(const MixP& P, int b, int h, LAS unsigned char* lds) {
    int tid_ = threadIdx.x; asm volatile("" : "+v"(tid_));
    const int tid = tid_, lane = tid & 63, w = __builtin_amdgcn_readfirstlane(tid >> 6), g = lane >> 4, li = lane & 15;
    const int kk_ = tid & 127, tq = tid >> 7;
    const float lb = P.hg_lb[h * 128 + kk_], oml = 1.0f - lb;
    LAS float* BQ = (LAS float*)(lds + HG_BQ); LAS float* SS = (LAS float*)(lds + HG_SS); LAS float* DD = (LAS float*)(lds + HG_DD);
    f32x4 Sacc[8];
#pragma unroll
    for (int i = 0; i < 8; ++i) Sacc[i] = (f32x4){0.f, 0.f, 0.f, 0.f};
    const unsigned ldsb = (unsigned)(uintptr_t)lds;
    const float ng = P.hg_norm_g[16 * w + li];
    v4u pf[8];
#define HG_LOADPF(cc) do { const size_t r0_ = (size_t)b * T + (size_t)(cc) * 64; _Pragma("unroll") for (int i_ = 0; i_ < 8; ++i_) { const int ix_ = tid + 512 * (i_ & 1); \
        pf[i_] = *(const v4u*)(P.proj + (r0_ + (ix_ >> 4)) * INW + (i_ >> 1) * 512 + h * 128 + (ix_ & 15) * 8); } } while (0)
#define LBAR() asm volatile("s_waitcnt lgkmcnt(0)\n\ts_barrier" ::: "memory")
#define HG_YSTORE(cp) do { const size_t r0_ = (size_t)b * T + (size_t)(cp) * 64; _Pragma("unroll") for (int i_ = 0; i_ < 2; ++i_) { const int ix_ = tid + 512 * i_; \
        const v4u v_ = *(const LAS v4u*)(lds + HG_QT + (ix_ >> 4) * HS + (ix_ & 15) * 16); bf16* d_ = P.ocat + (r0_ + (ix_ >> 4)) * 1536 + h * 128 + (ix_ & 15) * 8; ST16_WT(d_, v_); } } while (0)
    HG_LOADPF(0);
#pragma unroll 1
    for (int c = 0; c < 64; ++c) {
        const size_t row0 = (size_t)b * T + (size_t)c * 64;
        const bool pub = (c > 4) && ((c & 3) == 1);
        if (pub) VM_WAIT();
        if (c > 0) HG_YSTORE(c - 1);
#pragma unroll
        for (int i = 0; i < 8; ++i) { const int ix = tid + 512 * (i & 1); const int reg = (i >> 1) == 0 ? HG_QH : (i >> 1) == 1 ? HG_KT : (i >> 1) == 2 ? HG_VV : HG_OG;
            *(LAS v4u*)(lds + reg + (ix >> 4) * HS + (ix & 15) * 16) = pf[i]; }
        if (c < 63) HG_LOADPF(c + 1);
        LBAR();
        if (pub && tid == 0) { (void)__hip_atomic_fetch_add(P.rdy + b * 16 + (c >> 2) - 1, 1u, RLX_AGENT); (void)__hip_atomic_fetch_add(P.ptot, 1u, RLX_AGENT); }
        float cs[16], kv[16]; float run = 0.f;
#pragma unroll
        for (int i = 0; i < 16; ++i) { const float z = bf2f(*(const LAS unsigned short*)(lds + HG_KT + (16 * tq + i) * HS + kk_ * 2)); const float sg = sigmoidf_(z); const float f = lb + oml * sg;
            run += __logf(fmaxf(f, HG_F_MIN)); cs[i] = run; kv[i] = oml * (1.0f - sg); }
        BQ[tq * 128 + kk_] = run;
        LBAR();
        const float q0 = BQ[kk_], q1 = BQ[128 + kk_], q2 = BQ[256 + kk_], q3 = BQ[384 + kk_];
        const float off = (tq > 0 ? q0 : 0.f) + (tq > 1 ? q1 : 0.f) + (tq > 2 ? q2 : 0.f);
        const float blast = (q0 + q1) + (q2 + q3), ref = q0 + q1;
        if (tq == 0) DD[kk_] = __expf(blast);
        {   const float cref = __expf(blast - ref), eref = __expf(ref); unsigned khw[8];
#pragma unroll
            for (int i = 0; i < 16; ++i) { const int t = 16 * tq + i; const float bt = off + cs[i];
                const float q = bf2f(*(const LAS unsigned short*)(lds + HG_QH + t * HS + kk_ * 2));
                const float e1 = __expf(fminf(fmaxf(bt - ref, -60.f), 60.f)), ie1 = __builtin_amdgcn_rcpf(e1);
                const float kt = kv[i] * ie1, kh = kt * cref;
                const float qe = q * e1;
                *(LAS unsigned short*)(lds + HG_QH + t * HS + kk_ * 2) = (unsigned short)pk2a(qe * eref, 0.f);
                *(LAS unsigned short*)(lds + HG_QT + t * HS + kk_ * 2) = (unsigned short)pk2a(qe, 0.f);
                *(LAS unsigned short*)(lds + HG_KT + t * HS + kk_ * 2) = (unsigned short)pk2a(kt, 0.f);
                if (i & 1) khw[i >> 1] = pk2a(cs[i - 1], kh); else cs[i] = kh; }
            *(LAS v4u*)(lds + HG_KHT + kk_ * HS2 + 32 * tq) = (v4u){khw[0], khw[1], khw[2], khw[3]};
            *(LAS v4u*)(lds + HG_KHT + kk_ * HS2 + 32 * tq + 16) = (v4u){khw[4], khw[5], khw[6], khw[7]}; }
        LBAR();
        {   const int mt = w >> 1;
#pragma unroll
            for (int j = 0; j < 2; ++j) { const int st = 2 * (w & 1) + j; f32x4 a = (f32x4){0.f, 0.f, 0.f, 0.f};
#pragma unroll
                for (int ks = 0; ks < 4; ++ks) { const bf16x8 fa = *(const LAS bf16x8*)(lds + HG_KT + (16 * st + li) * HS + ks * 64 + g * 16);
                    const bf16x8 fb = *(const LAS bf16x8*)(lds + HG_QT + (16 * mt + li) * HS + ks * 64 + g * 16);
                    a = __builtin_amdgcn_mfma_f32_16x16x32_bf16(fa, fb, a, 0, 0, 0); }
                const int tt = 16 * mt + li, s0 = 16 * st + 4 * g;
                v2u wv; wv.x = pk2(s0 <= tt ? a[0] : 0.f, s0 + 1 <= tt ? a[1] : 0.f); wv.y = pk2(s0 + 2 <= tt ? a[2] : 0.f, s0 + 3 <= tt ? a[3] : 0.f);
                *(LAS v2u*)(lds + HG_AM + tt * HS2 + s0 * 2) = wv; }
        }
        LBAR();
        bf16x8 vf[2];
        {   const int q = li >> 2, p = li & 3; const unsigned a0 = ldsb + HG_VV + (8 * g + q) * HS + (16 * w + 4 * p) * 2; s16x4 l0, h0, l1, h1;
            asm volatile("ds_read_b64_tr_b16 %0, %4\n\tds_read_b64_tr_b16 %1, %4 offset:1088\n\tds_read_b64_tr_b16 %2, %4 offset:8704\n\tds_read_b64_tr_b16 %3, %4 offset:9792\n\ts_waitcnt lgkmcnt(0)"
                         : "=&v"(l0), "=&v"(h0), "=&v"(l1), "=&v"(h1) : "v"(a0) : "memory");
            vf[0] = (bf16x8){l0[0], l0[1], l0[2], l0[3], h0[0], h0[1], h0[2], h0[3]}; vf[1] = (bf16x8){l1[0], l1[1], l1[2], l1[3], h1[0], h1[1], h1[2], h1[3]}; }
        bf16x8 sb[4];
#pragma unroll
        for (int s = 0; s < 4; ++s) { v4u x; x.x = pk2(Sacc[2 * s][0], Sacc[2 * s][1]); x.y = pk2(Sacc[2 * s][2], Sacc[2 * s][3]); x.z = pk2(Sacc[2 * s + 1][0], Sacc[2 * s + 1][1]); x.w = pk2(Sacc[2 * s + 1][2], Sacc[2 * s + 1][3]);
            sb[s] = __builtin_bit_cast(bf16x8, x); }
        f32x4 o[4];
#pragma unroll
        for (int mt = 0; mt < 4; ++mt) { f32x4 a = (f32x4){0.f, 0.f, 0.f, 0.f};
#pragma unroll
            for (int ks = 0; ks < 2; ++ks) { const bf16x8 fa = *(const LAS bf16x8*)(lds + HG_AM + (16 * mt + li) * HS2 + ks * 64 + g * 16);
                a = __builtin_amdgcn_mfma_f32_16x16x32_bf16(fa, vf[ks], a, 0, 0, 0); }
#pragma unroll
            for (int s = 0; s < 4; ++s) { const LAS unsigned char* qp = lds + HG_QH + (16 * mt + li) * HS + (32 * s + 4 * g) * 2;
                const v2u lo = *(const LAS v2u*)qp, hi = *(const LAS v2u*)(qp + 32);
                v4u x; x.x = lo.x; x.y = lo.y; x.z = hi.x; x.w = hi.y;
                a = __builtin_amdgcn_mfma_f32_16x16x32_bf16(__builtin_bit_cast(bf16x8, x), sb[s], a, 0, 0, 0); }
            o[mt] = a; }
#pragma unroll
        for (int kt = 0; kt < 8; ++kt) { const f32x4 d = *(const LAS f32x4*)(DD + 16 * kt + 4 * g); f32x4 a = Sacc[kt] * d;
#pragma unroll
            for (int ks = 0; ks < 2; ++ks) { const bf16x8 fa = *(const LAS bf16x8*)(lds + HG_KHT + (16 * kt + li) * HS2 + ks * 64 + g * 16);
                a = __builtin_amdgcn_mfma_f32_16x16x32_bf16(fa, vf[ks], a, 0, 0, 0); }
            Sacc[kt] = a; }
#pragma unroll
        for (int mt = 0; mt < 4; ++mt)
#pragma unroll
            for (int r = 0; r < 4; ++r) { float s = sum16(o[mt][r] * o[mt][r]);
                if (li == 0) SS[(16 * mt + 4 * g + r) * 8 + w] = s; }
        LBAR();
#pragma unroll
        for (int mt = 0; mt < 4; ++mt)
#pragma unroll
            for (int r = 0; r < 4; ++r) { const int t = 16 * mt + 4 * g + r; const f32x4 s0 = *(const LAS f32x4*)(SS + t * 8), s1 = *(const LAS f32x4*)(SS + t * 8 + 4);
                const float ss = ((s0[0] + s0[1]) + (s0[2] + s0[3])) + ((s1[0] + s1[1]) + (s1[2] + s1[3]));
                const float rs = rsqrtf(ss * (1.0f / 128.0f) + RMS_EPS);
                const float og = bf2f(*(const LAS unsigned short*)(lds + HG_OG + t * HS + (16 * w + li) * 2));
                const float y = o[mt][r] * rs * ng * (og * sigmoidf_(og));
                *(LAS unsigned short*)(lds + HG_QT + t * HS + (16 * w + li) * 2) = (unsigned short)f2bf(y); }
        LBAR();
    }
    HG_YSTORE(63);
    VM_WAIT(); __syncthreads();
    if (tid == 0) { (void)__hip_atomic_fetch_add(P.rdy + b * 16 + 15, 1u, RLX_AGENT); (void)__hip_atomic_fetch_add(P.ptot, 1u, RLX_AGENT); }
}
#undef HG_YSTORE
#undef HG_LOADPF

constexpr int RS = 144;
constexpr int RW_RT = 0, RW_AT = 9216, RW_BT = 18432, RW_KT = 27648, RW_ATT = 36864, RW_BHT = 46080, RW_KHT = 55296, RW_VTT = 64512, RW_G = 73728,
              RW_X = 82944,
              RW_LW = RW_X, RW_A1 = RW_X + 17408, RW_WW = RW_X, RW_O = RW_X + 9216,
              RW_AAB = 109568, RW_AAKT = RW_AAB + 4096, RW_ARB = RW_AAKT + 2048, RW_ARK = RW_ARB + 2048, RW_TM = RW_ARK + 2048, RW_TAM = RW_TM + 2048,
              RW_GC = RW_TAM + 2048, RW_BON = RW_GC + 1024, RW_CST = RW_BON + 256, RW_END2 = RW_CST + 3072,
              RW_TW = RW_RT, RW_AD = RW_AT, RW_SG = RW_BT;
static_assert(RW_END2 <= 131072, "rwkv lds");
#ifndef RWDUP
#define RWDUP 0
#endif
#define RWD(k) _Pragma("unroll 1") for (int rwd_ = 0; rwd_ < 1 + ((RWDUP >> (k)) & 1); ++rwd_)
#define RWDB(k) do { if (((RWDUP >> (k)) & 1) && rwd_ == 0) LBAR(); } while (0)
#ifndef RWTIME
#define RWTIME 0
#endif
__device__ __forceinline__ unsigned long long rwkv_unit(const MixP& P, int b, int h, LAS unsigned char* lds) {
    unsigned long long rwacc_ = 0, rwt0_ = 0; (void)rwt0_;
    int tid0_ = threadIdx.x; asm volatile("" : "+v"(tid0_));
    const int hc = h * 64;
    int tid = tid0_, lane = tid & 63, g = lane >> 4, li = lane & 15, tt = tid >> 3, sg = tid & 7, c0 = sg * 8;
    const int w = __builtin_amdgcn_readfirstlane(tid >> 6);
    LAS float* LW = (LAS float*)(lds + RW_LW); LAS float* O = (LAS float*)(lds + RW_O); LAS float* GC = (LAS float*)(lds + RW_GC); LAS float* BON = (LAS float*)(lds + RW_BON);
    LAS float* AAB = (LAS float*)(lds + RW_AAB);
    const unsigned ldsb = (unsigned)(uintptr_t)lds;
    f32x4 St[4];
#pragma unroll
    for (int i = 0; i < 4; ++i) St[i] = (f32x4){0.f, 0.f, 0.f, 0.f};
    LAS float* CST = (LAS float*)(lds + RW_CST);
    for (int e = tid; e < 768; e += NTHR) { float v;
        if (e < 192) v = P.rw_mu[(e >> 6) * 512 + hc + (e & 63)]; else if (e < 448) v = P.rw_mu[1536 + (e - 192)];
        else { const int q = (e - 448) >> 6, c = (e - 448) & 63; const float* src = q == 0 ? P.rw_k_k : q == 1 ? P.rw_k_a : q == 2 ? P.rw_r_k : q == 3 ? P.rw_gn_g : P.rw_gn_b; v = src[hc + c]; }
        CST[e] = v; }
    LBAR();
#define LD8(dst, off) do { const f32x4 a_ = *(const LAS f32x4*)(CST + (off)), b_ = *(const LAS f32x4*)(CST + (off) + 4); _Pragma("unroll") for (int q_ = 0; q_ < 4; ++q_) { dst[q_] = a_[q_]; dst[4 + q_] = b_[q_]; } } while (0)
    const int lmt = w >> 1;
    float w0c[2], a0c[2];
#pragma unroll
    for (int n = 0; n < 2; ++n) { const int cc = 16 * (2 * (w & 1) + n) + li; w0c[n] = P.rw_w0[hc + cc]; a0c[n] = P.rw_a0[hc + cc]; }
    {
#pragma unroll 1
        for (int pb = 0; pb < 8; ++pb) { const size_t row = (size_t)b * T + (size_t)h * 512 + (size_t)pb * 64 + tt; const bf16* src = P.proj + row * INW; const bf16* sp = src - INW;
            v4u cw[4], pw[4];
            cw[0] = *(const v4u*)(src + C_RWWD + c0); cw[1] = *(const v4u*)(src + C_RWAD + c0); cw[2] = *(const v4u*)(src + C_RWGD + sg * 16); cw[3] = *(const v4u*)(src + C_RWGD + sg * 16 + 8);
            if (h > 0 || pb > 0 || tt > 0) { pw[0] = *(const v4u*)(sp + C_RWWD + c0); pw[1] = *(const v4u*)(sp + C_RWAD + c0); pw[2] = *(const v4u*)(sp + C_RWGD + sg * 16); pw[3] = *(const v4u*)(sp + C_RWGD + sg * 16 + 8); }
            else { pw[0] = (v4u){0u, 0u, 0u, 0u}; pw[1] = pw[0]; pw[2] = pw[0]; pw[3] = pw[0]; }
            float xw[8], xa[8], xg[16];
#define SHIFT8P(dst, ci, muv) do { const unsigned cw_[4] = {cw[ci].x, cw[ci].y, cw[ci].z, cw[ci].w}, pw_[4] = {pw[ci].x, pw[ci].y, pw[ci].z, pw[ci].w}; \
            _Pragma("unroll") for (int q_ = 0; q_ < 4; ++q_) { const float c_lo = bflo(cw_[q_]), c_hi = bfhi(cw_[q_]); dst[2 * q_] = c_lo + (bflo(pw_[q_]) - c_lo) * muv[2 * q_]; dst[2 * q_ + 1] = c_hi + (bfhi(pw_[q_]) - c_hi) * muv[2 * q_ + 1]; } } while (0)
            float mu_[8];
            LD8(mu_, 192 + c0); SHIFT8P(xw, 0, mu_); LD8(mu_, 256 + c0); SHIFT8P(xa, 1, mu_);
            { float* xg0 = xg; float* xg1 = xg + 8; LD8(mu_, 320 + sg * 16); SHIFT8P(xg0, 2, mu_); LD8(mu_, 328 + sg * 16); SHIFT8P(xg1, 3, mu_); }
#undef SHIFT8P
            bf16* dst = P.act + row * 256; v4u o;
            o.x = pk2a(tanh_fast(xw[0]), tanh_fast(xw[1])); o.y = pk2a(tanh_fast(xw[2]), tanh_fast(xw[3])); o.z = pk2a(tanh_fast(xw[4]), tanh_fast(xw[5])); o.w = pk2a(tanh_fast(xw[6]), tanh_fast(xw[7]));
            { bf16* d_ = dst + c0; ST16_WT(d_, o); }
            o.x = pk2a(xa[0], xa[1]); o.y = pk2a(xa[2], xa[3]); o.z = pk2a(xa[4], xa[5]); o.w = pk2a(xa[6], xa[7]);
            { bf16* d_ = dst + 64 + c0; ST16_WT(d_, o); }
            o.x = pk2a(sigmoidf_(xg[0]), sigmoidf_(xg[1])); o.y = pk2a(sigmoidf_(xg[2]), sigmoidf_(xg[3])); o.z = pk2a(sigmoidf_(xg[4]), sigmoidf_(xg[5])); o.w = pk2a(sigmoidf_(xg[6]), sigmoidf_(xg[7]));
            { bf16* d_ = dst + 128 + sg * 16; ST16_WT(d_, o); }
            o.x = pk2a(sigmoidf_(xg[8]), sigmoidf_(xg[9])); o.y = pk2a(sigmoidf_(xg[10]), sigmoidf_(xg[11])); o.z = pk2a(sigmoidf_(xg[12]), sigmoidf_(xg[13])); o.w = pk2a(sigmoidf_(xg[14]), sigmoidf_(xg[15]));
            { bf16* d_ = dst + 128 + sg * 16 + 8; ST16_WT(d_, o); }
        }
        VM_WAIT(); __syncthreads();
        if (threadIdx.x == 0) { (void)__hip_atomic_fetch_add(P.pre + b, 1u, RLX_AGENT);
            unsigned sp_ = 0; while (__hip_atomic_load(P.pre + b, RLX_AGENT) < 8u) { __builtin_amdgcn_s_sleep(1); if (++sp_ > XB_SPIN_CAP) break; }
            __builtin_amdgcn_fence(__ATOMIC_ACQUIRE, "agent"); asm volatile("s_waitcnt vmcnt(0)" ::: "memory"); }
        __syncthreads();
    }
    v4u cur[3], prv[3], act[4];
    {   const bf16* src = P.proj + ((size_t)b * T + tt) * INW; const bf16* ap = P.act + ((size_t)b * T + tt) * 256;
        cur[0] = *(const v4u*)(src + C_RWR + hc + c0); cur[1] = *(const v4u*)(src + C_RWK + hc + c0); cur[2] = *(const v4u*)(src + C_RWV + hc + c0);
        act[0] = *(const v4u*)(ap + c0); act[1] = *(const v4u*)(ap + 64 + c0); act[2] = *(const v4u*)(ap + 128 + sg * 16); act[3] = *(const v4u*)(ap + 128 + sg * 16 + 8);
        if (tt > 0) { const bf16* sp = src - INW; prv[0] = *(const v4u*)(sp + C_RWR + hc + c0); prv[1] = *(const v4u*)(sp + C_RWK + hc + c0); prv[2] = *(const v4u*)(sp + C_RWV + hc + c0); }
        else {
#pragma unroll
            for (int i = 0; i < 3; ++i) prv[i] = (v4u){0u, 0u, 0u, 0u}; } }
    bf16x8 bwf[2][2], baf[2][2], bgf[2][4];
#define RW_LOADW() do { _Pragma("unroll") for (int n = 0; n < 2; ++n) { const int cc = 16 * (2 * (w & 1) + n) + li; \
        _Pragma("unroll") for (int ks = 0; ks < 2; ++ks) { bwf[n][ks] = *(const bf16x8*)(P.wupT + (size_t)(hc + cc) * 64 + ks * 32 + g * 8); baf[n][ks] = *(const bf16x8*)(P.aupT + (size_t)(hc + cc) * 64 + ks * 32 + g * 8); } \
        _Pragma("unroll") for (int ks = 0; ks < 4; ++ks) bgf[n][ks] = *(const bf16x8*)(P.gupT + (size_t)(hc + cc) * 128 + ks * 32 + g * 8); } \
    } while (0)
    RW_LOADW();
#pragma unroll 1
    for (int blk = 0; blk < 64; ++blk) {
        const size_t row0 = (size_t)b * T + (size_t)blk * 64;
        { int t_ = tid0_; asm volatile("" : "+v"(t_)); tid = t_; lane = tid & 63; g = lane >> 4; li = lane & 15; tt = tid >> 3; sg = tid & 7; c0 = sg * 8; }
        if (RWTIME == 2) rwt0_ = __builtin_amdgcn_s_memrealtime();
        float rr[8], k1[8], vv[8];
        RWD(0) {
#define SHIFT8(dst, ci, muv) do { const unsigned cw_[4] = {cur[ci].x, cur[ci].y, cur[ci].z, cur[ci].w}, pw_[4] = {prv[ci].x, prv[ci].y, prv[ci].z, prv[ci].w}; \
            _Pragma("unroll") for (int q_ = 0; q_ < 4; ++q_) { const float c_lo = bflo(cw_[q_]), c_hi = bfhi(cw_[q_]); dst[2 * q_] = c_lo + (bflo(pw_[q_]) - c_lo) * muv[2 * q_]; dst[2 * q_ + 1] = c_hi + (bfhi(pw_[q_]) - c_hi) * muv[2 * q_ + 1]; } } while (0)
            float mu_[8];
            LD8(mu_, c0); SHIFT8(rr, 0, mu_); LD8(mu_, 64 + c0); SHIFT8(k1, 1, mu_); LD8(mu_, 128 + c0); SHIFT8(vv, 2, mu_);
#undef SHIFT8
            *(LAS v4u*)(lds + RW_TW + tt * RS + c0 * 2) = act[0];
            *(LAS v4u*)(lds + RW_AD + tt * RS + c0 * 2) = act[1];
            *(LAS v4u*)(lds + RW_SG + tt * 272 + sg * 32) = act[2];
            *(LAS v4u*)(lds + RW_SG + tt * 272 + sg * 32 + 16) = act[3];
        RWDB(0); }
        LBAR();
        if (RWTIME == 2) rwacc_ += __builtin_amdgcn_s_memrealtime() - rwt0_;
        RWD(1) {
#pragma unroll
        for (int n = 0; n < 2; ++n) { const int ntile = 2 * (w & 1) + n, cc = 16 * ntile + li;
            f32x4 aw = (f32x4){0.f, 0.f, 0.f, 0.f}, aa = aw, ag = aw;
#pragma unroll
            for (int ks = 0; ks < 2; ++ks) { const bf16x8 f1 = *(const LAS bf16x8*)(lds + RW_TW + (16 * lmt + li) * RS + ks * 64 + g * 16), f2 = *(const LAS bf16x8*)(lds + RW_AD + (16 * lmt + li) * RS + ks * 64 + g * 16);
                aw = __builtin_amdgcn_mfma_f32_16x16x32_bf16(f1, bwf[n][ks], aw, 0, 0, 0); aa = __builtin_amdgcn_mfma_f32_16x16x32_bf16(f2, baf[n][ks], aa, 0, 0, 0); }
#pragma unroll
            for (int ks = 0; ks < 4; ++ks) { const bf16x8 f3 = *(const LAS bf16x8*)(lds + RW_SG + (16 * lmt + li) * 272 + ks * 64 + g * 16);
                ag = __builtin_amdgcn_mfma_f32_16x16x32_bf16(f3, bgf[n][ks], ag, 0, 0, 0); }
            float lw4[4];
#pragma unroll
            for (int r = 0; r < 4; ++r) lw4[r] = -0.60653065971263342f * sigmoidf_(w0c[n] + aw[r]);
            lw4[1] += lw4[0]; lw4[2] += lw4[1]; lw4[3] += lw4[2];
            float tot = lw4[3]; { const float u1 = __shfl_up(tot, 16); if (g >= 1) tot += u1; const float u2 = __shfl_up(tot, 32); if (g >= 2) tot += u2; }
            const float excl = tot - lw4[3];
#pragma unroll
            for (int r = 0; r < 4; ++r) { const int t = 16 * lmt + 4 * g + r;
                LW[t * 68 + cc] = excl + lw4[r];
                *(LAS unsigned short*)(lds + RW_A1 + t * RS + cc * 2) = (unsigned short)f2bf(sigmoidf_(a0c[n] + aa[r]));
                *(LAS unsigned short*)(lds + RW_G + t * RS + cc * 2) = (unsigned short)f2bf(ag[r]); }
            if (g == 3) GC[lmt * 64 + cc] = __expf(tot);
        }
        RWDB(1); }
        const bool pub = (blk > 4) && ((blk & 3) == 1);
        if (pub) asm volatile("s_waitcnt vmcnt(1)" ::: "memory");
        LBAR();
        if (pub && tid == 0) { (void)__hip_atomic_fetch_add(P.rdr + b * 16 + (blk >> 2) - 1, 1u, RLX_AGENT); (void)__hip_atomic_fetch_add(P.ptot, 1u, RLX_AGENT); }
        RWD(2) {   float a[8], clt[8], clm[8], clc[8];
            { const v4u av = *(const LAS v4u*)(lds + RW_A1 + tt * RS + c0 * 2); a[0] = bflo(av.x); a[1] = bfhi(av.x); a[2] = bflo(av.y); a[3] = bfhi(av.y); a[4] = bflo(av.z); a[5] = bfhi(av.z); a[6] = bflo(av.w); a[7] = bfhi(av.w); }
            const int tl = tt & 15, tC = (tt | 15);
            { const f32x4 x0 = *(const LAS f32x4*)(LW + tt * 68 + c0), x1 = *(const LAS f32x4*)(LW + tt * 68 + c0 + 4), y0 = *(const LAS f32x4*)(LW + tC * 68 + c0), y1 = *(const LAS f32x4*)(LW + tC * 68 + c0 + 4);
              f32x4 z0 = (f32x4){0.f, 0.f, 0.f, 0.f}, z1 = z0; if (tl > 0) { z0 = *(const LAS f32x4*)(LW + (tt - 1) * 68 + c0); z1 = *(const LAS f32x4*)(LW + (tt - 1) * 68 + c0 + 4); }
#pragma unroll
              for (int j = 0; j < 4; ++j) { clt[j] = x0[j]; clt[4 + j] = x1[j]; clc[j] = y0[j]; clc[4 + j] = y1[j]; clm[j] = z0[j]; clm[4 + j] = z1[j]; } }
            float kk[8], kkc[8], kac[8], rkc[8]; float ss = 0.f;
            LD8(kkc, 448 + c0); LD8(kac, 512 + c0); LD8(rkc, 576 + c0);
#pragma unroll
            for (int j = 0; j < 8; ++j) { kk[j] = k1[j] * kkc[j]; ss += kk[j] * kk[j]; }
            ss = sum8(ss);
            const float inv = rsqrtf(fmaxf(ss, 1e-12f)); float bon = 0.f;
            float rt[8], at[8], bt[8], kt[8], bh[8], kh[8];
#pragma unroll
            for (int j = 0; j < 8; ++j) { const float kn = kk[j] * inv, k2 = k1[j] * (1.0f + (a[j] - 1.0f) * kac[j]); const float av = -kn, bv = kn * a[j];
                const float ig = __expf(-clt[j]), gh = __expf(clc[j] - clt[j]);
                rt[j] = rr[j] * __expf(clt[j]); at[j] = av * __expf(clm[j]); bt[j] = bv * ig; kt[j] = k2 * ig; bh[j] = bv * gh; kh[j] = k2 * gh; bon += rr[j] * k2 * rkc[j]; }
            bon = sum8(bon);
            if (sg == 0) BON[tt] = bon;
            v4u o;
#define PK8(src) (o.x = pk2a(src[0], src[1]), o.y = pk2a(src[2], src[3]), o.z = pk2a(src[4], src[5]), o.w = pk2a(src[6], src[7]), o)
            *(LAS v4u*)(lds + RW_RT + tt * RS + c0 * 2) = PK8(rt); *(LAS v4u*)(lds + RW_AT + tt * RS + c0 * 2) = PK8(at); *(LAS v4u*)(lds + RW_BT + tt * RS + c0 * 2) = PK8(bt); *(LAS v4u*)(lds + RW_KT + tt * RS + c0 * 2) = PK8(kt);
            *(LAS v4u*)(lds + RW_BHT + tt * RS + c0 * 2) = PK8(bh); *(LAS v4u*)(lds + RW_KHT + tt * RS + c0 * 2) = PK8(kh); *(LAS v4u*)(lds + RW_VTT + tt * RS + c0 * 2) = PK8(vv);
#undef PK8
        RWDB(2); }
        LBAR();
        RWD(3) {   const int j = w >> 1; const int rowb = (16 * j + li) * RS;
            bf16x8 fat[2], fbt[2], fkt[2], frt[2];
#pragma unroll
            for (int ks = 0; ks < 2; ++ks) { fbt[ks] = *(const LAS bf16x8*)(lds + RW_BT + rowb + ks * 64 + g * 16); fkt[ks] = *(const LAS bf16x8*)(lds + RW_KT + rowb + ks * 64 + g * 16);
                if ((w & 1) == 0) fat[ks] = *(const LAS bf16x8*)(lds + RW_AT + rowb + ks * 64 + g * 16); else frt[ks] = *(const LAS bf16x8*)(lds + RW_RT + rowb + ks * 64 + g * 16); }
            if ((w & 1) == 0) {
                f32x4 x = (f32x4){0.f, 0.f, 0.f, 0.f}, y = x;
#pragma unroll
                for (int ks = 0; ks < 2; ++ks) { x = __builtin_amdgcn_mfma_f32_16x16x32_bf16(fbt[ks], fat[ks], x, 0, 0, 0);
                    y = __builtin_amdgcn_mfma_f32_16x16x32_bf16(fat[ks], fkt[ks], y, 0, 0, 0); }
                f32x4 xm; v2u ym;
#pragma unroll
                for (int r = 0; r < 4; ++r) xm[r] = (4 * g + r < li) ? x[r] : 0.f;
                *(LAS f32x4*)(AAB + (j * 16 + li) * 16 + 4 * g) = xm;
                ym.x = pk2(li < 4 * g ? y[0] : 0.f, li < 4 * g + 1 ? y[1] : 0.f); ym.y = pk2(li < 4 * g + 2 ? y[2] : 0.f, li < 4 * g + 3 ? y[3] : 0.f);
                *(LAS v2u*)(lds + RW_AAKT + (j * 16 + li) * 32 + 8 * g) = ym;
            } else {
                f32x4 x = (f32x4){0.f, 0.f, 0.f, 0.f}, y = x;
#pragma unroll
                for (int ks = 0; ks < 2; ++ks) { x = __builtin_amdgcn_mfma_f32_16x16x32_bf16(fbt[ks], frt[ks], x, 0, 0, 0);
                    y = __builtin_amdgcn_mfma_f32_16x16x32_bf16(fkt[ks], frt[ks], y, 0, 0, 0); }
                v2u xm, ym;
                xm.x = pk2(4 * g <= li ? x[0] : 0.f, 4 * g + 1 <= li ? x[1] : 0.f); xm.y = pk2(4 * g + 2 <= li ? x[2] : 0.f, 4 * g + 3 <= li ? x[3] : 0.f);
                ym.x = pk2(4 * g <= li ? y[0] : 0.f, 4 * g + 1 <= li ? y[1] : 0.f); ym.y = pk2(4 * g + 2 <= li ? y[2] : 0.f, 4 * g + 3 <= li ? y[3] : 0.f);
                *(LAS v2u*)(lds + RW_ARB + (j * 16 + li) * 32 + 8 * g) = xm; *(LAS v2u*)(lds + RW_ARK + (j * 16 + li) * 32 + 8 * g) = ym;
            }
        RWDB(3); }
        LBAR();
        RWD(4) { if (w == 0) { const int j = g, col = li; float x[16];
#pragma unroll
            for (int t = 0; t < 16; ++t) { float pq[4] = {(t == col) ? 1.f : 0.f, 0.f, 0.f, 0.f};
#pragma unroll
                for (int q = 0; q < (t + 3) / 4; ++q) { const f32x4 av = *(const LAS f32x4*)(AAB + (j * 16 + t) * 16 + 4 * q);
#pragma unroll
                    for (int e = 0; e < 4; ++e) if (4 * q + e < t) pq[q] += av[e] * x[4 * q + e]; }
                const float s = (pq[0] + pq[1]) + (pq[2] + pq[3]);
                x[t] = s; }
#pragma unroll
            for (int t = 0; t < 16; ++t) *(LAS unsigned short*)(lds + RW_TM + (j * 16 + t) * 32 + col * 2) = (unsigned short)f2bf(x[t]); }
        RWDB(4); }
        LBAR();
        RWD(5) {   const int j = w >> 1; const bf16x8 zf = (bf16x8){0, 0, 0, 0, 0, 0, 0, 0};
            const bf16x8 ft = (g < 2) ? *(const LAS bf16x8*)(lds + RW_TM + (j * 16 + li) * 32 + g * 16) : zf;
#pragma unroll
            for (int n = 0; n < 2; ++n) { const int ct = 2 * (w & 1) + n;
                bf16x8 fa; { const unsigned a0_ = ldsb + RW_AT + (16 * j + 8 * (g & 1) + (li >> 2)) * RS + (16 * ct + 4 * (li & 3)) * 2; s16x4 lo_, hi_;
                    asm volatile("ds_read_b64_tr_b16 %0, %2\n\tds_read_b64_tr_b16 %1, %2 offset:576\n\ts_waitcnt lgkmcnt(0)" : "=&v"(lo_), "=&v"(hi_) : "v"(a0_) : "memory");
                    fa = (g < 2) ? (bf16x8){lo_[0], lo_[1], lo_[2], lo_[3], hi_[0], hi_[1], hi_[2], hi_[3]} : zf; }
                f32x4 x = __builtin_amdgcn_mfma_f32_16x16x32_bf16(fa, ft, (f32x4){0.f, 0.f, 0.f, 0.f}, 0, 0, 0);
                v2u xm; xm.x = pk2(x[0], x[1]); xm.y = pk2(x[2], x[3]);
                *(LAS v2u*)(lds + RW_WW + (16 * j + li) * RS + (16 * ct + 4 * g) * 2) = xm; }
            if ((w & 1) == 0) { const bf16x8 fa = (g < 2) ? *(const LAS bf16x8*)(lds + RW_AAKT + (j * 16 + li) * 32 + g * 16) : zf;
                f32x4 x = __builtin_amdgcn_mfma_f32_16x16x32_bf16(fa, ft, (f32x4){0.f, 0.f, 0.f, 0.f}, 0, 0, 0);
                v2u xm; xm.x = pk2(x[0], x[1]); xm.y = pk2(x[2], x[3]);
                *(LAS v2u*)(lds + RW_TAM + (j * 16 + li) * 32 + 8 * g) = xm; }
        RWDB(5); }
        LBAR();
        if (blk < 63) { const bf16* src = P.proj + (row0 + 64 + tt) * INW; const bf16* sp = src - INW; const bf16* ap = P.act + (row0 + 64 + tt) * 256;
            cur[0] = *(const v4u*)(src + C_RWR + hc + c0); cur[1] = *(const v4u*)(src + C_RWK + hc + c0); cur[2] = *(const v4u*)(src + C_RWV + hc + c0);
            prv[0] = *(const v4u*)(sp + C_RWR + hc + c0); prv[1] = *(const v4u*)(sp + C_RWK + hc + c0); prv[2] = *(const v4u*)(sp + C_RWV + hc + c0);
            act[0] = *(const v4u*)(ap + c0); act[1] = *(const v4u*)(ap + 64 + c0); act[2] = *(const v4u*)(ap + 128 + sg * 16); act[3] = *(const v4u*)(ap + 128 + sg * 16 + 8); }
        if (RWTIME == 1) rwt0_ = __builtin_amdgcn_s_memrealtime();
        if (w < 4) {
#pragma unroll 1
            for (int j = 0; j < 4; ++j) {
                bf16x8 sb[2];
#pragma unroll
                for (int s = 0; s < 2; ++s) { v4u x; x.x = pk2(St[2 * s][0], St[2 * s][1]); x.y = pk2(St[2 * s][2], St[2 * s][3]); x.z = pk2(St[2 * s + 1][0], St[2 * s + 1][1]); x.w = pk2(St[2 * s + 1][2], St[2 * s + 1][3]); sb[s] = __builtin_bit_cast(bf16x8, x); }
                v2u vf, bhf[4], khf[4];
                {   const unsigned rb_ = (16 * j + 4 * g + (li >> 2)) * RS + 4 * (li & 3) * 2; const unsigned av_ = ldsb + RW_VTT + rb_ + 32 * w, ab_ = ldsb + RW_BHT + rb_, ak_ = ldsb + RW_KHT + rb_;
                    asm volatile("ds_read_b64_tr_b16 %0, %9\n\tds_read_b64_tr_b16 %1, %10\n\tds_read_b64_tr_b16 %2, %10 offset:32\n\tds_read_b64_tr_b16 %3, %10 offset:64\n\tds_read_b64_tr_b16 %4, %10 offset:96\n\t"
                                 "ds_read_b64_tr_b16 %5, %11\n\tds_read_b64_tr_b16 %6, %11 offset:32\n\tds_read_b64_tr_b16 %7, %11 offset:64\n\tds_read_b64_tr_b16 %8, %11 offset:96\n\ts_waitcnt lgkmcnt(0)"
                                 : "=&v"(vf), "=&v"(bhf[0]), "=&v"(bhf[1]), "=&v"(bhf[2]), "=&v"(bhf[3]), "=&v"(khf[0]), "=&v"(khf[1]), "=&v"(khf[2]), "=&v"(khf[3]) : "v"(av_), "v"(ab_), "v"(ak_) : "memory"); }
                const int trow = (16 * j + li) * RS;
                f32x4 u = (f32x4){0.f, 0.f, 0.f, 0.f}, o = u;
#pragma unroll
                for (int s = 0; s < 2; ++s) { const v2u lo = *(const LAS v2u*)(lds + RW_WW + trow + (32 * s + 4 * g) * 2), hi = *(const LAS v2u*)(lds + RW_WW + trow + (32 * s + 16 + 4 * g) * 2);
                    v4u x; x.x = lo.x; x.y = lo.y; x.z = hi.x; x.w = hi.y; u = __builtin_amdgcn_mfma_f32_16x16x32_bf16(__builtin_bit_cast(bf16x8, x), sb[s], u, 0, 0, 0);
                    const v2u lo2 = *(const LAS v2u*)(lds + RW_RT + trow + (32 * s + 4 * g) * 2), hi2 = *(const LAS v2u*)(lds + RW_RT + trow + (32 * s + 16 + 4 * g) * 2);
                    v4u y; y.x = lo2.x; y.y = lo2.y; y.z = hi2.x; y.w = hi2.y; o = __builtin_amdgcn_mfma_f32_16x16x32_bf16(__builtin_bit_cast(bf16x8, y), sb[s], o, 0, 0, 0); }
                {   const v2u ta = *(const LAS v2u*)(lds + RW_TAM + (j * 16 + li) * 32 + 8 * g);
                    v4u x; x.x = ta.x; x.y = ta.y; x.z = 0u; x.w = 0u; v4u y; y.x = vf.x; y.y = vf.y; y.z = 0u; y.w = 0u;
                    u = __builtin_amdgcn_mfma_f32_16x16x32_bf16(__builtin_bit_cast(bf16x8, x), __builtin_bit_cast(bf16x8, y), u, 0, 0, 0); }
                v4u b2; b2.x = pk2(u[0], u[1]); b2.y = pk2(u[2], u[3]); b2.z = vf.x; b2.w = vf.y;
                const bf16x8 b2f = __builtin_bit_cast(bf16x8, b2);
                {   const v2u rb = *(const LAS v2u*)(lds + RW_ARB + (j * 16 + li) * 32 + 8 * g), rk = *(const LAS v2u*)(lds + RW_ARK + (j * 16 + li) * 32 + 8 * g);
                    v4u x; x.x = rb.x; x.y = rb.y; x.z = rk.x; x.w = rk.y; o = __builtin_amdgcn_mfma_f32_16x16x32_bf16(__builtin_bit_cast(bf16x8, x), b2f, o, 0, 0, 0); }
#pragma unroll
                for (int r = 0; r < 4; ++r) O[(16 * j + 4 * g + r) * 68 + 16 * w + li] = o[r];
#pragma unroll
                for (int kt = 0; kt < 4; ++kt) { const f32x4 gc = *(const LAS f32x4*)(GC + j * 64 + 16 * kt + 4 * g);
                    v4u x; x.x = bhf[kt].x; x.y = bhf[kt].y; x.z = khf[kt].x; x.w = khf[kt].y;
                    St[kt] = __builtin_amdgcn_mfma_f32_16x16x32_bf16(__builtin_bit_cast(bf16x8, x), b2f, St[kt] * gc, 0, 0, 0); }
            }
        }
        LBAR();
        if (RWTIME == 1) rwacc_ += __builtin_amdgcn_s_memrealtime() - rwt0_;
        RW_LOADW();
        RWD(6) {   const f32x4 o0 = *(const LAS f32x4*)(O + tt * 68 + c0), o1 = *(const LAS f32x4*)(O + tt * 68 + c0 + 4); float ov[8];
#pragma unroll
            for (int j = 0; j < 4; ++j) { ov[j] = o0[j]; ov[4 + j] = o1[j]; }
            float s = 0.f;
#pragma unroll
            for (int j = 0; j < 8; ++j) s += ov[j];
            s = sum8(s);
            const float mean = s * (1.0f / 64.0f); float q = 0.f;
#pragma unroll
            for (int j = 0; j < 8; ++j) { const float d = ov[j] - mean; q += d * d; }
            q = sum8(q);
            const float rs = rsqrtf(q * (1.0f / 64.0f) + RW_GN_EPS), bon = BON[tt];
            const v4u gv = *(const LAS v4u*)(lds + RW_G + tt * RS + c0 * 2); const float gg[8] = {bflo(gv.x), bfhi(gv.x), bflo(gv.y), bfhi(gv.y), bflo(gv.z), bfhi(gv.z), bflo(gv.w), bfhi(gv.w)};
            float y[8], gng[8], gnb[8]; LD8(gng, 640 + c0); LD8(gnb, 704 + c0);
#pragma unroll
            for (int j = 0; j < 8; ++j) y[j] = ((ov[j] - mean) * rs * gng[j] + gnb[j] + bon * vv[j]) * gg[j];
            v4u wv; wv.x = pk2a(y[0], y[1]); wv.y = pk2a(y[2], y[3]); wv.z = pk2a(y[4], y[5]); wv.w = pk2a(y[6], y[7]);
            bf16* dst_ = P.ocat + (row0 + tt) * 1536 + 1024 + hc + c0; ST16_WT(dst_, wv); RWDB(6); }
    }
    VM_WAIT(); __syncthreads();
    if (threadIdx.x == 0) { (void)__hip_atomic_fetch_add(P.rdr + b * 16 + 15, 1u, RLX_AGENT); (void)__hip_atomic_fetch_add(P.ptot, 1u, RLX_AGENT); }
    return rwacc_;
#undef RW_LOADW
#undef LD8
#undef LBAR
}
struct Args { const float* in[31]; float* out; unsigned char* ws; int ph_lo, ph_hi; };
typedef const __attribute__((address_space(4))) Args* ArgP;
struct Frame {
    LAS unsigned char* lds; volatile LAS unsigned* MISC; gu32* ctl;
    int tid, lane, wave, vcu, G, bx;
};
constexpr int SM_HGLB = 0;
constexpr int SM_LAM = 2048;

__device__ __forceinline__ void transpose_item(const float* W, int K, int N, bf16* WT, int k0, int n0, int drow0, LAS float* scr, int lane, int dp = 0) {
    if (dp == 0) dp = K;
#pragma unroll
    for (int i = 0; i < 8; ++i) { const int kk = 8 * i + (lane >> 3), nq = (lane & 7) * 4; const f32x4 v = *(const f32x4*)(W + (size_t)(k0 + kk) * N + n0 + nq);
        scr[kk * 33 + nq] = v[0]; scr[kk * 33 + nq + 1] = v[1]; scr[kk * 33 + nq + 2] = v[2]; scr[kk * 33 + nq + 3] = v[3]; }
    LDS_WAIT(); asm volatile("" ::: "memory");
    const int c = lane & 7;
#pragma unroll
    for (int j = 0; j < 4; ++j) { const int n = (lane >> 3) + 8 * j; const LAS float* s = scr + (8 * c) * 33 + n;
        v4u o; o.x = pk2(s[0 * 33], s[1 * 33]); o.y = pk2(s[2 * 33], s[3 * 33]); o.z = pk2(s[4 * 33], s[5 * 33]); o.w = pk2(s[6 * 33], s[7 * 33]);
        *(GAS v4u*)(WT + (size_t)(drow0 + n) * dp + k0 + 8 * c) = o; }
    LDS_WAIT(); asm volatile("" ::: "memory");
}
constexpr int CV_IN = 2688, CV_MG = 1536, CV_BR = 768, CV_OUT = 512, CV_EX = 4096, CV_TOTAL = CV_IN + CV_MG + CV_BR + CV_OUT + 3 * CV_EX;
__device__ __forceinline__ void conv_layer(const Frame& F, ArgP A, int l) {
    LAS float* scr = (LAS float*)(F.lds + F.wave * 16384);
    const int gw = F.vcu * NWAVES + F.wave, NGW = F.G * NWAVES;
    bf16* wa = (bf16*)(A->ws + WS_WA); bf16* we = (bf16*)(A->ws + WS_WE);
    for (int it = gw; it < CV_TOTAL; it += NGW) {
        int r = it;
        if (r < CV_IN) { const int kb = r / 168, nb = r % 168; transpose_item(A->in[4] + (size_t)l * DM * INW, DM, INW, wa + WA_IN / 2, 64 * kb, 32 * nb, 32 * nb, scr, F.lane); continue; } r -= CV_IN;
        if (r < CV_MG) { const int br = r / 512, q = r % 512, kb = q / 32, nb = q % 32; transpose_item(A->in[20] + ((size_t)l * 3 + br) * DM * DM, DM, DM, wa + WA_MERGE / 2 + (size_t)br * DM * DM, 64 * kb, 32 * nb, 32 * nb, scr, F.lane); continue; } r -= CV_MG;
        if (r < CV_BR) { const int kb = r / 32, nb = r % 32; transpose_item(A->in[22] + (size_t)l * 1536 * DM, 1536, DM, wa + WA_BRANCH / 2, 64 * kb, 32 * nb, 32 * nb, scr, F.lane); continue; } r -= CV_BR;
        if (r < CV_OUT) { const int kb = r / 32, nb = r % 32; transpose_item(A->in[23] + (size_t)l * DM * DM, DM, DM, wa + WA_OUT / 2, 64 * kb, 32 * nb, 32 * nb, scr, F.lane); continue; } r -= CV_OUT;
        if (r < 2 * CV_EX) { const int up = r / CV_EX, q = r % CV_EX, e = q / 256, q2 = q % 256, kb = q2 / 16, nb = q2 % 16, n0 = 32 * nb;
            transpose_item(A->in[28 + up] + ((size_t)l * NE + e) * DM * DE, DM, DE, we + WE_GU / 2 + (size_t)e * DM * DM, 64 * kb, n0, (n0 >> 7) * 256 + up * 128 + (n0 & 127), scr, F.lane); continue; } r -= 2 * CV_EX;
        { const int e = r / 256, q2 = r % 256, kb = q2 / 32, nb = q2 % 32; transpose_item(A->in[30] + ((size_t)l * NE + e) * DE * DM, DE, DM, we + WE_DT / 2 + (size_t)e * DM * DE, 64 * kb, 32 * nb, 32 * nb, scr, F.lane); }
    }
}

__device__ __forceinline__ void phase_prologue(const Frame& F, ArgP A) {
    {   LAS float* cond = (LAS float*)(F.lds);
        float* modp = (float*)(A->ws + WS_MODP);
        for (int it = F.vcu; it < NL * 24 * 4; it += F.G) { const int l = it / 96, r = it % 96, nb = r / 4, kq = r % 4;
            __syncthreads();
            for (int e = F.tid; e < 8 * 256; e += NTHR) { const float cv = A->in[1][(e >> 8) * DM + kq * 256 + (e & 255)]; cond[e] = cv * sigmoidf_(cv); }
            __syncthreads();
            const int n = nb * 256 + (F.tid & 255), kh = F.tid >> 8; float acc[8];
#pragma unroll
            for (int b = 0; b < 8; ++b) acc[b] = 0.f;
            const float* wp = A->in[2] + ((size_t)l * DM + kq * 256 + kh * 128) * 6144 + n;
#pragma unroll 4
            for (int k = 0; k < 128; ++k) { const float wv = wp[(size_t)k * 6144];
#pragma unroll
                for (int b = 0; b < 8; ++b) acc[b] += cond[b * 256 + kh * 128 + k] * wv; }
            const int kp = kq * 2 + kh;
#pragma unroll
            for (int b = 0; b < 8; ++b) modp[(((size_t)kp * NL + l) * NB + b) * 6144 + n] = acc[b]; }
        __syncthreads();
    }
    conv_layer(F, A, 0);
    {   bf16* lo = (bf16*)(A->ws + WS_LORA); const int gt = F.vcu * NTHR + F.tid, NGT = F.G * NTHR;
        for (int e = gt; e < NL * 512 * 64; e += NGT) { const int l = e / 32768, r = e % 32768, c = r >> 6, j = r & 63;
            lo[(size_t)l * 131072 + c * 64 + j] = (bf16)f2bf(A->in[11][(size_t)l * 32768 + j * 512 + c]);
            lo[(size_t)l * 131072 + 32768 + c * 64 + j] = (bf16)f2bf(A->in[13][(size_t)l * 32768 + j * 512 + c]); }
        for (int e = gt; e < NL * 512 * 128; e += NGT) { const int l = e / 65536, r = e % 65536, c = r >> 7, j = r & 127;
            lo[(size_t)l * 131072 + 65536 + c * 128 + j] = (bf16)f2bf(A->in[14][(size_t)l * 65536 + j * 512 + c]); }
    }
    if (F.vcu == 0) { float* sm = (float*)(A->ws + WS_SMALL);
        { const int k = F.tid; float z[4], mx = -1e30f;
#pragma unroll
          for (int l = 0; l < 4; ++l) { z[l] = A->in[5][l * 512 + k]; mx = fmaxf(mx, z[l]); }
          float s = 0.f;
#pragma unroll
          for (int l = 0; l < 4; ++l) { z[l] = __expf(z[l] - mx); s += z[l]; }
          const float inv = 1.0f / s;
          sm[SM_HGLB + k] = 0.f; sm[SM_HGLB + 512 + k] = z[1] * inv; sm[SM_HGLB + 1024 + k] = (z[1] + z[2]) * inv; sm[SM_HGLB + 1536 + k] = (z[1] + z[2] + z[3]) * inv; }
        if (F.wave < 4) { const int l = F.wave; const float* dl = A->in[7] + l * 256;
            const float s1 = wave_sum(dl[F.lane] * dl[64 + F.lane]), s2 = wave_sum(dl[128 + F.lane] * dl[192 + F.lane]);
            const float li = 0.8f - 0.6f * expf(-0.3f * (float)l);
            if (F.lane == 0) { sm[SM_LAM + l] = expf(s1) - expf(s2) + li; sm[SM_LAM + 4 + l] = 1.0f - li; } }
    }
}
__device__ __forceinline__ float mod_from_partials(ArgP A, int l, int b, int n) {
    const float* mp = (const float*)(A->ws + WS_MODP) + ((size_t)l * NB + b) * 6144 + n; float s = A->in[3][l * 6144 + n];
#pragma unroll
    for (int kp = 0; kp < 8; ++kp) s += mp[(size_t)kp * NL * NB * 6144];
    return s;
}
__device__ __forceinline__ void phase_mod_u0(const Frame& F, ArgP A) {
    float* mod = (float*)(A->ws + WS_MOD);
    for (int e = F.vcu * NTHR + F.tid; e < NL * NB * 6144; e += F.G * NTHR) { const int l = e / (NB * 6144), r = e % (NB * 6144); mod[e] = mod_from_partials(A, l, r / 6144, r % 6144); }
    bf16* U = (bf16*)(A->ws + WS_U);
    for (int rb = F.vcu; rb < M / 128; rb += F.G) { const int b = rb / 32;
        float sh[16], sc[16];
#pragma unroll
        for (int j = 0; j < 4; ++j)
#pragma unroll
            for (int i = 0; i < 4; ++i) { const int c = 4 * F.lane + 256 * j + i; sh[j * 4 + i] = mod_from_partials(A, 0, b, c); sc[j * 4 + i] = 1.0f + mod_from_partials(A, 0, b, 1024 + c); }
        for (int i = 0; i < 16; ++i) { const size_t row = (size_t)rb * 128 + F.wave * 16 + i;
            const f32x4* xr = (const f32x4*)(A->in[0] + row * DM) + F.lane; v2u* ur = (v2u*)(U + row * UP_) + F.lane;
#pragma unroll
            for (int j = 0; j < 4; ++j) { const f32x4 v = xr[64 * j]; v2u w; w.x = pk2(v[0] * sc[j * 4 + 0] + sh[j * 4 + 0], v[1] * sc[j * 4 + 1] + sh[j * 4 + 1]); w.y = pk2(v[2] * sc[j * 4 + 2] + sh[j * 4 + 2], v[3] * sc[j * 4 + 3] + sh[j * 4 + 3]); ur[64 * j] = w; } }
    }
}

constexpr int L1_WS = 2064;
constexpr int L1_WR = 0, L1_LG = 3 * 16 * L1_WS, L1_TE = L1_LG + 8192, L1_TB = L1_TE + 1024, L1_END = L1_TB + 64;
static_assert(L1_END <= RING_BYTES, "ln1 lds");
__device__ __forceinline__ void phase_ln1(const Frame& F, ArgP A, int l) {
    const float* mod = (const float*)(A->ws + WS_MOD);
    const bf16* MIX = (const bf16*)(A->ws + WS_MIX); bf16* U = (bf16*)(A->ws + WS_U);
    const float* xin = (l == 0) ? A->in[0] : A->out;
    LAS float* lgt = (LAS float*)(F.lds + L1_LG) + F.wave * 256;
    LAS int* te = (LAS int*)(F.lds + L1_TE); LAS int* tbase = (LAS int*)(F.lds + L1_TB);
    int* tokpos = (int*)(A->ws + WS_TOK); float* tokw = (float*)(A->ws + WS_TOK + (size_t)M * 8);
    __syncthreads();
    for (int idx = F.tid; idx < 16 * 1024; idx += NTHR) { const int k = idx >> 4, ex = idx & 15; const float w = A->in[26][idx];
        const unsigned h = f2bf(w); const float r1 = w - bf2f((unsigned short)h); const unsigned m = f2bf(r1); const float r2 = r1 - bf2f((unsigned short)m); const unsigned lo = f2bf(r2);
        *(LAS unsigned short*)(F.lds + L1_WR + (0 * 16 + ex) * L1_WS + k * 2) = (unsigned short)h; *(LAS unsigned short*)(F.lds + L1_WR + (1 * 16 + ex) * L1_WS + k * 2) = (unsigned short)m;
        *(LAS unsigned short*)(F.lds + L1_WR + (2 * 16 + ex) * L1_WS + k * 2) = (unsigned short)lo; }
    __syncthreads();
    for (int rb = F.vcu; rb < M / 128; rb += F.G) { const int b = rb / 32; const float* mb = mod + ((size_t)l * NB + b) * 6144;
        float g1[16], sh2[16], sc2[16], lg[16], lb[16];
#pragma unroll
        for (int j = 0; j < 4; ++j)
#pragma unroll
            for (int i = 0; i < 4; ++i) { const int c = 4 * F.lane + 256 * j + i, q = j * 4 + i; g1[q] = 1.0f + mb[2048 + c]; sh2[q] = mb[3072 + c]; sc2[q] = 1.0f + mb[4096 + c]; lg[q] = A->in[24][(l * 2 + 0) * DM + c]; lb[q] = A->in[25][(l * 2 + 0) * DM + c]; }
        const size_t rw0 = (size_t)rb * 128 + F.wave * 16;
#pragma unroll 1
        for (int i = 0; i < 16; ++i) { const size_t row = rw0 + i;
            const f32x4* xr = (const f32x4*)(xin + row * DM) + F.lane; const v2u* mr = (const v2u*)(MIX + row * DM) + F.lane;
            float y[16]; float s = 0.f;
#pragma unroll
            for (int j = 0; j < 4; ++j) { const f32x4 v = xr[64 * j]; const v2u m2 = mr[64 * j];
                y[j * 4 + 0] = ALPHA * v[0] + g1[j * 4 + 0] * bflo(m2.x); y[j * 4 + 1] = ALPHA * v[1] + g1[j * 4 + 1] * bfhi(m2.x);
                y[j * 4 + 2] = ALPHA * v[2] + g1[j * 4 + 2] * bflo(m2.y); y[j * 4 + 3] = ALPHA * v[3] + g1[j * 4 + 3] * bfhi(m2.y);
                s += (y[j * 4] + y[j * 4 + 1]) + (y[j * 4 + 2] + y[j * 4 + 3]); }
            const float mean = wave_sum(s) * (1.0f / DM); float q = 0.f;
#pragma unroll
            for (int k = 0; k < 16; ++k) { y[k] -= mean; q += y[k] * y[k]; }
            const float rstd = rsqrtf(wave_sum(q) * (1.0f / DM) + LN_EPS);
            f32x4* xo = (f32x4*)(A->out + row * DM) + F.lane; v2u* ur = (v2u*)(U + row * UP_) + F.lane;
#pragma unroll
            for (int j = 0; j < 4; ++j) { f32x4 o; float u2[4];
#pragma unroll
                for (int k = 0; k < 4; ++k) { o[k] = y[j * 4 + k] * rstd * lg[j * 4 + k] + lb[j * 4 + k]; u2[k] = o[k] * sc2[j * 4 + k] + sh2[j * 4 + k]; }
                xo[64 * j] = o; v2u w; w.x = pk2(u2[0], u2[1]); w.y = pk2(u2[2], u2[3]); ur[64 * j] = w; }
        }
        VM_WAIT(); __syncthreads();
        {   const int r = F.lane & 15, g = F.lane >> 4; const bf16* up = U + (rw0 + r) * UP_ + 8 * g; const LAS unsigned char* wp = F.lds + L1_WR + r * L1_WS + 16 * g;
            f32x4 acc = (f32x4){0.f, 0.f, 0.f, 0.f};
#pragma unroll 16
            for (int ks = 0; ks < 32; ++ks) { const bf16x8 af = *(const bf16x8*)(up + 32 * ks);
#pragma unroll
                for (int tm = 0; tm < 3; ++tm) { const bf16x8 bfr = *(const LAS bf16x8*)(wp + tm * 16 * L1_WS + ks * 64); acc = __builtin_amdgcn_mfma_f32_16x16x32_bf16(af, bfr, acc, 0, 0, 0); } }
#pragma unroll
            for (int j = 0; j < 4; ++j) lgt[(4 * g + j) * 16 + r] = acc[j];
        }
        LDS_WAIT();
        if (F.lane < 16) { const int tl = F.wave * 16 + F.lane; const size_t row = rw0 + F.lane;
            float sc[16]; float mx = -1e30f;
#pragma unroll
            for (int q4 = 0; q4 < 4; ++q4) { const f32x4 v = *(const LAS f32x4*)(lgt + F.lane * 16 + 4 * q4); sc[4 * q4] = v[0]; sc[4 * q4 + 1] = v[1]; sc[4 * q4 + 2] = v[2]; sc[4 * q4 + 3] = v[3]; }
#pragma unroll
            for (int e = 0; e < 16; ++e) mx = fmaxf(mx, sc[e]);
            float den = 0.f;
#pragma unroll
            for (int e = 0; e < 16; ++e) { sc[e] = __expf(sc[e] - mx); den += sc[e]; }
            const float iden = 1.0f / den; float sel[16];
#pragma unroll
            for (int e = 0; e < 16; ++e) { sc[e] *= iden; sel[e] = sc[e] + A->in[27][e]; }
            int bg = 0; float bgs = -1e30f;
#pragma unroll
            for (int gq = 0; gq < 4; ++gq) { float m1 = -1e30f, m2 = -1e30f;
#pragma unroll
                for (int k = 0; k < 4; ++k) { const float v = sel[gq * 4 + k]; if (v > m1) { m2 = m1; m1 = v; } else if (v > m2) m2 = v; }
                const float gs = m1 + m2; if (gs > bgs) { bgs = gs; bg = gq; } }
            int i0 = 0, i1 = 0; float v0 = -1e30f, v1 = -1e30f, w0 = 0.f, w1 = 0.f;
#pragma unroll
            for (int e = 0; e < 16; ++e) { if ((e >> 2) == bg) { const float v = sel[e]; if (v > v0) { v1 = v0; i1 = i0; w1 = w0; v0 = v; i0 = e; w0 = sc[e]; } else if (v > v1) { v1 = v; i1 = e; w1 = sc[e]; } } }
            const float iw = 1.0f / (w0 + w1);
            te[tl * 2] = i0; te[tl * 2 + 1] = i1; tokw[row * 2] = w0 * iw; tokw[row * 2 + 1] = w1 * iw; }
        __syncthreads();
        if (F.wave == 0) { int my[4], rank[4] = {0, 0, 0, 0}; int tot = 0;
#pragma unroll
            for (int p = 0; p < 4; ++p) my[p] = te[64 * p + F.lane];
            const unsigned long long ltm = (1ull << F.lane) - 1ull;
#pragma unroll 1
            for (int e = 0; e < 16; ++e) { int acc = 0;
#pragma unroll
                for (int p = 0; p < 4; ++p) { const unsigned long long mk = __ballot(my[p] == e); if (my[p] == e) rank[p] = acc + __popcll(mk & ltm); acc += __popcll(mk); }
                if (F.lane == e) tot = acc; }
            int base = 0; if (F.lane < 16) base = (int)__hip_atomic_fetch_add(F.ctl + CW_ECNT + 1024 * l + 64 * F.lane, (unsigned)tot, RLX_AGENT);
            int* elist = (int*)(A->ws + WS_MODP);
#pragma unroll
            for (int p = 0; p < 4; ++p) { const int e = my[p], pos = __shfl(base, e) + rank[p], k = 64 * p + F.lane;
                tokpos[(size_t)rb * 256 + k] = (e << 24) | pos; elist[e * 32768 + pos] = (int)(((size_t)rb * 256 + k) >> 1); } }
        __syncthreads();
    }
}
__device__ __forceinline__ void load_hb(const Frame& F, int l, volatile LAS int* hb, int c) {
    __syncthreads();
    if (F.tid == 0) { int acc = 0, cnt[16]; for (int e = 0; e < 16; ++e) { hb[e] = acc; cnt[e] = (int)__hip_atomic_load(F.ctl + CW_ECNT + 1024 * l + 64 * e, RLX_AGENT); acc += (cnt[e] + 255) & ~255; } hb[16] = acc; hb[17] = acc >> 8;
        const int nun = (acc >> 8) * 4; int n = 0;
        for (int L = c; L < nun && n < 12; L += F.G) { const int j = L >> 2, pn = L & 3; int e = 0, ce = cnt[0]; for (int k = 1; k < 16; ++k) if (hb[k] <= j * 256) { e = k; ce = cnt[k]; }
            const int pos0 = j * 256 - hb[e]; int valid = ce - pos0; valid = valid > 256 ? 256 : valid;
            hb[19 + 2 * n] = (j << 8) | (pn << 4) | e; hb[20 + 2 * n] = (valid << 20) | (e * 32768 + pos0); ++n; }
        hb[18] = n; }
    __syncthreads();
}
__device__ __forceinline__ void phase_ln2(const Frame& F, ArgP A, int l) {
    const float* mod = (const float*)(A->ws + WS_MOD);
    const bf16* Y = (const bf16*)(A->ws + WS_Y); bf16* U = (bf16*)(A->ws + WS_U);
    const int* tokpos = (const int*)(A->ws + WS_TOK); const float* tokw = (const float*)(A->ws + WS_TOK + (size_t)M * 8);
    volatile LAS int* hb = (volatile LAS int*)(F.lds + LDSCTL_OFF + 128);
    load_hb(F, l, hb, 0);
    for (int rb = F.vcu; rb < M / 128; rb += F.G) { const int b = rb / 32; const float* mb = mod + ((size_t)l * NB + b) * 6144; const float* mn = mod + ((size_t)(l < NL - 1 ? l + 1 : l) * NB + b) * 6144;
        const size_t rw0 = (size_t)rb * 128 + F.wave * 16;
        int myr0 = 0, myr1 = 0; float myw0 = 0.f, myw1 = 0.f;
        if (F.lane < 16) { const int tp0 = tokpos[(rw0 + F.lane) * 2], tp1 = tokpos[(rw0 + F.lane) * 2 + 1]; myr0 = hb[tp0 >> 24] + (tp0 & 0xffffff); myr1 = hb[tp1 >> 24] + (tp1 & 0xffffff); myw0 = tokw[(rw0 + F.lane) * 2]; myw1 = tokw[(rw0 + F.lane) * 2 + 1]; }
        float g2[16], sh1[16], sc1[16], lg[16], lb[16];
#pragma unroll
        for (int j = 0; j < 4; ++j)
#pragma unroll
            for (int i = 0; i < 4; ++i) { const int c = 4 * F.lane + 256 * j + i, q = j * 4 + i; g2[q] = 1.0f + mb[5120 + c]; sh1[q] = mn[c]; sc1[q] = 1.0f + mn[1024 + c]; lg[q] = A->in[24][(l * 2 + 1) * DM + c]; lb[q] = A->in[25][(l * 2 + 1) * DM + c]; }
        f32x4 xv[4]; v2u ya[4], yc[4];
#define LN2_LOAD(i_) do { const int r0_ = __builtin_amdgcn_readlane(myr0, (i_)), r1_ = __builtin_amdgcn_readlane(myr1, (i_)); \
        const f32x4* xr_ = (const f32x4*)(A->out + (rw0 + (i_)) * DM) + F.lane; const v2u* y0_ = (const v2u*)(Y + (size_t)r0_ * DM) + F.lane; const v2u* y1_ = (const v2u*)(Y + (size_t)r1_ * DM) + F.lane; \
        _Pragma("unroll") for (int j_ = 0; j_ < 4; ++j_) { xv[j_] = xr_[64 * j_]; ya[j_] = y0_[64 * j_]; yc[j_] = y1_[64 * j_]; } } while (0)
        LN2_LOAD(0);
#pragma unroll
        for (int i = 0; i < 16; ++i) { const size_t row = rw0 + i;
            const float w0 = __builtin_bit_cast(float, __builtin_amdgcn_readlane(__builtin_bit_cast(int, myw0), i)), w1 = __builtin_bit_cast(float, __builtin_amdgcn_readlane(__builtin_bit_cast(int, myw1), i));
            float y[16]; float s = 0.f;
#pragma unroll
            for (int j = 0; j < 4; ++j) { const f32x4 v = xv[j]; const v2u a = ya[j], c = yc[j];
                y[j * 4 + 0] = ALPHA * v[0] + g2[j * 4 + 0] * (w0 * bflo(a.x) + w1 * bflo(c.x)); y[j * 4 + 1] = ALPHA * v[1] + g2[j * 4 + 1] * (w0 * bfhi(a.x) + w1 * bfhi(c.x));
                y[j * 4 + 2] = ALPHA * v[2] + g2[j * 4 + 2] * (w0 * bflo(a.y) + w1 * bflo(c.y)); y[j * 4 + 3] = ALPHA * v[3] + g2[j * 4 + 3] * (w0 * bfhi(a.y) + w1 * bfhi(c.y));
                s += (y[j * 4] + y[j * 4 + 1]) + (y[j * 4 + 2] + y[j * 4 + 3]); }
            if (i < 15) LN2_LOAD(i + 1);
            const float mean = wave_sum(s) * (1.0f / DM); float q = 0.f;
#pragma unroll
            for (int k = 0; k < 16; ++k) { y[k] -= mean; q += y[k] * y[k]; }
            const float rstd = rsqrtf(wave_sum(q) * (1.0f / DM) + LN_EPS);
            f32x4* xo = (f32x4*)(A->out + row * DM) + F.lane; v2u* ur = (v2u*)(U + row * UP_) + F.lane;
#pragma unroll
            for (int j = 0; j < 4; ++j) { f32x4 o; float u[4];
#pragma unroll
                for (int k = 0; k < 4; ++k) { o[k] = y[j * 4 + k] * rstd * lg[j * 4 + k] + lb[j * 4 + k]; u[k] = o[k] * sc1[j * 4 + k] + sh1[j * 4 + k]; }
                xo[64 * j] = o; if (l < NL - 1) { v2u w; w.x = pk2a(u[0], u[1]); w.y = pk2a(u[2], u[3]); ur[64 * j] = w; } }
        }
#undef LN2_LOAD
    }
}
struct SchedProj {
    static constexpr unsigned LDA = UP_ * 2, LDB = 2048; static constexpr int NT = 16; static constexpr bool VARNT = false;
    const char* U; const char* W; const char* WM; int G, c;
    __device__ __forceinline__ bool next(int i, pg8::GUnit& u, pg8::GOps& o) const { int pm, pn; if (!pg8::static_tile(M / 256, (INW + 3072) / 256, G, c, i, pm, pn)) return false;
        o.A = U + (size_t)pm * 256 * LDA; o.B = (pn < INW / 256) ? W + (size_t)pn * 256 * 2048 : WM + (size_t)(pn - INW / 256) * 256 * 2048;
        u.kind = (pn < INW / 256) ? ((pn >= 8 && pn < 12) ? 4 : 0) : 1; u.r0 = pm * 256; u.c0 = pn * 256; u.aux = (pn == 8 || pn == 9) ? 1 : 0; return true; }
};
struct SchedBranch {
    static constexpr unsigned LDA = 3072, LDB = 3072; static constexpr int NT = 24; static constexpr bool VARNT = false;
    const char* OC; const char* WB; int G, c;
    __device__ __forceinline__ bool next(int i, pg8::GUnit& u, pg8::GOps& o) const { int pm, pn; if (!pg8::static_tile(M / 256, 4, G, c, i, pm, pn)) return false;
        u.r0 = pm * 256; u.c0 = pn * 256; o.A = OC + (size_t)pm * 256 * 3072; o.B = WB + (size_t)pn * 256 * 3072; u.kind = 2; u.aux = 0; return true; }
};
struct SchedBranch1 {
    static constexpr unsigned LDA = 3072, LDB = 3072; static constexpr int NT = 24; static constexpr bool VARNT = false;
    const char* OC; const char* WB; int pm, pn;
    __device__ __forceinline__ bool next(int i, pg8::GUnit& u, pg8::GOps& o) const { if (i > 0) return false;
        u.r0 = pm * 256; u.c0 = pn * 256; o.A = OC + (size_t)pm * 256 * 3072; o.B = WB + (size_t)pn * 256 * 3072; u.kind = 2; u.aux = 0; return true; }
};
struct SchedOut1 {
    static constexpr unsigned LDA = 2048, LDB = 2048; static constexpr int NT = 16; static constexpr bool VARNT = false;
    const char* Am; const char* W; int pm, pn;
    __device__ __forceinline__ bool next(int i, pg8::GUnit& u, pg8::GOps& o) const { if (i > 0) return false;
        o.A = Am + (size_t)pm * 256 * 2048; o.B = W + (size_t)pn * 256 * 2048; u.kind = 0; u.r0 = pm * 256; u.c0 = pn * 256; u.aux = 0; return true; }
};
struct SchedOut {
    static constexpr unsigned LDA = 2048, LDB = 2048; static constexpr int NT = 16; static constexpr bool VARNT = false;
    const char* Am; const char* W; int G, c;
    __device__ __forceinline__ bool next(int i, pg8::GUnit& u, pg8::GOps& o) const { int pm, pn; if (!pg8::static_tile(M / 256, 4, G, c, i, pm, pn)) return false;
        o.A = Am + (size_t)pm * 256 * 2048; o.B = W + (size_t)pn * 256 * 2048; u.kind = 0; u.r0 = pm * 256; u.c0 = pn * 256; u.aux = 0; return true; }
};
template <int UP> struct SchedMoe {
    static constexpr unsigned LDA = UP ? UP_ * 2 : 1024, LDB = UP ? 2048 : 1024; static constexpr int NT = UP ? 16 : 8; static constexpr bool VARNT = false;
    const char* Am; const char* W; volatile LAS int* hb; const int* elist;
    __device__ __forceinline__ bool next(int i, pg8::GUnit& u, pg8::GOps& o) const { const int n = __builtin_amdgcn_readfirstlane(hb[18]); if (i >= n) return false;
        const int pk = __builtin_amdgcn_readfirstlane(hb[19 + 2 * i]); const int j = pk >> 8, pn = (pk >> 4) & 15, e = pk & 15;
        u.r0 = j * 256; u.aux = __builtin_amdgcn_readfirstlane(hb[20 + 2 * i]); u.kind = UP ? 3 : 0; u.c0 = UP ? pn * 128 : pn * 256;
        o.A = UP ? Am : Am + (size_t)j * 256 * LDA; o.B = W + ((size_t)e * 1024 + pn * 256) * LDB;
        return true; }
    __device__ __forceinline__ unsigned arow(const pg8::GUnit& u, int r) const { const int valid = u.aux >> 20; const int tok = (r < valid) ? elist[(u.aux & 0xfffff) + r] : 0; return (unsigned)tok * LDA; }
};

constexpr int NPH = 2 + 9 * NL;
#ifndef PH_MASK
#define PH_MASK 0xffff
#endif
#define PHM(b) ((PH_MASK >> (b)) & 1)
#ifndef RPT_MASK
#define RPT_MASK 0
#endif
#define RPT(b) (1 + ((RPT_MASK >> (b)) & 1))
#ifndef TPROBE
#define TPROBE (-1)
#endif
#define TP0(kind) unsigned long long tp0_ = 0; if (TPROBE == (kind)) tp0_ = __builtin_amdgcn_s_memrealtime()
#define TP1(kind) do { if (TPROBE == (kind)) tacc += __builtin_amdgcn_s_memrealtime() - tp0_; } while (0)
__global__ void __launch_bounds__(NTHR, 2) hybrid_fwd(Args args) {
    extern __shared__ __attribute__((aligned(16))) unsigned char lds[];
    Frame F; unsigned char* ws; ArgP A;
#define FRESH() do { int t_ = threadIdx.x; asm volatile("" : "+v"(t_)); { unsigned long long p_ = (unsigned long long)__builtin_amdgcn_kernarg_segment_ptr(); asm volatile("" : "+s"(p_)); A = (ArgP)p_; } ws = A->ws; \
        F.lds = (LAS unsigned char*)lds; F.MISC = (volatile LAS unsigned*)(F.lds + MISC_OFF); F.tid = t_; F.lane = t_ & 63; F.wave = __builtin_amdgcn_readfirstlane(t_ >> 6); \
        { int g_ = gridDim.x, b_ = blockIdx.x; asm volatile("" : "+s"(g_), "+s"(b_)); F.G = g_; F.bx = b_; F.vcu = (g_ % 8 == 0) ? (b_ % 8) * (g_ / 8) + b_ / 8 : b_; } F.ctl = (gu32*)(ws + WS_CTL); } while (0)
    FRESH();
    for (int u = F.tid; u < (LDS_BYTES - LDSCTL_OFF) / 4; u += NTHR) ((LAS unsigned*)(F.lds + LDSCTL_OFF))[u] = 0u;
    __syncthreads();
    XcdBarrier bar; bar.bar = (unsigned*)(ws + WS_CTL) + CW_BAR; bar.x = 0; bar.st = nullptr;
    if (!MK_PER_PHASE) bar = xcd_barrier_post((unsigned*)(ws + WS_CTL) + CW_BAR, F.MISC + 8);
    const int lo = A->ph_lo, hi = A->ph_hi; unsigned long long tacc = 0;
#define IN(k) (lo <= (k) && (k) < hi)
#define SEAM(k) do { if (IN(k) && IN((k) + 1)) xcd_barrier(bar); } while (0)

    if (PHM(0) && IN(0)) { TP0(0); FRESH(); phase_prologue(F, A); SEAM(0); TP1(0); }
    if (PHM(1) && IN(1)) { TP0(1); FRESH(); phase_mod_u0(F, A); SEAM(1); TP1(1); }

#pragma unroll 1
    for (int l = 0; l < NL; ++l) {
        const int pb = 2 + 9 * l;
        if (PHM(2) && IN(pb + 0)) { TP0(2);
            FRESH(); const char* WA = (const char*)(ws + WS_WA); const char* WE = (const char*)(ws + WS_WE); (void)WA; (void)WE;
            SchedProj S{(const char*)(ws + WS_U), WA + WA_IN, WA + WA_MERGE, F.G, F.bx};
            pg8::Epi<19> E{(bf16*)(ws + WS_PROJ), INW, C2Q, A->in[21] + (size_t)l * 3 * DM, (unsigned char*)(ws + WS_GATES), INW, (float*)(ws + WS_CTL) + CW_NRM, nullptr};
            for (int rep = 0; rep < RPT(2); ++rep) pg8::gemm_phase<false, false>(F.lds, S, E);
            SEAM(pb + 0); TP1(2);
        }
        if (IN(pb + 1)) { TP0(3); if (TPROBE >= 20 && TPROBE <= 23) tp0_ = __builtin_amdgcn_s_memrealtime();
            FRESH();
            const float* sm = (const float*)(ws + WS_SMALL);
            MixP P;
            P.proj = (const bf16*)(ws + WS_PROJ); P.ocat = (bf16*)(ws + WS_OCAT); P.oatt = (bf16*)(ws + WS_OATT);
            P.hg_lb = sm + SM_HGLB + l * 512; P.hg_norm_g = A->in[6] + l * 128; P.lamp = sm + SM_LAM + l; P.da_subln_g = A->in[8] + l * 128;
            P.rw_mu = A->in[9] + l * 1792; P.rw_w0 = A->in[10] + l * 512; P.rw_a0 = A->in[12] + l * 512; P.rw_k_k = A->in[15] + l * 512; P.rw_k_a = A->in[16] + l * 512;
            P.rw_r_k = A->in[17] + l * 512; P.rw_gn_g = A->in[18] + l * 512; P.rw_gn_b = A->in[19] + l * 512;
            const bf16* lo_ = (const bf16*)(ws + WS_LORA) + (size_t)l * 131072; P.wupT = lo_; P.aupT = lo_ + 32768; P.gupT = lo_ + 65536;
            P.aq = F.ctl + CW_AQ + 64 * l;
            P.nrm = F.ctl + CW_NRM;
            P.rdy = F.ctl + CW_RDY + 128 * l; P.ptot = F.ctl + CW_PTOT + 16 * l; P.rdr = F.ctl + CW_RDR + 128 * l; P.atot = F.ctl + CW_ATOT + 16 * l;
            P.act = (bf16*)(ws + WS_ACT); P.pre = F.ctl + CW_PRE + 8 * l;
            if (F.G >= 128) {
                int role = 2, rb_ = 0, rh_ = 0;
                if (F.G == 256) { const int xq = F.vcu >> 5, xi = F.vcu & 31; if (xi < 8) { role = 0; rb_ = xq; rh_ = xi; } else if (xi < 12) { role = 1; rb_ = xq; rh_ = xi - 8; } }
                else if (F.vcu < 64) { role = 0; rb_ = F.vcu >> 3; rh_ = F.vcu & 7; } else if (F.vcu < 96) { role = 1; rb_ = (F.vcu - 64) >> 2; rh_ = (F.vcu - 64) & 3; }
                if (PHM(3) && role == 0) { for (int rep = 0; rep < RPT(3); ++rep) { const unsigned long long rt_ = rwkv_unit(P, rb_, rh_, F.lds); if (RWTIME) tacc += rt_; } }
                else if (PHM(4) && role == 1) { for (int rep = 0; rep < RPT(4); ++rep) hgrn_unit(P, rb_, rh_, F.lds); }
                if ((TPROBE == 20 && role < 2) || (TPROBE == 22 && role == 0) || (TPROBE == 23 && role == 1)) tacc += __builtin_amdgcn_s_memrealtime() - tp0_;
                __syncthreads();
                if (PHM(5)) { for (int rep = 0; rep < RPT(5); ++rep) { P.aq = F.ctl + CW_AQ + 64 * l + 32 * rep; attn_worker(P, (char*)lds, F.MISC + 16, F.tid); } }
                if (TPROBE == 21 && role == 2) tacc += __builtin_amdgcn_s_memrealtime() - tp0_;
                if (PHM(6)) {
                    const char* WA = (const char*)(ws + WS_WA);
                    pg8::Epi<36> E{(bf16*)(ws + WS_MERGED), DM, 1.0f, nullptr, (unsigned char*)(ws + WS_GATES), 0, nullptr, nullptr};
                    gu32* mdn = F.ctl + CW_MDN + 128 * l;
                    gu32* bq = F.ctl + CW_AQ + 64 * l + 48; volatile LAS unsigned* bcast = F.MISC + 16;
                    for (;;) {
                        __syncthreads();
                        if (F.tid == 0) bcast[0] = __hip_atomic_fetch_add(bq, 1u, RLX_AGENT);
                        __syncthreads();
                        const unsigned idx = bcast[0];
                        if (idx >= 512u) break;
                        const int j = (int)(idx >> 5), b = (int)((idx >> 2) & 7u), pn = (int)(idx & 3u);
                        if (F.tid == 0) { gu32* rw = P.rdy + b * 16 + j; unsigned* barw = (unsigned*)(ws + WS_CTL) + CW_BAR; unsigned sp_ = 0;
                            while (__hip_atomic_load(rw, RLX_AGENT) < 8u) { __builtin_amdgcn_s_sleep(2);
                                if ((++sp_ & 255u) == 0u) { if (xb_ld(&barw[XB_TMO])) break; if (sp_ > XB_SPIN_CAP) { atomicAdd(&barw[XB_TMO], 1u); break; } } }
                            __builtin_amdgcn_fence(__ATOMIC_ACQUIRE, "agent");
                            asm volatile("s_waitcnt vmcnt(0)" ::: "memory"); }
                        __syncthreads();
                        SchedBranch1 S{(const char*)(ws + WS_OCAT), WA + WA_BRANCH, b * 16 + j, pn};
                        pg8::Epi<36> Et = E; Et.rwait = P.rdr + b * 16 + j;
                        pg8::gemm_phase<false, false>(F.lds, S, Et);
                        if (F.tid == 0) (void)__hip_atomic_fetch_add(mdn + b * 16 + j, 1u, RLX_AGENT);
                    }
                    if (PHM(7)) {
                        pg8::Epi<1> Eo{(bf16*)(ws + WS_MIX), DM, 1.0f, nullptr, nullptr, 0, nullptr, nullptr};
                        gu32* oq = F.ctl + CW_AQ + 64 * l + 56; gu32* atot = F.ctl + CW_ATOT + 16 * l;
                        for (;;) {
                            __syncthreads();
                            if (F.tid == 0) bcast[0] = __hip_atomic_fetch_add(oq, 1u, RLX_AGENT);
                            __syncthreads();
                            const unsigned idx = bcast[0];
                            if (idx >= 512u) break;
                            const int j = (int)(idx >> 5), b = (int)((idx >> 2) & 7u), pn = (int)(idx & 3u);
                            if (F.tid == 0) { unsigned* barw = (unsigned*)(ws + WS_CTL) + CW_BAR; unsigned sp_ = 0;
                                while (__hip_atomic_load(mdn + b * 16 + j, RLX_AGENT) < 4u || __hip_atomic_load(atot, RLX_AGENT) < 512u) { __builtin_amdgcn_s_sleep(2);
                                    if ((++sp_ & 255u) == 0u) { if (xb_ld(&barw[XB_TMO])) break; if (sp_ > XB_SPIN_CAP) { atomicAdd(&barw[XB_TMO], 1u); break; } } }
                                __builtin_amdgcn_fence(__ATOMIC_ACQUIRE, "agent");
                                asm volatile("s_waitcnt vmcnt(0)" ::: "memory"); }
                            __syncthreads();
                            SchedOut1 So{(const char*)(ws + WS_MERGED), WA + WA_OUT, b * 16 + j, pn};
                            pg8::gemm_phase<false, false>(F.lds, So, Eo);
                        }
                    }
                }
            }
            SEAM(pb + 1); TP1(3);
        }
        if (PHM(8) && IN(pb + 4)) { TP0(8); FRESH(); phase_ln1(F, A, l); SEAM(pb + 4); TP1(8); }
        if (PHM(10) && IN(pb + 6)) { TP0(10);
            FRESH(); const char* WA = (const char*)(ws + WS_WA); const char* WE = (const char*)(ws + WS_WE); (void)WA; (void)WE;
            volatile LAS int* hb = (volatile LAS int*)(F.lds + LDSCTL_OFF + 128);
            load_hb(F, l, hb, F.bx);
            SchedMoe<1> S{(const char*)(ws + WS_U), WE + WE_GU, hb, (const int*)(ws + WS_MODP)};
            pg8::Epi<8> E{(bf16*)(ws + WS_H), DE, 1.0f, nullptr, nullptr, 0, nullptr, nullptr};
            for (int rep = 0; rep < RPT(10); ++rep) pg8::gemm_phase<false, true>(F.lds, S, E);
            SEAM(pb + 6); TP1(10);
        }
        if (PHM(11) && IN(pb + 7)) { TP0(11);
            FRESH(); const char* WA = (const char*)(ws + WS_WA); const char* WE = (const char*)(ws + WS_WE); (void)WA; (void)WE;
            volatile LAS int* hb = (volatile LAS int*)(F.lds + LDSCTL_OFF + 128);
            load_hb(F, l, hb, F.bx);
            SchedMoe<0> S{(const char*)(ws + WS_H), WE + WE_DT, hb, nullptr};
            pg8::Epi<1> E{(bf16*)(ws + WS_Y), DM, 1.0f, nullptr, nullptr, 0, nullptr, nullptr};
            for (int rep = 0; rep < RPT(11); ++rep) pg8::gemm_phase<false, false>(F.lds, S, E);
            SEAM(pb + 7); TP1(11);
        }
        if (PHM(12) && IN(pb + 8)) { TP0(12); FRESH(); if (l < NL - 1) conv_layer(F, A, l + 1); phase_ln2(F, A, l); SEAM(pb + 8); TP1(12); }
    }
    if (TPROBE >= 0 || RWTIME) { const unsigned long long te_ = __builtin_amdgcn_s_memrealtime(); while (__builtin_amdgcn_s_memrealtime() - te_ < tacc) __builtin_amdgcn_s_sleep(8); }
#undef IN
#undef SEAM
}

extern "C" void kernel_launch(void* const* d_in, const int* in_sizes, int n_in, void* d_out, int out_size, void* d_ws, size_t ws_size, hipStream_t stream) {
    static int grid = 0;
    if (grid == 0) {
        if (n_in != 31 || out_size != M * DM || ws_size < WS_END) { fprintf(stderr, "kernel_launch: unexpected shapes (n_in %d, out %d, ws %zu < %zu); nothing launched\n", n_in, out_size, ws_size, (size_t)WS_END); grid = -1; return; }
        int dev = 0, cus = 0, per_cu = 0;
        if (hipGetDevice(&dev) != hipSuccess || hipDeviceGetAttribute(&cus, hipDeviceAttributeMultiprocessorCount, dev) != hipSuccess) { grid = -1; return; }
        if (hipFuncSetAttribute((const void*)hybrid_fwd, hipFuncAttributeMaxDynamicSharedMemorySize, LDS_BYTES) != hipSuccess) { fprintf(stderr, "kernel_launch: hipFuncSetAttribute failed\n"); grid = -1; return; }
        if (hipOccupancyMaxActiveBlocksPerMultiprocessor(&per_cu, (const void*)hybrid_fwd, NTHR, LDS_BYTES) != hipSuccess || per_cu < 1) { fprintf(stderr, "kernel_launch: occupancy query reports %d\n", per_cu); }
        (void)hipGetLastError();
        grid = cus;
        if (grid > 256) grid = 256;
    }
    if (grid < 0) return;
    (void)hipMemsetAsync((char*)d_ws + WS_CTL, 0, CTL_ZERO_BYTES, stream);
    Args a{};
    for (int i = 0; i < 31; ++i) a.in[i] = (const float*)d_in[i];
    a.out = (float*)d_out; a.ws = (unsigned char*)d_ws;
#if MK_PER_PHASE
    for (int p = 0; p < NPH; ++p) { a.ph_lo = p; a.ph_hi = p + 1; hipLaunchKernelGGL(hybrid_fwd, dim3(grid), dim3(NTHR), LDS_BYTES, stream, a); }
#else
    a.ph_lo = 0; a.ph_hi = NPH; hipLaunchKernelGGL(hybrid_fwd, dim3(grid), dim3(NTHR), LDS_BYTES, stream, a);
#endif
}
```

```cpp
#include <hip/hip_runtime.h>
#include <hip/hip_bf16.h>
#include <cstdio>
#include <cstdint>

#ifndef MK_PER_PHASE
#define MK_PER_PHASE 0
#endif

#define GAS __attribute__((address_space(1)))
#define LAS __attribute__((address_space(3)))
typedef unsigned short bf16;
typedef unsigned v4u __attribute__((ext_vector_type(4)));
typedef unsigned v2u __attribute__((ext_vector_type(2)));
typedef float f32x4 __attribute__((ext_vector_type(4)));
typedef float f32x2 __attribute__((ext_vector_type(2)));
typedef float f32x16 __attribute__((ext_vector_type(16)));
typedef short bf16x8 __attribute__((ext_vector_type(8)));
typedef short s16x4 __attribute__((ext_vector_type(4)));
typedef GAS unsigned gu32;
#define RLX_AGENT __ATOMIC_RELAXED, __HIP_MEMORY_SCOPE_AGENT
#define LDS_WAIT() asm volatile("s_waitcnt lgkmcnt(0)" ::: "memory")
#define VM_WAIT() asm volatile("s_waitcnt vmcnt(0)" ::: "memory")
#define ST8_WT(p, v) asm volatile("global_store_dwordx2 %0, %1, off sc1\n\ts_nop 1" :: "v"(p), "v"(v) : "memory")
#define ST16_WT(p, v) asm volatile("global_store_dwordx4 %0, %1, off sc1\n\ts_nop 1" :: "v"(p), "v"(v) : "memory")

constexpr int DM = 1024, NB = 8, T = 4096, NL = 4, M = NB * T;
constexpr int INW = 5376;
constexpr int C_HGQ = 0, C_HGF = 512, C_HGI = 1024, C_HGO = 1536, C_DAQ = 2048, C_DAK = 2560, C_DAV = 3072, C_RW = 3584;
constexpr int C_RWR = C_RW, C_RWK = C_RW + 512, C_RWV = C_RW + 1024, C_RWWD = C_RW + 1536, C_RWAD = C_RW + 1600, C_RWGD = C_RW + 1664;
constexpr int NE = 16, DE = 512;
constexpr float ALPHA = 1.681792830507429f;
constexpr float LN_EPS = 1e-5f, RMS_EPS = 1e-6f, RW_GN_EPS = 64e-5f, HG_F_MIN = 1e-6f;
constexpr float LOG2E = 1.4426950408889634f;
constexpr float C2Q = 0.125f * LOG2E;

constexpr size_t MiB = 1u << 20;
constexpr size_t WS_CTL = 0, CTL_ZERO_BYTES = 1 * MiB;
constexpr size_t WS_MODP = 1 * MiB;
constexpr size_t WS_MOD = 7 * MiB;
constexpr size_t WS_SMALL = 8 * MiB;
constexpr size_t WS_TOK = 9 * MiB;
constexpr size_t WS_LORA = 11 * MiB;
constexpr int UP_ = 1536;
constexpr size_t WS_WA = 12 * MiB;
constexpr size_t WA_IN = 0, WA_MERGE = (size_t)INW * DM * 2, WA_BRANCH = WA_MERGE + (size_t)3 * DM * UP_ * 2, WA_OUT = WA_BRANCH + (size_t)DM * 1536 * 2, WA_END = WA_OUT + (size_t)DM * DM * 2;
constexpr size_t WS_WE = 40 * MiB;
constexpr size_t WE_GU = 0, WE_DT = (size_t)32 * MiB;
constexpr size_t WS_U = 88 * MiB;
constexpr size_t WS_PROJ = 184 * MiB;
constexpr size_t WS_OCAT = 520 * MiB;
constexpr size_t WS_OATT = 616 * MiB;
constexpr size_t WS_GATES = 680 * MiB;
constexpr size_t WS_END = 776 * MiB;
constexpr size_t WS_ACT_IN_OCAT = 2048;
constexpr size_t WS_MERGED = WS_U;
constexpr size_t WS_MIX = WS_OATT;
constexpr size_t WS_AS = WS_PROJ;
constexpr size_t WS_H = WS_PROJ + 224 * MiB;
constexpr size_t WS_Y = WS_OCAT;
constexpr int MAXROWS = 2 * M + NE * 256;
static_assert(WA_END <= 28 * MiB, "WA");
static_assert((size_t)MAXROWS * 2048 <= 160 * MiB && (size_t)MAXROWS * 1024 <= 112 * MiB, "moe buffers");

constexpr int CW_TMO = 0, CW_CODE = 1;
constexpr int CW_BAR = 4096;
constexpr int CW_ECNT = 16384;
constexpr int CW_AQ = 20480;
constexpr int CW_RDY = 49152;
constexpr int CW_PRE = 49664;
constexpr int CW_ATOT = 50560;
constexpr int CW_PTOT = 50432;
constexpr int CW_MDN = 50688;
constexpr int CW_RDR = 51712;
constexpr int CW_GDN = 50624;
constexpr int CW_MOEC = 50496;
constexpr int CW_NRM = 32768;

constexpr int RING_BYTES = 131072;
constexpr int LDSCTL_OFF = RING_BYTES, MISC_OFF = LDSCTL_OFF + 320;
constexpr int HWTAB_OFF = LDSCTL_OFF + 8192;
__device__ __forceinline__ unsigned mk_hwslot() { return (unsigned)__builtin_amdgcn_s_getreg((5 << 11) | 4); }
__device__ __forceinline__ int mk_tid() { const unsigned a = (unsigned)HWTAB_OFF + 4u * mk_hwslot(); int w;
    asm volatile("ds_read_b32 %0, %1\n\ts_waitcnt lgkmcnt(0)" : "=v"(w) : "v"(a) : "memory");
    int ln; asm volatile("v_mbcnt_lo_u32_b32 %0, -1, 0\n\tv_mbcnt_hi_u32_b32 %0, -1, %0" : "=v"(ln));
    return (w << 6) | ln; }
constexpr int LDS_BYTES = 147456;
constexpr int NWAVES = 8, NTHR = 512;

typedef float f32x2_t_ __attribute__((ext_vector_type(2))); typedef __bf16 bf16x2_t_ __attribute__((ext_vector_type(2)));
__device__ __forceinline__ unsigned pk2(float lo, float hi) { const f32x2_t_ v = {lo, hi}; const bf16x2_t_ b = __builtin_convertvector(v, bf16x2_t_); return __builtin_bit_cast(unsigned, b); }
__device__ __forceinline__ unsigned pk2a(float lo, float hi) { return pk2(lo, hi); }
__device__ __forceinline__ unsigned cvt4_fp8(float a, float b, float c, float d) { unsigned r = 0u; r = (unsigned)__builtin_amdgcn_cvt_pk_fp8_f32(a, b, (int)r, false); r = (unsigned)__builtin_amdgcn_cvt_pk_fp8_f32(c, d, (int)r, true); return r; }
constexpr float M8_SCALE = 16.0f;
constexpr float H8_SCALE = 4.0f;
constexpr unsigned F8_PROJ_COLS = 0x1FFFFFu;
constexpr int NLATE = 11;
constexpr float WG8_SCALE = 64.0f;
__device__ __forceinline__ unsigned f2bf(float f) { return pk2(f, 0.f) & 0xffffu; }
__device__ __forceinline__ float tanh_fast(float x) { return 1.0f - 2.0f * __builtin_amdgcn_rcpf(1.0f + __expf(2.0f * x)); }
__device__ __forceinline__ float bf2f(unsigned short b) { return __builtin_bit_cast(float, ((unsigned)b) << 16); }
__device__ __forceinline__ float bflo(unsigned w) { return __builtin_bit_cast(float, w << 16); }
__device__ __forceinline__ float bfhi(unsigned w) { return __builtin_bit_cast(float, w & 0xffff0000u); }
__device__ __forceinline__ unsigned cvt_pk_bf16(float lo, float hi) { unsigned r; asm volatile("v_cvt_pk_bf16_f32 %0, %1, %2" : "=v"(r) : "v"(lo), "v"(hi)); return r; }
__device__ __forceinline__ float sigmoidf_(float x) { return __builtin_amdgcn_rcpf(1.0f + __expf(-x)); }
#define DPPF(x, ctrl) __builtin_bit_cast(float, __builtin_amdgcn_update_dpp(0, __builtin_bit_cast(int, (x)), (ctrl), 0xf, 0xf, true))
__device__ __forceinline__ float sum4(float v) { v += DPPF(v, 0xB1); v += DPPF(v, 0x4E); return v; }
__device__ __forceinline__ float sum8(float v) { v = sum4(v); v += DPPF(v, 0x141); return v; }
__device__ __forceinline__ float sum16(float v) { v = sum8(v); v += DPPF(v, 0x140); return v; }
__device__ __forceinline__ float wave_sum(float v) { v = sum16(v); v += __shfl_xor(v, 16); v += __shfl_xor(v, 32); return v; }

#define XB_TMO      128
#define XB_XCNT(j)  (256  + 64 * (j))
#define XB_XSUB(j)  (1280 + 64 * (j))
#define XB_XGEN(j)  (2304 + 64 * (j))
#define XB_TOP      3328
#define XB_TOPGEN   3392
#define XCD_BAR_WORDS 3456
#define XB_SPIN_CAP (1u << 20)

__device__ __forceinline__ unsigned xb_ld(unsigned* p)              { return __hip_atomic_load(p, __ATOMIC_RELAXED, __HIP_MEMORY_SCOPE_AGENT); }
__device__ __forceinline__ unsigned xb_add(unsigned* p, unsigned v) { return __hip_atomic_fetch_add(p, v, __ATOMIC_RELAXED, __HIP_MEMORY_SCOPE_AGENT); }
__device__ __forceinline__ unsigned xb_xcc_id() { return (unsigned)__builtin_amdgcn_s_getreg((3 << 11) | 20) & 0xFu; }
#define XB_SPIN(cond, bar) do { unsigned _sp = 0; while (cond) { __builtin_amdgcn_s_sleep(1); \
    if ((++_sp & 255u) == 0u) { if (xb_ld(&(bar)[XB_TMO])) break; if (_sp > XB_SPIN_CAP) { atomicAdd(&(bar)[XB_TMO], 1u); break; } } } } while (0)

struct XcdBarrier { unsigned* bar; unsigned x; volatile LAS unsigned* st; };

__device__ __forceinline__ XcdBarrier xcd_barrier_post(unsigned* bar, volatile LAS unsigned* st) {
    XcdBarrier b; b.bar = bar; b.x = xb_xcc_id(); b.st = st;
    if (mk_tid() == 0) (void)xb_add(&bar[XB_XCNT(b.x)], 1u);
    return b;
}
__device__ __forceinline__ void xcd_barrier_complete(unsigned* bar, unsigned x, unsigned& nloc, unsigned& nx) {
    const unsigned G = gridDim.x * gridDim.y * gridDim.z;
    unsigned sum, cnt, mine, sp = 0u;
    for (;;) {
        sum = 0u; cnt = 0u; mine = 0u;
#pragma unroll 1
        for (unsigned j = 0; j < 16; ++j) { const unsigned c = xb_ld(&bar[XB_XCNT(j)]); sum += c; cnt += (c > 0u) ? 1u : 0u; mine = (j == x) ? c : mine; }
        if (sum == G) break;
        __builtin_amdgcn_s_sleep(1);
        if ((++sp & 255u) == 0u) { if (xb_ld(&bar[XB_TMO])) break; if (sp > XB_SPIN_CAP) { atomicAdd(&bar[XB_TMO], 1u); break; } }
    }
    nloc = mine > 0u ? mine : 1u; nx = cnt > 0u ? cnt : 1u;
}
__device__ __forceinline__ void xcd_barrier(const XcdBarrier& b) {
    asm volatile("s_waitcnt vmcnt(0)" ::: "memory");
    __syncthreads();
    if (mk_tid() == 0) {
        unsigned* bar = b.bar;
        __builtin_amdgcn_s_waitcnt(0);
        unsigned nloc = b.st[0], nx = b.st[1];
        if (nloc == 0u) { xcd_barrier_complete(bar, b.x, nloc, nx); b.st[0] = nloc; b.st[1] = nx; }
        const unsigned old = xb_add(&bar[XB_XSUB(b.x)], 1u);
        const unsigned gen = old / nloc;
        if (old + 1u == (gen + 1u) * nloc) {
            __builtin_amdgcn_fence(__ATOMIC_RELEASE, "agent");
            asm volatile("s_waitcnt vmcnt(0)" ::: "memory");
            const unsigned og = xb_add(&bar[XB_TOP], 1u);
            const unsigned tg = og / nx;
            if (og + 1u == (tg + 1u) * nx) xb_add(&bar[XB_TOPGEN], 1u);
            else XB_SPIN(xb_ld(&bar[XB_TOPGEN]) == tg, bar);
            __builtin_amdgcn_fence(__ATOMIC_ACQUIRE, "agent");
            xb_add(&bar[XB_XGEN(b.x)], 1u);
            asm volatile("s_waitcnt vmcnt(0)" ::: "memory");
        } else {
            XB_SPIN(xb_ld(&bar[XB_XGEN(b.x)]) == gen, bar);
            __builtin_amdgcn_fence(__ATOMIC_ACQUIRE, "agent");
            asm volatile("s_waitcnt vmcnt(0)" ::: "memory");
        }
    }
    __syncthreads();
}
namespace pg8 {
#define PG8_LAS __attribute__((address_space(3)))
constexpr int BM = 256, BK = 64, HALF = 128, HTB = HALF * BK * 2, STAGE_BYTES = 8 * HTB, NXCD = 8, WGM = 8;
__host__ __device__ __forceinline__ int lds_byte(int r, int c) { const int st = (r >> 4) * 2 + (c >> 5), rr = r & 15, cc = c & 31, ob = rr * 64 + cc * 2; return st * 1024 + (ob ^ (((ob >> 9) & 1) << 5)); }
__host__ __device__ __forceinline__ void stage_rc(int b, int& R, int& C) { const int st = b / 1024, sb = b % 1024, swz = sb ^ (((sb >> 9) & 1) << 5); R = (st >> 1) * 16 + swz / 64; C = (st & 1) * 32 + (swz % 64) / 2; }
__host__ __device__ __forceinline__ int perm32(int rho) { const int n = rho >> 4, i = rho & 15; return 8 * (i >> 2) + 4 * n + (i & 3); }

struct GUnit {
    int kind;
    int r0, c0;
    int aux;
};
struct GOps {
    const char* A; const char* B; unsigned lda, ldb; int nt;
};
__device__ __forceinline__ bool static_tile(int nM, int nN, int G, int c, int i, int& pm, int& pn) {
    const int nwg = nM * nN; const long L = (long)i * G + c; if (L >= nwg) return false;
    int wgid = (int)L; { const int q = nwg / NXCD, r = nwg % NXCD, xcd = wgid % NXCD, off = wgid / NXCD; wgid = (xcd < r ? xcd * (q + 1) : r * (q + 1) + (xcd - r) * q) + off; }
    const int nig = WGM * nN, gid = wgid / nig, fm = gid * WGM, gsz = (nM - fm) < WGM ? (nM - fm) : WGM;
    pm = fm + ((wgid % nig) % gsz); pn = (wgid % nig) / gsz; return true;
}

template <bool VARLD, bool GATHER, class Sched, class Epi>
__device__ __forceinline__ void gemm_phase(PG8_LAS unsigned char* lds, const Sched& S, const Epi& E) {
    int tid_ = mk_tid(); asm volatile("" : "+v"(tid_));
    const int tid = tid_, wid = __builtin_amdgcn_readfirstlane(tid >> 6), lane = tid & 63, wr = wid >> 2, wc = wid & 3, fr = lane & 15, fq = lane >> 4;
    int R0, C0, R1, C1; stage_rc(tid * 16, R0, C0); stage_rc(tid * 16 + 8192, R1, C1);
    const int Rb0 = (R0 & ~31) + perm32(R0 & 31), Rb1 = (R1 & ~31) + perm32(R1 & 31);
    const unsigned ldsw = (unsigned)wid * 1024u;
    const int aoff = lds_byte(wr * 64 + fr, fq * 8), boff = lds_byte(wc * 32 + fr, fq * 8);
#define PG8_SA(b, h) (((b) * 2 + (h)) * HTB)
#define PG8_SB(b, h) ((4 + (b) * 2 + (h)) * HTB)
#define PG8_STAGE(bufoff, gbase, v0, v1) do { \
        __builtin_amdgcn_global_load_lds((const unsigned*)((const char*)(gbase) + (v0)), (PG8_LAS unsigned*)(lds + (bufoff) + ldsw), 16, 0, 0); \
        __builtin_amdgcn_global_load_lds((const unsigned*)((const char*)(gbase) + (v1)), (PG8_LAS unsigned*)(lds + (bufoff) + ldsw + 8192), 16, 0, 0); } while (0)
#define PG8_LDA(dst, b, h) do { _Pragma("unroll") for (int m = 0; m < 4; ++m) _Pragma("unroll") for (int k = 0; k < 2; ++k) dst[m][k] = *(const PG8_LAS bf16x8*)(lds + PG8_SA(b, h) + aoff + m * 2048 + k * 1024); } while (0)
#define PG8_LDB(dst, b, h) do { _Pragma("unroll") for (int n = 0; n < 2; ++n) _Pragma("unroll") for (int k = 0; k < 2; ++k) dst[n][k] = *(const PG8_LAS bf16x8*)(lds + PG8_SB(b, h) + boff + n * 2048 + k * 1024); } while (0)
#define PG8_MMA(ai, bj, At, Bt) do { __builtin_amdgcn_s_setprio(1); _Pragma("unroll") for (int m = 0; m < 4; ++m) _Pragma("unroll") for (int n = 0; n < 2; ++n) _Pragma("unroll") for (int k = 0; k < 2; ++k) \
        acc[ai][bj][m][n] = __builtin_amdgcn_mfma_f32_16x16x32_bf16(Bt[n][k], At[m][k], acc[ai][bj][m][n], 0, 0, 0); __builtin_amdgcn_s_setprio(0); } while (0)
#define PG8_CAT8(p0, p1) __builtin_shufflevector(*(const PG8_LAS pg8_v4i*)(p0), *(const PG8_LAS pg8_v4i*)(p1), 0, 1, 2, 3, 4, 5, 6, 7)
#define PG8_XLDA(b, h) do { if constexpr (Sched::HASF8) { _Pragma("unroll") for (int m = 0; m < 4; ++m) A8[m] = PG8_CAT8(lds + PG8_SA(b, h) + aoff + m * 2048, lds + PG8_SA(b, h) + aoff + m * 2048 + 1024); } else PG8_LDA(At, b, h); } while (0)
#define PG8_XLDB(Bv, B8v, b, h) do { if constexpr (Sched::HASF8) { _Pragma("unroll") for (int n = 0; n < 2; ++n) B8v[n] = PG8_CAT8(lds + PG8_SB(b, h) + boff + n * 2048, lds + PG8_SB(b, h) + boff + n * 2048 + 1024); } else PG8_LDB(Bv, b, h); } while (0)
#define PG8_XMM(ai, bj, Bv, B8v) do { if constexpr (Sched::HASF8) { __builtin_amdgcn_s_setprio(1); _Pragma("unroll") for (int m = 0; m < 4; ++m) _Pragma("unroll") for (int n = 0; n < 2; ++n) \
        asm volatile("v_mfma_f32_16x16x128_f8f6f4 %0, %1, %2, %0" : "+v"(acc[ai][bj][m][n]) : "v"(B8v[n]), "v"(A8[m])); __builtin_amdgcn_s_setprio(0); }        else PG8_MMA(ai, bj, At, Bv); } while (0)
#define PG8_WAIT_V(n) asm volatile("s_waitcnt vmcnt(" #n ")" ::: "memory")
#define PG8_WAIT_L(n) asm volatile("s_waitcnt lgkmcnt(" #n ")" ::: "memory")
#define PG8_BAR __builtin_amdgcn_s_barrier()
#define PG8_SCHED __builtin_amdgcn_sched_barrier(0)
    typedef int pg8_v8i __attribute__((ext_vector_type(8))); typedef int pg8_v4i __attribute__((ext_vector_type(4)));
    GUnit cur, nxt; GOps co, no_; int ui = 0;
    if (!S.next(0, cur, co)) return;
    f32x4 acc[2][2][4][2];
#pragma unroll
    for (int a = 0; a < 2; ++a)
#pragma unroll
        for (int b = 0; b < 2; ++b)
#pragma unroll
            for (int m = 0; m < 4; ++m)
#pragma unroll
                for (int n = 0; n < 2; ++n) acc[a][b][m][n] = (f32x4){0.f, 0.f, 0.f, 0.f};
    bf16x8 At[4][2], B0[2][2], B1[2][2]; pg8_v8i A8[4], B08[2], B18[2];
    const char* cA = co.A; const char* cB = co.B;
    unsigned ldA = VARLD ? co.lda : Sched::LDA, ldB = VARLD ? co.ldb : Sched::LDB; int nt = (VARLD || Sched::VARNT) ? co.nt : Sched::NT;
    unsigned vA0 = (unsigned)R0 * ldA + (unsigned)C0 * 2u, vA1 = (unsigned)R1 * ldA + (unsigned)C1 * 2u;
    unsigned vB0 = (unsigned)Rb0 * ldB + (unsigned)C0 * 2u, vB1 = (unsigned)Rb1 * ldB + (unsigned)C1 * 2u;
    unsigned hA = (unsigned)HALF * ldA, hB = (unsigned)HALF * ldB;
    unsigned gC00 = 0, gC01 = 0, gC10 = 0, gC11 = 0, gN00 = 0, gN01 = 0, gN10 = 0, gN11 = 0;
    if constexpr (GATHER) { gC00 = S.arow(cur, R0) + (unsigned)C0 * 2u; gC01 = S.arow(cur, R1) + (unsigned)C1 * 2u; gC10 = S.arow(cur, HALF + R0) + (unsigned)C0 * 2u; gC11 = S.arow(cur, HALF + R1) + (unsigned)C1 * 2u; hA = 0; }
    PG8_STAGE(PG8_SB(0, 0), cB, vB0, vB1); PG8_STAGE(PG8_SB(0, 1), cB + hB, vB0, vB1); PG8_STAGE(PG8_SA(0, 0), cA, GATHER ? gC00 : vA0, GATHER ? gC01 : vA1); PG8_STAGE(PG8_SA(0, 1), cA + hA, GATHER ? gC10 : vA0, GATHER ? gC11 : vA1);
    if (wr == 1) PG8_BAR;
    PG8_WAIT_V(2); PG8_BAR;
    PG8_STAGE(PG8_SB(1, 0), cB + 128, vB0, vB1); PG8_STAGE(PG8_SA(1, 0), cA + 128, GATHER ? gC00 : vA0, GATHER ? gC01 : vA1); PG8_STAGE(PG8_SB(1, 1), cB + hB + 128, vB0, vB1);
    PG8_WAIT_V(6); PG8_BAR;
    for (;;) {
        const bool has_next = S.next(ui + 1, nxt, no_);
        const char* nA = has_next ? no_.A : cA; const char* nB = has_next ? no_.B : cB;
        const unsigned nlda = (VARLD && has_next) ? no_.lda : ldA, nldb = (VARLD && has_next) ? no_.ldb : ldB;
        const int nnt = ((VARLD || Sched::VARNT) && has_next) ? no_.nt : nt;
        if constexpr (GATHER) { if (has_next) { gN00 = S.arow(nxt, R0) + (unsigned)C0 * 2u; gN01 = S.arow(nxt, R1) + (unsigned)C1 * 2u; gN10 = S.arow(nxt, HALF + R0) + (unsigned)C0 * 2u; gN11 = S.arow(nxt, HALF + R1) + (unsigned)C1 * 2u; }
                      else { gN00 = gC00; gN01 = gC01; gN10 = gC10; gN11 = gC11; } }
#pragma unroll 1
        for (int t = 0; t < nt; t += 2) {
            const bool last = (t == nt - 2);
            if (Epi::HAS_MID) { PG8_SCHED; E.mid(acc, cur, t, wr, wc, fr, fq); PG8_SCHED; }
            const char* a1 = cA + (size_t)(t + 1) * 128;
            const char* a2 = last ? nA : cA + (size_t)(t + 2) * 128; const char* b2 = last ? nB : cB + (size_t)(t + 2) * 128;
            const char* a3 = a2 + 128; const char* b3 = b2 + 128;
            unsigned xA0 = vA0, xA1 = vA1, xB0 = vB0, xB1 = vB1, xhA = hA, xhB = hB;
            const unsigned s00 = GATHER ? (last ? gN00 : gC00) : 0u, s01 = GATHER ? (last ? gN01 : gC01) : 0u, s10 = GATHER ? (last ? gN10 : gC10) : 0u, s11 = GATHER ? (last ? gN11 : gC11) : 0u;
            if (VARLD && last) { xA0 = (unsigned)R0 * nlda + (unsigned)C0 * 2u; xA1 = (unsigned)R1 * nlda + (unsigned)C1 * 2u; xB0 = (unsigned)Rb0 * nldb + (unsigned)C0 * 2u; xB1 = (unsigned)Rb1 * nldb + (unsigned)C1 * 2u; xhA = (unsigned)HALF * nlda; xhB = (unsigned)HALF * nldb; }
            PG8_XLDB(B0, B08, 0, 0); PG8_XLDB(B1, B18, 0, 1); PG8_SCHED; PG8_XLDA(0, 0); PG8_STAGE(PG8_SA(1, 1), a1 + hA, GATHER ? gC10 : vA0, GATHER ? gC11 : vA1);
            PG8_WAIT_V(8); PG8_WAIT_L(0); PG8_BAR; PG8_XMM(0, 0, B0, B08); PG8_XMM(0, 1, B1, B18); PG8_BAR; PG8_SCHED;
            PG8_XLDA(0, 1); PG8_STAGE(PG8_SB(0, 0), b2, xB0, xB1); PG8_STAGE(PG8_SB(0, 1), b2 + xhB, xB0, xB1); PG8_STAGE(PG8_SA(0, 0), a2, GATHER ? s00 : xA0, GATHER ? s01 : xA1);
            PG8_WAIT_V(8); PG8_WAIT_L(0); PG8_BAR; PG8_XMM(1, 0, B0, B08); PG8_XMM(1, 1, B1, B18); PG8_BAR; PG8_SCHED;
            PG8_XLDB(B0, B08, 1, 0); PG8_XLDB(B1, B18, 1, 1); PG8_SCHED; PG8_XLDA(1, 0); PG8_STAGE(PG8_SA(0, 1), a2 + xhA, GATHER ? s10 : xA0, GATHER ? s11 : xA1);
            PG8_WAIT_V(8); PG8_WAIT_L(0); PG8_BAR; PG8_XMM(0, 0, B0, B08); PG8_XMM(0, 1, B1, B18); PG8_BAR; PG8_SCHED;
            PG8_XLDA(1, 1); PG8_STAGE(PG8_SB(1, 0), b3, xB0, xB1); PG8_STAGE(PG8_SB(1, 1), b3 + xhB, xB0, xB1); PG8_STAGE(PG8_SA(1, 0), a3, GATHER ? s00 : xA0, GATHER ? s01 : xA1);
            PG8_WAIT_V(8); PG8_WAIT_L(0); PG8_BAR; PG8_XMM(1, 0, B0, B08); PG8_XMM(1, 1, B1, B18); PG8_BAR; PG8_SCHED;
        }
        if (wr == 0) PG8_BAR;
        if constexpr (Sched::HASF8) asm volatile("s_nop 15\n\ts_nop 7" ::: "memory");
        PG8_SCHED; E(acc, cur, wr, wc, fr, fq); PG8_SCHED;
        if (!has_next) break;
#pragma unroll
        for (int a = 0; a < 2; ++a)
#pragma unroll
            for (int b = 0; b < 2; ++b)
#pragma unroll
                for (int m = 0; m < 4; ++m)
#pragma unroll
                    for (int n = 0; n < 2; ++n) acc[a][b][m][n] = (f32x4){0.f, 0.f, 0.f, 0.f};
        cur = nxt; cA = nA; cB = nB; ++ui;
        if (GATHER) { gC00 = gN00; gC01 = gN01; gC10 = gN10; gC11 = gN11; }
        if (VARLD || Sched::VARNT) nt = nnt;
        if (VARLD) { ldA = nlda; ldB = nldb; vA0 = (unsigned)R0 * ldA + (unsigned)C0 * 2u; vA1 = (unsigned)R1 * ldA + (unsigned)C1 * 2u; vB0 = (unsigned)Rb0 * ldB + (unsigned)C0 * 2u; vB1 = (unsigned)Rb1 * ldB + (unsigned)C1 * 2u; hA = (unsigned)HALF * ldA; hB = (unsigned)HALF * ldB; }
        if (wr == 1) PG8_BAR;
    }
    PG8_WAIT_V(0);
    PG8_BAR;
#undef PG8_SA
#undef PG8_SB
#undef PG8_STAGE
#undef PG8_LDA
#undef PG8_LDB
#undef PG8_MMA
#undef PG8_XMM
#undef PG8_XLDA
#undef PG8_XLDB
#undef PG8_CAT8
#undef PG8_WAIT_V
#undef PG8_WAIT_L
#undef PG8_BAR
#undef PG8_SCHED
}

__device__ __forceinline__ void unpack8(const v2u x, float (&f)[8]) {
    f[0] = (float)(x.x & 0xffu); f[1] = (float)((x.x >> 8) & 0xffu); f[2] = (float)((x.x >> 16) & 0xffu); f[3] = (float)(x.x >> 24);
    f[4] = (float)(x.y & 0xffu); f[5] = (float)((x.y >> 8) & 0xffu); f[6] = (float)((x.y >> 16) & 0xffu); f[7] = (float)(x.y >> 24); }
template <int KM> struct Epi {
    static constexpr bool HAS_MID = (KM & 4) != 0;
    bf16* O; int ldc;
    float scale;
    const float* bias;
    unsigned char* G;
    int gc0;
    float* nrm;
    gu32* rwait;
    float scale2 = 0.0f;
    __device__ __forceinline__ void mid(f32x4 (&acc)[2][2][4][2], const GUnit& u, int t, int wr, int wc, int fr, int fq) const {
        constexpr int T1 = (KM & 256) ? 4 : 8, T2 = (KM & 256) ? 8 : 16, TW = (KM & 256) ? 6 : 14;
        if ((KM & 4) && u.kind == 2 && t == TW && rwait) {
            unsigned sp_ = 0; while (__hip_atomic_load(rwait, RLX_AGENT) < 8u) { __builtin_amdgcn_s_sleep(1); if (++sp_ > XB_SPIN_CAP) break; }
            __builtin_amdgcn_fence(__ATOMIC_ACQUIRE, "agent"); return; }
        if (!(KM & 4) || u.kind != 2 || (t != T1 && t != T2)) return;
        const int sa = (t == T1) ? 0 : 1;
        const unsigned char* gp = G + (size_t)(u.r0 + wr * 64 + fr) * 3072 + sa * 1024 + u.c0 + wc * 32 + 8 * fq;
#pragma unroll
        for (int ai = 0; ai < 2; ++ai) { v2u xs[4][2], ys[4][2];
#pragma unroll
            for (int m = 0; m < 4; ++m) { const unsigned char* rp = gp + (size_t)(ai * HALF + m * 16) * 3072; asm volatile("" : "+v"(rp));
#pragma unroll
                for (int bj = 0; bj < 2; ++bj) { xs[m][bj] = *(const v2u*)(rp + bj * HALF); ys[m][bj] = *(const v2u*)(rp + bj * HALF + 1024); } }
#pragma unroll
            for (int m = 0; m < 4; ++m)
#pragma unroll
                for (int bj = 0; bj < 2; ++bj) { float fa[8], fb[8]; unpack8(xs[m][bj], fa); unpack8(ys[m][bj], fb);
                    f32x4 r0, r1;
#pragma unroll
                    for (int j = 0; j < 4; ++j) { r0[j] = fa[j] * __builtin_amdgcn_rcpf(fb[j]); r1[j] = fa[4 + j] * __builtin_amdgcn_rcpf(fb[4 + j]); }
                    acc[ai][bj][m][0] *= r0; acc[ai][bj][m][1] *= r1; }
            asm volatile("" ::: "memory"); }
    }
    __device__ __forceinline__ void operator()(f32x4 (&acc)[2][2][4][2], const GUnit& u, int wr, int wc, int fr, int fq) const {
        if ((KM & 16) && u.kind == 4) {
            const float sc = (u.aux == 2) ? scale2 : (u.aux ? scale : 1.0f);
            const int row0 = u.r0 + wr * 64 + fr, col0 = u.c0 + wc * 32 + 8 * fq;
            float mx[2] = {0.f, 0.f};
#pragma unroll
            for (int ai = 0; ai < 2; ++ai)
#pragma unroll
                for (int m = 0; m < 4; ++m) { bf16* rowp = O + (size_t)(row0 + ai * HALF + m * 16) * ldc + col0;
#pragma unroll
                    for (int bj = 0; bj < 2; ++bj) { const f32x4 v0 = acc[ai][bj][m][0] * sc, v1 = acc[ai][bj][m][1] * sc;
                        v4u w; w.x = cvt_pk_bf16(v0[0], v0[1]); w.y = cvt_pk_bf16(v0[2], v0[3]); w.z = cvt_pk_bf16(v1[0], v1[1]); w.w = cvt_pk_bf16(v1[2], v1[3]);
                        *(v4u*)(rowp + bj * HALF) = w;
                        float ss = (v0[0] * v0[0] + v0[1] * v0[1]) + (v0[2] * v0[2] + v0[3] * v0[3]) + (v1[0] * v1[0] + v1[1] * v1[1]) + (v1[2] * v1[2] + v1[3] * v1[3]);
                        ss += __shfl_xor(ss, 16); ss += __shfl_xor(ss, 32);
                        mx[bj] = fmaxf(mx[bj], ss); } }
#pragma unroll
            for (int bj = 0; bj < 2; ++bj) { float v = mx[bj]; v = fmaxf(v, DPPF(v, 0xB1)); v = fmaxf(v, DPPF(v, 0x4E)); v = fmaxf(v, DPPF(v, 0x141)); v = fmaxf(v, DPPF(v, 0x140));
                if (fr == 0 && fq == 0) nrm[(((u.r0 >> 8) * 16 + ((u.c0 - 2048) >> 6) + 2 * bj + (wc >> 1)) * 2 + (wc & 1)) * 2 + wr] = v; }
        } else if ((KM & 1) && u.kind == 0) {
            const float sc = u.aux ? scale : 1.0f;
            const int row0 = u.r0 + wr * 64 + fr, col0 = u.c0 + wc * 32 + 8 * fq;
#pragma unroll
            for (int ai = 0; ai < 2; ++ai)
#pragma unroll
                for (int m = 0; m < 4; ++m) { bf16* rowp = O + (size_t)(row0 + ai * HALF + m * 16) * ldc + col0;
#pragma unroll
                    for (int bj = 0; bj < 2; ++bj) { const f32x4 v0 = acc[ai][bj][m][0] * sc, v1 = acc[ai][bj][m][1] * sc;
                        v4u w; w.x = cvt_pk_bf16(v0[0], v0[1]); w.y = cvt_pk_bf16(v0[2], v0[3]); w.z = cvt_pk_bf16(v1[0], v1[1]); w.w = cvt_pk_bf16(v1[2], v1[3]);
                        *(v4u*)(rowp + bj * HALF) = w; } }
        } else if ((KM & 2) && u.kind == 1) {
            const int gcol0 = (u.c0 - gc0) + wc * 32 + 8 * fq; const float* bp = bias + gcol0;
            unsigned char* gp = G + (size_t)(u.r0 + wr * 64 + fr) * 3072 + gcol0;
#pragma unroll
            for (int bj = 0; bj < 2; ++bj) { const f32x4 b0 = *(const f32x4*)(bp + bj * HALF), b1 = *(const f32x4*)(bp + bj * HALF + 4);
#pragma unroll
                for (int ai = 0; ai < 2; ++ai)
#pragma unroll
                    for (int m = 0; m < 4; ++m) { const f32x4 z0 = acc[ai][bj][m][0] * (1.0f / WG8_SCALE) + b0, z1 = acc[ai][bj][m][1] * (1.0f / WG8_SCALE) + b1; unsigned q[8];
#pragma unroll
                        for (int j = 0; j < 4; ++j) { q[j] = (unsigned)fminf(fmaxf(sigmoidf_(z0[j]) * 255.0f + 0.5f, 1.0f), 255.0f); q[4 + j] = (unsigned)fminf(fmaxf(sigmoidf_(z1[j]) * 255.0f + 0.5f, 1.0f), 255.0f); }
                        v2u w; w.x = q[0] | (q[1] << 8) | (q[2] << 16) | (q[3] << 24); w.y = q[4] | (q[5] << 8) | (q[6] << 16) | (q[7] << 24);
                        if (KM & 64) { unsigned char* d_ = gp + (size_t)(ai * HALF + m * 16) * 3072 + bj * HALF; ST8_WT(d_, w); } else *(v2u*)(gp + (size_t)(ai * HALF + m * 16) * 3072 + bj * HALF) = w; } }
        } else if ((KM & 4) && u.kind == 2) {
            const int row0 = u.r0 + wr * 64 + fr, col0 = u.c0 + wc * 32 + 8 * fq;
            const unsigned char* gp = G + (size_t)row0 * 3072 + 2048 + col0;
#pragma unroll
            for (int ai = 0; ai < 2; ++ai) { v2u ys[4][2];
#pragma unroll
                for (int m = 0; m < 4; ++m) { const unsigned char* rp = gp + (size_t)(ai * HALF + m * 16) * 3072; asm volatile("" : "+v"(rp)); ys[m][0] = *(const v2u*)rp; ys[m][1] = *(const v2u*)(rp + HALF); }
#pragma unroll
                for (int m = 0; m < 4; ++m) { bf16* rowp = O + (size_t)(row0 + ai * HALF + m * 16) * ldc + col0;
#pragma unroll
                    for (int bj = 0; bj < 2; ++bj) { float fy[8]; unpack8(ys[m][bj], fy); constexpr float fs_ = (KM & 256) ? 1.0f / (255.0f * WG8_SCALE) : 1.0f / 255.0f; const f32x4 a0 = acc[ai][bj][m][0] * fs_, a1 = acc[ai][bj][m][1] * fs_;
                        if (KM & 512) { v2u w8; w8.x = cvt4_fp8(a0[0] * fy[0] * M8_SCALE, a0[1] * fy[1] * M8_SCALE, a0[2] * fy[2] * M8_SCALE, a0[3] * fy[3] * M8_SCALE); w8.y = cvt4_fp8(a1[0] * fy[4] * M8_SCALE, a1[1] * fy[5] * M8_SCALE, a1[2] * fy[6] * M8_SCALE, a1[3] * fy[7] * M8_SCALE);
                            unsigned char* d_ = (unsigned char*)O + (size_t)(row0 + ai * HALF + m * 16) * ldc * 2 + col0 + bj * HALF; ST8_WT(d_, w8); continue; }
                        v4u w; w.x = cvt_pk_bf16(a0[0] * fy[0], a0[1] * fy[1]); w.y = cvt_pk_bf16(a0[2] * fy[2], a0[3] * fy[3]);
                        w.z = cvt_pk_bf16(a1[0] * fy[4], a1[1] * fy[5]); w.w = cvt_pk_bf16(a1[2] * fy[6], a1[3] * fy[7]);
                        if (KM & 32) { bf16* d_ = rowp + bj * HALF; ST16_WT(d_, w); } else *(v4u*)(rowp + bj * HALF) = w; } }
                asm volatile("" ::: "memory"); }
        } else if (KM & 8) {
            const int row0 = u.r0 + wr * 64 + fr, col0 = u.c0 + wc * 32 + 8 * fq;
#pragma unroll
            for (int ai = 0; ai < 2; ++ai)
#pragma unroll
                for (int m = 0; m < 4; ++m) { bf16* rowp = O + (size_t)(row0 + ai * HALF + m * 16) * ldc + col0; float hv[8];
#pragma unroll
                    for (int n = 0; n < 2; ++n)
#pragma unroll
                        for (int j = 0; j < 4; ++j) { const float gt = acc[ai][0][m][n][j] * ((KM & 128) ? 1.0f / WG8_SCALE : 1.0f), up = acc[ai][1][m][n][j] * ((KM & 128) ? 1.0f / WG8_SCALE : 1.0f); hv[n * 4 + j] = gt * sigmoidf_(gt) * up; }
                    if (KM & 128) { v2u w8; w8.x = cvt4_fp8(hv[0] * H8_SCALE, hv[1] * H8_SCALE, hv[2] * H8_SCALE, hv[3] * H8_SCALE); w8.y = cvt4_fp8(hv[4] * H8_SCALE, hv[5] * H8_SCALE, hv[6] * H8_SCALE, hv[7] * H8_SCALE);
                        *(v2u*)((char*)O + (size_t)(row0 + ai * HALF + m * 16) * ldc * 2 + col0) = w8; }
                    else { v4u w; w.x = cvt_pk_bf16(hv[0], hv[1]); w.y = cvt_pk_bf16(hv[2], hv[3]); w.z = cvt_pk_bf16(hv[4], hv[5]); w.w = cvt_pk_bf16(hv[6], hv[7]);
                    *(v4u*)rowp = w; } }
        }
    }
};
}
namespace attn_body {
using bf16=__hip_bfloat16;
using bf16x8=__attribute__((ext_vector_type(8)))short;
using s16x4=__attribute__((ext_vector_type(4)))short;
using f32x16=__attribute__((ext_vector_type(16)))float;
using u32x4=__attribute__((ext_vector_type(4)))unsigned;
constexpr int SEQ=4096,D=64,PQ=5376,PO=1024;
constexpr int NW=8,QBLK=32,QB=QBLK*NW,KVBLK=64,NQB=SEQ/QB;
constexpr int ATTN_UNIT_ROWS=QB;
__device__ __forceinline__ int crow(int r,int hi){return (r&3)+8*(r>>2)+4*hi;}
#define SBAR() __builtin_amdgcn_sched_barrier(0)
__device__ __forceinline__ void cmask(f32x16&p0,f32x16&p1,int jb,int qrel,int hi){
  const float NEG=-INFINITY; int kb=64*jb+4*hi;
  #pragma unroll
  for(int r=0;r<16;++r){int kv=kb+(r&3)+8*(r>>2); if(kv>qrel)p0[r]=NEG; if(kv+32>qrel)p1[r]=NEG;}
}

constexpr int NSLOT=3, SLOTB=8192;
constexpr int LDS_K=0, LDS_V=NSLOT*SLOTB, LDS_WS=3*NSLOT*SLOTB, LDS_OST=LDS_WS+NW*64*4, LDS_BYTES=LDS_OST+NW*4096;
constexpr float C2=0.125f*1.4426950408889634f;
__device__ __forceinline__ void glds16(const void*gsrc,unsigned lds_dst){unsigned keep;
  asm volatile("s_mov_b32 %0, m0\n\ts_mov_b32 m0, %2\n\ts_nop 0\n\tglobal_load_lds_dwordx4 %1, off\n\ts_mov_b32 m0, %0":"=&s"(keep):"v"(gsrc),"s"(lds_dst):"memory");}
__device__ __forceinline__ float max3f(float a,float b,float c){float r;asm("v_max3_f32 %0, %1, %2, %3":"=v"(r):"v"(a),"v"(b),"v"(c));return r;}
__device__ __forceinline__ float max2f(float a,float b){float r;asm("v_max_f32_e32 %0, %1, %2":"=v"(r):"v"(a),"v"(b));return r;}
__device__ __forceinline__ float fadd_s(float a,float b){float r;asm("v_add_f32_e32 %0, %1, %2":"=v"(r):"v"(a),"v"(b));return r;}
__device__ __forceinline__ float fsub_s(float a,float b){float r;asm("v_sub_f32_e32 %0, %1, %2":"=v"(r):"v"(a),"v"(b));return r;}
typedef float f32x2_t __attribute__((ext_vector_type(2))); typedef __bf16 bf16x2_t __attribute__((ext_vector_type(2)));
__device__ __forceinline__ unsigned cvtpk_s(float lo,float hi){f32x2_t v={lo,hi};bf16x2_t b=__builtin_convertvector(v,bf16x2_t);return __builtin_bit_cast(unsigned,b);}
#define WAIT_BAR(N) asm volatile("s_waitcnt vmcnt(" #N ") lgkmcnt(0)\n\ts_barrier":::"memory")

__device__ __forceinline__ void qkt(f32x16&p0,f32x16&p1,const char*Kslot,const bf16x8*qr,int r32,int hi){ const f32x16 negm=f32x16{};
  const char*kb=Kslot+hi*1024+r32*16;
  #pragma unroll
  for(int d0=0;d0<4;++d0){
    const bf16x8 b0=*reinterpret_cast<const bf16x8*>(kb+d0*2048);
    const bf16x8 b1=*reinterpret_cast<const bf16x8*>(kb+d0*2048+512);
    if(d0==0){p0=__builtin_amdgcn_mfma_f32_32x32x16_bf16(b0,qr[0],negm,0,0,0);p1=__builtin_amdgcn_mfma_f32_32x32x16_bf16(b1,qr[0],negm,0,0,0);}
    else{p0=__builtin_amdgcn_mfma_f32_32x32x16_bf16(b0,qr[d0],p0,0,0,0);p1=__builtin_amdgcn_mfma_f32_32x32x16_bf16(b1,qr[d0],p1,0,0,0);}}
}
typedef __attribute__((address_space(3))) const char* lds_cptr;
typedef short v4i16_t __attribute__((ext_vector_type(4)));
__device__ __forceinline__ void kload8(bf16x8*kf,lds_cptr kp){
  kf[0]=*(const __attribute__((address_space(3))) bf16x8*)(kp);      kf[1]=*(const __attribute__((address_space(3))) bf16x8*)(kp+512);
  kf[2]=*(const __attribute__((address_space(3))) bf16x8*)(kp+2048); kf[3]=*(const __attribute__((address_space(3))) bf16x8*)(kp+2560);
  kf[4]=*(const __attribute__((address_space(3))) bf16x8*)(kp+4096); kf[5]=*(const __attribute__((address_space(3))) bf16x8*)(kp+4608);
  kf[6]=*(const __attribute__((address_space(3))) bf16x8*)(kp+6144); kf[7]=*(const __attribute__((address_space(3))) bf16x8*)(kp+6656);
}
__device__ __forceinline__ void kload2(bf16x8*kf,lds_cptr kp,int j){ kf[2*j]=*(const __attribute__((address_space(3))) bf16x8*)(kp+j*2048); kf[2*j+1]=*(const __attribute__((address_space(3))) bf16x8*)(kp+j*2048+512); }
__device__ __forceinline__ s16x4 vtr(lds_cptr p){ return __builtin_bit_cast(s16x4,__builtin_amdgcn_ds_read_tr16_b64_v4i16((__attribute__((address_space(3))) v4i16_t*)p)); }
__device__ __forceinline__ float rowmax(const f32x16&p0,const f32x16&p1){
  float a=max3f(p0[0],p0[1],p1[0]),b=max3f(p0[2],p0[3],p1[1]);a=max3f(a,p1[2],p1[3]);
  #pragma unroll
  for(int r=4;r<16;r+=4){a=max3f(a,p0[r],p0[r+1]);b=max3f(b,p0[r+2],p0[r+3]);a=max3f(a,p1[r],p1[r+1]);b=max3f(b,p1[r+2],p1[r+3]);}
  const float m=max2f(a,b);
  auto rr=__builtin_amdgcn_permlane32_swap(__float_as_uint(m),__float_as_uint(m),false,false);
  return max2f(__uint_as_float(rr[0]),__uint_as_float(rr[1]));
}
__device__ __forceinline__ void pv(f32x16*o,int vb,bf16x8 pa0,bf16x8 pa1,bf16x8 pa2,bf16x8 pa3){
  #pragma unroll
  for(int d0=0;d0<4;++d0){s16x4 lo[4],hi[4];
    #pragma unroll
    for(int ks=0;ks<4;++ks){
      asm volatile("ds_read_b64_tr_b16 %0,%1 offset:%c2":"=&v"(lo[ks]):"v"(vb),"i"(d0*4096+ks*1024):"memory");
      asm volatile("ds_read_b64_tr_b16 %0,%1 offset:%c2":"=&v"(hi[ks]):"v"(vb),"i"(d0*4096+ks*1024+512):"memory");}
    asm volatile("s_waitcnt lgkmcnt(0)":::"memory");SBAR();
    #define PK(k) (bf16x8){lo[k][0],lo[k][1],lo[k][2],lo[k][3],hi[k][0],hi[k][1],hi[k][2],hi[k][3]}
    o[d0]=__builtin_amdgcn_mfma_f32_32x32x16_bf16(pa0,PK(0),o[d0],0,0,0);
    o[d0]=__builtin_amdgcn_mfma_f32_32x32x16_bf16(pa1,PK(1),o[d0],0,0,0);
    o[d0]=__builtin_amdgcn_mfma_f32_32x32x16_bf16(pa2,PK(2),o[d0],0,0,0);
    o[d0]=__builtin_amdgcn_mfma_f32_32x32x16_bf16(pa3,PK(3),o[d0],0,0,0);
    #undef PK
  }
}

#ifndef ATTN_STORE16
#define ATTN_STORE16(p,v) (*(u32x4*)(p)=(v))
#endif
template<int THRL> __device__ __forceinline__ void attn_unit(int b,int qcol,int kcol,int vcol,int ocol,float slope2,int qb,int t0,const bf16*__restrict__ P,bf16*O,char*shm){
  int tid_=mk_tid(); asm volatile("":"+v"(tid_));
  const int tid=tid_,lane=tid&63,r32=lane&31,hi=lane>>5; const int wid=__builtin_amdgcn_readfirstlane(tid>>6);
  const long rowbase=(long)b*SEQ; const int q0=qb*QB;
  const bf16*Qw=P+(rowbase+q0+wid*QBLK)*PQ+qcol;
  const bf16*Kh=P+(rowbase+(long)t0*KVBLK)*PQ+kcol,*Vh=P+(rowbase+(long)t0*KVBLK)*PQ+vcol;
  const unsigned lds0=(unsigned)(uintptr_t)shm;
  float*wsf=(float*)(shm+LDS_WS)+wid*64;
  const bf16*ksrc=Kh+(long)lane*PQ+wid*8;
  const bf16*vsrc=Vh+(long)(16*(wid&3)+(lane>>2))*PQ+(wid>>2)*32+(lane&3)*8;
  const unsigned kdst=lds0+LDS_K+wid*1024, vdst=lds0+LDS_V+wid*1024;
  #define DMA_K(t,slot) glds16(ksrc+(long)(t)*KVBLK*PQ,(unsigned)__builtin_amdgcn_readfirstlane(kdst+(slot)))
  #define DMA_V(t,slot) do{ glds16(vsrc+(long)(t)*KVBLK*PQ,(unsigned)__builtin_amdgcn_readfirstlane(vdst+2*(slot))); glds16(vsrc+(long)(t)*KVBLK*PQ+64,(unsigned)__builtin_amdgcn_readfirstlane(vdst+2*(slot)+8192)); }while(0)
  const int vb0=(int)(lds0+LDS_V)+((lane>>4)&1)*32+(lane&3)*8+(4*hi+((lane&15)>>2))*64;
  const char*Kbase=shm+LDS_K; bf16x8 kf[8];
  const lds_cptr shm3=(lds_cptr)shm; const lds_cptr kp0=shm3+LDS_K+hi*1024+r32*16; const lds_cptr vp0=shm3+LDS_V+((lane>>4)&1)*32+(lane&3)*8+(4*hi+((lane&15)>>2))*64;
  const int NT=(q0+QB)/KVBLK-t0;
  DMA_K(0,0);DMA_V(0,0);DMA_K(1,SLOTB);
  bf16x8 qr[4];
  #pragma unroll
  for(int d0=0;d0<4;++d0)qr[d0]=*reinterpret_cast<const bf16x8*>(&Qw[(long)r32*PQ+d0*16+hi*8]);
  float mhat=0.f,l_reg=0.f;f32x16 o[4];o[0]=f32x16{};o[1]=f32x16{};o[2]=f32x16{};o[3]=f32x16{};const f32x16 negm=f32x16{};
  const float sr1_=__builtin_bit_cast(float,__builtin_amdgcn_readfirstlane(__builtin_bit_cast(int,slope2))), sr2_=__builtin_bit_cast(float,__builtin_amdgcn_readfirstlane(__builtin_bit_cast(int,2.f*slope2))), sr3_=__builtin_bit_cast(float,__builtin_amdgcn_readfirstlane(__builtin_bit_cast(int,3.f*slope2)));
  const float hib=slope2*(float)(4*hi);
  #define ALIBI(P0,P1,t) do{ const float tm0_=slope2*(float)(64*(t))+hib-mhat; \
    _Pragma("unroll") for(int q_=0;q_<4;++q_){ const float a_=tm0_+(8.f*slope2)*(float)q_, b_=a_+32.f*slope2; \
      P0[4*q_]+=a_; P0[4*q_+1]=(P0[4*q_+1]+a_)+sr1_; P0[4*q_+2]=(P0[4*q_+2]+a_)+sr2_; P0[4*q_+3]=(P0[4*q_+3]+a_)+sr3_; \
      P1[4*q_]+=b_; P1[4*q_+1]=(P1[4*q_+1]+b_)+sr1_; P1[4*q_+2]=(P1[4*q_+2]+b_)+sr2_; P1[4*q_+3]=(P1[4*q_+3]+b_)+sr3_; } }while(0)
  const int qrel=wid*QBLK+r32;
  #define CMASK(P0,P1,t) do{int jb_=(t)-(NT-4); if(jb_>=0)cmask(P0,P1,jb_,qrel,hi);}while(0)
  bool resc=false;
  #define START(P0,P1) do{ const float rm=rowmax(P0,P1); resc=false; \
    { const float dl=rm; mhat=fadd_s(mhat,dl); \
      _Pragma("unroll") for(int r=0;r<16;++r){P0[r]=fsub_s(P0[r],dl);P1[r]=fsub_s(P1[r],dl);} \
      } \
    _Pragma("unroll") for(int r=0;r<16;++r)P0[r]=__builtin_amdgcn_exp2f(P0[r]); }while(0)
  #define RESC() do{ if(resc){ asm volatile("s_waitcnt lgkmcnt(0)":::"memory"); \
      _Pragma("unroll") for(int d_=0;d_<4;++d_) _Pragma("unroll") for(int r=0;r<16;++r)o[d_][r]*=wsf[crow(r,hi)]; } }while(0)
  f32x16 pA0,pA1,pB0,pB1;
  int sl_prev=0,sl_cur=0,sl_next=SLOTB;
  #define ROT() do{sl_prev=sl_cur;sl_cur=sl_next;sl_next=(sl_next==(NSLOT-1)*SLOTB)?0:sl_next+SLOTB;}while(0)
  DMA_K(2,2*SLOTB);
  WAIT_BAR(4);
  qkt(pA0,pA1,Kbase,qr,r32,hi);asm volatile("s_nop 15\n\ts_nop 7":"+v"(pA0),"+v"(pA1));ALIBI(pA0,pA1,0);asm volatile("":"+v"(pA0),"+v"(pA1));CMASK(pA0,pA1,0);
  START(pA0,pA1);
  _Pragma("unroll") for(int r=0;r<16;++r)pA1[r]=__builtin_amdgcn_exp2f(pA1[r]);
  WAIT_BAR(0);
  DMA_K(3,0);DMA_V(1,SLOTB);
  ROT();
  kload8(kf,kp0+sl_cur);
  WAIT_BAR(3);
  s16x4 vlo[4],vhi[4]; u32x4 pw0,pw1,pw2,pw3;
  #define PKW(P,B) cvtpk_s(P[B],P[B+1])
  #define PAF(k) __builtin_bit_cast(bf16x8,pw##k)
  #define VFR(s) (bf16x8){vlo[s][0],vlo[s][1],vlo[s][2],vlo[s][3],vhi[s][0],vhi[s][1],vhi[s][2],vhi[s][3]}
  #define PIN(x) asm volatile("":"+v"(x))
  #define MX3(a,b,c) __builtin_fmaxf(__builtin_fmaxf((a),(b)),(c))
  #define GAPA(MF,A0,A1,A2,A3,W0,W1,PW) do{ MF; sacc+=A0; sacc+=A1; sacc+=A2; sacc+=A3; PIN(sacc); W0; W1; PIN(PW); SBAR(); }while(0)
  #define EX(v) __builtin_amdgcn_exp2f(v)
  #define GAPB(MF,X,B) do{ MF; X[B]=EX(X[B]); X[B+1]=EX(X[B+1]); PIN(X); SBAR(); }while(0)
  #define VRD(s,f) do{ vlo[s]=vtr(vp_+(((f)>>2)*4096+((f)&3)*1024)); vhi[s]=vtr(vp_+(((f)>>2)*4096+((f)&3)*1024+512)); }while(0)
  #define KRD(G,j) do{ if(G){ kload2(kf,kp0+sl_next,j); SBAR(); } }while(0)
  #define PVM(i,kq,X,B) do{ GAPB(o[(i)&3]=__builtin_amdgcn_mfma_f32_32x32x16_bf16(PAF(kq),VFR((i)&3),o[(i)&3],0,0,0), X,B); if((i)+4<16){ VRD((i)&3,4*(((i)+4)&3)+(((i)+4)>>2)); SBAR(); } }while(0)
  #define STEP(C0,C1,P0,P1,t,GK,GV,GL) do{ SBAR(); \
    const lds_cptr vp_=vp0+2*sl_prev; \
    float sacc=(P0[0]+P0[1]); \
    GAPA(C0=__builtin_amdgcn_mfma_f32_32x32x16_bf16(kf[0],qr[0],negm,0,0,0), P0[2],P0[3],P0[4],P0[5],     pw0[0]=PKW(P0,0), pw0[1]=PKW(P0,2), pw0); \
    GAPA(C1=__builtin_amdgcn_mfma_f32_32x32x16_bf16(kf[1],qr[0],negm,0,0,0), P0[6],P0[7],P0[8],P0[9],     pw0[2]=PKW(P0,4), pw0[3]=PKW(P0,6), pw0); \
    GAPA(C0=__builtin_amdgcn_mfma_f32_32x32x16_bf16(kf[2],qr[1],C0,0,0,0),   P0[10],P0[11],P0[12],P0[13], pw1[0]=PKW(P0,8), pw1[1]=PKW(P0,10), pw1); \
    GAPA(C1=__builtin_amdgcn_mfma_f32_32x32x16_bf16(kf[3],qr[1],C1,0,0,0),   P0[14],P0[15],P1[0],P1[1],   pw1[2]=PKW(P0,12),pw1[3]=PKW(P0,14), pw1); \
    VRD(0,0); SBAR(); GAPA(C0=__builtin_amdgcn_mfma_f32_32x32x16_bf16(kf[4],qr[2],C0,0,0,0),   P1[2],P1[3],P1[4],P1[5],     pw2[0]=PKW(P1,0), pw2[1]=PKW(P1,2), pw2); \
    VRD(1,4); SBAR(); GAPA(C1=__builtin_amdgcn_mfma_f32_32x32x16_bf16(kf[5],qr[2],C1,0,0,0),   P1[6],P1[7],P1[8],P1[9],     pw2[2]=PKW(P1,4), pw2[3]=PKW(P1,6), pw2); \
    VRD(2,8); SBAR(); GAPA(C0=__builtin_amdgcn_mfma_f32_32x32x16_bf16(kf[6],qr[3],C0,0,0,0),   P1[10],P1[11],P1[12],P1[13], pw3[0]=PKW(P1,8), pw3[1]=PKW(P1,10), pw3); \
    VRD(3,12); SBAR(); GAPA(C1=__builtin_amdgcn_mfma_f32_32x32x16_bf16(kf[7],qr[3],C1,0,0,0),   P1[14],P1[15],0.f,0.f,       pw3[2]=PKW(P1,12),pw3[3]=PKW(P1,14), pw3); \
    l_reg+=sacc; \
    if(GK){DMA_K((t)+3,sl_cur);} if(GV){DMA_V((t)+1,sl_next);} \
    ALIBI(C0,C1,t); CMASK(C0,C1,t); \
    { float a=MX3(C0[0],C0[1],C1[0]),b=MX3(C0[2],C0[3],C1[1]); a=MX3(a,C1[2],C1[3]); \
      _Pragma("unroll") for(int r=4;r<16;r+=4){a=MX3(a,C0[r],C0[r+1]);b=MX3(b,C0[r+2],C0[r+3]);a=MX3(a,C1[r],C1[r+1]);b=MX3(b,C1[r+2],C1[r+3]);} \
      float rm=__builtin_fmaxf(a,b); { auto rr=__builtin_amdgcn_permlane32_swap(__float_as_uint(rm),__float_as_uint(rm),false,false); rm=__builtin_fmaxf(__uint_as_float(rr[0]),__uint_as_float(rr[1])); } \
      resc=false; \
      if(__builtin_expect(__any(rm>(float)THRL),0)){ const float dl=__builtin_fmaxf(rm,0.f); mhat+=dl; \
        _Pragma("unroll") for(int r=0;r<16;++r){C0[r]-=dl;C1[r]-=dl;} \
        const float f=__builtin_amdgcn_exp2f(-dl); l_reg*=f; if(hi==0)wsf[r32]=f; resc=true; } } \
    SBAR(); \
    PVM(0,0,C0,0); PVM(1,0,C0,2); PVM(2,0,C0,4); PVM(3,0,C0,6); \
    KRD(GL,0); PVM(4,1,C0,8); PVM(5,1,C0,10); KRD(GL,1); PVM(6,1,C0,12); PVM(7,1,C0,14); \
    KRD(GL,2); PVM(8,2,C1,0); PVM(9,2,C1,2); KRD(GL,3); PVM(10,2,C1,4); PVM(11,2,C1,6); \
    PVM(12,3,C1,8); PVM(13,3,C1,10); PVM(14,3,C1,12); PVM(15,3,C1,14); \
    }while(0)
  int t=1;
  #undef CMASK
  #define CMASK(P0,P1,t) do{}while(0)
  for(;t+5<NT;t+=2){
    STEP(pB0,pB1,pA0,pA1,t,true,true,true);     WAIT_BAR(3); RESC(); ROT();
    STEP(pA0,pA1,pB0,pB1,t+1,true,true,true);   WAIT_BAR(3); RESC(); ROT();
  }
  #undef CMASK
  #define CMASK(P0,P1,t) do{int jb_=(t)-(NT-4); if(jb_>=0)cmask(P0,P1,jb_,qrel,hi);}while(0)
  #define ENDW(tt) do{ if((tt)+3<NT){WAIT_BAR(3);} else if((tt)+2<NT){WAIT_BAR(2);} else {WAIT_BAR(0);} }while(0)
  for(;t+1<NT;t+=2){
    STEP(pB0,pB1,pA0,pA1,t,(t+3<NT),(t+1<NT),(t+1<NT));       ENDW(t);   RESC(); ROT();
    STEP(pA0,pA1,pB0,pB1,t+1,(t+4<NT),(t+2<NT),(t+2<NT));     ENDW(t+1); RESC(); ROT();
  }
  STEP(pB0,pB1,pA0,pA1,NT-1,false,false,false); RESC();
  { float sacc=pB0[0]+pB0[1]; _Pragma("unroll") for(int r=2;r<16;++r)sacc+=pB0[r]; _Pragma("unroll") for(int r=0;r<16;++r)sacc+=pB1[r]; l_reg+=sacc;
    pw0=(u32x4){PKW(pB0,0),PKW(pB0,2),PKW(pB0,4),PKW(pB0,6)};pw1=(u32x4){PKW(pB0,8),PKW(pB0,10),PKW(pB0,12),PKW(pB0,14)};pw2=(u32x4){PKW(pB1,0),PKW(pB1,2),PKW(pB1,4),PKW(pB1,6)};pw3=(u32x4){PKW(pB1,8),PKW(pB1,10),PKW(pB1,12),PKW(pB1,14)};
    SBAR(); pv(o,vb0+2*sl_cur,PAF(0),PAF(1),PAF(2),PAF(3)); }
  #undef PKW
  #undef PAF
  #undef VFR
  #undef PIN
  #undef MX3
  #undef GAPA
  #undef GAPB
  #undef EX
  #undef VRD
  #undef KRD
  #undef PVM
  #undef STEP
  #undef ENDW
  {auto rr=__builtin_amdgcn_permlane32_swap(__float_as_uint(l_reg),__float_as_uint(l_reg),false,false);l_reg=__uint_as_float(rr[0])+__uint_as_float(rr[1]);}
  if(hi==0)wsf[32+r32]=l_reg;asm volatile("s_waitcnt lgkmcnt(0)":::"memory");
  float rli[16];
  #pragma unroll
  for(int r=0;r<16;++r)rli[r]=__builtin_amdgcn_rcpf(wsf[32+crow(r,hi)]);
  bf16*Ow=O+(rowbase+q0+wid*QBLK)*PO+ocol;
  { bf16*stg=(bf16*)(shm+LDS_OST)+wid*2048;
    #pragma unroll
    for(int hp=0;hp<2;++hp){
      #pragma unroll
      for(int r=0;r<16;++r){const int orow=crow(r,hi);
        #pragma unroll
        for(int d0=0;d0<2;++d0)stg[orow*64+d0*32+r32]=__float2bfloat16(o[2*hp+d0][r]*rli[r]);}
      asm volatile("s_waitcnt lgkmcnt(0)":::"memory");
      #pragma unroll
      for(int i=0;i<4;++i){const int row=i*8+(lane>>3),ch=lane&7; const u32x4 v=*(const u32x4*)(stg+row*64+ch*8); ATTN_STORE16(Ow+(long)row*PO+hp*64+ch*8,v);}
      asm volatile("s_waitcnt lgkmcnt(0)":::"memory"); } }
  asm volatile("s_waitcnt lgkmcnt(0)\n\ts_barrier":::"memory");
  #undef DMA_K
  #undef DMA_V
  #undef CMASK
  #undef START
  #undef RESC
  #undef ROT
  #undef ALIBI
}
constexpr int ATTN_LDS_BYTES=LDS_BYTES;
#undef SBAR
#undef WAIT_BAR
}
struct MixP {
    const bf16* proj; bf16* ocat; bf16* oatt;
    const float* hg_lb;
    const float* hg_norm_g;
    const float* lamp;
    const float* da_subln_g;
    const float *rw_mu, *rw_w0, *rw_a0, *rw_k_k, *rw_k_a, *rw_r_k, *rw_gn_g, *rw_gn_b;
    const bf16 *wupT, *aupT, *gupT;
    gu32* aq;
    gu32* nrm;
    bf16* act;
    gu32* pre;
    gu32* ptot;
    gu32* atot;
    gu32* rdr;
    gu32* rdy;
};

__device__ __forceinline__ void attn_group(const MixP& P, int b, int h, int qb, char* lds) {
    const float slope2 = exp2f(-2.0f * (float)(h + 1)) * LOG2E;
    const float s2 = __builtin_bit_cast(float, __builtin_amdgcn_readfirstlane(__builtin_bit_cast(int, slope2)));
    const attn_body::bf16* pr = (const attn_body::bf16*)P.proj; attn_body::bf16* oa = (attn_body::bf16*)P.oatt;
    int t0m[2];
    {   int lane_ = mk_tid() & 63; asm volatile("" : "+v"(lane_)); const int kb = lane_ & 15;
#pragma unroll
        for (int mp = 0; mp < 2; ++mp) {
            const gu32* nq = P.nrm + (((b * 16 + qb) * 16 + 2 * h + mp) * 4), * nk = P.nrm + (((b * 16 + (kb <= qb ? kb : qb)) * 16 + 8 + 2 * h + mp) * 4);
            const float q0_ = __uint_as_float(__hip_atomic_load(nq, RLX_AGENT)), q1_ = __uint_as_float(__hip_atomic_load(nq + 1, RLX_AGENT)), q2_ = __uint_as_float(__hip_atomic_load(nq + 2, RLX_AGENT)), q3_ = __uint_as_float(__hip_atomic_load(nq + 3, RLX_AGENT));
            const float k0_ = __uint_as_float(__hip_atomic_load(nk, RLX_AGENT)), k1_ = __uint_as_float(__hip_atomic_load(nk + 1, RLX_AGENT)), k2_ = __uint_as_float(__hip_atomic_load(nk + 2, RLX_AGENT)), k3_ = __uint_as_float(__hip_atomic_load(nk + 3, RLX_AGENT));
            const float qn = 1.01f * sqrtf(fmaxf(q0_, q1_) + fmaxf(q2_, q3_)), kn = 1.01f * sqrtf(fmaxf(k0_, k1_) + fmaxf(k2_, k3_));
            const float knq = __shfl(kn, qb);
            const bool skip = (kb < qb) && (qn * (kn + knq) - s2 * (float)(256 * (qb - kb) - 255) < -160.0f);
            const unsigned long long mk = __ballot(skip);
            const unsigned lowm = (unsigned)(mk & 0xffffull);
            t0m[mp] = __builtin_amdgcn_readfirstlane(4 * __builtin_ctz(~lowm));
        }
    }
#pragma unroll 1
    for (int mp = 0; mp < 2; ++mp)
        attn_body::attn_unit<30>(b, C_DAQ + h * 128 + mp * 64, C_DAK + h * 128 + mp * 64, C_DAV + h * 128, h * 256 + mp * 128, s2, qb, mp ? t0m[1] : t0m[0], pr, oa, lds);
    VM_WAIT(); __syncthreads();
    {
        int tid_ = mk_tid(); asm volatile("" : "+v"(tid_)); const int tid = tid_, row = tid >> 1, hf = tid & 1;
        const float lam_ = P.lamp[0], oml_ = P.lamp[4];
        const size_t grow = (size_t)b * T + (size_t)qb * 256 + row;
        const bf16* o0 = P.oatt + grow * 1024 + h * 256 + hf * 64; const bf16* o1 = o0 + 128;
        float v[64]; float ss = 0.f;
#pragma unroll
        for (int c = 0; c < 8; ++c) { const v4u x = __builtin_nontemporal_load((const v4u*)(o0) + c), y = __builtin_nontemporal_load((const v4u*)(o1) + c);
            const unsigned xs[4] = {x.x, x.y, x.z, x.w}, ys[4] = {y.x, y.y, y.z, y.w};
#pragma unroll
            for (int j = 0; j < 4; ++j) { const float a = bflo(xs[j]) - lam_ * bflo(ys[j]), d = bfhi(xs[j]) - lam_ * bfhi(ys[j]); v[c * 8 + 2 * j] = a; v[c * 8 + 2 * j + 1] = d; ss += a * a + d * d; } }
        ss += DPPF(ss, 0xB1);
        const float rs = rsqrtf(ss * (1.0f / 128.0f) + RMS_EPS) * oml_;
        unsigned char* dst = (unsigned char*)P.ocat + grow * 3072 + 512 + h * 128 + hf * 64; const float* g = P.da_subln_g + hf * 64;
#pragma unroll
        for (int c = 0; c < 8; ++c) { v2u w; w.x = cvt4_fp8(v[c * 8 + 0] * rs * g[c * 8 + 0], v[c * 8 + 1] * rs * g[c * 8 + 1], v[c * 8 + 2] * rs * g[c * 8 + 2], v[c * 8 + 3] * rs * g[c * 8 + 3]);
            w.y = cvt4_fp8(v[c * 8 + 4] * rs * g[c * 8 + 4], v[c * 8 + 5] * rs * g[c * 8 + 5], v[c * 8 + 6] * rs * g[c * 8 + 6], v[c * 8 + 7] * rs * g[c * 8 + 7]);
            { unsigned char* d_ = dst + c * 8; ST8_WT(d_, w); } }
    }
    VM_WAIT(); __syncthreads();
    if (mk_tid() == 0) { (void)__hip_atomic_fetch_add(P.rdy + b * 16 + qb, 1u, RLX_AGENT); (void)__hip_atomic_fetch_add(P.ptot, 1u, RLX_AGENT); (void)__hip_atomic_fetch_add(P.atot, 1u, RLX_AGENT); }
}
__device__ __forceinline__ void attn_worker(const MixP& P, char* lds, volatile LAS unsigned* bcast, int tid) {
    for (;;) {
        if (tid == 0) bcast[0] = __hip_atomic_fetch_add(P.aq, 1u, RLX_AGENT);
        __syncthreads();
        const unsigned idx = bcast[0];
        __syncthreads();
        if (idx >= 512u) break;
        const int qb = 15 - (int)(idx >> 5), bh = (int)(idx & 31u);
        attn_group(P, bh >> 2, bh & 3, qb, lds);
    }
}

constexpr int HG_QH = 0, HG_QT = 17408, HG_KT = 34816, HG_KHT = 52224, HG_VV = 70656, HG_OG = 88064, HG_AM = 105472, HG_BQ = 114688, HG_SS = 116736, HG_DD = 118784, HG_END = 119296;
constexpr int HS = 272, HS2 = 144;
__device__ __forceinline__ s16x4 tr_rd(unsigned addr) { s16x4 r; asm volatile("ds_read_b64_tr_b16 %0, %1\n\ts_waitcnt lgkmcnt(0)" : "=&v"(r) : "v"(addr) : "memory"); return r; }
__device__ __forceinline__ void hgrn_unit(const MixP& P, int b, int h, LAS unsigned char* lds) {
    int tid_ = mk_tid(); asm volatile("" : "+v"(tid_));
    const int tid = tid_, lane = tid & 63, w = __builtin_amdgcn_readfirstlane(tid >> 6), g = lane >> 4, li = lane & 15;
    const int kk_ = tid & 127, tq = tid >> 7;
    const float lb = P.hg_lb[h * 128 + kk_], oml = 1.0f - lb;
    LAS float* BQ = (LAS float*)(lds + HG_BQ); LAS float* SS = (LAS float*)(lds + HG_SS); LAS float* DD = (LAS float*)(lds + HG_DD);
    f32x4 Sacc[8];
#pragma unroll
    for (int i = 0; i < 8; ++i) Sacc[i] = (f32x4){0.f, 0.f, 0.f, 0.f};
    const unsigned ldsb = (unsigned)(uintptr_t)lds;
    const float ng = P.hg_norm_g[16 * w + li];
    v4u pf[8];
#define HG_LOADPF(cc) do { const size_t r0_ = (size_t)b * T + (size_t)(cc) * 64; _Pragma("unroll") for (int i_ = 0; i_ < 8; ++i_) { const int ix_ = tid + 512 * (i_ & 1); \
        pf[i_] = *(const v4u*)(P.proj + (r0_ + (ix_ >> 4)) * INW + (i_ >> 1) * 512 + h * 128 + (ix_ & 15) * 8); } } while (0)
#define LBAR() asm volatile("s_waitcnt lgkmcnt(0)\n\ts_barrier" ::: "memory")
#define HG_YSTORE(cp) do { const size_t r0_ = (size_t)b * T + (size_t)(cp) * 64; _Pragma("unroll") for (int i_ = 0; i_ < 2; ++i_) { const int ix_ = tid + 512 * i_; \
        const v4u v_ = *(const LAS v4u*)(lds + HG_QT + (ix_ >> 4) * HS + (ix_ & 15) * 16); unsigned char* d_ = (unsigned char*)P.ocat + (r0_ + (ix_ >> 4)) * 3072 + h * 128 + (ix_ & 15) * 8; \
        v2u w8_; w8_.x = cvt4_fp8(bflo(v_.x), bfhi(v_.x), bflo(v_.y), bfhi(v_.y)); w8_.y = cvt4_fp8(bflo(v_.z), bfhi(v_.z), bflo(v_.w), bfhi(v_.w)); ST8_WT(d_, w8_); } } while (0)
    HG_LOADPF(0);
#pragma unroll 1
    for (int c = 0; c < 64; ++c) {
        const size_t row0 = (size_t)b * T + (size_t)c * 64;
        const bool pub = (c > 4) && ((c & 3) == 1);
        if (pub) VM_WAIT();
        if (c > 0) HG_YSTORE(c - 1);
#pragma unroll
        for (int i = 0; i < 8; ++i) { const int ix = tid + 512 * (i & 1); const int reg = (i >> 1) == 0 ? HG_QH : (i >> 1) == 1 ? HG_KT : (i >> 1) == 2 ? HG_VV : HG_OG;
            *(LAS v4u*)(lds + reg + (ix >> 4) * HS + (ix & 15) * 16) = pf[i]; }
        if (c < 63) HG_LOADPF(c + 1);
        LBAR();
        if (pub && tid == 0) { (void)__hip_atomic_fetch_add(P.rdy + b * 16 + (c >> 2) - 1, 1u, RLX_AGENT); (void)__hip_atomic_fetch_add(P.ptot, 1u, RLX_AGENT); }
        float cs[16], kv[16]; float run = 0.f;
#pragma unroll
        for (int i = 0; i < 16; ++i) { const float z = bf2f(*(const LAS unsigned short*)(lds + HG_KT + (16 * tq + i) * HS + kk_ * 2)); const float sg = sigmoidf_(z); const float f = lb + oml * sg;
            run += __logf(fmaxf(f, HG_F_MIN)); cs[i] = run; kv[i] = oml * (1.0f - sg); }
        BQ[tq * 128 + kk_] = run;
        LBAR();
        const float q0 = BQ[kk_], q1 = BQ[128 + kk_], q2 = BQ[256 + kk_], q3 = BQ[384 + kk_];
        const float off = (tq > 0 ? q0 : 0.f) + (tq > 1 ? q1 : 0.f) + (tq > 2 ? q2 : 0.f);
        const float blast = (q0 + q1) + (q2 + q3), ref = q0 + q1;
        if (tq == 0) DD[kk_] = __expf(blast);
        {   const float cref = __expf(blast - ref), eref = __expf(ref); unsigned khw[8];
#pragma unroll
            for (int i = 0; i < 16; ++i) { const int t = 16 * tq + i; const float bt = off + cs[i];
                const float q = bf2f(*(const LAS unsigned short*)(lds + HG_QH + t * HS + kk_ * 2));
                const float e1 = __expf(fminf(fmaxf(bt - ref, -60.f), 60.f)), ie1 = __builtin_amdgcn_rcpf(e1);
                const float kt = kv[i] * ie1, kh = kt * cref;
                const float qe = q * e1;
                *(LAS unsigned short*)(lds + HG_QH + t * HS + kk_ * 2) = (unsigned short)pk2a(qe * eref, 0.f);
                *(LAS unsigned short*)(lds + HG_QT + t * HS + kk_ * 2) = (unsigned short)pk2a(qe, 0.f);
                *(LAS unsigned short*)(lds + HG_KT + t * HS + kk_ * 2) = (unsigned short)pk2a(kt, 0.f);
                if (i & 1) khw[i >> 1] = pk2a(cs[i - 1], kh); else cs[i] = kh; }
            *(LAS v4u*)(lds + HG_KHT + kk_ * HS2 + 32 * tq) = (v4u){khw[0], khw[1], khw[2], khw[3]};
            *(LAS v4u*)(lds + HG_KHT + kk_ * HS2 + 32 * tq + 16) = (v4u){khw[4], khw[5], khw[6], khw[7]}; }
        LBAR();
        {   const int mt = w >> 1;
#pragma unroll
            for (int j = 0; j < 2; ++j) { const int st = 2 * (w & 1) + j; f32x4 a = (f32x4){0.f, 0.f, 0.f, 0.f};
#pragma unroll
                for (int ks = 0; ks < 4; ++ks) { const bf16x8 fa = *(const LAS bf16x8*)(lds + HG_KT + (16 * st + li) * HS + ks * 64 + g * 16);
                    const bf16x8 fb = *(const LAS bf16x8*)(lds + HG_QT + (16 * mt + li) * HS + ks * 64 + g * 16);
                    a = __builtin_amdgcn_mfma_f32_16x16x32_bf16(fa, fb, a, 0, 0, 0); }
                const int tt = 16 * mt + li, s0 = 16 * st + 4 * g;
                v2u wv; wv.x = pk2(s0 <= tt ? a[0] : 0.f, s0 + 1 <= tt ? a[1] : 0.f); wv.y = pk2(s0 + 2 <= tt ? a[2] : 0.f, s0 + 3 <= tt ? a[3] : 0.f);
                *(LAS v2u*)(lds + HG_AM + tt * HS2 + s0 * 2) = wv; }
        }
        LBAR();
        bf16x8 vf[2];
        {   const int q = li >> 2, p = li & 3; const unsigned a0 = ldsb + HG_VV + (8 * g + q) * HS + (16 * w + 4 * p) * 2; s16x4 l0, h0, l1, h1;
            asm volatile("ds_read_b64_tr_b16 %0, %4\n\tds_read_b64_tr_b16 %1, %4 offset:1088\n\tds_read_b64_tr_b16 %2, %4 offset:8704\n\tds_read_b64_tr_b16 %3, %4 offset:9792\n\ts_waitcnt lgkmcnt(0)"
                         : "=&v"(l0), "=&v"(h0), "=&v"(l1), "=&v"(h1) : "v"(a0) : "memory");
            vf[0] = (bf16x8){l0[0], l0[1], l0[2], l0[3], h0[0], h0[1], h0[2], h0[3]}; vf[1] = (bf16x8){l1[0], l1[1], l1[2], l1[3], h1[0], h1[1], h1[2], h1[3]}; }
        bf16x8 sb[4];
#pragma unroll
        for (int s = 0; s < 4; ++s) { v4u x; x.x = pk2(Sacc[2 * s][0], Sacc[2 * s][1]); x.y = pk2(Sacc[2 * s][2], Sacc[2 * s][3]); x.z = pk2(Sacc[2 * s + 1][0], Sacc[2 * s + 1][1]); x.w = pk2(Sacc[2 * s + 1][2], Sacc[2 * s + 1][3]);
            sb[s] = __builtin_bit_cast(bf16x8, x); }
        f32x4 o[4];
#pragma unroll
        for (int mt = 0; mt < 4; ++mt) { f32x4 a = (f32x4){0.f, 0.f, 0.f, 0.f};
#pragma unroll
            for (int ks = 0; ks < 2; ++ks) { const bf16x8 fa = *(const LAS bf16x8*)(lds + HG_AM + (16 * mt + li) * HS2 + ks * 64 + g * 16);
                a = __builtin_amdgcn_mfma_f32_16x16x32_bf16(fa, vf[ks], a, 0, 0, 0); }
#pragma unroll
            for (int s = 0; s < 4; ++s) { const LAS unsigned char* qp = lds + HG_QH + (16 * mt + li) * HS + (32 * s + 4 * g) * 2;
                const v2u lo = *(const LAS v2u*)qp, hi = *(const LAS v2u*)(qp + 32);
                v4u x; x.x = lo.x; x.y = lo.y; x.z = hi.x; x.w = hi.y;
                a = __builtin_amdgcn_mfma_f32_16x16x32_bf16(__builtin_bit_cast(bf16x8, x), sb[s], a, 0, 0, 0); }
            o[mt] = a; }
#pragma unroll
        for (int kt = 0; kt < 8; ++kt) { const f32x4 d = *(const LAS f32x4*)(DD + 16 * kt + 4 * g); f32x4 a = Sacc[kt] * d;
#pragma unroll
            for (int ks = 0; ks < 2; ++ks) { const bf16x8 fa = *(const LAS bf16x8*)(lds + HG_KHT + (16 * kt + li) * HS2 + ks * 64 + g * 16);
                a = __builtin_amdgcn_mfma_f32_16x16x32_bf16(fa, vf[ks], a, 0, 0, 0); }
            Sacc[kt] = a; }
#pragma unroll
        for (int mt = 0; mt < 4; ++mt)
#pragma unroll
            for (int r = 0; r < 4; ++r) { float s = sum16(o[mt][r] * o[mt][r]);
                if (li == 0) SS[(16 * mt + 4 * g + r) * 8 + w] = s; }
        LBAR();
#pragma unroll
        for (int mt = 0; mt < 4; ++mt)
#pragma unroll
            for (int r = 0; r < 4; ++r) { const int t = 16 * mt + 4 * g + r; const f32x4 s0 = *(const LAS f32x4*)(SS + t * 8), s1 = *(const LAS f32x4*)(SS + t * 8 + 4);
                const float ss = ((s0[0] + s0[1]) + (s0[2] + s0[3])) + ((s1[0] + s1[1]) + (s1[2] + s1[3]));
                const float rs = rsqrtf(ss * (1.0f / 128.0f) + RMS_EPS);
                const float og = bf2f(*(const LAS unsigned short*)(lds + HG_OG + t * HS + (16 * w + li) * 2));
                const float y = o[mt][r] * rs * ng * (og * sigmoidf_(og));
                *(LAS unsigned short*)(lds + HG_QT + t * HS + (16 * w + li) * 2) = (unsigned short)f2bf(y); }
        LBAR();
    }
    HG_YSTORE(63);
    VM_WAIT(); __syncthreads();
    if (tid == 0) { (void)__hip_atomic_fetch_add(P.rdy + b * 16 + 15, 1u, RLX_AGENT); (void)__hip_atomic_fetch_add(P.ptot, 1u, RLX_AGENT); }
}
#undef HG_YSTORE
#undef HG_LOADPF

constexpr int RS = 144;
constexpr int RW_RT = 0, RW_AT = 9216, RW_BT = 18432, RW_KT = 27648, RW_ATT = 36864, RW_BHT = 46080, RW_KHT = 55296, RW_VTT = 64512, RW_G = 73728,
              RW_X = 82944,
              RW_LW = RW_X, RW_A1 = RW_X + 17408, RW_WW = RW_X, RW_O = RW_X + 9216,
              RW_AAB = 109568, RW_AAKT = RW_AAB + 4096, RW_ARB = RW_AAKT + 2048, RW_ARK = RW_ARB + 2048, RW_TM = RW_ARK + 2048, RW_TAM = RW_TM + 2048,
              RW_GC = RW_TAM + 2048, RW_BON = RW_GC + 1024, RW_CST = RW_BON + 256, RW_END2 = RW_CST + 3072,
              RW_TW = RW_RT, RW_AD = RW_AT, RW_SG = RW_BT;
static_assert(RW_END2 <= 131072, "rwkv lds");
#ifndef RWDUP
#define RWDUP 0
#endif
#define RWD(k) _Pragma("unroll 1") for (int rwd_ = 0; rwd_ < 1 + ((RWDUP >> (k)) & 1); ++rwd_)
#define RWDB(k) do { if (((RWDUP >> (k)) & 1) && rwd_ == 0) LBAR(); } while (0)
#ifndef RWTIME
#define RWTIME 0
#endif
__device__ __forceinline__ unsigned long long rwkv_unit(const MixP& P, int b, int h, LAS unsigned char* lds) {
    unsigned long long rwacc_ = 0, rwt0_ = 0; (void)rwt0_;
    int tid0_ = mk_tid(); asm volatile("" : "+v"(tid0_));
    const int hc = h * 64;
    int tid = tid0_, lane = tid & 63, g = lane >> 4, li = lane & 15, tt = tid >> 3, sg = tid & 7, c0 = sg * 8;
    const int w = __builtin_amdgcn_readfirstlane(tid >> 6);
    LAS float* LW = (LAS float*)(lds + RW_LW); LAS float* O = (LAS float*)(lds + RW_O); LAS float* GC = (LAS float*)(lds + RW_GC); LAS float* BON = (LAS float*)(lds + RW_BON);
    LAS float* AAB = (LAS float*)(lds + RW_AAB);
    const unsigned ldsb = (unsigned)(uintptr_t)lds;
    f32x4 St[4];
#pragma unroll
    for (int i = 0; i < 4; ++i) St[i] = (f32x4){0.f, 0.f, 0.f, 0.f};
    LAS float* CST = (LAS float*)(lds + RW_CST);
    for (int e = tid; e < 768; e += NTHR) { float v;
        if (e < 192) v = P.rw_mu[(e >> 6) * 512 + hc + (e & 63)]; else if (e < 448) v = P.rw_mu[1536 + (e - 192)];
        else { const int q = (e - 448) >> 6, c = (e - 448) & 63; const float* src = q == 0 ? P.rw_k_k : q == 1 ? P.rw_k_a : q == 2 ? P.rw_r_k : q == 3 ? P.rw_gn_g : P.rw_gn_b; v = src[hc + c]; }
        CST[e] = v; }
    LBAR();
#define LD8(dst, off) do { const f32x4 a_ = *(const LAS f32x4*)(CST + (off)), b_ = *(const LAS f32x4*)(CST + (off) + 4); _Pragma("unroll") for (int q_ = 0; q_ < 4; ++q_) { dst[q_] = a_[q_]; dst[4 + q_] = b_[q_]; } } while (0)
    const int lmt = w >> 1;
    float w0c[2], a0c[2];
#pragma unroll
    for (int n = 0; n < 2; ++n) { const int cc = 16 * (2 * (w & 1) + n) + li; w0c[n] = P.rw_w0[hc + cc]; a0c[n] = P.rw_a0[hc + cc]; }
    {
#pragma unroll 1
        for (int pb = 0; pb < 8; ++pb) { const size_t row = (size_t)b * T + (size_t)h * 512 + (size_t)pb * 64 + tt; const bf16* src = P.proj + row * INW; const bf16* sp = src - INW;
            v4u cw[4], pw[4];
            cw[0] = *(const v4u*)(src + C_RWWD + c0); cw[1] = *(const v4u*)(src + C_RWAD + c0); cw[2] = *(const v4u*)(src + C_RWGD + sg * 16); cw[3] = *(const v4u*)(src + C_RWGD + sg * 16 + 8);
            if (h > 0 || pb > 0 || tt > 0) { pw[0] = *(const v4u*)(sp + C_RWWD + c0); pw[1] = *(const v4u*)(sp + C_RWAD + c0); pw[2] = *(const v4u*)(sp + C_RWGD + sg * 16); pw[3] = *(const v4u*)(sp + C_RWGD + sg * 16 + 8); }
            else { pw[0] = (v4u){0u, 0u, 0u, 0u}; pw[1] = pw[0]; pw[2] = pw[0]; pw[3] = pw[0]; }
            float xw[8], xa[8], xg[16];
#define SHIFT8P(dst, ci, muv) do { const unsigned cw_[4] = {cw[ci].x, cw[ci].y, cw[ci].z, cw[ci].w}, pw_[4] = {pw[ci].x, pw[ci].y, pw[ci].z, pw[ci].w}; \
            _Pragma("unroll") for (int q_ = 0; q_ < 4; ++q_) { const float c_lo = bflo(cw_[q_]), c_hi = bfhi(cw_[q_]); dst[2 * q_] = c_lo + (bflo(pw_[q_]) - c_lo) * muv[2 * q_]; dst[2 * q_ + 1] = c_hi + (bfhi(pw_[q_]) - c_hi) * muv[2 * q_ + 1]; } } while (0)
            float mu_[8];
            LD8(mu_, 192 + c0); SHIFT8P(xw, 0, mu_); LD8(mu_, 256 + c0); SHIFT8P(xa, 1, mu_);
            { float* xg0 = xg; float* xg1 = xg + 8; LD8(mu_, 320 + sg * 16); SHIFT8P(xg0, 2, mu_); LD8(mu_, 328 + sg * 16); SHIFT8P(xg1, 3, mu_); }
#undef SHIFT8P
            bf16* dst = P.act + row * 1536; v4u o;
            o.x = pk2a(tanh_fast(xw[0]), tanh_fast(xw[1])); o.y = pk2a(tanh_fast(xw[2]), tanh_fast(xw[3])); o.z = pk2a(tanh_fast(xw[4]), tanh_fast(xw[5])); o.w = pk2a(tanh_fast(xw[6]), tanh_fast(xw[7]));
            { bf16* d_ = dst + c0; ST16_WT(d_, o); }
            o.x = pk2a(xa[0], xa[1]); o.y = pk2a(xa[2], xa[3]); o.z = pk2a(xa[4], xa[5]); o.w = pk2a(xa[6], xa[7]);
            { bf16* d_ = dst + 64 + c0; ST16_WT(d_, o); }
            o.x = pk2a(sigmoidf_(xg[0]), sigmoidf_(xg[1])); o.y = pk2a(sigmoidf_(xg[2]), sigmoidf_(xg[3])); o.z = pk2a(sigmoidf_(xg[4]), sigmoidf_(xg[5])); o.w = pk2a(sigmoidf_(xg[6]), sigmoidf_(xg[7]));
            { bf16* d_ = dst + 128 + sg * 16; ST16_WT(d_, o); }
            o.x = pk2a(sigmoidf_(xg[8]), sigmoidf_(xg[9])); o.y = pk2a(sigmoidf_(xg[10]), sigmoidf_(xg[11])); o.z = pk2a(sigmoidf_(xg[12]), sigmoidf_(xg[13])); o.w = pk2a(sigmoidf_(xg[14]), sigmoidf_(xg[15]));
            { bf16* d_ = dst + 128 + sg * 16 + 8; ST16_WT(d_, o); }
        }
        VM_WAIT(); __syncthreads();
        if (mk_tid() == 0) { (void)__hip_atomic_fetch_add(P.pre + b, 1u, RLX_AGENT);
            unsigned sp_ = 0; while (__hip_atomic_load(P.pre + b, RLX_AGENT) < 8u) { __builtin_amdgcn_s_sleep(1); if (++sp_ > XB_SPIN_CAP) break; }
            __builtin_amdgcn_fence(__ATOMIC_ACQUIRE, "agent"); asm volatile("s_waitcnt vmcnt(0)" ::: "memory"); }
        __syncthreads();
    }
    v4u cur[3], prv[3], act[4];
    {   const bf16* src = P.proj + ((size_t)b * T + tt) * INW; const bf16* ap = P.act + ((size_t)b * T + tt) * 1536;
        cur[0] = *(const v4u*)(src + C_RWR + hc + c0); cur[1] = *(const v4u*)(src + C_RWK + hc + c0); cur[2] = *(const v4u*)(src + C_RWV + hc + c0);
        act[0] = *(const v4u*)(ap + c0); act[1] = *(const v4u*)(ap + 64 + c0); act[2] = *(const v4u*)(ap + 128 + sg * 16); act[3] = *(const v4u*)(ap + 128 + sg * 16 + 8);
        if (tt > 0) { const bf16* sp = src - INW; prv[0] = *(const v4u*)(sp + C_RWR + hc + c0); prv[1] = *(const v4u*)(sp + C_RWK + hc + c0); prv[2] = *(const v4u*)(sp + C_RWV + hc + c0); }
        else {
#pragma unroll
            for (int i = 0; i < 3; ++i) prv[i] = (v4u){0u, 0u, 0u, 0u}; } }
    bf16x8 bwf[2][2], baf[2][2], bgf[2][4];
#define RW_LOADW() do { _Pragma("unroll") for (int n = 0; n < 2; ++n) { const int cc = 16 * (2 * (w & 1) + n) + li; \
        _Pragma("unroll") for (int ks = 0; ks < 2; ++ks) { bwf[n][ks] = *(const bf16x8*)(P.wupT + (size_t)(hc + cc) * 64 + ks * 32 + g * 8); baf[n][ks] = *(const bf16x8*)(P.aupT + (size_t)(hc + cc) * 64 + ks * 32 + g * 8); } \
        _Pragma("unroll") for (int ks = 0; ks < 4; ++ks) bgf[n][ks] = *(const bf16x8*)(P.gupT + (size_t)(hc + cc) * 128 + ks * 32 + g * 8); } \
    } while (0)
    RW_LOADW();
#pragma unroll 1
    for (int blk = 0; blk < 64; ++blk) {
        const size_t row0 = (size_t)b * T + (size_t)blk * 64;
        { int t_ = tid0_; asm volatile("" : "+v"(t_)); tid = t_; lane = tid & 63; g = lane >> 4; li = lane & 15; tt = tid >> 3; sg = tid & 7; c0 = sg * 8; }
        if (RWTIME == 2) rwt0_ = __builtin_amdgcn_s_memrealtime();
        float rr[8], k1[8], vv[8];
        RWD(0) {
#define SHIFT8(dst, ci, muv) do { const unsigned cw_[4] = {cur[ci].x, cur[ci].y, cur[ci].z, cur[ci].w}, pw_[4] = {prv[ci].x, prv[ci].y, prv[ci].z, prv[ci].w}; \
            _Pragma("unroll") for (int q_ = 0; q_ < 4; ++q_) { const float c_lo = bflo(cw_[q_]), c_hi = bfhi(cw_[q_]); dst[2 * q_] = c_lo + (bflo(pw_[q_]) - c_lo) * muv[2 * q_]; dst[2 * q_ + 1] = c_hi + (bfhi(pw_[q_]) - c_hi) * muv[2 * q_ + 1]; } } while (0)
            float mu_[8];
            LD8(mu_, c0); SHIFT8(rr, 0, mu_); LD8(mu_, 64 + c0); SHIFT8(k1, 1, mu_); LD8(mu_, 128 + c0); SHIFT8(vv, 2, mu_);
#undef SHIFT8
            *(LAS v4u*)(lds + RW_TW + tt * RS + c0 * 2) = act[0];
            *(LAS v4u*)(lds + RW_AD + tt * RS + c0 * 2) = act[1];
            *(LAS v4u*)(lds + RW_SG + tt * 272 + sg * 32) = act[2];
            *(LAS v4u*)(lds + RW_SG + tt * 272 + sg * 32 + 16) = act[3];
        RWDB(0); }
        LBAR();
        if (RWTIME == 2) rwacc_ += __builtin_amdgcn_s_memrealtime() - rwt0_;
        RWD(1) {
#pragma unroll
        for (int n = 0; n < 2; ++n) { const int ntile = 2 * (w & 1) + n, cc = 16 * ntile + li;
            f32x4 aw = (f32x4){0.f, 0.f, 0.f, 0.f}, aa = aw, ag = aw;
#pragma unroll
            for (int ks = 0; ks < 2; ++ks) { const bf16x8 f1 = *(const LAS bf16x8*)(lds + RW_TW + (16 * lmt + li) * RS + ks * 64 + g * 16), f2 = *(const LAS bf16x8*)(lds + RW_AD + (16 * lmt + li) * RS + ks * 64 + g * 16);
                aw = __builtin_amdgcn_mfma_f32_16x16x32_bf16(f1, bwf[n][ks], aw, 0, 0, 0); aa = __builtin_amdgcn_mfma_f32_16x16x32_bf16(f2, baf[n][ks], aa, 0, 0, 0); }
#pragma unroll
            for (int ks = 0; ks < 4; ++ks) { const bf16x8 f3 = *(const LAS bf16x8*)(lds + RW_SG + (16 * lmt + li) * 272 + ks * 64 + g * 16);
                ag = __builtin_amdgcn_mfma_f32_16x16x32_bf16(f3, bgf[n][ks], ag, 0, 0, 0); }
            float lw4[4];
#pragma unroll
            for (int r = 0; r < 4; ++r) lw4[r] = -0.60653065971263342f * sigmoidf_(w0c[n] + aw[r]);
            lw4[1] += lw4[0]; lw4[2] += lw4[1]; lw4[3] += lw4[2];
            float tot = lw4[3]; { const float u1 = __shfl_up(tot, 16); if (g >= 1) tot += u1; const float u2 = __shfl_up(tot, 32); if (g >= 2) tot += u2; }
            const float excl = tot - lw4[3];
#pragma unroll
            for (int r = 0; r < 4; ++r) { const int t = 16 * lmt + 4 * g + r;
                LW[t * 68 + cc] = excl + lw4[r];
                *(LAS unsigned short*)(lds + RW_A1 + t * RS + cc * 2) = (unsigned short)f2bf(sigmoidf_(a0c[n] + aa[r]));
                *(LAS unsigned short*)(lds + RW_G + t * RS + cc * 2) = (unsigned short)f2bf(ag[r]); }
            if (g == 3) GC[lmt * 64 + cc] = __expf(tot);
        }
        RWDB(1); }
        const bool pub = (blk > 4) && ((blk & 3) == 1);
        if (pub) asm volatile("s_waitcnt vmcnt(1)" ::: "memory");
        LBAR();
        if (pub && tid == 0) { (void)__hip_atomic_fetch_add(P.rdr + b * 16 + (blk >> 2) - 1, 1u, RLX_AGENT); (void)__hip_atomic_fetch_add(P.ptot, 1u, RLX_AGENT); }
        RWD(2) {   float a[8], clt[8], clm[8], clc[8];
            { const v4u av = *(const LAS v4u*)(lds + RW_A1 + tt * RS + c0 * 2); a[0] = bflo(av.x); a[1] = bfhi(av.x); a[2] = bflo(av.y); a[3] = bfhi(av.y); a[4] = bflo(av.z); a[5] = bfhi(av.z); a[6] = bflo(av.w); a[7] = bfhi(av.w); }
            const int tl = tt & 15, tC = (tt | 15);
            { const f32x4 x0 = *(const LAS f32x4*)(LW + tt * 68 + c0), x1 = *(const LAS f32x4*)(LW + tt * 68 + c0 + 4), y0 = *(const LAS f32x4*)(LW + tC * 68 + c0), y1 = *(const LAS f32x4*)(LW + tC * 68 + c0 + 4);
              f32x4 z0 = (f32x4){0.f, 0.f, 0.f, 0.f}, z1 = z0; if (tl > 0) { z0 = *(const LAS f32x4*)(LW + (tt - 1) * 68 + c0); z1 = *(const LAS f32x4*)(LW + (tt - 1) * 68 + c0 + 4); }
#pragma unroll
              for (int j = 0; j < 4; ++j) { clt[j] = x0[j]; clt[4 + j] = x1[j]; clc[j] = y0[j]; clc[4 + j] = y1[j]; clm[j] = z0[j]; clm[4 + j] = z1[j]; } }
            float kk[8], kkc[8], kac[8], rkc[8]; float ss = 0.f;
            LD8(kkc, 448 + c0); LD8(kac, 512 + c0); LD8(rkc, 576 + c0);
#pragma unroll
            for (int j = 0; j < 8; ++j) { kk[j] = k1[j] * kkc[j]; ss += kk[j] * kk[j]; }
            ss = sum8(ss);
            const float inv = rsqrtf(fmaxf(ss, 1e-12f)); float bon = 0.f;
            float rt[8], at[8], bt[8], kt[8], bh[8], kh[8];
#pragma unroll
            for (int j = 0; j < 8; ++j) { const float kn = kk[j] * inv, k2 = k1[j] * (1.0f + (a[j] - 1.0f) * kac[j]); const float av = -kn, bv = kn * a[j];
                const float ig = __expf(-clt[j]), gh = __expf(clc[j] - clt[j]);
                rt[j] = rr[j] * __expf(clt[j]); at[j] = av * __expf(clm[j]); bt[j] = bv * ig; kt[j] = k2 * ig; bh[j] = bv * gh; kh[j] = k2 * gh; bon += rr[j] * k2 * rkc[j]; }
            bon = sum8(bon);
            if (sg == 0) BON[tt] = bon;
            v4u o;
#define PK8(src) (o.x = pk2a(src[0], src[1]), o.y = pk2a(src[2], src[3]), o.z = pk2a(src[4], src[5]), o.w = pk2a(src[6], src[7]), o)
            *(LAS v4u*)(lds + RW_RT + tt * RS + c0 * 2) = PK8(rt); *(LAS v4u*)(lds + RW_AT + tt * RS + c0 * 2) = PK8(at); *(LAS v4u*)(lds + RW_BT + tt * RS + c0 * 2) = PK8(bt); *(LAS v4u*)(lds + RW_KT + tt * RS + c0 * 2) = PK8(kt);
            *(LAS v4u*)(lds + RW_BHT + tt * RS + c0 * 2) = PK8(bh); *(LAS v4u*)(lds + RW_KHT + tt * RS + c0 * 2) = PK8(kh); *(LAS v4u*)(lds + RW_VTT + tt * RS + c0 * 2) = PK8(vv);
#undef PK8
        RWDB(2); }
        LBAR();
        RWD(3) {   const int j = w >> 1; const int rowb = (16 * j + li) * RS;
            bf16x8 fat[2], fbt[2], fkt[2], frt[2];
#pragma unroll
            for (int ks = 0; ks < 2; ++ks) { fbt[ks] = *(const LAS bf16x8*)(lds + RW_BT + rowb + ks * 64 + g * 16); fkt[ks] = *(const LAS bf16x8*)(lds + RW_KT + rowb + ks * 64 + g * 16);
                if ((w & 1) == 0) fat[ks] = *(const LAS bf16x8*)(lds + RW_AT + rowb + ks * 64 + g * 16); else frt[ks] = *(const LAS bf16x8*)(lds + RW_RT + rowb + ks * 64 + g * 16); }
            if ((w & 1) == 0) {
                f32x4 x = (f32x4){0.f, 0.f, 0.f, 0.f}, y = x;
#pragma unroll
                for (int ks = 0; ks < 2; ++ks) { x = __builtin_amdgcn_mfma_f32_16x16x32_bf16(fbt[ks], fat[ks], x, 0, 0, 0);
                    y = __builtin_amdgcn_mfma_f32_16x16x32_bf16(fat[ks], fkt[ks], y, 0, 0, 0); }
                f32x4 xm; v2u ym;
#pragma unroll
                for (int r = 0; r < 4; ++r) xm[r] = (4 * g + r < li) ? x[r] : 0.f;
                *(LAS f32x4*)(AAB + (j * 16 + li) * 16 + 4 * g) = xm;
                ym.x = pk2(li < 4 * g ? y[0] : 0.f, li < 4 * g + 1 ? y[1] : 0.f); ym.y = pk2(li < 4 * g + 2 ? y[2] : 0.f, li < 4 * g + 3 ? y[3] : 0.f);
                *(LAS v2u*)(lds + RW_AAKT + (j * 16 + li) * 32 + 8 * g) = ym;
            } else {
                f32x4 x = (f32x4){0.f, 0.f, 0.f, 0.f}, y = x;
#pragma unroll
                for (int ks = 0; ks < 2; ++ks) { x = __builtin_amdgcn_mfma_f32_16x16x32_bf16(fbt[ks], frt[ks], x, 0, 0, 0);
                    y = __builtin_amdgcn_mfma_f32_16x16x32_bf16(fkt[ks], frt[ks], y, 0, 0, 0); }
                v2u xm, ym;
                xm.x = pk2(4 * g <= li ? x[0] : 0.f, 4 * g + 1 <= li ? x[1] : 0.f); xm.y = pk2(4 * g + 2 <= li ? x[2] : 0.f, 4 * g + 3 <= li ? x[3] : 0.f);
                ym.x = pk2(4 * g <= li ? y[0] : 0.f, 4 * g + 1 <= li ? y[1] : 0.f); ym.y = pk2(4 * g + 2 <= li ? y[2] : 0.f, 4 * g + 3 <= li ? y[3] : 0.f);
                *(LAS v2u*)(lds + RW_ARB + (j * 16 + li) * 32 + 8 * g) = xm; *(LAS v2u*)(lds + RW_ARK + (j * 16 + li) * 32 + 8 * g) = ym;
            }
        RWDB(3); }
        LBAR();
        RWD(4) { if (w == 0) { const int j = g, col = li; float x[16];
#pragma unroll
            for (int t = 0; t < 16; ++t) { float pq[4] = {(t == col) ? 1.f : 0.f, 0.f, 0.f, 0.f};
#pragma unroll
                for (int q = 0; q < (t + 3) / 4; ++q) { const f32x4 av = *(const LAS f32x4*)(AAB + (j * 16 + t) * 16 + 4 * q);
#pragma unroll
                    for (int e = 0; e < 4; ++e) if (4 * q + e < t) pq[q] += av[e] * x[4 * q + e]; }
                const float s = (pq[0] + pq[1]) + (pq[2] + pq[3]);
                x[t] = s; }
#pragma unroll
            for (int t = 0; t < 16; ++t) *(LAS unsigned short*)(lds + RW_TM + (j * 16 + t) * 32 + col * 2) = (unsigned short)f2bf(x[t]); }
        RWDB(4); }
        LBAR();
        RWD(5) {   const int j = w >> 1; const bf16x8 zf = (bf16x8){0, 0, 0, 0, 0, 0, 0, 0};
            const bf16x8 ft = (g < 2) ? *(const LAS bf16x8*)(lds + RW_TM + (j * 16 + li) * 32 + g * 16) : zf;
#pragma unroll
            for (int n = 0; n < 2; ++n) { const int ct = 2 * (w & 1) + n;
                bf16x8 fa; { const unsigned a0_ = ldsb + RW_AT + (16 * j + 8 * (g & 1) + (li >> 2)) * RS + (16 * ct + 4 * (li & 3)) * 2; s16x4 lo_, hi_;
                    asm volatile("ds_read_b64_tr_b16 %0, %2\n\tds_read_b64_tr_b16 %1, %2 offset:576\n\ts_waitcnt lgkmcnt(0)" : "=&v"(lo_), "=&v"(hi_) : "v"(a0_) : "memory");
                    fa = (g < 2) ? (bf16x8){lo_[0], lo_[1], lo_[2], lo_[3], hi_[0], hi_[1], hi_[2], hi_[3]} : zf; }
                f32x4 x = __builtin_amdgcn_mfma_f32_16x16x32_bf16(fa, ft, (f32x4){0.f, 0.f, 0.f, 0.f}, 0, 0, 0);
                v2u xm; xm.x = pk2(x[0], x[1]); xm.y = pk2(x[2], x[3]);
                *(LAS v2u*)(lds + RW_WW + (16 * j + li) * RS + (16 * ct + 4 * g) * 2) = xm; }
            if ((w & 1) == 0) { const bf16x8 fa = (g < 2) ? *(const LAS bf16x8*)(lds + RW_AAKT + (j * 16 + li) * 32 + g * 16) : zf;
                f32x4 x = __builtin_amdgcn_mfma_f32_16x16x32_bf16(fa, ft, (f32x4){0.f, 0.f, 0.f, 0.f}, 0, 0, 0);
                v2u xm; xm.x = pk2(x[0], x[1]); xm.y = pk2(x[2], x[3]);
                *(LAS v2u*)(lds + RW_TAM + (j * 16 + li) * 32 + 8 * g) = xm; }
        RWDB(5); }
        LBAR();
        if (blk < 63) { const bf16* src = P.proj + (row0 + 64 + tt) * INW; const bf16* sp = src - INW; const bf16* ap = P.act + (row0 + 64 + tt) * 1536;
            cur[0] = *(const v4u*)(src + C_RWR + hc + c0); cur[1] = *(const v4u*)(src + C_RWK + hc + c0); cur[2] = *(const v4u*)(src + C_RWV + hc + c0);
            prv[0] = *(const v4u*)(sp + C_RWR + hc + c0); prv[1] = *(const v4u*)(sp + C_RWK + hc + c0); prv[2] = *(const v4u*)(sp + C_RWV + hc + c0);
            act[0] = *(const v4u*)(ap + c0); act[1] = *(const v4u*)(ap + 64 + c0); act[2] = *(const v4u*)(ap + 128 + sg * 16); act[3] = *(const v4u*)(ap + 128 + sg * 16 + 8); }
        if (RWTIME == 1) rwt0_ = __builtin_amdgcn_s_memrealtime();
        if (w < 4) {
#pragma unroll 1
            for (int j = 0; j < 4; ++j) {
                bf16x8 sb[2];
#pragma unroll
                for (int s = 0; s < 2; ++s) { v4u x; x.x = pk2(St[2 * s][0], St[2 * s][1]); x.y = pk2(St[2 * s][2], St[2 * s][3]); x.z = pk2(St[2 * s + 1][0], St[2 * s + 1][1]); x.w = pk2(St[2 * s + 1][2], St[2 * s + 1][3]); sb[s] = __builtin_bit_cast(bf16x8, x); }
                v2u vf, bhf[4], khf[4];
                {   const unsigned rb_ = (16 * j + 4 * g + (li >> 2)) * RS + 4 * (li & 3) * 2; const unsigned av_ = ldsb + RW_VTT + rb_ + 32 * w, ab_ = ldsb + RW_BHT + rb_, ak_ = ldsb + RW_KHT + rb_;
                    asm volatile("ds_read_b64_tr_b16 %0, %9\n\tds_read_b64_tr_b16 %1, %10\n\tds_read_b64_tr_b16 %2, %10 offset:32\n\tds_read_b64_tr_b16 %3, %10 offset:64\n\tds_read_b64_tr_b16 %4, %10 offset:96\n\t"
                                 "ds_read_b64_tr_b16 %5, %11\n\tds_read_b64_tr_b16 %6, %11 offset:32\n\tds_read_b64_tr_b16 %7, %11 offset:64\n\tds_read_b64_tr_b16 %8, %11 offset:96\n\ts_waitcnt lgkmcnt(0)"
                                 : "=&v"(vf), "=&v"(bhf[0]), "=&v"(bhf[1]), "=&v"(bhf[2]), "=&v"(bhf[3]), "=&v"(khf[0]), "=&v"(khf[1]), "=&v"(khf[2]), "=&v"(khf[3]) : "v"(av_), "v"(ab_), "v"(ak_) : "memory"); }
                const int trow = (16 * j + li) * RS;
                f32x4 u = (f32x4){0.f, 0.f, 0.f, 0.f}, o = u;
#pragma unroll
                for (int s = 0; s < 2; ++s) { const v2u lo = *(const LAS v2u*)(lds + RW_WW + trow + (32 * s + 4 * g) * 2), hi = *(const LAS v2u*)(lds + RW_WW + trow + (32 * s + 16 + 4 * g) * 2);
                    v4u x; x.x = lo.x; x.y = lo.y; x.z = hi.x; x.w = hi.y; u = __builtin_amdgcn_mfma_f32_16x16x32_bf16(__builtin_bit_cast(bf16x8, x), sb[s], u, 0, 0, 0);
                    const v2u lo2 = *(const LAS v2u*)(lds + RW_RT + trow + (32 * s + 4 * g) * 2), hi2 = *(const LAS v2u*)(lds + RW_RT + trow + (32 * s + 16 + 4 * g) * 2);
                    v4u y; y.x = lo2.x; y.y = lo2.y; y.z = hi2.x; y.w = hi2.y; o = __builtin_amdgcn_mfma_f32_16x16x32_bf16(__builtin_bit_cast(bf16x8, y), sb[s], o, 0, 0, 0); }
                {   const v2u ta = *(const LAS v2u*)(lds + RW_TAM + (j * 16 + li) * 32 + 8 * g);
                    v4u x; x.x = ta.x; x.y = ta.y; x.z = 0u; x.w = 0u; v4u y; y.x = vf.x; y.y = vf.y; y.z = 0u; y.w = 0u;
                    u = __builtin_amdgcn_mfma_f32_16x16x32_bf16(__builtin_bit_cast(bf16x8, x), __builtin_bit_cast(bf16x8, y), u, 0, 0, 0); }
                v4u b2; b2.x = pk2(u[0], u[1]); b2.y = pk2(u[2], u[3]); b2.z = vf.x; b2.w = vf.y;
                const bf16x8 b2f = __builtin_bit_cast(bf16x8, b2);
                {   const v2u rb = *(const LAS v2u*)(lds + RW_ARB + (j * 16 + li) * 32 + 8 * g), rk = *(const LAS v2u*)(lds + RW_ARK + (j * 16 + li) * 32 + 8 * g);
                    v4u x; x.x = rb.x; x.y = rb.y; x.z = rk.x; x.w = rk.y; o = __builtin_amdgcn_mfma_f32_16x16x32_bf16(__builtin_bit_cast(bf16x8, x), b2f, o, 0, 0, 0); }
#pragma unroll
                for (int r = 0; r < 4; ++r) O[(16 * j + 4 * g + r) * 68 + 16 * w + li] = o[r];
#pragma unroll
                for (int kt = 0; kt < 4; ++kt) { const f32x4 gc = *(const LAS f32x4*)(GC + j * 64 + 16 * kt + 4 * g);
                    v4u x; x.x = bhf[kt].x; x.y = bhf[kt].y; x.z = khf[kt].x; x.w = khf[kt].y;
                    St[kt] = __builtin_amdgcn_mfma_f32_16x16x32_bf16(__builtin_bit_cast(bf16x8, x), b2f, St[kt] * gc, 0, 0, 0); }
            }
        }
        LBAR();
        if (RWTIME == 1) rwacc_ += __builtin_amdgcn_s_memrealtime() - rwt0_;
        RW_LOADW();
        RWD(6) {   const f32x4 o0 = *(const LAS f32x4*)(O + tt * 68 + c0), o1 = *(const LAS f32x4*)(O + tt * 68 + c0 + 4); float ov[8];
#pragma unroll
            for (int j = 0; j < 4; ++j) { ov[j] = o0[j]; ov[4 + j] = o1[j]; }
            float s = 0.f;
#pragma unroll
            for (int j = 0; j < 8; ++j) s += ov[j];
            s = sum8(s);
            const float mean = s * (1.0f / 64.0f); float q = 0.f;
#pragma unroll
            for (int j = 0; j < 8; ++j) { const float d = ov[j] - mean; q += d * d; }
            q = sum8(q);
            const float rs = rsqrtf(q * (1.0f / 64.0f) + RW_GN_EPS), bon = BON[tt];
            const v4u gv = *(const LAS v4u*)(lds + RW_G + tt * RS + c0 * 2); const float gg[8] = {bflo(gv.x), bfhi(gv.x), bflo(gv.y), bfhi(gv.y), bflo(gv.z), bfhi(gv.z), bflo(gv.w), bfhi(gv.w)};
            float y[8], gng[8], gnb[8]; LD8(gng, 640 + c0); LD8(gnb, 704 + c0);
#pragma unroll
            for (int j = 0; j < 8; ++j) y[j] = ((ov[j] - mean) * rs * gng[j] + gnb[j] + bon * vv[j]) * gg[j];
            v2u wv; wv.x = cvt4_fp8(y[0], y[1], y[2], y[3]); wv.y = cvt4_fp8(y[4], y[5], y[6], y[7]);
            unsigned char* dst_ = (unsigned char*)P.ocat + (row0 + tt) * 3072 + 1024 + hc + c0; ST8_WT(dst_, wv); RWDB(6); }
    }
    VM_WAIT(); __syncthreads();
    if (mk_tid() == 0) { (void)__hip_atomic_fetch_add(P.rdr + b * 16 + 15, 1u, RLX_AGENT); (void)__hip_atomic_fetch_add(P.ptot, 1u, RLX_AGENT); }
    return rwacc_;
#undef RW_LOADW
#undef LD8
#undef LBAR
}
struct Args { const float* in[31]; float* out; unsigned char* ws; int ph_lo, ph_hi; };
typedef const __attribute__((address_space(4))) Args* ArgP;
struct Frame {
    LAS unsigned char* lds; volatile LAS unsigned* MISC; gu32* ctl;
    int tid, lane, wave, vcu, G, bx;
};
constexpr int SM_HGLB = 0;
constexpr int SM_LAM = 2048;

__device__ __forceinline__ void transpose_item_f8(const float* W, int N, unsigned char* WT8, int k0, int n0, int drow0, LAS float* scr, int lane, int dpb = 2048) {
#pragma unroll
    for (int i = 0; i < 8; ++i) { const int kk = 8 * i + (lane >> 3), nq = (lane & 7) * 4; const f32x4 v = *(const f32x4*)(W + (size_t)(k0 + kk) * N + n0 + nq);
        scr[kk * 33 + nq] = v[0]; scr[kk * 33 + nq + 1] = v[1]; scr[kk * 33 + nq + 2] = v[2]; scr[kk * 33 + nq + 3] = v[3]; }
    LDS_WAIT(); asm volatile("" ::: "memory");
    const int c = lane & 7;
#pragma unroll
    for (int j = 0; j < 4; ++j) { const int n = (lane >> 3) + 8 * j; const LAS float* s = scr + (8 * c) * 33 + n;
        v2u o; o.x = cvt4_fp8(s[0 * 33] * WG8_SCALE, s[1 * 33] * WG8_SCALE, s[2 * 33] * WG8_SCALE, s[3 * 33] * WG8_SCALE); o.y = cvt4_fp8(s[4 * 33] * WG8_SCALE, s[5 * 33] * WG8_SCALE, s[6 * 33] * WG8_SCALE, s[7 * 33] * WG8_SCALE);
        *(GAS v2u*)(WT8 + (size_t)(drow0 + n) * dpb + k0 + 8 * c) = o; }
    LDS_WAIT(); asm volatile("" ::: "memory");
}
__device__ __forceinline__ void transpose_item(const float* W, int K, int N, bf16* WT, int k0, int n0, int drow0, LAS float* scr, int lane, int dp = 0) {
    if (dp == 0) dp = K;
#pragma unroll
    for (int i = 0; i < 8; ++i) { const int kk = 8 * i + (lane >> 3), nq = (lane & 7) * 4; const f32x4 v = *(const f32x4*)(W + (size_t)(k0 + kk) * N + n0 + nq);
        scr[kk * 33 + nq] = v[0]; scr[kk * 33 + nq + 1] = v[1]; scr[kk * 33 + nq + 2] = v[2]; scr[kk * 33 + nq + 3] = v[3]; }
    LDS_WAIT(); asm volatile("" ::: "memory");
    const int c = lane & 7;
#pragma unroll
    for (int j = 0; j < 4; ++j) { const int n = (lane >> 3) + 8 * j; const LAS float* s = scr + (8 * c) * 33 + n;
        v4u o; o.x = pk2(s[0 * 33], s[1 * 33]); o.y = pk2(s[2 * 33], s[3 * 33]); o.z = pk2(s[4 * 33], s[5 * 33]); o.w = pk2(s[6 * 33], s[7 * 33]);
        *(GAS v4u*)(WT + (size_t)(drow0 + n) * dp + k0 + 8 * c) = o; }
    LDS_WAIT(); asm volatile("" ::: "memory");
}
constexpr int CV_IN = 2688, CV_MG = 1536, CV_BR = 768, CV_OUT = 512, CV_EX = 4096, CV_TOTAL = CV_IN + CV_MG + CV_BR + CV_OUT + 3 * CV_EX;
__device__ __forceinline__ void conv_layer(const Frame& F, ArgP A, int l) {
    LAS float* scr = (LAS float*)(F.lds + F.wave * 16384);
    const int gw = F.vcu * NWAVES + F.wave, NGW = F.G * NWAVES;
    bf16* wa = (bf16*)(A->ws + WS_WA); bf16* we = (bf16*)(A->ws + WS_WE);
    for (int it = gw; it < CV_TOTAL; it += NGW) {
        int r = it;
        if (r < CV_IN) { const int kb = r / 168, nb = r % 168;
            if ((F8_PROJ_COLS >> (nb >> 3)) & 1u) transpose_item_f8(A->in[4] + (size_t)l * DM * INW, INW, (unsigned char*)wa + WA_IN, 64 * kb, 32 * nb, 32 * nb, scr, F.lane, 2048);
            else transpose_item(A->in[4] + (size_t)l * DM * INW, DM, INW, wa + WA_IN / 2, 64 * kb, 32 * nb, 32 * nb, scr, F.lane); continue; } r -= CV_IN;
        if (r < CV_MG) { const int br = r / 512, q = r % 512, kb = q / 32, nb = q % 32; transpose_item_f8(A->in[20] + ((size_t)l * 3 + br) * DM * DM, DM, (unsigned char*)wa + WA_MERGE, 64 * kb, 32 * nb, br * DM + 32 * nb, scr, F.lane); continue; } r -= CV_MG;
        if (r < CV_BR) { const int kb = r / 32, nb = r % 32; transpose_item_f8(A->in[22] + (size_t)l * 1536 * DM, DM, (unsigned char*)wa + WA_BRANCH, 64 * kb, 32 * nb, 32 * nb, scr, F.lane, 3072); continue; } r -= CV_BR;
        if (r < CV_OUT) { const int kb = r / 32, nb = r % 32; transpose_item_f8(A->in[23] + (size_t)l * DM * DM, DM, (unsigned char*)wa + WA_OUT, 64 * kb, 32 * nb, 32 * nb, scr, F.lane, 2048); continue; } r -= CV_OUT;
        if (r < 2 * CV_EX) { const int up = r / CV_EX, q = r % CV_EX, e = q / 256, q2 = q % 256, kb = q2 / 16, nb = q2 % 16, n0 = 32 * nb;
            transpose_item_f8(A->in[28 + up] + ((size_t)l * NE + e) * DM * DE, DE, (unsigned char*)we + WE_GU + (size_t)e * DM * DM * 2, 64 * kb, n0, (n0 >> 7) * 256 + up * 128 + (n0 & 127), scr, F.lane, 2048); continue; } r -= 2 * CV_EX;
        { const int e = r / 256, q2 = r % 256, kb = q2 / 32, nb = q2 % 32; transpose_item_f8(A->in[30] + ((size_t)l * NE + e) * DE * DM, DM, (unsigned char*)we + WE_DT + (size_t)e * DM * DE * 2, 64 * kb, 32 * nb, 32 * nb, scr, F.lane, 1024); }
    }
}

__device__ __forceinline__ void phase_prologue(const Frame& F, ArgP A) {
    {   LAS float* cond = (LAS float*)(F.lds);
        float* modp = (float*)(A->ws + WS_MODP);
        for (int it = F.vcu; it < NL * 24 * 4; it += F.G) { const int l = it / 96, r = it % 96, nb = r / 4, kq = r % 4;
            __syncthreads();
            for (int e = F.tid; e < 8 * 256; e += NTHR) { const float cv = A->in[1][(e >> 8) * DM + kq * 256 + (e & 255)]; cond[e] = cv * sigmoidf_(cv); }
            __syncthreads();
            const int n = nb * 256 + (F.tid & 255), kh = F.tid >> 8; float acc[8];
#pragma unroll
            for (int b = 0; b < 8; ++b) acc[b] = 0.f;
            const float* wp = A->in[2] + ((size_t)l * DM + kq * 256 + kh * 128) * 6144 + n;
#pragma unroll 4
            for (int k = 0; k < 128; ++k) { const float wv = wp[(size_t)k * 6144];
#pragma unroll
                for (int b = 0; b < 8; ++b) acc[b] += cond[b * 256 + kh * 128 + k] * wv; }
            const int kp = kq * 2 + kh;
#pragma unroll
            for (int b = 0; b < 8; ++b) modp[(((size_t)kp * NL + l) * NB + b) * 6144 + n] = acc[b]; }
        __syncthreads();
    }
    conv_layer(F, A, 0);
    {   bf16* lo = (bf16*)(A->ws + WS_LORA); const int gt = F.vcu * NTHR + F.tid, NGT = F.G * NTHR;
        for (int e = gt; e < NL * 512 * 64; e += NGT) { const int l = e / 32768, r = e % 32768, c = r >> 6, j = r & 63;
            lo[(size_t)l * 131072 + c * 64 + j] = (bf16)f2bf(A->in[11][(size_t)l * 32768 + j * 512 + c]);
            lo[(size_t)l * 131072 + 32768 + c * 64 + j] = (bf16)f2bf(A->in[13][(size_t)l * 32768 + j * 512 + c]); }
        for (int e = gt; e < NL * 512 * 128; e += NGT) { const int l = e / 65536, r = e % 65536, c = r >> 7, j = r & 127;
            lo[(size_t)l * 131072 + 65536 + c * 128 + j] = (bf16)f2bf(A->in[14][(size_t)l * 65536 + j * 512 + c]); }
    }
    if (F.vcu == 0) { float* sm = (float*)(A->ws + WS_SMALL);
        { const int k = F.tid; float z[4], mx = -1e30f;
#pragma unroll
          for (int l = 0; l < 4; ++l) { z[l] = A->in[5][l * 512 + k]; mx = fmaxf(mx, z[l]); }
          float s = 0.f;
#pragma unroll
          for (int l = 0; l < 4; ++l) { z[l] = __expf(z[l] - mx); s += z[l]; }
          const float inv = 1.0f / s;
          sm[SM_HGLB + k] = 0.f; sm[SM_HGLB + 512 + k] = z[1] * inv; sm[SM_HGLB + 1024 + k] = (z[1] + z[2]) * inv; sm[SM_HGLB + 1536 + k] = (z[1] + z[2] + z[3]) * inv; }
        if (F.wave < 4) { const int l = F.wave; const float* dl = A->in[7] + l * 256;
            const float s1 = wave_sum(dl[F.lane] * dl[64 + F.lane]), s2 = wave_sum(dl[128 + F.lane] * dl[192 + F.lane]);
            const float li = 0.8f - 0.6f * expf(-0.3f * (float)l);
            if (F.lane == 0) { sm[SM_LAM + l] = expf(s1) - expf(s2) + li; sm[SM_LAM + 4 + l] = 1.0f - li; } }
    }
}
__device__ __forceinline__ float mod_from_partials(ArgP A, int l, int b, int n) {
    const float* mp = (const float*)(A->ws + WS_MODP) + ((size_t)l * NB + b) * 6144 + n; float s = A->in[3][l * 6144 + n];
#pragma unroll
    for (int kp = 0; kp < 8; ++kp) s += mp[(size_t)kp * NL * NB * 6144];
    return s;
}
__device__ __forceinline__ void phase_mod_u0(const Frame& F, ArgP A) {
    float* mod = (float*)(A->ws + WS_MOD);
    for (int e = F.vcu * NTHR + F.tid; e < NL * NB * 6144; e += F.G * NTHR) { const int l = e / (NB * 6144), r = e % (NB * 6144); mod[e] = mod_from_partials(A, l, r / 6144, r % 6144); }
    bf16* U = (bf16*)(A->ws + WS_U);
    for (int rb = F.vcu; rb < M / 128; rb += F.G) { const int b = rb / 32;
        float sh[16], sc[16];
#pragma unroll
        for (int j = 0; j < 4; ++j)
#pragma unroll
            for (int i = 0; i < 4; ++i) { const int c = 4 * F.lane + 256 * j + i; sh[j * 4 + i] = mod_from_partials(A, 0, b, c); sc[j * 4 + i] = 1.0f + mod_from_partials(A, 0, b, 1024 + c); }
        for (int i = 0; i < 16; ++i) { const size_t row = (size_t)rb * 128 + F.wave * 16 + i;
            const f32x4* xr = (const f32x4*)(A->in[0] + row * DM) + F.lane; v2u* ur = (v2u*)(U + row * UP_) + F.lane;
#pragma unroll
            for (int j = 0; j < 4; ++j) { const f32x4 v = xr[64 * j]; const float u0 = v[0] * sc[j * 4 + 0] + sh[j * 4 + 0], u1 = v[1] * sc[j * 4 + 1] + sh[j * 4 + 1], u2_ = v[2] * sc[j * 4 + 2] + sh[j * 4 + 2], u3 = v[3] * sc[j * 4 + 3] + sh[j * 4 + 3];
                ((unsigned*)((char*)(U + row * UP_) + 2048) + F.lane)[64 * j] = cvt4_fp8(u0, u1, u2_, u3); } }
    }
}

constexpr int L1_WS = 2064;
constexpr int L1_WR = 0, L1_LG = 3 * 16 * L1_WS, L1_TE = L1_LG + 8192, L1_TB = L1_TE + 1024, L1_END = L1_TB + 64;
static_assert(L1_END <= RING_BYTES, "ln1 lds");
__device__ __forceinline__ void phase_ln1(const Frame& F, ArgP A, int l) {
    const float* mod = (const float*)(A->ws + WS_MOD);
    const bf16* MIX = (const bf16*)(A->ws + WS_MIX); bf16* U = (bf16*)(A->ws + WS_U);
    const float* xin = (l == 0) ? A->in[0] : A->out;
    LAS float* lgt = (LAS float*)(F.lds + L1_LG) + F.wave * 256;
    LAS int* te = (LAS int*)(F.lds + L1_TE); LAS int* tbase = (LAS int*)(F.lds + L1_TB);
    int* tokpos = (int*)(A->ws + WS_TOK); float* tokw = (float*)(A->ws + WS_TOK + (size_t)M * 8);
    __syncthreads();
    for (int idx = F.tid; idx < 16 * 1024; idx += NTHR) { const int k = idx >> 4, ex = idx & 15; const float w = A->in[26][idx];
        const unsigned h = f2bf(w); const float r1 = w - bf2f((unsigned short)h); const unsigned m = f2bf(r1); const float r2 = r1 - bf2f((unsigned short)m); const unsigned lo = f2bf(r2);
        *(LAS unsigned short*)(F.lds + L1_WR + (0 * 16 + ex) * L1_WS + k * 2) = (unsigned short)h; *(LAS unsigned short*)(F.lds + L1_WR + (1 * 16 + ex) * L1_WS + k * 2) = (unsigned short)m;
        *(LAS unsigned short*)(F.lds + L1_WR + (2 * 16 + ex) * L1_WS + k * 2) = (unsigned short)lo; }
    __syncthreads();
    for (int rb = F.vcu; rb < M / 128; rb += F.G) { const int b = rb / 32; const float* mb = mod + ((size_t)l * NB + b) * 6144;
        float g1[16], sh2[16], sc2[16], lg[16], lb[16];
#pragma unroll
        for (int j = 0; j < 4; ++j)
#pragma unroll
            for (int i = 0; i < 4; ++i) { const int c = 4 * F.lane + 256 * j + i, q = j * 4 + i; g1[q] = 1.0f + mb[2048 + c]; sh2[q] = mb[3072 + c]; sc2[q] = 1.0f + mb[4096 + c]; lg[q] = A->in[24][(l * 2 + 0) * DM + c]; lb[q] = A->in[25][(l * 2 + 0) * DM + c]; }
        const size_t rw0 = (size_t)rb * 128 + F.wave * 16;
#pragma unroll 1
        for (int i = 0; i < 16; ++i) { const size_t row = rw0 + i;
            const f32x4* xr = (const f32x4*)(xin + row * DM) + F.lane; const v2u* mr = (const v2u*)(MIX + row * DM) + F.lane;
            float y[16]; float s = 0.f;
#pragma unroll
            for (int j = 0; j < 4; ++j) { const f32x4 v = xr[64 * j]; const v2u m2 = mr[64 * j];
                y[j * 4 + 0] = ALPHA * v[0] + g1[j * 4 + 0] * bflo(m2.x); y[j * 4 + 1] = ALPHA * v[1] + g1[j * 4 + 1] * bfhi(m2.x);
                y[j * 4 + 2] = ALPHA * v[2] + g1[j * 4 + 2] * bflo(m2.y); y[j * 4 + 3] = ALPHA * v[3] + g1[j * 4 + 3] * bfhi(m2.y);
                s += (y[j * 4] + y[j * 4 + 1]) + (y[j * 4 + 2] + y[j * 4 + 3]); }
            const float mean = wave_sum(s) * (1.0f / DM); float q = 0.f;
#pragma unroll
            for (int k = 0; k < 16; ++k) { y[k] -= mean; q += y[k] * y[k]; }
            const float rstd = rsqrtf(wave_sum(q) * (1.0f / DM) + LN_EPS);
            f32x4* xo = (f32x4*)(A->out + row * DM) + F.lane; v2u* ur = (v2u*)(U + row * UP_) + F.lane;
#pragma unroll
            for (int j = 0; j < 4; ++j) { f32x4 o; float u2[4];
#pragma unroll
                for (int k = 0; k < 4; ++k) { o[k] = y[j * 4 + k] * rstd * lg[j * 4 + k] + lb[j * 4 + k]; u2[k] = o[k] * sc2[j * 4 + k] + sh2[j * 4 + k]; }
                xo[64 * j] = o; v2u w; w.x = pk2(u2[0], u2[1]); w.y = pk2(u2[2], u2[3]); ur[64 * j] = w; ((unsigned*)((char*)(U + row * UP_) + 2048) + F.lane)[64 * j] = cvt4_fp8(u2[0], u2[1], u2[2], u2[3]); }
        }
        VM_WAIT(); __syncthreads();
        {   const int r = F.lane & 15, g = F.lane >> 4; const bf16* up = U + (rw0 + r) * UP_ + 8 * g; const LAS unsigned char* wp = F.lds + L1_WR + r * L1_WS + 16 * g;
            f32x4 acc = (f32x4){0.f, 0.f, 0.f, 0.f};
#pragma unroll 16
            for (int ks = 0; ks < 32; ++ks) { const bf16x8 af = *(const bf16x8*)(up + 32 * ks);
#pragma unroll
                for (int tm = 0; tm < 3; ++tm) { const bf16x8 bfr = *(const LAS bf16x8*)(wp + tm * 16 * L1_WS + ks * 64); acc = __builtin_amdgcn_mfma_f32_16x16x32_bf16(af, bfr, acc, 0, 0, 0); } }
#pragma unroll
            for (int j = 0; j < 4; ++j) lgt[(4 * g + j) * 16 + r] = acc[j];
        }
        LDS_WAIT();
        if (F.lane < 16) { const int tl = F.wave * 16 + F.lane; const size_t row = rw0 + F.lane;
            float sc[16]; float mx = -1e30f;
#pragma unroll
            for (int q4 = 0; q4 < 4; ++q4) { const f32x4 v = *(const LAS f32x4*)(lgt + F.lane * 16 + 4 * q4); sc[4 * q4] = v[0]; sc[4 * q4 + 1] = v[1]; sc[4 * q4 + 2] = v[2]; sc[4 * q4 + 3] = v[3]; }
#pragma unroll
            for (int e = 0; e < 16; ++e) mx = fmaxf(mx, sc[e]);
            float den = 0.f;
#pragma unroll
            for (int e = 0; e < 16; ++e) { sc[e] = __expf(sc[e] - mx); den += sc[e]; }
            const float iden = 1.0f / den; float sel[16];
#pragma unroll
            for (int e = 0; e < 16; ++e) { sc[e] *= iden; sel[e] = sc[e] + A->in[27][e]; }
            int bg = 0; float bgs = -1e30f;
#pragma unroll
            for (int gq = 0; gq < 4; ++gq) { float m1 = -1e30f, m2 = -1e30f;
#pragma unroll
                for (int k = 0; k < 4; ++k) { const float v = sel[gq * 4 + k]; if (v > m1) { m2 = m1; m1 = v; } else if (v > m2) m2 = v; }
                const float gs = m1 + m2; if (gs > bgs) { bgs = gs; bg = gq; } }
            int i0 = 0, i1 = 0; float v0 = -1e30f, v1 = -1e30f, w0 = 0.f, w1 = 0.f;
#pragma unroll
            for (int e = 0; e < 16; ++e) { if ((e >> 2) == bg) { const float v = sel[e]; if (v > v0) { v1 = v0; i1 = i0; w1 = w0; v0 = v; i0 = e; w0 = sc[e]; } else if (v > v1) { v1 = v; i1 = e; w1 = sc[e]; } } }
            const float iw = 1.0f / (w0 + w1);
            te[tl * 2] = i0; te[tl * 2 + 1] = i1; tokw[row * 2] = w0 * iw; tokw[row * 2 + 1] = w1 * iw; }
        __syncthreads();
        if (F.wave == 0) { int my[4], rank[4] = {0, 0, 0, 0}; int tot = 0;
#pragma unroll
            for (int p = 0; p < 4; ++p) my[p] = te[64 * p + F.lane];
            const unsigned long long ltm = (1ull << F.lane) - 1ull;
#pragma unroll 1
            for (int e = 0; e < 16; ++e) { int acc = 0;
#pragma unroll
                for (int p = 0; p < 4; ++p) { const unsigned long long mk = __ballot(my[p] == e); if (my[p] == e) rank[p] = acc + __popcll(mk & ltm); acc += __popcll(mk); }
                if (F.lane == e) tot = acc; }
            int base = 0; if (F.lane < 16) base = (int)__hip_atomic_fetch_add(F.ctl + CW_ECNT + 1024 * l + 64 * F.lane, (unsigned)tot, RLX_AGENT);
            int* elist = (int*)(A->ws + WS_MODP);
#pragma unroll
            for (int p = 0; p < 4; ++p) { const int e = my[p], pos = __shfl(base, e) + rank[p], k = 64 * p + F.lane;
                tokpos[(size_t)rb * 256 + k] = (e << 24) | pos; elist[e * 32768 + pos] = (int)(((size_t)rb * 256 + k) >> 1); } }
        __syncthreads();
    }
}
__device__ __forceinline__ void load_hb(const Frame& F, int l, volatile LAS int* hb, int c) {
    __syncthreads();
    if (F.tid == 0) { int acc = 0, cnt[16]; for (int e = 0; e < 16; ++e) { hb[e] = acc; cnt[e] = (int)__hip_atomic_load(F.ctl + CW_ECNT + 1024 * l + 64 * e, RLX_AGENT); acc += (cnt[e] + 255) & ~255; } hb[16] = acc; hb[17] = acc >> 8;
        const int nun = (acc >> 8) * 4; int n = 0;
        for (int L = c; L < nun && n < 12; L += F.G) { const int j = L >> 2, pn = L & 3; int e = 0, ce = cnt[0]; for (int k = 1; k < 16; ++k) if (hb[k] <= j * 256) { e = k; ce = cnt[k]; }
            const int pos0 = j * 256 - hb[e]; int valid = ce - pos0; valid = valid > 256 ? 256 : valid;
            hb[19 + 2 * n] = (j << 8) | (pn << 4) | e; hb[20 + 2 * n] = (valid << 20) | (e * 32768 + pos0); ++n; }
        hb[18] = n;
        {   const int L = 1024 + (F.G - 1 - c); int vx = 0;
            if (F.G == 256 && L < nun) { const int j = L >> 2, pn = L & 3; int e = 0, ce = cnt[0]; for (int k = 1; k < 16; ++k) if (hb[k] <= j * 256) { e = k; ce = cnt[k]; }
                const int pos0 = j * 256 - hb[e]; int valid = ce - pos0; valid = valid > 256 ? 256 : valid;
                hb[43] = (j << 8) | (pn << 4) | e; hb[44] = (valid << 20) | (e * 32768 + pos0); vx = 1; }
            hb[45] = vx; } }
    __syncthreads();
}
__device__ __forceinline__ void phase_ln2(const Frame& F, ArgP A, int l) {
    const float* mod = (const float*)(A->ws + WS_MOD);
    const bf16* Y = (const bf16*)(A->ws + WS_Y); bf16* U = (bf16*)(A->ws + WS_U);
    const int* tokpos = (const int*)(A->ws + WS_TOK); const float* tokw = (const float*)(A->ws + WS_TOK + (size_t)M * 8);
    volatile LAS int* hb = (volatile LAS int*)(F.lds + LDSCTL_OFF + 128);
    load_hb(F, l, hb, 0);
    for (int rb = F.vcu; rb < M / 128; rb += F.G) { const int b = rb / 32; const float* mb = mod + ((size_t)l * NB + b) * 6144; const float* mn = mod + ((size_t)(l < NL - 1 ? l + 1 : l) * NB + b) * 6144;
        const size_t rw0 = (size_t)rb * 128 + F.wave * 16;
        int myr0 = 0, myr1 = 0; float myw0 = 0.f, myw1 = 0.f;
        if (F.lane < 16) { const int tp0 = tokpos[(rw0 + F.lane) * 2], tp1 = tokpos[(rw0 + F.lane) * 2 + 1]; myr0 = hb[tp0 >> 24] + (tp0 & 0xffffff); myr1 = hb[tp1 >> 24] + (tp1 & 0xffffff); myw0 = tokw[(rw0 + F.lane) * 2]; myw1 = tokw[(rw0 + F.lane) * 2 + 1]; }
        float g2[16], sh1[16], sc1[16], lg[16], lb[16];
#pragma unroll
        for (int j = 0; j < 4; ++j)
#pragma unroll
            for (int i = 0; i < 4; ++i) { const int c = 4 * F.lane + 256 * j + i, q = j * 4 + i; g2[q] = 1.0f + mb[5120 + c]; sh1[q] = mn[c]; sc1[q] = 1.0f + mn[1024 + c]; lg[q] = A->in[24][(l * 2 + 1) * DM + c]; lb[q] = A->in[25][(l * 2 + 1) * DM + c]; }
        f32x4 xv[4]; v2u ya[4], yc[4];
#define LN2_LOAD(i_) do { const int r0_ = __builtin_amdgcn_readlane(myr0, (i_)), r1_ = __builtin_amdgcn_readlane(myr1, (i_)); \
        const f32x4* xr_ = (const f32x4*)(A->out + (rw0 + (i_)) * DM) + F.lane; const v2u* y0_ = (const v2u*)(Y + (size_t)r0_ * DM) + F.lane; const v2u* y1_ = (const v2u*)(Y + (size_t)r1_ * DM) + F.lane; \
        _Pragma("unroll") for (int j_ = 0; j_ < 4; ++j_) { xv[j_] = xr_[64 * j_]; ya[j_] = y0_[64 * j_]; yc[j_] = y1_[64 * j_]; } } while (0)
        LN2_LOAD(0);
#pragma unroll
        for (int i = 0; i < 16; ++i) { const size_t row = rw0 + i;
            const float w0 = __builtin_bit_cast(float, __builtin_amdgcn_readlane(__builtin_bit_cast(int, myw0), i)), w1 = __builtin_bit_cast(float, __builtin_amdgcn_readlane(__builtin_bit_cast(int, myw1), i));
            float y[16]; float s = 0.f;
#pragma unroll
            for (int j = 0; j < 4; ++j) { const f32x4 v = xv[j]; const v2u a = ya[j], c = yc[j];
                y[j * 4 + 0] = ALPHA * v[0] + g2[j * 4 + 0] * (w0 * bflo(a.x) + w1 * bflo(c.x)); y[j * 4 + 1] = ALPHA * v[1] + g2[j * 4 + 1] * (w0 * bfhi(a.x) + w1 * bfhi(c.x));
                y[j * 4 + 2] = ALPHA * v[2] + g2[j * 4 + 2] * (w0 * bflo(a.y) + w1 * bflo(c.y)); y[j * 4 + 3] = ALPHA * v[3] + g2[j * 4 + 3] * (w0 * bfhi(a.y) + w1 * bfhi(c.y));
                s += (y[j * 4] + y[j * 4 + 1]) + (y[j * 4 + 2] + y[j * 4 + 3]); }
            if (i < 15) LN2_LOAD(i + 1);
            const float mean = wave_sum(s) * (1.0f / DM); float q = 0.f;
#pragma unroll
            for (int k = 0; k < 16; ++k) { y[k] -= mean; q += y[k] * y[k]; }
            const float rstd = rsqrtf(wave_sum(q) * (1.0f / DM) + LN_EPS);
            f32x4* xo = (f32x4*)(A->out + row * DM) + F.lane; v2u* ur = (v2u*)(U + row * UP_) + F.lane;
#pragma unroll
            for (int j = 0; j < 4; ++j) { f32x4 o; float u[4];
#pragma unroll
                for (int k = 0; k < 4; ++k) { o[k] = y[j * 4 + k] * rstd * lg[j * 4 + k] + lb[j * 4 + k]; u[k] = o[k] * sc1[j * 4 + k] + sh1[j * 4 + k]; }
                xo[64 * j] = o; if (l < NL - 1) ((unsigned*)((char*)(U + row * UP_) + 2048) + F.lane)[64 * j] = cvt4_fp8(u[0], u[1], u[2], u[3]); }
        }
#undef LN2_LOAD
    }
}
struct SchedGates {
    static constexpr unsigned LDA = UP_ * 2, LDB = 2048; static constexpr int NT = 8; static constexpr bool VARNT = false; static constexpr bool HASF8 = true;
    const char* U; const char* W; const char* WM; int G, c;
    __device__ __forceinline__ bool next(int i, pg8::GUnit& u, pg8::GOps& o) const { int pm, q; if (!pg8::static_tile(M / 256, 21 + 12 - NLATE, G, c, i, pm, q)) return false;
        o.A = U + (size_t)pm * 256 * LDA + 2048; u.r0 = pm * 256;
        if (q < 21) { const int pn = q;
            o.B = W + (size_t)pn * 256 * 2048; u.kind = (pn >= 8 && pn < 12) ? 4 : 0; u.c0 = pn * 256; u.aux = (pn == 8 || pn == 9) ? 2 : 1; }
        else { const int pn = q - 21; o.B = WM + (size_t)pn * 256 * 2048; u.kind = 1; u.c0 = INW + pn * 256; u.aux = 0; }
        return true; }
};
struct SchedGateLate {
    static constexpr unsigned LDA = UP_ * 2, LDB = 2048; static constexpr int NT = 8; static constexpr bool VARNT = false; static constexpr bool HASF8 = true;
    const char* U; const char* WM; int r;
    __device__ __forceinline__ bool next(int i, pg8::GUnit& u, pg8::GOps& o) const { const int idx = r + 160 * i; if (idx >= 128 * NLATE) return false; const int pm = idx & 127, pn = 12 - NLATE + (idx >> 7);
        o.A = U + (size_t)pm * 256 * LDA + 2048; o.B = WM + (size_t)pn * 256 * 2048; u.kind = 1; u.r0 = pm * 256; u.c0 = INW + pn * 256; u.aux = 0; return true; }
};
struct SchedBranch1 {
    static constexpr unsigned LDA = 3072, LDB = 3072; static constexpr int NT = 12; static constexpr bool VARNT = false; static constexpr bool HASF8 = true;
    const char* OC; const char* WB; int pm, pn;
    __device__ __forceinline__ bool next(int i, pg8::GUnit& u, pg8::GOps& o) const { if (i > 0) return false;
        u.r0 = pm * 256; u.c0 = pn * 256; o.A = OC + (size_t)pm * 256 * 3072; o.B = WB + (size_t)pn * 256 * 3072; u.kind = 2; u.aux = 0; return true; }
};
struct SchedOut1 {
    static constexpr unsigned LDA = 2048, LDB = 2048; static constexpr int NT = 8; static constexpr bool VARNT = false; static constexpr bool HASF8 = true;
    const char* Am; const char* W; int pm, pn;
    __device__ __forceinline__ bool next(int i, pg8::GUnit& u, pg8::GOps& o) const { if (i > 0) return false;
        o.A = Am + (size_t)pm * 256 * 2048; o.B = W + (size_t)pn * 256 * 2048; u.kind = 0; u.r0 = pm * 256; u.c0 = pn * 256; u.aux = 1; return true; }
};
struct SchedOut {
    static constexpr unsigned LDA = 2048, LDB = 2048; static constexpr int NT = 16; static constexpr bool VARNT = false; static constexpr bool HASF8 = false;
    const char* Am; const char* W; int G, c;
    __device__ __forceinline__ bool next(int i, pg8::GUnit& u, pg8::GOps& o) const { int pm, pn; if (!pg8::static_tile(M / 256, 4, G, c, i, pm, pn)) return false;
        o.A = Am + (size_t)pm * 256 * 2048; o.B = W + (size_t)pn * 256 * 2048; u.kind = 0; u.r0 = pm * 256; u.c0 = pn * 256; u.aux = 0; return true; }
};
template <int UP> struct SchedMoe {
    static constexpr unsigned LDA = UP ? UP_ * 2 : 1024, LDB = UP ? 2048 : 1024; static constexpr int NT = UP ? 8 : 4; static constexpr bool VARNT = false; static constexpr bool HASF8 = true;
    const char* Am; const char* W; volatile LAS int* hb; const int* elist; int i0, nn;
    __device__ __forceinline__ bool next(int ii, pg8::GUnit& u, pg8::GOps& o) const { if (ii >= nn) return false; const int i = i0 + ii;
        const int pk = __builtin_amdgcn_readfirstlane(hb[19 + 2 * i]); const int j = pk >> 8, pn = (pk >> 4) & 15, e = pk & 15;
        u.r0 = j * 256; u.aux = __builtin_amdgcn_readfirstlane(hb[20 + 2 * i]); u.kind = UP ? 3 : 0; u.c0 = UP ? pn * 128 : pn * 256;
        o.A = UP ? Am : Am + (size_t)j * 256 * LDA; o.B = W + ((size_t)e * 1024 + pn * 256) * LDB;
        return true; }
    __device__ __forceinline__ unsigned arow(const pg8::GUnit& u, int r) const { const int valid = u.aux >> 20; const int tok = (r < valid) ? elist[(u.aux & 0xfffff) + r] : 0; return (unsigned)tok * LDA; }
};

constexpr int NPH = 2 + 9 * NL;
#ifndef PH_MASK
#define PH_MASK 0xffff
#endif
#define PHM(b) ((PH_MASK >> (b)) & 1)
#ifndef RPT_MASK
#define RPT_MASK 0
#endif
#define RPT(b) (1 + ((RPT_MASK >> (b)) & 1))
#ifndef TPROBE
#define TPROBE (-1)
#endif
#define TP0(kind) unsigned long long tp0_ = 0; if (TPROBE == (kind)) tp0_ = __builtin_amdgcn_s_memrealtime()
#define TP1(kind) do { if (TPROBE == (kind)) tacc += __builtin_amdgcn_s_memrealtime() - tp0_; } while (0)
__global__ void __launch_bounds__(NTHR, 2) hybrid_fwd(Args args) {
    extern __shared__ __attribute__((aligned(16))) unsigned char lds[];
    Frame F; unsigned char* ws; ArgP A;
#define FRESH() do { int t_ = mk_tid(); asm volatile("" : "+v"(t_)); { unsigned long long p_ = (unsigned long long)__builtin_amdgcn_kernarg_segment_ptr(); asm volatile("" : "+s"(p_)); A = (ArgP)p_; } ws = A->ws; \
        F.lds = (LAS unsigned char*)lds; F.MISC = (volatile LAS unsigned*)(F.lds + MISC_OFF); F.tid = t_; F.lane = t_ & 63; F.wave = __builtin_amdgcn_readfirstlane(t_ >> 6); \
        { int g_ = gridDim.x, b_ = blockIdx.x; asm volatile("" : "+s"(g_), "+s"(b_)); F.G = g_; F.bx = b_; F.vcu = (g_ % 8 == 0) ? (b_ % 8) * (g_ / 8) + b_ / 8 : b_; } F.ctl = (gu32*)(ws + WS_CTL); } while (0)
    {
        const int t0_ = (int)threadIdx.x;
        for (int u = t0_; u < (LDS_BYTES - LDSCTL_OFF) / 4; u += NTHR) ((LAS unsigned*)((LAS unsigned char*)lds + LDSCTL_OFF))[u] = 0u;
        __syncthreads();
        if ((t0_ & 63) == 0) *(LAS int*)((LAS unsigned char*)lds + HWTAB_OFF + 4 * mk_hwslot()) = t0_ >> 6;
        __syncthreads(); }
    FRESH();
    XcdBarrier bar; bar.bar = (unsigned*)(ws + WS_CTL) + CW_BAR; bar.x = 0; bar.st = nullptr;
    if (!MK_PER_PHASE) bar = xcd_barrier_post((unsigned*)(ws + WS_CTL) + CW_BAR, F.MISC + 8);
    const int lo = A->ph_lo, hi = A->ph_hi; unsigned long long tacc = 0;
#define IN(k) (lo <= (k) && (k) < hi)
#define SEAM(k) do { if (IN(k) && IN((k) + 1)) xcd_barrier(bar); } while (0)

    if (PHM(0) && IN(0)) { TP0(0); FRESH(); phase_prologue(F, A); SEAM(0); TP1(0); }
    if (PHM(1) && IN(1)) { TP0(1); FRESH(); phase_mod_u0(F, A); SEAM(1); TP1(1); }

#pragma unroll 1
    for (int l = 0; l < NL; ++l) {
        const int pb = 2 + 9 * l;
        if (PHM(2) && IN(pb + 0)) { TP0(2);
            FRESH(); const char* WA = (const char*)(ws + WS_WA); const char* WE = (const char*)(ws + WS_WE); (void)WA; (void)WE;
            pg8::Epi<19> E{(bf16*)(ws + WS_PROJ), INW, C2Q, A->in[21] + (size_t)l * 3 * DM, (unsigned char*)(ws + WS_GATES), INW, (float*)(ws + WS_CTL) + CW_NRM, nullptr};
            {   SchedGates S{(const char*)(ws + WS_U), WA + WA_IN, WA + WA_MERGE, F.G, F.bx};
                pg8::Epi<19> E8 = E; E8.scale = 1.0f / WG8_SCALE; E8.scale2 = C2Q / WG8_SCALE;
                pg8::gemm_phase<false, false>(F.lds, S, E8); }
            SEAM(pb + 0); TP1(2);
        }
        if (IN(pb + 1)) { TP0(3); if (TPROBE >= 20 && TPROBE <= 23) tp0_ = __builtin_amdgcn_s_memrealtime();
            FRESH();
            const float* sm = (const float*)(ws + WS_SMALL);
            MixP P;
            P.proj = (const bf16*)(ws + WS_PROJ); P.ocat = (bf16*)(ws + WS_OCAT); P.oatt = (bf16*)(ws + WS_OATT);
            P.hg_lb = sm + SM_HGLB + l * 512; P.hg_norm_g = A->in[6] + l * 128; P.lamp = sm + SM_LAM + l; P.da_subln_g = A->in[8] + l * 128;
            P.rw_mu = A->in[9] + l * 1792; P.rw_w0 = A->in[10] + l * 512; P.rw_a0 = A->in[12] + l * 512; P.rw_k_k = A->in[15] + l * 512; P.rw_k_a = A->in[16] + l * 512;
            P.rw_r_k = A->in[17] + l * 512; P.rw_gn_g = A->in[18] + l * 512; P.rw_gn_b = A->in[19] + l * 512;
            const bf16* lo_ = (const bf16*)(ws + WS_LORA) + (size_t)l * 131072; P.wupT = lo_; P.aupT = lo_ + 32768; P.gupT = lo_ + 65536;
            P.aq = F.ctl + CW_AQ + 64 * l;
            P.nrm = F.ctl + CW_NRM;
            P.rdy = F.ctl + CW_RDY + 128 * l; P.ptot = F.ctl + CW_PTOT + 16 * l; P.rdr = F.ctl + CW_RDR + 128 * l; P.atot = F.ctl + CW_ATOT + 16 * l;
            P.act = (bf16*)(ws + WS_OCAT + WS_ACT_IN_OCAT); P.pre = F.ctl + CW_PRE + 8 * l;
            if (F.G >= 128) {
                if (PHM(3) && F.vcu < 64) { for (int rep = 0; rep < RPT(3); ++rep) { const unsigned long long rt_ = rwkv_unit(P, F.vcu >> 3, F.vcu & 7, F.lds); if (RWTIME) tacc += rt_; } }
                else if (PHM(4) && F.vcu < 96) { for (int rep = 0; rep < RPT(4); ++rep) hgrn_unit(P, (F.vcu - 64) >> 2, (F.vcu - 64) & 3, F.lds); }
                if ((TPROBE == 20 && F.vcu < 96) || (TPROBE == 22 && F.vcu < 64) || (TPROBE == 23 && F.vcu >= 64 && F.vcu < 96)) tacc += __builtin_amdgcn_s_memrealtime() - tp0_;
                if (F.vcu >= 96) {
                    const char* WA = (const char*)(ws + WS_WA);
                    SchedGateLate Sg{(const char*)(ws + WS_U), WA + WA_MERGE, F.vcu - 96};
                    pg8::Epi<66> Eg{(bf16*)(ws + WS_PROJ), INW, C2Q, A->in[21] + (size_t)l * 3 * DM, (unsigned char*)(ws + WS_GATES), INW, nullptr, nullptr};
                    pg8::gemm_phase<false, false>(F.lds, Sg, Eg);
                    if (F.tid == 0) { int n_ = 0; for (int i_ = 0; F.vcu - 96 + 160 * i_ < 128 * NLATE; ++i_) ++n_; (void)__hip_atomic_fetch_add(F.ctl + CW_GDN + 16 * l, (unsigned)n_, RLX_AGENT); }
                }
                __syncthreads();
                if (PHM(5)) { for (int rep = 0; rep < RPT(5); ++rep) { P.aq = F.ctl + CW_AQ + 64 * l + 32 * rep; attn_worker(P, (char*)lds, F.MISC + 16, F.tid); } }
                if (TPROBE == 21 && F.vcu >= 96) tacc += __builtin_amdgcn_s_memrealtime() - tp0_;
                if (PHM(6)) {
                    const char* WA = (const char*)(ws + WS_WA);
                    pg8::Epi<804> E{(bf16*)(ws + WS_MERGED), DM, 1.0f, nullptr, (unsigned char*)(ws + WS_GATES), 0, nullptr, nullptr};
                    gu32* mdn = F.ctl + CW_MDN + 128 * l;
                    gu32* bq = F.ctl + CW_AQ + 64 * l + 48; volatile LAS unsigned* bcast = F.MISC + 16;
                    for (;;) {
                        __syncthreads();
                        if (F.tid == 0) bcast[0] = __hip_atomic_fetch_add(bq, 1u, RLX_AGENT);
                        __syncthreads();
                        const unsigned idx = bcast[0];
                        if (idx >= 512u) break;
                        const int j = (int)(idx >> 5), b = (int)((idx >> 2) & 7u), pn = (int)(idx & 3u);
                        if (F.tid == 0) { gu32* rw = P.rdy + b * 16 + j; unsigned* barw = (unsigned*)(ws + WS_CTL) + CW_BAR; unsigned sp_ = 0;
                            while (__hip_atomic_load(rw, RLX_AGENT) < 8u || __hip_atomic_load(F.ctl + CW_GDN + 16 * l, RLX_AGENT) < (unsigned)(128 * NLATE)) {        __builtin_amdgcn_s_sleep(2);
                                if ((++sp_ & 255u) == 0u) { if (xb_ld(&barw[XB_TMO])) break; if (sp_ > XB_SPIN_CAP) { atomicAdd(&barw[XB_TMO], 1u); break; } } }
                            __builtin_amdgcn_fence(__ATOMIC_ACQUIRE, "agent");
                            asm volatile("s_waitcnt vmcnt(0)" ::: "memory"); }
                        __syncthreads();
                        SchedBranch1 S{(const char*)(ws + WS_OCAT), WA + WA_BRANCH, b * 16 + j, pn};
                        pg8::Epi<804> Et = E; Et.rwait = P.rdr + b * 16 + j;
                        pg8::gemm_phase<false, false>(F.lds, S, Et);
                        if (F.tid == 0) (void)__hip_atomic_fetch_add(mdn + b * 16 + j, 1u, RLX_AGENT);
                    }
                    if (PHM(7)) {
                        pg8::Epi<1> Eo{(bf16*)(ws + WS_MIX), DM, 1.0f / (WG8_SCALE * M8_SCALE), nullptr, nullptr, 0, nullptr, nullptr};
                        gu32* oq = F.ctl + CW_AQ + 64 * l + 56; gu32* atot = F.ctl + CW_ATOT + 16 * l;
                        for (;;) {
                            __syncthreads();
                            if (F.tid == 0) bcast[0] = __hip_atomic_fetch_add(oq, 1u, RLX_AGENT);
                            __syncthreads();
                            const unsigned idx = bcast[0];
                            if (idx >= 512u) break;
                            const int j = (int)(idx >> 5), b = (int)((idx >> 2) & 7u), pn = (int)(idx & 3u);
                            if (F.tid == 0) { unsigned* barw = (unsigned*)(ws + WS_CTL) + CW_BAR; unsigned sp_ = 0;
                                while (__hip_atomic_load(mdn + b * 16 + j, RLX_AGENT) < 4u || __hip_atomic_load(atot, RLX_AGENT) < 512u) { __builtin_amdgcn_s_sleep(2);
                                    if ((++sp_ & 255u) == 0u) { if (xb_ld(&barw[XB_TMO])) break; if (sp_ > XB_SPIN_CAP) { atomicAdd(&barw[XB_TMO], 1u); break; } } }
                                __builtin_amdgcn_fence(__ATOMIC_ACQUIRE, "agent");
                                asm volatile("s_waitcnt vmcnt(0)" ::: "memory"); }
                            __syncthreads();
                            SchedOut1 So{(const char*)(ws + WS_MERGED), WA + WA_OUT, b * 16 + j, pn};
                            pg8::gemm_phase<false, false>(F.lds, So, Eo);
                        }
                    }
                }
            }
            SEAM(pb + 1); TP1(3);
        }
        if (PHM(8) && IN(pb + 4)) { TP0(8); FRESH(); phase_ln1(F, A, l); SEAM(pb + 4); TP1(8); }
        if (PHM(10) && IN(pb + 6)) { TP0(10);
            FRESH(); const char* WA = (const char*)(ws + WS_WA); const char* WE = (const char*)(ws + WS_WE); (void)WA; (void)WE;
            volatile LAS int* hb = (volatile LAS int*)(F.lds + LDSCTL_OFF + 128);
            load_hb(F, l, hb, F.bx);
            pg8::Epi<136> E1{(bf16*)(ws + WS_H), DE, 1.0f, nullptr, nullptr, 0, nullptr, nullptr};
            pg8::Epi<1> E2{(bf16*)(ws + WS_Y), DM, 1.0f / (WG8_SCALE * H8_SCALE), nullptr, nullptr, 0, nullptr, nullptr};
            const int nu = __builtin_amdgcn_readfirstlane(hb[18]);
            if (F.G == 256) {
                const int n4 = nu < 4 ? nu : 4, nun = __builtin_amdgcn_readfirstlane(hb[17]) * 4, t4 = nun < 1024 ? nun : 1024, t5 = nun - t4;
                gu32* c4 = F.ctl + CW_MOEC + 16 * l; gu32* c5 = c4 + 8; unsigned* barw = (unsigned*)(ws + WS_CTL) + CW_BAR;
#define MOE_PUBLISH(ctr, k) do { if (F.tid == 0) { __builtin_amdgcn_fence(__ATOMIC_RELEASE, "agent"); asm volatile("s_waitcnt vmcnt(0)" ::: "memory"); (void)__hip_atomic_fetch_add((ctr), (unsigned)(k), RLX_AGENT); } } while (0)
#define MOE_WAIT(ctr, tgt) do { if (F.tid == 0) { unsigned sp_ = 0; while (__hip_atomic_load((ctr), RLX_AGENT) < (unsigned)(tgt)) { __builtin_amdgcn_s_sleep(2); \
                        if ((++sp_ & 255u) == 0u) { if (xb_ld(&barw[XB_TMO])) break; if (sp_ > XB_SPIN_CAP) { atomicAdd(&barw[XB_TMO], 1u); break; } } } \
                        __builtin_amdgcn_fence(__ATOMIC_ACQUIRE, "agent"); asm volatile("s_waitcnt vmcnt(0)" ::: "memory"); } __syncthreads(); } while (0)
                {   SchedMoe<1> S{(const char*)(ws + WS_U) + 2048, WE + WE_GU, hb, (const int*)(ws + WS_MODP), 0, n4};
                    pg8::gemm_phase<false, true>(F.lds, S, E1); }
                MOE_PUBLISH(c4, n4);
                if (nu > 4) { SchedMoe<1> S{(const char*)(ws + WS_U) + 2048, WE + WE_GU, hb, (const int*)(ws + WS_MODP), 4, nu - 4};
                    pg8::gemm_phase<false, true>(F.lds, S, E1);
                    MOE_PUBLISH(c5, nu - 4); }
                if (PHM(11)) {
                    MOE_WAIT(c4, t4);
                    {   SchedMoe<0> S{(const char*)(ws + WS_H), WE + WE_DT, hb, nullptr, 0, n4};
                        pg8::gemm_phase<false, false>(F.lds, S, E2); }
                    if (__builtin_amdgcn_readfirstlane(hb[45])) {
                        MOE_WAIT(c5, t5);
                        SchedMoe<0> S{(const char*)(ws + WS_H), WE + WE_DT, hb, nullptr, 12, 1};
                        pg8::gemm_phase<false, false>(F.lds, S, E2); }
                }
#undef MOE_PUBLISH
#undef MOE_WAIT
            } else {
                {   SchedMoe<1> S{(const char*)(ws + WS_U) + 2048, WE + WE_GU, hb, (const int*)(ws + WS_MODP), 0, nu};
                    pg8::gemm_phase<false, true>(F.lds, S, E1); }
                xcd_barrier(bar);
                {   SchedMoe<0> S{(const char*)(ws + WS_H), WE + WE_DT, hb, nullptr, 0, nu};
                    pg8::gemm_phase<false, false>(F.lds, S, E2); }
            }
            SEAM(pb + 7); TP1(10);
        }
        if (PHM(12) && IN(pb + 8)) { TP0(12); FRESH(); if (l < NL - 1) conv_layer(F, A, l + 1); phase_ln2(F, A, l); SEAM(pb + 8); TP1(12); }
    }
    if (TPROBE >= 0 || RWTIME) { const unsigned long long te_ = __builtin_amdgcn_s_memrealtime(); while (__builtin_amdgcn_s_memrealtime() - te_ < tacc) __builtin_amdgcn_s_sleep(8); }
#undef IN
#undef SEAM
}

extern "C" void kernel_launch(void* const* d_in, const int* in_sizes, int n_in, void* d_out, int out_size, void* d_ws, size_t ws_size, hipStream_t stream) {
    static int grid = 0;
    if (grid == 0) {
        if (n_in != 31 || out_size != M * DM || ws_size < WS_END) { fprintf(stderr, "kernel_launch: unexpected shapes (n_in %d, out %d, ws %zu < %zu); nothing launched\n", n_in, out_size, ws_size, (size_t)WS_END); grid = -1; return; }
        int dev = 0, cus = 0, per_cu = 0;
        if (hipGetDevice(&dev) != hipSuccess || hipDeviceGetAttribute(&cus, hipDeviceAttributeMultiprocessorCount, dev) != hipSuccess) { grid = -1; return; }
        if (hipFuncSetAttribute((const void*)hybrid_fwd, hipFuncAttributeMaxDynamicSharedMemorySize, LDS_BYTES) != hipSuccess) { fprintf(stderr, "kernel_launch: hipFuncSetAttribute failed\n"); grid = -1; return; }
        if (hipOccupancyMaxActiveBlocksPerMultiprocessor(&per_cu, (const void*)hybrid_fwd, NTHR, LDS_BYTES) != hipSuccess || per_cu < 1) { fprintf(stderr, "kernel_launch: occupancy query reports %d\n", per_cu); }
        (void)hipGetLastError();
        grid = cus;
        if (grid > 256) grid = 256;
    }
    if (grid < 0) return;
    (void)hipMemsetAsync((char*)d_ws + WS_CTL, 0, CTL_ZERO_BYTES, stream);
    Args a{};
    for (int i = 0; i < 31; ++i) a.in[i] = (const float*)d_in[i];
    a.out = (float*)d_out; a.ws = (unsigned char*)d_ws;
#if MK_PER_PHASE
    for (int p = 0; p < NPH; ++p) { a.ph_lo = p; a.ph_hi = p + 1; hipLaunchKernelGGL(hybrid_fwd, dim3(grid), dim3(NTHR), LDS_BYTES, stream, a); }
#else
    a.ph_lo = 0; a.ph_hi = NPH; hipLaunchKernelGGL(hybrid_fwd, dim3(grid), dim3(NTHR), LDS_BYTES, stream, a);
#endif
}
```
